# Optimizing an MI355X kernel written in HIP

```python
import jax, jax.numpy as jnp
from jax import lax
import numpy as np

D_MODEL = 1024
BATCH = 8
SEQ = 4096
DEPTH = 2

GRID_W = 64
CTX_LEN = 256
D_MIX = D_MODEL
N_MIXERS = 4
W_GROUP = D_MIX // N_MIXERS
N_SUB = 4
D_SUB = W_GROUP // N_SUB
OFF_A_X = 0
OFF_A_G = W_GROUP
OFF_B = 2 * W_GROUP
OFF_C = 3 * W_GROUP
OFF_D = 4 * W_GROUP
D_IN = 6 * W_GROUP
RG_CONV = 4
RG_C = 8.0
POOL_WINDOWS = (2, 4, 8, 16)
CONF_KERNEL = 31
N_EXPERTS = 32
TOP_K = 4
D_FF = D_MODEL
SWIGLU_LIMIT = 7.0
SWIGLU_ALPHA = 1.702
MOE_BLOCK = 256
EPS = 1e-6

kernel_name = "hybrid_rglru_pool_fourier_conformer_moe_dit"


def rmsnorm(x, g):
    xf = x.astype(jnp.float32)
    y = xf * lax.rsqrt(jnp.mean(xf * xf, axis=-1, keepdims=True) + EPS)
    return (y * g.astype(jnp.float32)).astype(x.dtype)


def modulate(h, shift, scale):
    return h * (1 + scale) + shift


def pos_embed_2d(n_tokens, dtype):
    rows_n = n_tokens // GRID_W
    row = jnp.repeat(jnp.arange(rows_n), GRID_W).astype(jnp.float32)
    col = jnp.tile(jnp.arange(GRID_W), rows_n).astype(jnp.float32)
    q = D_MODEL // 4
    omega = 1.0 / (10000.0 ** (jnp.arange(q, dtype=jnp.float32) / q))

    def emb(p):
        ang = p[:, None] * omega[None, :]
        return jnp.concatenate([jnp.sin(ang), jnp.cos(ang)], axis=-1)

    return jnp.concatenate([emb(row), emb(col)], axis=-1).astype(dtype)


def depthwise_conv(x, w, b, pad):
    y = lax.conv_general_dilated(x, w[:, None, :].astype(x.dtype), window_strides=(1,), padding=[pad],
                                 dimension_numbers=('NWC', 'WIO', 'NWC'), feature_group_count=x.shape[-1])
    return y + b


def linear_scan(a, b, h0):
    b = b.at[:, 0].add(a[:, 0] * h0)

    def comb(l, r):
        return (l[0] * r[0], r[0] * l[1] + r[1])

    _, h = lax.associative_scan(comb, (a, b), axis=1)
    return h


def rglru_direction(xa, conv_w, conv_b, w_r, b_r, w_i, b_i, lam, h0):
    bn, L, _ = xa.shape
    xc = depthwise_conv(xa, conv_w, conv_b, (RG_CONV - 1, 0))
    xh = xc.reshape(bn, L, N_SUB, D_SUB)
    r = jax.nn.sigmoid(jnp.einsum('blhc,hcd->blhd', xh, w_r) + b_r).reshape(bn, L, W_GROUP)
    i = jax.nn.sigmoid(jnp.einsum('blhc,hcd->blhd', xh, w_i) + b_i).reshape(bn, L, W_GROUP)
    log_a = -RG_C * r.astype(jnp.float32) * jax.nn.softplus(-lam.astype(jnp.float32))
    a = jnp.exp(log_a)
    bterm = jnp.sqrt(-jnp.expm1(2.0 * log_a)) * (i * xc).astype(jnp.float32)
    h = linear_scan(a, bterm, h0)
    return h.astype(xa.dtype), h[:, -1]


def pool_mixer(xb, w_pool, b_pool, pool_scale):
    bn, L, _ = xb.shape
    xg = xb.reshape(bn, L, N_SUB, D_SUB)
    cs = jnp.concatenate([jnp.zeros((bn, 1, N_SUB, D_SUB), jnp.float32),
                          jnp.cumsum(xg.astype(jnp.float32), axis=1)], axis=1)
    t = jnp.arange(L)
    outs = []
    for g, w in enumerate(POOL_WINDOWS):
        lo = jnp.clip(t - w // 2, 0, L)
        hi = jnp.clip(t + w - w // 2, 0, L)
        s = cs[:, hi, g] - cs[:, lo, g]
        outs.append(s / (hi - lo).astype(jnp.float32)[None, :, None])
    pooled = jnp.stack(outs, axis=2).astype(xb.dtype) - xg
    y = jnp.einsum('blgc,gcd->blgd', pooled, w_pool) + b_pool
    return y.reshape(bn, L, W_GROUP) * pool_scale


def fourier_mixer(xc, w_four, b_four):
    bn, L, _ = xc.shape
    xg = xc.reshape(bn, L, N_SUB, D_SUB).astype(jnp.float32)
    f = jnp.fft.fft2(xg, axes=(1, 3), norm='ortho').real.astype(xc.dtype)
    y = jnp.einsum('blgc,gcd->blgd', f, w_four) + b_four
    return y.reshape(bn, L, W_GROUP)


def conformer_conv(xd, conv_w, conv_b, ln_g, ln_b, w_pw, b_pw):
    bn, L, _ = xd.shape
    v = xd[..., :W_GROUP] * jax.nn.sigmoid(xd[..., W_GROUP:])
    v = depthwise_conv(v, conv_w, conv_b, (CONF_KERNEL // 2, CONF_KERNEL // 2))
    vh = v.reshape(bn, L, N_SUB, D_SUB).astype(jnp.float32)
    mu = jnp.mean(vh, axis=-1, keepdims=True)
    var = jnp.mean(jnp.square(vh - mu), axis=-1, keepdims=True)
    vh = (vh - mu) * lax.rsqrt(var + EPS)
    v = (vh.reshape(bn, L, W_GROUP) * ln_g.astype(jnp.float32) + ln_b.astype(jnp.float32)).astype(xd.dtype)
    return jax.nn.silu(v) @ w_pw + b_pw


def token_mixers(u, h0_f, h0_b, w_in, b_in, conv_a_w, conv_a_b, w_rg_r, b_rg_r, w_rg_i, b_rg_i, rg_lambda,
                 w_pool, b_pool, pool_scale, w_four, b_four, conv_d_w, conv_d_b, ln_d_g, ln_d_b, w_pw, b_pw,
                 w_out, b_out):
    proj = u @ w_in + b_in
    xa = proj[..., OFF_A_X:OFF_A_G]
    ga = proj[..., OFF_A_G:OFF_B]
    xb = proj[..., OFF_B:OFF_C]
    xc = proj[..., OFF_C:OFF_D]
    xd = proj[..., OFF_D:]
    y_f, hf = rglru_direction(xa, conv_a_w[0], conv_a_b[0], w_rg_r[0], b_rg_r[0], w_rg_i[0], b_rg_i[0],
                              rg_lambda[0], h0_f)
    y_b, hb = rglru_direction(jnp.flip(xa, axis=1), conv_a_w[1], conv_a_b[1], w_rg_r[1], b_rg_r[1],
                              w_rg_i[1], b_rg_i[1], rg_lambda[1], h0_b)
    ya = (y_f + jnp.flip(y_b, axis=1)) * jax.nn.gelu(ga)
    yb = pool_mixer(xb, w_pool, b_pool, pool_scale)
    yc = fourier_mixer(xc, w_four, b_four)
    yd = conformer_conv(xd, conv_d_w, conv_d_b, ln_d_g, ln_d_b, w_pw, b_pw)
    y = jnp.concatenate([ya, yb, yc, yd], axis=-1) @ w_out + b_out
    return (y, hf, hb)


def moe(h, w_router, b_router, w_gu, b_gu, w_down, b_down):
    T, D = h.shape
    logits = (h @ w_router + b_router).astype(jnp.float32)
    top_vals, top_idx = lax.top_k(logits, TOP_K)
    gates = jax.nn.softmax(top_vals, axis=-1)
    A = T * TOP_K
    e_flat = top_idx.reshape(A)
    g_flat = gates.reshape(A)
    tok_flat = jnp.arange(A, dtype=jnp.int32) // TOP_K
    order = jnp.argsort(e_flat)
    e_s, tok_s, g_s = e_flat[order], tok_flat[order], g_flat[order]
    counts = jnp.bincount(e_flat, length=N_EXPERTS)
    padded = ((counts + MOE_BLOCK - 1) // MOE_BLOCK) * MOE_BLOCK
    start = jnp.cumsum(counts) - counts
    pend = jnp.cumsum(padded)
    pstart = pend - padded
    dest = pstart[e_s] + (jnp.arange(A, dtype=jnp.int32) - start[e_s])
    n_blocks = -(-A // MOE_BLOCK) + N_EXPERTS
    P = n_blocks * MOE_BLOCK
    xs = jnp.zeros((P, D), h.dtype).at[dest].set(h[tok_s])
    block_e = jnp.minimum(jnp.searchsorted(pend, jnp.arange(n_blocks) * MOE_BLOCK, side='right'),
                          N_EXPERTS - 1)

    def expert_block(args):
        xb, e = args
        gu = xb @ w_gu[e] + b_gu[e]
        gt = jnp.minimum(gu[:, :D_FF], SWIGLU_LIMIT)
        up = jnp.clip(gu[:, D_FF:], -SWIGLU_LIMIT, SWIGLU_LIMIT)
        act = (up + 1) * (gt * jax.nn.sigmoid(SWIGLU_ALPHA * gt))
        return act @ w_down[e] + b_down[e]

    ys = lax.map(expert_block, (xs.reshape(n_blocks, MOE_BLOCK, D), block_e)).reshape(P, D)
    return jnp.zeros((T, D), h.dtype).at[tok_s].add(ys[dest] * g_s[:, None].astype(h.dtype))


def setup_inputs(seed: int = 0) -> dict:
    key = jax.random.key(seed)
    keys = jax.random.split(key, 40)
    f32 = jnp.float32
    D = D_MODEL

    def nrm(i, shape, scale):
        return scale * jax.random.normal(keys[i], shape, f32)

    def gain(i, shape):
        return 1.0 + nrm(i, shape, 0.02)

    u = jax.random.uniform(keys[39], (DEPTH, 2, W_GROUP), f32, 0.9, 0.999)
    s = u ** (1.0 / RG_C)
    rg_lambda = jnp.log(s) - jnp.log1p(-s)
    return {
        "x": nrm(0, (BATCH, SEQ, D), 1.0),
        "c": nrm(1, (BATCH, D), 1.0),
        "ctx": nrm(2, (BATCH, CTX_LEN, D), 1.0),
        "c_ctx": nrm(3, (D,), 1.0),
        "w_mod": nrm(4, (DEPTH, D, 6 * D), 0.5 * D ** -0.5),
        "b_mod": nrm(5, (DEPTH, 6 * D), 0.01),
        "norm1_g": gain(6, (DEPTH, D)),
        "norm2_g": gain(7, (DEPTH, D)),
        "w_in": nrm(8, (DEPTH, D, D_IN), D ** -0.5),
        "b_in": nrm(9, (DEPTH, D_IN), 0.01),
        "conv_a_w": nrm(10, (DEPTH, 2, RG_CONV, W_GROUP), RG_CONV ** -0.5),
        "conv_a_b": nrm(11, (DEPTH, 2, W_GROUP), 0.01),
        "w_rg_r": nrm(12, (DEPTH, 2, N_SUB, D_SUB, D_SUB), D_SUB ** -0.5),
        "b_rg_r": nrm(13, (DEPTH, 2, N_SUB, D_SUB), 0.01),
        "w_rg_i": nrm(14, (DEPTH, 2, N_SUB, D_SUB, D_SUB), D_SUB ** -0.5),
        "b_rg_i": nrm(15, (DEPTH, 2, N_SUB, D_SUB), 0.01),
        "rg_lambda": rg_lambda,
        "w_pool": nrm(16, (DEPTH, N_SUB, D_SUB, D_SUB), D_SUB ** -0.5),
        "b_pool": nrm(17, (DEPTH, N_SUB, D_SUB), 0.01),
        "pool_scale": gain(18, (DEPTH, W_GROUP)),
        "w_four": nrm(19, (DEPTH, N_SUB, D_SUB, D_SUB), D_SUB ** -0.5),
        "b_four": nrm(20, (DEPTH, N_SUB, D_SUB), 0.01),
        "conv_d_w": nrm(21, (DEPTH, CONF_KERNEL, W_GROUP), CONF_KERNEL ** -0.5),
        "conv_d_b": nrm(22, (DEPTH, W_GROUP), 0.01),
        "ln_d_g": gain(23, (DEPTH, W_GROUP)),
        "ln_d_b": nrm(24, (DEPTH, W_GROUP), 0.01),
        "w_pw": nrm(25, (DEPTH, W_GROUP, W_GROUP), W_GROUP ** -0.5),
        "b_pw": nrm(26, (DEPTH, W_GROUP), 0.01),
        "w_out": nrm(27, (DEPTH, D_MIX, D), D_MIX ** -0.5),
        "b_out": nrm(28, (DEPTH, D), 0.01),
        "w_router": nrm(29, (DEPTH, D, N_EXPERTS), D ** -0.5),
        "b_router": nrm(30, (DEPTH, N_EXPERTS), 0.01),
        "w_gu": nrm(31, (DEPTH, N_EXPERTS, D, 2 * D_FF), D ** -0.5),
        "b_gu": nrm(32, (DEPTH, N_EXPERTS, 2 * D_FF), 0.01),
        "w_down": nrm(33, (DEPTH, N_EXPERTS, D_FF, D), D_FF ** -0.5),
        "b_down": nrm(34, (DEPTH, N_EXPERTS, D), 0.01),
        "final_norm_g": gain(35, (D,)),
    }


def reference(x, c, ctx, c_ctx, w_mod, b_mod, norm1_g, norm2_g, w_in, b_in, conv_a_w, conv_a_b, w_rg_r, b_rg_r,
              w_rg_i, b_rg_i, rg_lambda, w_pool, b_pool, pool_scale, w_four, b_four, conv_d_w, conv_d_b, ln_d_g,
              ln_d_b, w_pw, b_pw, w_out, b_out, w_router, b_router, w_gu, b_gu, w_down, b_down, final_norm_g):
    bn, L, D = x.shape
    Lc = ctx.shape[1]
    x = x + pos_embed_2d(L, x.dtype)[None]
    sc = jax.nn.silu(c)
    scc = jax.nn.silu(c_ctx)
    for l in range(DEPTH):
        last = l == DEPTH - 1
        mod = sc @ w_mod[l] + b_mod[l]
        mod_c = scc @ w_mod[l] + b_mod[l]
        sh1, sc1, g1, sh2, sc2, g2 = jnp.split(mod[:, None, :], 6, axis=-1)
        csh1, csc1, cg1, csh2, csc2, cg2 = jnp.split(mod_c, 6, axis=-1)
        mix_p = (w_in[l], b_in[l], conv_a_w[l], conv_a_b[l], w_rg_r[l], b_rg_r[l], w_rg_i[l], b_rg_i[l],
                 rg_lambda[l], w_pool[l], b_pool[l], pool_scale[l], w_four[l], b_four[l], conv_d_w[l],
                 conv_d_b[l], ln_d_g[l], ln_d_b[l], w_pw[l], b_pw[l], w_out[l], b_out[l])
        moe_p = (w_router[l], b_router[l], w_gu[l], b_gu[l], w_down[l], b_down[l])
        h0 = jnp.zeros((bn, W_GROUP), jnp.float32)
        u_ctx = modulate(rmsnorm(ctx, norm1_g[l]), csh1, csc1)
        y_ctx, hf, hb = token_mixers(u_ctx, h0, h0, *mix_p)
        u_x = modulate(rmsnorm(x, norm1_g[l]), sh1, sc1)
        y_x, _, _ = token_mixers(u_x, hf, hb, *mix_p)
        x = x + g1 * y_x
        h_x = modulate(rmsnorm(x, norm2_g[l]), sh2, sc2)
        if not last:
            ctx = ctx + cg1 * y_ctx
            h_c = modulate(rmsnorm(ctx, norm2_g[l]), csh2, csc2)
            y_all = moe(jnp.concatenate([h_c.reshape(-1, D), h_x.reshape(-1, D)], axis=0), *moe_p)
            ctx = ctx + cg2 * y_all[:bn * Lc].reshape(bn, Lc, D)
            x = x + g2 * y_all[bn * Lc:].reshape(bn, L, D)
        else:
            x = x + g2 * moe(h_x.reshape(-1, D), *moe_p).reshape(bn, L, D)
    return rmsnorm(x, final_norm_g)
```

```cpp
#include <hip/hip_runtime.h>
#include <cstdio>
#include <cstdint>

#ifndef MK_N_LAUNCHES
#define MK_N_LAUNCHES 0
#endif

#define LAS __attribute__((address_space(3)))
typedef unsigned short bf16_t;
typedef short bf16x8 __attribute__((ext_vector_type(8)));
typedef float f32x4 __attribute__((ext_vector_type(4)));
typedef float f32x2 __attribute__((ext_vector_type(2)));
typedef unsigned u32x4 __attribute__((ext_vector_type(4)));
typedef unsigned u32x2 __attribute__((ext_vector_type(2)));

constexpr int D = 1024, NB = 8, SEQ = 4096, LCX = 256, TL = NB * SEQ, TC = NB * LCX, TT = TL + TC;
constexpr int NPROJ = 1280;
constexpr int NE = 32, NCHUNK = 544;
constexpr int NTILE_MAX = 576;

constexpr size_t AL(size_t x) { return (x + 255) & ~(size_t)255; }
constexpr size_t CTL_BYTES = 65536;
constexpr size_t WS_CTL = 0;
constexpr size_t WS_MODV = WS_CTL + CTL_BYTES;
constexpr size_t WS_X = AL(WS_MODV + (size_t)2 * 9 * 6144 * 4);
constexpr size_t WS_U = AL(WS_X + (size_t)TT * D * 4);
constexpr size_t WS_PROJ = AL(WS_U + (size_t)TT * D * 2);
constexpr size_t WS_PQT = AL(WS_PROJ + (size_t)TT * NPROJ * 2);
constexpr size_t WS_PQC = AL(WS_PQT + (size_t)4096 * 4096 * 2);
constexpr size_t WS_UU = AL(WS_PQC + (size_t)2048 * 512 * 2);
constexpr size_t WS_VV = AL(WS_UU + (size_t)2304 * 2048 * 4);
constexpr size_t WS_YCX = AL(WS_VV + (size_t)2048 * 2048 * 4);
constexpr size_t WS_YCAT = AL(WS_YCX + (size_t)256 * 2048 * 4);
constexpr size_t WS_SUMM = AL(WS_YCAT + (size_t)TT * D * 2);
constexpr size_t WS_WINT = AL(WS_SUMM + (size_t)NCHUNK * 1024 * 4);
constexpr size_t WS_WFT = AL(WS_WINT + (size_t)2 * NPROJ * D * 2);
constexpr size_t WS_BIN = AL(WS_WFT + (size_t)2 * 512 * D * 2);
constexpr size_t WS_BF = AL(WS_BIN + (size_t)2 * NPROJ * 4);
constexpr size_t WS_WOUTT = AL(WS_BF + (size_t)2 * 512 * 4);
constexpr size_t WS_BOUT = AL(WS_WOUTT + (size_t)2 * D * D * 2);
constexpr size_t WS_WGUT = AL(WS_BOUT + (size_t)2 * D * 4);
constexpr size_t WS_WDT = AL(WS_WGUT + (size_t)2 * NE * 2048 * D * 2);
constexpr size_t WS_WRT = AL(WS_WDT + (size_t)2 * NE * D * D * 2);
constexpr size_t WS_WGT = AL(WS_WRT + (size_t)2 * 2 * NE * D * 2);
constexpr size_t WS_CMAT = AL(WS_WGT + (size_t)2 * 2 * 2 * 4 * 64 * 64 * 2);
constexpr size_t WS_SMAT = AL(WS_CMAT + (size_t)2304 * 4096 * 2);
constexpr size_t WS_DFTC = AL(WS_SMAT + (size_t)2048 * 4096 * 2);
constexpr size_t WS_RASG = AL(WS_DFTC + (size_t)256 * 512 * 2);
constexpr size_t WS_GATE = AL(WS_RASG + (size_t)NE * TT * 4);
constexpr size_t WS_ACT = AL(WS_GATE + (size_t)TT * 4 * 4);
constexpr size_t WS_YS = AL(WS_ACT + (size_t)NTILE_MAX * 256 * D * 2);
constexpr size_t WS_END = AL(WS_YS + (size_t)TT * 4 * D * 2);
constexpr int CW_COUNT = 4096;

constexpr int LDS_BYTES = 147456;
constexpr int LDS_BASE = 1024;

__device__ __forceinline__ unsigned cvt_pk_bf16(float lo, float hi) { unsigned r; asm("v_cvt_pk_bf16_f32 %0, %1, %2" : "=v"(r) : "v"(lo), "v"(hi)); return r; }
__device__ __forceinline__ bf16_t f2bf(float f) { return (bf16_t)(cvt_pk_bf16(f, 0.f) & 0xffffu); }
__device__ __forceinline__ float bf2f(bf16_t b) { return __uint_as_float(((unsigned)b) << 16); }
__device__ __forceinline__ float bflo(unsigned w) { return __uint_as_float(w << 16); }
__device__ __forceinline__ float bfhi(unsigned w) { return __uint_as_float(w & 0xffff0000u); }
__device__ __forceinline__ float sigmoidf_(float x) { return 1.0f / (1.0f + __expf(-x)); }
__device__ __forceinline__ int tid_() { int t = (int)threadIdx.x; asm volatile("" : "+v"(t)); return t; }
__device__ __forceinline__ float bperm(float v, int src) { return __int_as_float(__builtin_amdgcn_ds_bpermute(src << 2, __float_as_int(v))); }
__device__ __forceinline__ float wave_sum(float v, int lane) {
#pragma unroll
    for (int o = 32; o >= 1; o >>= 1) v += bperm(v, lane ^ o);
    return v;
}
__device__ __forceinline__ void unpack8(const u32x4 w, float (&f)[8]) { f[0] = bflo(w.x); f[1] = bfhi(w.x); f[2] = bflo(w.y); f[3] = bfhi(w.y); f[4] = bflo(w.z); f[5] = bfhi(w.z); f[6] = bflo(w.w); f[7] = bfhi(w.w); }
__device__ __forceinline__ u32x4 pack8(const float (&f)[8]) { u32x4 w; w.x = cvt_pk_bf16(f[0], f[1]); w.y = cvt_pk_bf16(f[2], f[3]); w.z = cvt_pk_bf16(f[4], f[5]); w.w = cvt_pk_bf16(f[6], f[7]); return w; }

#define XB_TMO      128
#define XB_XCNT(j)  (256  + 64 * (j))
#define XB_XSUB(j)  (1280 + 64 * (j))
#define XB_XGEN(j)  (2304 + 64 * (j))
#define XB_TOP      3328
#define XB_TOPGEN   3392
#define XCD_BAR_WORDS 3456
#define XB_SPIN_CAP (1u << 18)
__device__ __forceinline__ unsigned xb_ld(unsigned* p)              { return __hip_atomic_load(p, __ATOMIC_RELAXED, __HIP_MEMORY_SCOPE_AGENT); }
__device__ __forceinline__ unsigned xb_add(unsigned* p, unsigned v) { return __hip_atomic_fetch_add(p, v, __ATOMIC_RELAXED, __HIP_MEMORY_SCOPE_AGENT); }
__device__ __forceinline__ unsigned xb_xcc_id() { return (unsigned)__builtin_amdgcn_s_getreg((3 << 11) | 20) & 0xFu; }
#define XB_SPIN(cond, bar) do { unsigned _sp = 0; while (cond) { __builtin_amdgcn_s_sleep(1); \
    if ((++_sp & 255u) == 0u) { if (xb_ld(&(bar)[XB_TMO])) break; if (_sp > XB_SPIN_CAP) { atomicAdd(&(bar)[XB_TMO], 1u); break; } } } } while (0)
struct XcdBarrier { unsigned* bar; unsigned x; volatile LAS unsigned* st; };
__device__ __forceinline__ XcdBarrier xcd_barrier_post(unsigned* bar, volatile LAS unsigned* st) {
    XcdBarrier b; b.bar = bar; b.x = xb_xcc_id(); b.st = st;
    if (threadIdx.x == 0) (void)xb_add(&bar[XB_XCNT(b.x)], 1u);
    return b;
}
__device__ __forceinline__ void xcd_barrier_complete(unsigned* bar, unsigned x, unsigned& nloc, unsigned& nx) {
    const unsigned G = gridDim.x * gridDim.y * gridDim.z;
    unsigned sum, cnt, mine, sp = 0u;
    for (;;) {
        sum = 0u; cnt = 0u; mine = 0u;
#pragma unroll
        for (unsigned j = 0; j < 16; ++j) { const unsigned c = xb_ld(&bar[XB_XCNT(j)]); sum += c; cnt += (c > 0u) ? 1u : 0u; mine = (j == x) ? c : mine; }
        if (sum == G) break;
        __builtin_amdgcn_s_sleep(1);
        if ((++sp & 255u) == 0u) { if (xb_ld(&bar[XB_TMO])) break; if (sp > XB_SPIN_CAP) { atomicAdd(&bar[XB_TMO], 1u); break; } }
    }
    nloc = mine > 0u ? mine : 1u; nx = cnt > 0u ? cnt : 1u;
}
__device__ __forceinline__ void xcd_barrier(const XcdBarrier& b) {
    asm volatile("s_waitcnt vmcnt(0)" ::: "memory");
    __syncthreads();
    if (threadIdx.x == 0) {
        unsigned* bar = b.bar;
        __builtin_amdgcn_s_waitcnt(0);
        unsigned nloc = b.st[0], nx = b.st[1];
        if (nloc == 0u) { unsigned xo = b.x; asm volatile("" : "+s"(xo)); xcd_barrier_complete(bar, xo, nloc, nx); b.st[0] = nloc; b.st[1] = nx; }
        const unsigned old = xb_add(&bar[XB_XSUB(b.x)], 1u);
        const unsigned gen = old / nloc;
        if (old + 1u == (gen + 1u) * nloc) {
            __builtin_amdgcn_fence(__ATOMIC_RELEASE, "agent");
            asm volatile("s_waitcnt vmcnt(0)" ::: "memory");
            const unsigned og = xb_add(&bar[XB_TOP], 1u);
            const unsigned tg = og / nx;
            if (og + 1u == (tg + 1u) * nx) xb_add(&bar[XB_TOPGEN], 1u);
            else XB_SPIN(xb_ld(&bar[XB_TOPGEN]) == tg, bar);
            __builtin_amdgcn_fence(__ATOMIC_ACQUIRE, "agent");
            xb_add(&bar[XB_XGEN(b.x)], 1u);
            asm volatile("s_waitcnt vmcnt(0)" ::: "memory");
        } else {
            XB_SPIN(xb_ld(&bar[XB_XGEN(b.x)]) == gen, bar);
            __builtin_amdgcn_fence(__ATOMIC_ACQUIRE, "agent");
            asm volatile("s_waitcnt vmcnt(0)" ::: "memory");
        }
    }
    __syncthreads();
}

namespace g8 {
constexpr int BM = 256, BK = 64, HALF = 128, HTB = HALF * BK * 2, STAGE_BYTES = 8 * HTB;
__device__ __forceinline__ int lds_byte(int r, int c) { const int st = (r >> 4) * 2 + (c >> 5), rr = r & 15, cc = c & 31, ob = rr * 64 + cc * 2; return st * 1024 + (ob ^ (((ob >> 9) & 1) << 5)); }
__device__ __forceinline__ void stage_rc(int b, int& R, int& C) { const int st = b / 1024, sb = b % 1024, swz = sb ^ (((sb >> 9) & 1) << 5); R = (st >> 1) * 16 + swz / 64; C = (st & 1) * 32 + (swz % 64) / 2; }
__device__ __forceinline__ int perm32(int rho) { const int n = rho >> 4, i = rho & 15; return 8 * (i >> 2) + 4 * n + (i & 3); }

struct Unit { const char* a; const char* b; char* o; int kind, pm, pn, e; };

__device__ __forceinline__ int xcd_remap(int L, int nu) { const int q = nu / 8, r = nu % 8, xcd = L % 8, off = L / 8; return (xcd < r ? xcd * (q + 1) : r * (q + 1) + (xcd - r) * q) + off; }

template <class Epi, class Sched, bool GATHER>
__device__ __forceinline__ void gemm_phase(LAS unsigned char* lds, const int K, const Sched& S, const Epi& E) {
    const int tid = tid_(), wid = __builtin_amdgcn_readfirstlane(tid >> 6), lane = tid & 63, wr = wid >> 2, wc = wid & 3, fr = lane & 15, fq = lane >> 4;
    const int nt = K / BK;
    unsigned voffA[2], voffB[2];
#pragma unroll
    for (int i = 0; i < 2; ++i) { int R, C; stage_rc(tid * 16 + i * 8192, R, C); const int Rb = Epi::PERM ? ((R & ~31) + perm32(R & 31)) : R;
        voffA[i] = (unsigned)(R * K + C) * 2u; voffB[i] = (unsigned)(Rb * K + C) * 2u; }
    const size_t kstep = (size_t)(BK * 2);
    const size_t hstep = (size_t)HALF * K * 2;
    const unsigned ldsw = (unsigned)wid * 1024u;
    const int aoff = lds_byte(wr * 64 + fr, fq * 8), boff = lds_byte(wc * 32 + fr, fq * 8);
#define G8_SA(b, h) (((b) * 2 + (h)) * HTB)
#define G8_SB(b, h) ((4 + (b) * 2 + (h)) * HTB)
#define G8_ST2(bufoff, gbase, voff) do { _Pragma("unroll") for (int _i = 0; _i < 2; ++_i) \
        __builtin_amdgcn_global_load_lds((const unsigned*)((const char*)(gbase) + (voff)[_i]), (LAS unsigned*)(lds + (bufoff) + ldsw + _i * 8192), 16, 0, 0); } while (0)
#define G8_STA_CUR(bufoff, gbase, h) do { if constexpr (GATHER) { _Pragma("unroll") for (int _i = 0; _i < 2; ++_i) { const unsigned _o = ROFF[parA * 256 + (h) * 128 + (int)(rcq[_i] & 0xffffu)] + (rcq[_i] >> 16); \
        __builtin_amdgcn_global_load_lds((const unsigned*)((const char*)(gbase) + _o), (LAS unsigned*)(lds + (bufoff) + ldsw + _i * 8192), 16, 0, 0); } } else { G8_ST2(bufoff, (gbase) + (h) * hstep, voffA); } } while (0)
#define G8_LDA(dst, b, h) do { _Pragma("unroll") for (int m = 0; m < 4; ++m) _Pragma("unroll") for (int k = 0; k < 2; ++k) dst[m][k] = *(const LAS bf16x8*)(lds + G8_SA(b, h) + aoff + m * 2048 + k * 1024); } while (0)
#define G8_LDB(dst, b, h) do { _Pragma("unroll") for (int n = 0; n < 2; ++n) _Pragma("unroll") for (int k = 0; k < 2; ++k) dst[n][k] = *(const LAS bf16x8*)(lds + G8_SB(b, h) + boff + n * 2048 + k * 1024); } while (0)
#define G8_MMA(ai, bj, At, Bt) do { __builtin_amdgcn_s_setprio(1); _Pragma("unroll") for (int m = 0; m < 4; ++m) _Pragma("unroll") for (int n = 0; n < 2; ++n) _Pragma("unroll") for (int k = 0; k < 2; ++k) \
        acc[ai][bj][m][n] = __builtin_amdgcn_mfma_f32_16x16x32_bf16(Bt[n][k], At[m][k], acc[ai][bj][m][n], 0, 0, 0); __builtin_amdgcn_s_setprio(0); } while (0)
#define G8_WAIT_V(n) asm volatile("s_waitcnt vmcnt(" #n ")" ::: "memory")
#define G8_WAIT_L(n) asm volatile("s_waitcnt lgkmcnt(" #n ")" ::: "memory")
#define G8_BAR __builtin_amdgcn_s_barrier()
#define G8_SCHED __builtin_amdgcn_sched_barrier(0)
    Unit cur, nxt; int ui = 0;
    if (!S.next(0, cur)) return;
    f32x4 acc[2][2][4][2];
#pragma unroll
    for (int a = 0; a < 2; ++a)
#pragma unroll
        for (int b = 0; b < 2; ++b)
#pragma unroll
            for (int m = 0; m < 4; ++m)
#pragma unroll
                for (int n = 0; n < 2; ++n) acc[a][b][m][n] = (f32x4){0.f, 0.f, 0.f, 0.f};
    bf16x8 At[4][2], B0[2][2], B1[2][2];
    LAS unsigned* ROFF = (LAS unsigned*)(lds + STAGE_BYTES + 1024);
    unsigned rcq[2] = {0u, 0u}, pend = 0u; int parA = 0;
    if constexpr (GATHER) {
#pragma unroll
        for (int i = 0; i < 2; ++i) { int R, C; stage_rc(tid * 16 + i * 8192, R, C); rcq[i] = (unsigned)R | ((unsigned)(C * 2) << 16); }
        if (tid < 256) ROFF[tid] = (unsigned)S.row(cur, tid) * (unsigned)(K * 2);
        asm volatile("s_waitcnt lgkmcnt(0)" ::: "memory"); __builtin_amdgcn_s_barrier(); asm volatile("" ::: "memory");
    }
    const char* cA = cur.a; const char* cB = cur.b;
    G8_ST2(G8_SB(0, 0), cB, voffB); G8_ST2(G8_SB(0, 1), cB + hstep, voffB); G8_STA_CUR(G8_SA(0, 0), cA, 0); G8_STA_CUR(G8_SA(0, 1), cA, 1);
    if (wr == 1) G8_BAR;
    G8_WAIT_V(2); G8_BAR;
    G8_ST2(G8_SB(1, 0), cB + kstep, voffB); G8_STA_CUR(G8_SA(1, 0), cA + kstep, 0); G8_ST2(G8_SB(1, 1), cB + hstep + kstep, voffB);
    G8_WAIT_V(6); G8_BAR;
    for (;;) {
        const bool has_next = S.next(ui + 1, nxt);
        const char* nA = has_next ? nxt.a : cA; const char* nB = has_next ? nxt.b : cB;
        for (int t = 0; t < nt; t += 2) {
            const bool last = (t == nt - 2);
            const char* a1 = cA + (size_t)(t + 1) * kstep;
            const char* a2 = last ? nA : cA + (size_t)(t + 2) * kstep; const char* b2 = last ? nB : cB + (size_t)(t + 2) * kstep;
            const char* a3 = a2 + kstep; const char* b3 = b2 + kstep;
            if constexpr (GATHER) {
                if (has_next && t == nt - 4 && tid < 256) pend = (unsigned)S.row(nxt, tid) * (unsigned)(K * 2);
                if (has_next && last && tid < 256) ROFF[(parA ^ 1) * 256 + tid] = pend; }
            G8_LDB(B0, 0, 0); G8_LDB(B1, 0, 1); G8_SCHED; G8_LDA(At, 0, 0); G8_STA_CUR(G8_SA(1, 1), a1, 1);
            if constexpr (GATHER) { if (has_next && last) parA ^= 1; }
            G8_WAIT_V(8); G8_WAIT_L(0); G8_BAR; G8_MMA(0, 0, At, B0); G8_MMA(0, 1, At, B1); G8_BAR; G8_SCHED;
            G8_LDA(At, 0, 1); G8_ST2(G8_SB(0, 0), b2, voffB); G8_ST2(G8_SB(0, 1), b2 + hstep, voffB); G8_STA_CUR(G8_SA(0, 0), a2, 0);
            G8_WAIT_V(8); G8_WAIT_L(0); G8_BAR; G8_MMA(1, 0, At, B0); G8_MMA(1, 1, At, B1); G8_BAR; G8_SCHED;
            G8_LDB(B0, 1, 0); G8_LDB(B1, 1, 1); G8_SCHED; G8_LDA(At, 1, 0); G8_STA_CUR(G8_SA(0, 1), a2, 1);
            G8_WAIT_V(8); G8_WAIT_L(0); G8_BAR; G8_MMA(0, 0, At, B0); G8_MMA(0, 1, At, B1); G8_BAR; G8_SCHED;
            G8_LDA(At, 1, 1); G8_ST2(G8_SB(1, 0), b3, voffB); G8_ST2(G8_SB(1, 1), b3 + hstep, voffB); G8_STA_CUR(G8_SA(1, 0), a3, 0);
            G8_WAIT_V(8); G8_WAIT_L(0); G8_BAR; G8_MMA(1, 0, At, B0); G8_MMA(1, 1, At, B1); G8_BAR; G8_SCHED;
        }
        if (wr == 0) G8_BAR;
        E(acc, cur, wr, wc, fr, fq);
        if (!has_next) break;
#pragma unroll
        for (int a = 0; a < 2; ++a)
#pragma unroll
            for (int b = 0; b < 2; ++b)
#pragma unroll
                for (int m = 0; m < 4; ++m)
#pragma unroll
                    for (int n = 0; n < 2; ++n) acc[a][b][m][n] = (f32x4){0.f, 0.f, 0.f, 0.f};
        cur = nxt; cA = nA; cB = nB; ++ui;
        if (wr == 1) G8_BAR;
    }
    G8_WAIT_V(0);
    G8_BAR;
#undef G8_SA
#undef G8_SB
#undef G8_ST2
#undef G8_STA_CUR
#undef G8_LDA
#undef G8_LDB
#undef G8_MMA
#undef G8_WAIT_V
#undef G8_WAIT_L
#undef G8_BAR
#undef G8_SCHED
}
}

struct Params {
    const float *x, *c, *ctx, *c_ctx, *w_mod, *b_mod, *norm1_g, *norm2_g, *w_in, *b_in, *conv_a_w, *conv_a_b, *w_rg_r, *b_rg_r, *w_rg_i, *b_rg_i, *rg_lambda,
        *w_pool, *b_pool, *pool_scale, *w_four, *b_four, *conv_d_w, *conv_d_b, *ln_d_g, *ln_d_b, *w_pw, *b_pw, *w_out, *b_out, *w_router, *b_router,
        *w_gu, *b_gu, *w_down, *b_down, *final_norm_g;
    float* out; unsigned char* ws; int ph_lo, ph_hi;
};
typedef const Params __attribute__((address_space(4)))* CP;
__device__ __forceinline__ CP launder_params() { CP k = (CP)__builtin_amdgcn_kernarg_segment_ptr(); asm volatile("" : "+s"(k)); return k; }
__device__ __forceinline__ int row_mb(int row) { return row < TL ? (row >> 12) : 8; }

template <class RowMap>
__device__ __forceinline__ void tr_block(const float* __restrict__ src, int spitch, int k0, int n0, bf16_t* __restrict__ dst, int dpitch, int kd0, RowMap rm, LAS unsigned char* lds) {
    LAS unsigned* T = (LAS unsigned*)lds;
    const int tid = tid_();
    __syncthreads();
#pragma unroll
    for (int it = 0; it < 4; ++it) { const int task = it * 512 + tid, q = task & 63, kp = task >> 6;
        const f32x4 v0 = *(const f32x4*)(src + (size_t)(k0 + 2 * kp) * spitch + n0 + 4 * q), v1 = *(const f32x4*)(src + (size_t)(k0 + 2 * kp + 1) * spitch + n0 + 4 * q);
        u32x4 w; w.x = cvt_pk_bf16(v0[0], v1[0]); w.y = cvt_pk_bf16(v0[1], v1[1]); w.z = cvt_pk_bf16(v0[2], v1[2]); w.w = cvt_pk_bf16(v0[3], v1[3]);
        *(LAS u32x4*)(T + kp * 260 + 4 * q) = w; }
    __syncthreads();
#pragma unroll
    for (int it = 0; it < 4; ++it) { const int task = it * 512 + tid, n = task & 255, c = task >> 8;
        u32x4 w; w.x = T[(4 * c + 0) * 260 + n]; w.y = T[(4 * c + 1) * 260 + n]; w.z = T[(4 * c + 2) * 260 + n]; w.w = T[(4 * c + 3) * 260 + n];
        *(u32x4*)(dst + (size_t)rm(n0 + n) * dpitch + kd0 + 8 * c) = w; }
}
struct RmId { int off; __device__ __forceinline__ int operator()(int n) const { return n + off; } };
struct RmGu { __device__ __forceinline__ int operator()(int n) const { const int rem = n & 1023; return 256 * (rem >> 7) + 128 * (n >> 10) + (rem & 127); } };
struct RmIn { __device__ __forceinline__ int operator()(int n) const { return n < 512 ? n : n - 1024 + 768; } };

__device__ __forceinline__ void job_mod(CP p, int l, int cb, LAS unsigned char* lds) {
    LAS float* SC = (LAS float*)lds;
    LAS float* RED = (LAS float*)(lds + 49152);
    const int tid = tid_();
    __syncthreads();
    for (int i = tid; i < 9 * 1024; i += 512) { const int b = i >> 10, k = i & 1023; const float v = b < 8 ? p->c[b * 1024 + k] : p->c_ctx[k]; SC[k * 12 + b] = v * sigmoidf_(v); }
    __syncthreads();
    const int col = cb * 64 + (tid & 63), kg = tid >> 6;
    float acc[9];
#pragma unroll
    for (int b = 0; b < 9; ++b) acc[b] = 0.f;
    const float* wp = p->w_mod + (size_t)l * 1024 * 6144 + col;
#pragma unroll 8
    for (int kk = 0; kk < 128; ++kk) { const int k = kg * 128 + kk; const float w = wp[(size_t)k * 6144];
        const f32x4 s0 = *(const LAS f32x4*)(SC + k * 12), s1 = *(const LAS f32x4*)(SC + k * 12 + 4); const float s8 = SC[k * 12 + 8];
        acc[0] += s0[0] * w; acc[1] += s0[1] * w; acc[2] += s0[2] * w; acc[3] += s0[3] * w; acc[4] += s1[0] * w; acc[5] += s1[1] * w; acc[6] += s1[2] * w; acc[7] += s1[3] * w; acc[8] += s8 * w; }
#pragma unroll
    for (int b = 0; b < 9; ++b) RED[(kg * 9 + b) * 64 + (tid & 63)] = acc[b];
    __syncthreads();
    for (int i = tid; i < 9 * 64; i += 512) { const int b = i >> 6, cc = i & 63; float s = 0.f;
#pragma unroll
        for (int g = 0; g < 8; ++g) s += RED[(g * 9 + b) * 64 + cc];
        ((float*)(p->ws + WS_MODV))[(size_t)(l * 9 + b) * 6144 + cb * 64 + cc] = s + p->b_mod[l * 6144 + cb * 64 + cc]; }
}
__device__ __forceinline__ void job_fold_out(CP p, int l, int nb, LAS unsigned char* lds) {
    LAS float* WO = (LAS float*)lds;
    LAS float* PW = (LAS float*)(lds + 65536);
    const int tid = tid_(), lane = tid & 63, w = __builtin_amdgcn_readfirstlane(tid >> 6);
    __syncthreads();
#pragma unroll
    for (int it = 0; it < 8; ++it) { const int task = it * 512 + tid, j = task >> 4, q = task & 15;
        *(LAS f32x4*)(WO + j * 64 + 4 * q) = *(const f32x4*)(p->w_out + ((size_t)l * 1024 + 768 + j) * 1024 + nb * 64 + 4 * q); }
    float acc[32];
#pragma unroll
    for (int i = 0; i < 32; ++i) acc[i] = 0.f;
    for (int jc = 0; jc < 4; ++jc) {
        __syncthreads();
#pragma unroll
        for (int it = 0; it < 8; ++it) { const int task = it * 512 + tid, i = task & 255, jq = task >> 8;
            const f32x4 v = *(const f32x4*)(p->w_pw + ((size_t)l * 256 + i) * 256 + jc * 64 + 4 * jq);
            PW[(4 * jq + 0) * 256 + i] = v[0]; PW[(4 * jq + 1) * 256 + i] = v[1]; PW[(4 * jq + 2) * 256 + i] = v[2]; PW[(4 * jq + 3) * 256 + i] = v[3]; }
        __syncthreads();
        for (int jj = 0; jj < 64; ++jj) { const float b = WO[(jc * 64 + jj) * 64 + lane];
#pragma unroll
            for (int i4 = 0; i4 < 8; ++i4) { const f32x4 a = *(const LAS f32x4*)(PW + jj * 256 + 32 * w + 4 * i4);
                acc[4 * i4 + 0] += a[0] * b; acc[4 * i4 + 1] += a[1] * b; acc[4 * i4 + 2] += a[2] * b; acc[4 * i4 + 3] += a[3] * b; } }
    }
    bf16_t* dst = (bf16_t*)(p->ws + WS_WOUTT) + ((size_t)l * 1024 + nb * 64 + lane) * 1024 + 768 + 32 * w;
#pragma unroll
    for (int c = 0; c < 4; ++c) { float f[8];
#pragma unroll
        for (int e = 0; e < 8; ++e) f[e] = acc[8 * c + e];
        *(u32x4*)(dst + 8 * c) = pack8(f); }
    if (w == 0) { float s = p->b_out[l * 1024 + nb * 64 + lane];
        for (int j = 0; j < 256; ++j) s += p->b_pw[l * 256 + j] * WO[j * 64 + lane];
        ((float*)(p->ws + WS_BOUT))[l * 1024 + nb * 64 + lane] = s; }
}
__device__ __forceinline__ void job_fold_in(CP p, int l, int f, int g, int kb, LAS unsigned char* lds) {
    LAS float* M = (LAS float*)lds;
    LAS float* WI = (LAS float*)(lds + 16384);
    const int tid = tid_();
    const int cbase = f == 0 ? 512 : 768;
    __syncthreads();
#pragma unroll
    for (int it = 0; it < 8; ++it) { const int id = it * 512 + tid, i = id >> 6, j = id & 63; float s;
        if (f == 0) s = p->w_pool[(((size_t)l * 4 + g) * 64 + i) * 64 + j];
        else { s = 0.f; for (int m = 0; m < 64; ++m) { const float ang = (float)((i * m) & 63) * (1.0f / 32.0f); const float tr = f == 1 ? cospif(ang) : sinpif(ang);
                   s += tr * p->w_four[(((size_t)l * 4 + g) * 64 + m) * 64 + j]; } }
        M[i * 64 + j] = s; }
#pragma unroll
    for (int it = 0; it < 8; ++it) { const int task = it * 512 + tid, kk = task >> 4, i4 = task & 15;
        const f32x4 v = *(const f32x4*)(p->w_in + ((size_t)l * 1024 + kb * 256 + kk) * 1536 + cbase + 64 * g + 4 * i4);
        WI[kk * 65 + 4 * i4 + 0] = v[0]; WI[kk * 65 + 4 * i4 + 1] = v[1]; WI[kk * 65 + 4 * i4 + 2] = v[2]; WI[kk * 65 + 4 * i4 + 3] = v[3]; }
    __syncthreads();
    const int kk = tid & 255, jh = tid >> 8;
    float acc[32];
#pragma unroll
    for (int j = 0; j < 32; ++j) acc[j] = 0.f;
    for (int i = 0; i < 64; ++i) { const float a = WI[kk * 65 + i];
#pragma unroll
        for (int j4 = 0; j4 < 8; ++j4) { const f32x4 m = *(const LAS f32x4*)(M + i * 64 + 32 * jh + 4 * j4);
            acc[4 * j4 + 0] += a * m[0]; acc[4 * j4 + 1] += a * m[1]; acc[4 * j4 + 2] += a * m[2]; acc[4 * j4 + 3] += a * m[3]; } }
    bf16_t* dst = f == 0 ? (bf16_t*)(p->ws + WS_WINT) + ((size_t)l * NPROJ + 512 + 64 * g) * 1024 : (bf16_t*)(p->ws + WS_WFT) + ((size_t)l * 512 + (f - 1) * 256 + 64 * g) * 1024;
#pragma unroll
    for (int j = 0; j < 32; ++j) dst[(size_t)(32 * jh + j) * 1024 + kb * 256 + kk] = f2bf(acc[j]);
    if (kb == 0 && f >= 1 && tid < 64) { float s = 0.f;
        for (int i = 0; i < 64; ++i) s += p->b_in[l * 1536 + 768 + 64 * g + i] * M[i * 64 + tid];
        ((float*)(p->ws + WS_BF))[l * 512 + (f - 1) * 256 + 64 * g + tid] = s; }
    if (kb == 0 && f == 0 && g == 0) for (int i = tid; i < NPROJ; i += 512)
        ((float*)(p->ws + WS_BIN))[l * NPROJ + i] = i < 512 ? p->b_in[l * 1536 + i] : (i < 768 ? 0.f : p->b_in[l * 1536 + i - 768 + 1024]);
}
__device__ __forceinline__ void job_small(CP p, int j) {
    const int tid = tid_();
    if (j < 32) {
        const int l = j >> 4, d = (j >> 3) & 1, gate = (j >> 2) & 1, hd = j & 3;
        const float* src = (gate ? p->w_rg_i : p->w_rg_r) + ((size_t)((l * 2 + d) * 4 + hd)) * 4096;
        bf16_t* dst = (bf16_t*)(p->ws + WS_WGT) + (size_t)j * 4096;
        for (int id = tid; id < 4096; id += 512) { const int n = id >> 6, k = id & 63; dst[id] = f2bf(src[k * 64 + n]); }
        return; }
    j -= 32;
    if (j < 2) {
        const int l = j; bf16_t* hi = (bf16_t*)(p->ws + WS_WRT) + (size_t)l * 2 * NE * 1024; bf16_t* lo = hi + NE * 1024;
        for (int id = tid; id < NE * 1024; id += 512) { const int e = id >> 10, c = id & 1023; const float v = p->w_router[((size_t)l * 1024 + c) * NE + e];
            const bf16_t h = f2bf(v); hi[id] = h; lo[id] = f2bf(v - bf2f(h)); }
        return; }
    j -= 2;
    if (j < 144 + 128) {
        const bool sn = j >= 144; const int r0 = (sn ? j - 144 : j) * 16; bf16_t* dst = (bf16_t*)(p->ws + (sn ? WS_SMAT : WS_CMAT));
        for (int id = tid; id < 16 * 4096; id += 512) { const int k = r0 + (id >> 12), t = id & 4095; const float ang = (float)((k * t) & 4095) * (1.0f / 2048.0f);
            dst[(size_t)k * 4096 + t] = f2bf(sn ? sinpif(ang) : cospif(ang)); }
        return; }
    j -= 272;
    {
        bf16_t* dst = (bf16_t*)(p->ws + WS_DFTC);
        for (int id = tid; id < 256 * 512; id += 512) { const int k = id >> 9, jj = id & 511, t = jj & 255; const float ang = (float)((k * t) & 255) * (1.0f / 128.0f);
            dst[id] = f2bf(jj < 256 ? cospif(ang) : -sinpif(ang)); }
    }
}
constexpr int J_MOD = 192, J_FOUT = 32, J_FIN = 96, J_SMALL = 32 + 2 + 272 + 1, J_TIN = 128, J_TOUT = 96, J_TGU = 8192, J_TD = 4096;
constexpr int J_TOTAL = J_MOD + J_FOUT + J_FIN + J_SMALL + J_TIN + J_TOUT + J_TGU + J_TD;
__device__ __forceinline__ void phase_prologue(CP p, LAS unsigned char* lds) {
    for (int job = blockIdx.x; job < J_TOTAL; job += gridDim.x) {
        int j = job;
        if (j < J_MOD) { job_mod(p, j / 96, j % 96, lds); continue; } j -= J_MOD;
        if (j < J_FOUT) { job_fold_out(p, j >> 4, j & 15, lds); continue; } j -= J_FOUT;
        if (j < J_FIN) { const int l = j / 48, r = j % 48; job_fold_in(p, l, r / 16, (r >> 2) & 3, r & 3, lds); continue; } j -= J_FIN;
        if (j < J_SMALL) { job_small(p, j); continue; } j -= J_SMALL;
        if (j < J_TIN) { const int l = j >> 6, r = j & 63, kb = r >> 2, q = r & 3;
            tr_block(p->w_in + (size_t)l * 1024 * 1536, 1536, kb * 64, q < 2 ? q * 256 : 1024 + (q - 2) * 256, (bf16_t*)(p->ws + WS_WINT) + (size_t)l * NPROJ * 1024, 1024, kb * 64, RmIn{}, lds); continue; } j -= J_TIN;
        if (j < J_TOUT) { const int l = j / 48, r = j % 48, kb = r >> 2, q = r & 3;
            tr_block(p->w_out + (size_t)l * 1024 * 1024, 1024, kb * 64, q * 256, (bf16_t*)(p->ws + WS_WOUTT) + (size_t)l * 1024 * 1024, 1024, kb * 64, RmId{0}, lds); continue; } j -= J_TOUT;
        if (j < J_TGU) { const int le = j >> 7, r = j & 127, kb = r >> 3, q = r & 7;
            tr_block(p->w_gu + (size_t)le * 1024 * 2048, 2048, kb * 64, q * 256, (bf16_t*)(p->ws + WS_WGUT) + (size_t)le * 2048 * 1024, 1024, kb * 64, RmGu{}, lds); continue; } j -= J_TGU;
        { const int le = j >> 6, r = j & 63, kb = r >> 2, q = r & 3;
            tr_block(p->w_down + (size_t)le * 1024 * 1024, 1024, kb * 64, q * 256, (bf16_t*)(p->ws + WS_WDT) + (size_t)le * 1024 * 1024, 1024, kb * 64, RmId{0}, lds); }
    }
}

__device__ __forceinline__ void phase_norm(CP p, int mode) {
    const int tid = tid_(), lane = tid & 63, wid = tid >> 6;
    float* X = (float*)(p->ws + WS_X); bf16_t* U = (bf16_t*)(p->ws + WS_U); const bf16_t* YS = (const bf16_t*)(p->ws + WS_YS); const float* modv = (const float*)(p->ws + WS_MODV);
    float om[4];
#pragma unroll
    for (int i = 0; i < 4; ++i) om[i] = exp2f(-(float)(4 * lane + i) * (13.287712379549449f / 256.0f));
    const int nrows = mode == 2 ? TL : TT;
    const int lprev = mode == 2 ? 1 : 0, lcur = mode == 0 ? 0 : 1;
    for (int row = blockIdx.x * 8 + wid; row < nrows; row += gridDim.x * 8) {
        const int mb = row_mb(row);
        f32x4 v[4];
        if (mode == 0) {
            if (row < TL) { const int t = row & 4095; const float pr = (float)(t >> 6), pc = (float)(t & 63);
#pragma unroll
                for (int j = 0; j < 4; ++j) { v[j] = *(const f32x4*)(p->x + (size_t)row * D + 256 * j + 4 * lane);
#pragma unroll
                    for (int i = 0; i < 4; ++i) { const float a = (j < 2 ? pr : pc) * om[i]; v[j][i] += (j & 1) ? cosf(a) : sinf(a); } }
            } else {
#pragma unroll
                for (int j = 0; j < 4; ++j) v[j] = *(const f32x4*)(p->ctx + (size_t)(row - TL) * D + 256 * j + 4 * lane);
            }
        } else {
            const float* g2 = modv + (size_t)(lprev * 9 + mb) * 6144 + 5120;
#pragma unroll
            for (int j = 0; j < 4; ++j) { v[j] = *(const f32x4*)(X + (size_t)row * D + 256 * j + 4 * lane); f32x4 s = {0.f, 0.f, 0.f, 0.f};
#pragma unroll
                for (int k = 0; k < 4; ++k) { const u32x2 w = *(const u32x2*)(YS + ((size_t)row * 4 + k) * D + 256 * j + 4 * lane); s[0] += bflo(w.x); s[1] += bfhi(w.x); s[2] += bflo(w.y); s[3] += bfhi(w.y); }
                v[j] += *(const f32x4*)(g2 + 256 * j + 4 * lane) * s; }
        }
        float ss = 0.f;
#pragma unroll
        for (int j = 0; j < 4; ++j) ss += v[j][0] * v[j][0] + v[j][1] * v[j][1] + v[j][2] * v[j][2] + v[j][3] * v[j][3];
        ss = wave_sum(ss, lane);
        const float rstd = rsqrtf(ss * (1.0f / 1024.0f) + 1e-6f);
        if (mode == 2) {
#pragma unroll
            for (int j = 0; j < 4; ++j) *(f32x4*)(p->out + (size_t)row * D + 256 * j + 4 * lane) = v[j] * rstd * *(const f32x4*)(p->final_norm_g + 256 * j + 4 * lane);
        } else {
            const float* mv = modv + (size_t)(lcur * 9 + mb) * 6144;
#pragma unroll
            for (int j = 0; j < 4; ++j) { const int col = 256 * j + 4 * lane;
                *(f32x4*)(X + (size_t)row * D + col) = v[j];
                const f32x4 g = *(const f32x4*)(p->norm1_g + lcur * D + col), sc = *(const f32x4*)(mv + 1024 + col), sh = *(const f32x4*)(mv + col);
                const f32x4 u = v[j] * rstd * g * (sc + 1.0f) + sh;
                u32x2 w; w.x = cvt_pk_bf16(u[0], u[1]); w.y = cvt_pk_bf16(u[2], u[3]); *(u32x2*)(U + (size_t)row * D + col) = w; }
        }
    }
}

constexpr int HP = 2064;
__device__ __forceinline__ void phase_router(CP p, int l, LAS unsigned char* lds) {
    LAS unsigned char* HHI = lds; LAS unsigned char* HLO = lds + 32 * HP;
    LAS float* LG = (LAS float*)(lds + 64 * HP);
    LAS int* hist = (LAS int*)(lds + 64 * HP + 8448); LAS int* basee = hist + 32;
    const int tid = tid_(), lane = tid & 63, wid = __builtin_amdgcn_readfirstlane(tid >> 6), fr = lane & 15, fq = lane >> 4;
    const float* X = (const float*)(p->ws + WS_X); bf16_t* U = (bf16_t*)(p->ws + WS_U); const float* modv = (const float*)(p->ws + WS_MODV);
    unsigned* ctl = (unsigned*)(p->ws + WS_CTL); int* rasg = (int*)(p->ws + WS_RASG); float* gate = (float*)(p->ws + WS_GATE);
    const bf16_t* wrt = (const bf16_t*)(p->ws + WS_WRT) + (size_t)l * 2 * NE * 1024;
    const int ntiles = (l == 0 ? TT : TL) / 32;
    for (int tile = blockIdx.x; tile < ntiles; tile += gridDim.x) {
        const int row0 = tile * 32, mb = row_mb(row0);
        const float* mv = modv + (size_t)(l * 9 + mb) * 6144;
        __syncthreads();
        if (tid < 32) hist[tid] = 0;
        for (int rr = 0; rr < 4; ++rr) { const int r = wid * 4 + rr, row = row0 + r;
            f32x4 v[4]; float ss = 0.f;
#pragma unroll
            for (int j = 0; j < 4; ++j) { v[j] = *(const f32x4*)(X + (size_t)row * D + 256 * j + 4 * lane); ss += v[j][0] * v[j][0] + v[j][1] * v[j][1] + v[j][2] * v[j][2] + v[j][3] * v[j][3]; }
            ss = wave_sum(ss, lane); const float rstd = rsqrtf(ss * (1.0f / 1024.0f) + 1e-6f);
#pragma unroll
            for (int j = 0; j < 4; ++j) { const int col = 256 * j + 4 * lane;
                const f32x4 g = *(const f32x4*)(p->norm2_g + l * D + col), sc = *(const f32x4*)(mv + 4096 + col), sh = *(const f32x4*)(mv + 3072 + col);
                const f32x4 h = v[j] * rstd * g * (sc + 1.0f) + sh;
                u32x2 w; w.x = cvt_pk_bf16(h[0], h[1]); w.y = cvt_pk_bf16(h[2], h[3]); *(u32x2*)(U + (size_t)row * D + col) = w;
                u32x2 wl; wl.x = cvt_pk_bf16(h[0] - bflo(w.x), h[1] - bfhi(w.x)); wl.y = cvt_pk_bf16(h[2] - bflo(w.y), h[3] - bfhi(w.y));
                *(LAS u32x2*)(HHI + r * HP + col * 2) = w; *(LAS u32x2*)(HLO + r * HP + col * 2) = wl; }
        }
        __syncthreads();
        { const int mt = wid & 1, ntl = (wid >> 1) & 1, kh = wid >> 2;
          f32x4 acc = {0.f, 0.f, 0.f, 0.f};
          const bf16_t* bh = wrt + (size_t)(16 * ntl + fr) * 1024 + kh * 512 + 8 * fq; const bf16_t* bl = bh + NE * 1024;
          const LAS unsigned char* ah = HHI + (16 * mt + fr) * HP + (kh * 512 + 8 * fq) * 2; const LAS unsigned char* al = HLO + (16 * mt + fr) * HP + (kh * 512 + 8 * fq) * 2;
#pragma unroll 4
          for (int s = 0; s < 16; ++s) { const bf16x8 Ah = *(const LAS bf16x8*)(ah + s * 64), Al = *(const LAS bf16x8*)(al + s * 64); const bf16x8 Bh = *(const bf16x8*)(bh + s * 32), Bl = *(const bf16x8*)(bl + s * 32);
              acc = __builtin_amdgcn_mfma_f32_16x16x32_bf16(Ah, Bh, acc, 0, 0, 0); acc = __builtin_amdgcn_mfma_f32_16x16x32_bf16(Ah, Bl, acc, 0, 0, 0); acc = __builtin_amdgcn_mfma_f32_16x16x32_bf16(Al, Bh, acc, 0, 0, 0); }
#pragma unroll
          for (int j = 0; j < 4; ++j) LG[(kh * 32 + 16 * mt + 4 * fq + j) * 33 + 16 * ntl + fr] = acc[j]; }
        __syncthreads();
        int ek[4] = {0, 0, 0, 0}, rk[4] = {0, 0, 0, 0}; float gk[4] = {0.f, 0.f, 0.f, 0.f};
        if (tid < 32) { float lg[32];
#pragma unroll
            for (int e = 0; e < 32; ++e) lg[e] = LG[tid * 33 + e] + LG[(32 + tid) * 33 + e] + p->b_router[l * NE + e];
            float vk[4];
#pragma unroll
            for (int k = 0; k < 4; ++k) { float best = -3.0e38f; int bi = 0;
#pragma unroll
                for (int e = 0; e < 32; ++e) if (lg[e] > best) { best = lg[e]; bi = e; }
                vk[k] = best; ek[k] = bi;
#pragma unroll
                for (int e = 0; e < 32; ++e) if (e == bi) lg[e] = -3.0e38f; }
            float sum = 0.f;
#pragma unroll
            for (int k = 0; k < 4; ++k) { gk[k] = __expf(vk[k] - vk[0]); sum += gk[k]; }
            const float inv = 1.0f / sum;
#pragma unroll
            for (int k = 0; k < 4; ++k) { gk[k] *= inv; rk[k] = __hip_atomic_fetch_add(hist + ek[k], 1, __ATOMIC_RELAXED, __HIP_MEMORY_SCOPE_WORKGROUP); } }
        __syncthreads();
        if (tid < 32) { const int h = hist[tid]; basee[tid] = h ? (int)__hip_atomic_fetch_add(ctl + CW_COUNT + (l * NE + tid) * 64, (unsigned)h, __ATOMIC_RELAXED, __HIP_MEMORY_SCOPE_AGENT) : 0; }
        __syncthreads();
        if (tid < 32) { const int tok = row0 + tid;
#pragma unroll
            for (int k = 0; k < 4; ++k) { rasg[(size_t)ek[k] * TT + basee[ek[k]] + rk[k]] = tok * 4 + k; gate[tok * 4 + k] = gk[k]; } }
    }
}

constexpr int XCP = 144;
template <int PASS>
__device__ __forceinline__ void scan_unit(CP p, int l, int q, LAS unsigned char* lds) {
    const int tid = tid_(), lane = tid & 63, wid = __builtin_amdgcn_readfirstlane(tid >> 6), d = wid >> 2, hd = wid & 3, fr = lane & 15, fq = lane >> 4;
    LAS unsigned char* XC = lds + wid * (64 * XCP);
    LAS float* CAR = (LAS float*)(lds + 8 * 64 * XCP + wid * 256);
    LAS unsigned char* HB = lds + 8 * 64 * XCP + 2048;
    const bf16_t* PROJ = (const bf16_t*)(p->ws + WS_PROJ); float* SUMM = (float*)(p->ws + WS_SUMM);
    const bool lat = q < 512; const int b = lat ? q >> 6 : (q - 512) >> 2, jc = lat ? q & 63 : (q - 512) & 3, L = lat ? SEQ : LCX, rowbase = lat ? b * SEQ : TL + b * LCX, t0 = jc * 64;
    __syncthreads();
    { const int c = 64 * hd + lane; const float* cw = p->conv_a_w + ((size_t)(l * 2 + d) * 4) * 256 + c;
      const float w0 = cw[0], w1 = cw[256], w2 = cw[512], w3 = cw[768], cb = p->conv_a_b[(l * 2 + d) * 256 + c];
      const float k0 = d ? w3 : w0, k1 = d ? w2 : w1, k2 = d ? w1 : w2, k3 = d ? w0 : w3;
      const int f0 = d ? t0 : t0 - 3;
      auto ld = [&](int tt) -> float { return (tt >= 0 && tt < L) ? bf2f(PROJ[(size_t)(rowbase + tt) * NPROJ + c]) : 0.f; };
      float xa_ = ld(f0), xb_ = ld(f0 + 1), xc_ = ld(f0 + 2);
#pragma unroll 8
      for (int t = 0; t < 64; ++t) { const float xd_ = ld(f0 + t + 3); const float v = k0 * xa_ + k1 * xb_ + k2 * xc_ + k3 * xd_ + cb;
          *(LAS bf16_t*)(XC + t * XCP + lane * 2) = f2bf(v); xa_ = xb_; xb_ = xc_; xc_ = xd_; } }
    asm volatile("" ::: "memory");
    if (PASS == 2) { const int c = 64 * hd + lane; float car = 0.f;
        auto step = [&](int qq) { const float* s = SUMM + ((size_t)qq * 2 + d) * 512; car = s[c] * car + s[256 + c]; };
        if (d == 0) { const int nc = lat ? 4 : jc; for (int j = 0; j < nc; ++j) step(512 + b * 4 + j); if (lat) for (int j = 0; j < jc; ++j) step(b * 64 + j); }
        else { const int lo = lat ? 0 : jc + 1; for (int j = 3; j >= lo; --j) step(512 + b * 4 + j); if (lat) for (int j = 63; j > jc; --j) step(b * 64 + j); }
        CAR[lane] = car; }
    float cr[4], at[4], sp[4], brr[4], bii[4];
#pragma unroll
    for (int n = 0; n < 4; ++n) { const int ch = 16 * n + fr; cr[n] = PASS == 2 ? CAR[ch] : 0.f; at[n] = 1.f;
        const float lam = p->rg_lambda[(l * 2 + d) * 256 + 64 * hd + ch]; sp[n] = log1pf(__expf(-lam));
        brr[n] = p->b_rg_r[((l * 2 + d) * 4 + hd) * 64 + ch]; bii[n] = p->b_rg_i[((l * 2 + d) * 4 + hd) * 64 + ch]; }
    const bf16_t* wg = (const bf16_t*)(p->ws + WS_WGT) + (size_t)((l * 2 + d) * 2) * 4 * 4096;
    const int src1 = d ? lane + 16 : lane - 16, src2 = d ? lane + 32 : lane - 32, srct = d ? fr : 48 + fr;
    const bool has1 = d ? fq <= 2 : fq >= 1, has2 = d ? fq <= 1 : fq >= 2;
    for (int n = 0; n < 4; ++n) {
        bf16x8 Br[2], Bi[2];
#pragma unroll
        for (int s = 0; s < 2; ++s) { Br[s] = *(const bf16x8*)(wg + ((size_t)(0 * 4 + hd) * 64 + 16 * n + fr) * 64 + 32 * s + 8 * fq); Bi[s] = *(const bf16x8*)(wg + ((size_t)(1 * 4 + hd) * 64 + 16 * n + fr) * 64 + 32 * s + 8 * fq); }
        for (int mi = 0; mi < 4; ++mi) { const int mt = d ? 3 - mi : mi;
            const bf16x8 A0 = *(const LAS bf16x8*)(XC + (16 * mt + fr) * XCP + (8 * fq) * 2), A1 = *(const LAS bf16x8*)(XC + (16 * mt + fr) * XCP + (32 + 8 * fq) * 2);
            f32x4 ar = {0.f, 0.f, 0.f, 0.f}, ai = {0.f, 0.f, 0.f, 0.f};
            ar = __builtin_amdgcn_mfma_f32_16x16x32_bf16(A0, Br[0], ar, 0, 0, 0); ar = __builtin_amdgcn_mfma_f32_16x16x32_bf16(A1, Br[1], ar, 0, 0, 0);
            ai = __builtin_amdgcn_mfma_f32_16x16x32_bf16(A0, Bi[0], ai, 0, 0, 0); ai = __builtin_amdgcn_mfma_f32_16x16x32_bf16(A1, Bi[1], ai, 0, 0, 0);
            float a_[4], b_[4];
#pragma unroll
            for (int j = 0; j < 4; ++j) { const int tok = 16 * mt + 4 * fq + j; const float xcv = bf2f(*(const LAS bf16_t*)(XC + tok * XCP + (16 * n + fr) * 2));
                const float r = sigmoidf_(ar[j] + brr[n]), ig = sigmoidf_(ai[j] + bii[n]); const float a = __expf(-8.0f * r * sp[n]);
                a_[j] = a; b_[j] = sqrtf(fmaxf(1.0f - a * a, 0.f)) * (ig * xcv); }
            float Hj[4], Aj[4];
            if (d == 0) { Hj[0] = b_[0]; Aj[0] = a_[0];
#pragma unroll
                for (int j = 1; j < 4; ++j) { Hj[j] = a_[j] * Hj[j - 1] + b_[j]; Aj[j] = a_[j] * Aj[j - 1]; } }
            else { Hj[3] = b_[3]; Aj[3] = a_[3];
#pragma unroll
                for (int j = 2; j >= 0; --j) { Hj[j] = a_[j] * Hj[j + 1] + b_[j]; Aj[j] = a_[j] * Aj[j + 1]; } }
            float iA = d ? Aj[0] : Aj[3], iH = d ? Hj[0] : Hj[3];
            { const float pA = bperm(iA, src1), pH = bperm(iH, src1); if (has1) { iH = iA * pH + iH; iA = iA * pA; } }
            { const float pA = bperm(iA, src2), pH = bperm(iH, src2); if (has2) { iH = iA * pH + iH; iA = iA * pA; } }
            float eA = bperm(iA, src1), eH = bperm(iH, src1); if (!has1) { eA = 1.f; eH = 0.f; }
            const float tA = bperm(iA, srct), tH = bperm(iH, srct);
            const float hin = eH + eA * cr[n];
            if (PASS == 2) {
#pragma unroll
                for (int j = 0; j < 4; ++j) { const int tok = 16 * mt + 4 * fq + j; *(LAS bf16_t*)(HB + ((d * 64 + tok) * 256 + 64 * hd + 16 * n + fr) * 2) = f2bf(Hj[j] + Aj[j] * hin); } }
            cr[n] = tH + tA * cr[n]; at[n] *= tA;
        }
    }
    if (PASS == 1) { if (fq == 0) {
#pragma unroll
            for (int n = 0; n < 4; ++n) { float* s = SUMM + ((size_t)q * 2 + d) * 512 + 64 * hd + 16 * n + fr; s[0] = at[n]; s[256] = cr[n]; } } }
    else {
        __syncthreads();
        bf16_t* Y = (bf16_t*)(p->ws + WS_YCAT);
#pragma unroll
        for (int it = 0; it < 4; ++it) { const int task = it * 512 + tid, tok = task >> 5, cg = task & 31; const size_t row = (size_t)rowbase + t0 + tok;
            float hf[8], hb[8], ga[8], y[8];
            unpack8(*(const LAS u32x4*)(HB + ((0 * 64 + tok) * 256 + 8 * cg) * 2), hf); unpack8(*(const LAS u32x4*)(HB + ((1 * 64 + tok) * 256 + 8 * cg) * 2), hb);
            unpack8(*(const u32x4*)(PROJ + row * NPROJ + 256 + 8 * cg), ga);
#pragma unroll
            for (int e = 0; e < 8; ++e) { const float g = ga[e]; const float tt = tanhf(0.7978845608028654f * (g + 0.044715f * g * g * g)); y[e] = (hf[e] + hb[e]) * (0.5f * g * (1.0f + tt)); }
            *(u32x4*)(Y + row * D + 8 * cg) = pack8(y); }
    }
}

__device__ __forceinline__ void pool_four_unit(CP p, int l, int q, LAS unsigned char* lds) {
    LAS float* PB = (LAS float*)lds;
    const int tid = tid_();
    const bf16_t* PROJ = (const bf16_t*)(p->ws + WS_PROJ); bf16_t* Y = (bf16_t*)(p->ws + WS_YCAT);
    const bool lat = q < 512; const int b = lat ? q >> 6 : (q - 512) >> 2, jc = lat ? q & 63 : (q - 512) & 3, L = lat ? SEQ : LCX, rowbase = lat ? b * SEQ : TL + b * LCX, t0 = jc * 64;
    __syncthreads();
    for (int task = tid; task < 80 * 32; task += 512) { const int r = task >> 5, cg = task & 31, tt = t0 - 8 + r; float f[8];
        if (tt >= 0 && tt < L) unpack8(*(const u32x4*)(PROJ + (size_t)(rowbase + tt) * NPROJ + 512 + 8 * cg), f); else {
#pragma unroll
            for (int e = 0; e < 8; ++e) f[e] = 0.f; }
        *(LAS f32x4*)(PB + r * 256 + 8 * cg) = (f32x4){f[0], f[1], f[2], f[3]}; *(LAS f32x4*)(PB + r * 256 + 8 * cg + 4) = (f32x4){f[4], f[5], f[6], f[7]}; }
    __syncthreads();
    { const int c = tid & 255, th = tid >> 8, hw = 1 << (c >> 6); const float bp = p->b_pool[l * 256 + c], ps = p->pool_scale[l * 256 + c];
      for (int o = 0; o < 32; ++o) { const int tl = 32 * th + o, t = t0 + tl; const int lo = max(t - hw, 0), hi = min(t + hw, L); float s = 0.f;
          for (int tt = lo; tt < hi; ++tt) s += PB[(tt - t0 + 8) * 256 + c];
          const float yv = (s / (float)(hi - lo) - PB[(tl + 8) * 256 + c] + bp) * ps;
          Y[(size_t)(rowbase + t) * D + 256 + c] = f2bf(yv); } }
    const float* UU = (const float*)(p->ws + WS_UU); const float* VV = (const float*)(p->ws + WS_VV); const float* YCX = (const float*)(p->ws + WS_YCX);
#pragma unroll
    for (int it = 0; it < 4; ++it) { const int task = it * 512 + tid, tl = task >> 5, cg = task & 31, t = t0 + tl; float y[8];
        f32x4 u0, u1, v0 = {0.f, 0.f, 0.f, 0.f}, v1 = {0.f, 0.f, 0.f, 0.f}; float sgn, scale;
        if (lat) { const int k = t <= 2048 ? t : 4096 - t; sgn = t <= 2048 ? -1.0f : 1.0f; scale = 1.0f / 512.0f;
            const float* up = UU + (size_t)k * 2048 + b * 256 + 8 * cg; u0 = *(const f32x4*)up; u1 = *(const f32x4*)(up + 4);
            if (k < 2048) { const float* vp = VV + (size_t)k * 2048 + b * 256 + 8 * cg; v0 = *(const f32x4*)vp; v1 = *(const f32x4*)(vp + 4); } }
        else { sgn = 0.f; scale = 1.0f / 128.0f; const float* up = YCX + (size_t)t * 2048 + b * 256 + 8 * cg; u0 = *(const f32x4*)up; u1 = *(const f32x4*)(up + 4); }
        const f32x4 bf0 = *(const f32x4*)(p->b_four + l * 256 + 8 * cg), bf1 = *(const f32x4*)(p->b_four + l * 256 + 8 * cg + 4);
        const f32x4 r0 = (u0 + v0 * sgn) * scale + bf0, r1 = (u1 + v1 * sgn) * scale + bf1;
        y[0] = r0[0]; y[1] = r0[1]; y[2] = r0[2]; y[3] = r0[3]; y[4] = r1[0]; y[5] = r1[1]; y[6] = r1[2]; y[7] = r1[3];
        *(u32x4*)(Y + (size_t)(rowbase + t) * D + 512 + 8 * cg) = pack8(y); }
}
__device__ __forceinline__ void conformer_unit(CP p, int l, int q, LAS unsigned char* lds) {
    LAS float* V = (LAS float*)lds;
    const int tid = tid_(), lane = tid & 63, wid = __builtin_amdgcn_readfirstlane(tid >> 6), hd = wid & 3, th = wid >> 2;
    const bf16_t* PROJ = (const bf16_t*)(p->ws + WS_PROJ); bf16_t* Y = (bf16_t*)(p->ws + WS_YCAT);
    const bool lat = q < 512; const int b = lat ? q >> 6 : (q - 512) >> 2, jc = lat ? q & 63 : (q - 512) & 3, L = lat ? SEQ : LCX, rowbase = lat ? b * SEQ : TL + b * LCX, t0 = jc * 64;
    __syncthreads();
    for (int task = tid; task < 94 * 32; task += 512) { const int r = task >> 5, cg = task & 31, tt = t0 - 15 + r; float f[8];
        if (tt >= 0 && tt < L) { float a[8], g[8]; const bf16_t* pr = PROJ + (size_t)(rowbase + tt) * NPROJ + 768 + 8 * cg; unpack8(*(const u32x4*)pr, a); unpack8(*(const u32x4*)(pr + 256), g);
#pragma unroll
            for (int e = 0; e < 8; ++e) f[e] = a[e] * sigmoidf_(g[e]); }
        else {
#pragma unroll
            for (int e = 0; e < 8; ++e) f[e] = 0.f; }
        *(LAS f32x4*)(V + r * 256 + 8 * cg) = (f32x4){f[0], f[1], f[2], f[3]}; *(LAS f32x4*)(V + r * 256 + 8 * cg + 4) = (f32x4){f[4], f[5], f[6], f[7]}; }
    __syncthreads();
    const int c = 64 * hd + lane;
    float wk[31];
#pragma unroll
    for (int k = 0; k < 31; ++k) wk[k] = p->conv_d_w[((size_t)l * 31 + k) * 256 + c];
    const float cb = p->conv_d_b[l * 256 + c], lg = p->ln_d_g[l * 256 + c], lb = p->ln_d_b[l * 256 + c];
    for (int blk = 0; blk < 4; ++blk) { const int tl0 = 32 * th + 8 * blk;
        float win[38];
#pragma unroll
        for (int i = 0; i < 38; ++i) win[i] = V[(tl0 + i) * 256 + c];
#pragma unroll
        for (int o = 0; o < 8; ++o) { float s = cb;
#pragma unroll
            for (int k = 0; k < 31; ++k) s += wk[k] * win[o + k];
            const float mean = wave_sum(s, lane) * (1.0f / 64.0f); const float dv = s - mean; const float var = wave_sum(dv * dv, lane) * (1.0f / 64.0f);
            float yv = dv * rsqrtf(var + 1e-6f) * lg + lb; yv = yv * sigmoidf_(yv);
            Y[(size_t)(rowbase + t0 + tl0 + o) * D + 768 + c] = f2bf(yv); } }
}

struct SchedIn { const char *U, *W, *WF; char *PROJ, *PQT, *PQC;
    __device__ __forceinline__ bool next(int i, g8::Unit& u) const { const int L = i * (int)gridDim.x + (int)blockIdx.x; if (L >= 952) return false; const int id = g8::xcd_remap(L, 952);
        if (id < 680) { u.kind = 0; u.pm = id / 5; u.pn = id % 5; u.a = U + (size_t)u.pm * 256 * 2048; u.b = W + (size_t)u.pn * 256 * 2048; u.o = PROJ; u.e = 0; }
        else { const int r = id - 680; u.kind = 1; u.pm = r & 1; u.pn = r >> 1; u.a = WF + (size_t)u.pm * 256 * 2048; u.b = U + (size_t)u.pn * 256 * 2048; u.e = 0;
            if (u.pn < 128) u.o = PQT + ((size_t)(u.pm * 2048 + (u.pn >> 4) * 256) * 4096 + (u.pn & 15) * 256) * 2; else u.o = PQC + ((size_t)((u.pn - 128) * 256) * 512 + u.pm * 256) * 2; }
        return true; } };
struct EpiIn { static constexpr bool PERM = true; const float* bin; const float* bf;
    __device__ __forceinline__ void operator()(const f32x4 (&acc)[2][2][4][2], const g8::Unit& u, int wr, int wc, int fr, int fq) const {
        asm volatile("" : "+v"(fr), "+v"(fq));
        if (u.kind == 0) { const int row0 = u.pm * 256 + wr * 64 + fr, col0 = u.pn * 256 + wc * 32 + 8 * fq; bf16_t* O = (bf16_t*)u.o;
            f32x4 bv[2][2];
#pragma unroll
            for (int bj = 0; bj < 2; ++bj)
#pragma unroll
                for (int n = 0; n < 2; ++n) bv[bj][n] = *(const f32x4*)(bin + col0 + bj * 128 + 4 * n);
#pragma unroll
            for (int ai = 0; ai < 2; ++ai)
#pragma unroll
                for (int m = 0; m < 4; ++m) { bf16_t* rowp = O + (size_t)(row0 + ai * 128 + m * 16) * NPROJ + col0;
#pragma unroll
                    for (int bj = 0; bj < 2; ++bj) { const f32x4 v0 = acc[ai][bj][m][0] + bv[bj][0], v1 = acc[ai][bj][m][1] + bv[bj][1];
                        u32x4 w; w.x = cvt_pk_bf16(v0[0], v0[1]); w.y = cvt_pk_bf16(v0[2], v0[3]); w.z = cvt_pk_bf16(v1[0], v1[1]); w.w = cvt_pk_bf16(v1[2], v1[3]); *(u32x4*)(rowp + bj * 128) = w; } }
        } else { const int pitch = u.pn < 128 ? 4096 : 512; bf16_t* O = (bf16_t*)u.o; const int col0 = wc * 32 + 8 * fq;
#pragma unroll
            for (int ai = 0; ai < 2; ++ai)
#pragma unroll
                for (int m = 0; m < 4; ++m) { const int r = ai * 128 + wr * 64 + m * 16 + fr; const float bb = bf[u.pm * 256 + r]; bf16_t* rowp = O + (size_t)r * pitch + col0;
#pragma unroll
                    for (int bj = 0; bj < 2; ++bj) { const f32x4 v0 = acc[ai][bj][m][0] + bb, v1 = acc[ai][bj][m][1] + bb;
                        u32x4 w; w.x = cvt_pk_bf16(v0[0], v0[1]); w.y = cvt_pk_bf16(v0[2], v0[3]); w.z = cvt_pk_bf16(v1[0], v1[1]); w.w = cvt_pk_bf16(v1[2], v1[3]); *(u32x4*)(rowp + bj * 128) = w; } }
        } } };
struct SchedDft { const char *CM, *SM, *PQT; char *UU, *VV;
    __device__ __forceinline__ bool next(int i, g8::Unit& u) const { const int id = (int)blockIdx.x; if (i > 0 || id >= 136) return false; u.kind = 0; u.e = 0;
        if (id < 72) { u.pm = id >> 3; u.pn = id & 7; u.a = CM + (size_t)u.pm * 256 * 8192; u.b = PQT + (size_t)u.pn * 256 * 8192; u.o = UU + ((size_t)u.pm * 256 * 2048 + u.pn * 256) * 4; }
        else { const int r = id - 72; u.pm = r >> 3; u.pn = r & 7; u.a = SM + (size_t)u.pm * 256 * 8192; u.b = PQT + (size_t)(2048 + u.pn * 256) * 8192; u.o = VV + ((size_t)u.pm * 256 * 2048 + u.pn * 256) * 4; }
        return true; } };
struct SchedDftC { const char *DC, *PQC; char* YCX;
    __device__ __forceinline__ bool next(int i, g8::Unit& u) const { const int id = (int)blockIdx.x - 136; if (i > 0 || id < 0 || id >= 8) return false; u.kind = 0; u.e = 0; u.pm = 0; u.pn = id;
        u.a = DC; u.b = PQC + (size_t)id * 256 * 1024; u.o = YCX + (size_t)id * 256 * 4; return true; } };
struct EpiF32 { static constexpr bool PERM = false;
    __device__ __forceinline__ void operator()(const f32x4 (&acc)[2][2][4][2], const g8::Unit& u, int wr, int wc, int fr, int fq) const {
        asm volatile("" : "+v"(fr), "+v"(fq));
        float* O = (float*)u.o; const int row0 = wr * 64 + fr, col0 = wc * 32 + 4 * fq;
#pragma unroll
        for (int ai = 0; ai < 2; ++ai)
#pragma unroll
            for (int m = 0; m < 4; ++m) { float* rowp = O + (size_t)(row0 + ai * 128 + m * 16) * 2048 + col0;
#pragma unroll
                for (int bj = 0; bj < 2; ++bj)
#pragma unroll
                    for (int n = 0; n < 2; ++n) *(f32x4*)(rowp + bj * 128 + n * 16) = acc[ai][bj][m][n]; } } };
struct SchedOut { const char *Y, *W; int nm; const float* modv_l;
    __device__ __forceinline__ bool next(int i, g8::Unit& u) const { const int nu = nm * 4, L = i * (int)gridDim.x + (int)blockIdx.x; if (L >= nu) return false; const int id = g8::xcd_remap(L, nu);
        u.kind = 0; u.pm = id >> 2; u.pn = id & 3; u.a = Y + (size_t)u.pm * 256 * 2048; u.b = W + (size_t)u.pn * 256 * 2048; u.o = nullptr; u.e = u.pm < 128 ? u.pm >> 4 : 8; return true; } };
struct EpiOut { static constexpr bool PERM = false; float* X; const float* bout; const float* modv_l;
    __device__ __forceinline__ void operator()(const f32x4 (&acc)[2][2][4][2], const g8::Unit& u, int wr, int wc, int fr, int fq) const {
        asm volatile("" : "+v"(fr), "+v"(fq));
        const int row0 = u.pm * 256 + wr * 64 + fr, col0 = u.pn * 256 + wc * 32 + 4 * fq; const float* g1 = modv_l + (size_t)u.e * 6144 + 2048;
        f32x4 bv[2][2], gv[2][2];
#pragma unroll
        for (int bj = 0; bj < 2; ++bj)
#pragma unroll
            for (int n = 0; n < 2; ++n) { bv[bj][n] = *(const f32x4*)(bout + col0 + bj * 128 + n * 16); gv[bj][n] = *(const f32x4*)(g1 + col0 + bj * 128 + n * 16); }
#pragma unroll
        for (int ai = 0; ai < 2; ++ai)
#pragma unroll
            for (int m = 0; m < 4; ++m) { float* rowp = X + (size_t)(row0 + ai * 128 + m * 16) * D + col0;
#pragma unroll
                for (int bj = 0; bj < 2; ++bj)
#pragma unroll
                    for (int n = 0; n < 2; ++n) { f32x4* px = (f32x4*)(rowp + bj * 128 + n * 16); *px = *px + gv[bj][n] * (acc[ai][bj][m][n] + bv[bj][n]); } } } };
struct MoeTab { const LAS int* pref; const LAS int* cnt; int ntile;
    __device__ __forceinline__ int pref_(int e) const { return __builtin_amdgcn_readfirstlane(pref[e]); }
    __device__ __forceinline__ int cnt_(int e) const { return __builtin_amdgcn_readfirstlane(cnt[e]); }
    __device__ __forceinline__ int expert_of(int pm) const { int e = 0;
        for (int k = 1; k < 32; ++k) e += (pm >= pref_(k)) ? 1 : 0; return e; } };
struct SchedGu { MoeTab tb; const char *U, *W; char* ACT; const int* rasg;
    __device__ __forceinline__ bool next(int i, g8::Unit& u) const { const int nu = tb.ntile * 8, L = i * (int)gridDim.x + (int)blockIdx.x; if (L >= nu) return false; const int id = g8::xcd_remap(L, nu);
        u.kind = 0; u.pm = id >> 3; u.pn = id & 7; u.e = tb.expert_of(u.pm); u.a = U; u.b = W + ((size_t)u.e * 2048 + u.pn * 256) * 2048; u.o = ACT + (size_t)u.pm * 256 * 2048; return true; }
    __device__ __forceinline__ int row(const g8::Unit& u, int r) const { const int v = rasg[(size_t)u.e * TT + (u.pm - tb.pref_(u.e)) * 256 + r] >> 2; return min(max(v, 0), TT - 1); } };
struct EpiGu { static constexpr bool PERM = true; const float* bgu;
    __device__ __forceinline__ void operator()(const f32x4 (&acc)[2][2][4][2], const g8::Unit& u, int wr, int wc, int fr, int fq) const {
        asm volatile("" : "+v"(fr), "+v"(fq));
        const int col0 = u.pn * 128 + wc * 32 + 8 * fq; bf16_t* O = (bf16_t*)u.o; const float* bg = bgu + (size_t)u.e * 2048 + col0;
        f32x4 bgt[2], bup[2];
#pragma unroll
        for (int n = 0; n < 2; ++n) { bgt[n] = *(const f32x4*)(bg + 4 * n); bup[n] = *(const f32x4*)(bg + 1024 + 4 * n); }
#pragma unroll
        for (int ai = 0; ai < 2; ++ai)
#pragma unroll
            for (int m = 0; m < 4; ++m) { const int r = ai * 128 + wr * 64 + m * 16 + fr; float y[8];
#pragma unroll
                for (int n = 0; n < 2; ++n) { const f32x4 g4 = acc[ai][0][m][n] + bgt[n], u4 = acc[ai][1][m][n] + bup[n];
#pragma unroll
                    for (int e = 0; e < 4; ++e) { const float gt = fminf(g4[e], 7.0f), up = fminf(fmaxf(u4[e], -7.0f), 7.0f); y[4 * n + e] = (up + 1.0f) * (gt * sigmoidf_(1.702f * gt)); } }
                *(u32x4*)(O + (size_t)r * D + col0) = pack8(y); } } };
struct SchedDown { MoeTab tb; const char *ACT, *W;
    __device__ __forceinline__ bool next(int i, g8::Unit& u) const { const int nu = tb.ntile * 4, L = i * (int)gridDim.x + (int)blockIdx.x; if (L >= nu) return false; const int id = g8::xcd_remap(L, nu);
        u.kind = 0; u.pm = id >> 2; u.pn = id & 3; u.e = tb.expert_of(u.pm); u.a = ACT + (size_t)u.pm * 256 * 2048; u.b = W + ((size_t)u.e * 1024 + u.pn * 256) * 2048; u.o = nullptr; return true; } };
struct EpiDown { static constexpr bool PERM = true; MoeTab tb; const float* bd; const int* rasg; const float* gate; bf16_t* YS;
    __device__ __forceinline__ void operator()(const f32x4 (&acc)[2][2][4][2], const g8::Unit& u, int wr, int wc, int fr, int fq) const {
        asm volatile("" : "+v"(fr), "+v"(fq));
        const int col0 = u.pn * 256 + wc * 32 + 8 * fq; const float* bp = bd + (size_t)u.e * 1024 + col0; const int rank0 = (u.pm - tb.pref_(u.e)) * 256, cnt = tb.cnt_(u.e);
        f32x4 bv[2][2];
#pragma unroll
        for (int bj = 0; bj < 2; ++bj)
#pragma unroll
            for (int n = 0; n < 2; ++n) bv[bj][n] = *(const f32x4*)(bp + bj * 128 + 4 * n);
#pragma unroll
        for (int ai = 0; ai < 2; ++ai)
#pragma unroll
            for (int m = 0; m < 4; ++m) { const int rank = rank0 + ai * 128 + wr * 64 + m * 16 + fr;
                if (rank < cnt) { const int asg = rasg[(size_t)u.e * TT + rank]; const float g = gate[asg]; bf16_t* rowp = YS + (size_t)asg * D + col0;
#pragma unroll
                    for (int bj = 0; bj < 2; ++bj) { const f32x4 v0 = (acc[ai][bj][m][0] + bv[bj][0]) * g, v1 = (acc[ai][bj][m][1] + bv[bj][1]) * g;
                        u32x4 w; w.x = cvt_pk_bf16(v0[0], v0[1]); w.y = cvt_pk_bf16(v0[2], v0[3]); w.z = cvt_pk_bf16(v1[0], v1[1]); w.w = cvt_pk_bf16(v1[2], v1[3]); *(u32x4*)(rowp + bj * 128) = w; } } } } };
__device__ __forceinline__ MoeTab moe_tables(CP p, int l, LAS unsigned char* lds) {
    LAS int* pref = (LAS int*)(lds + g8::STAGE_BYTES); LAS int* cnt = pref + 64;
    unsigned* ctl = (unsigned*)(p->ws + WS_CTL);
    __syncthreads();
    if (tid_() < 32) cnt[tid_()] = (int)__hip_atomic_load(ctl + CW_COUNT + (l * NE + tid_()) * 64, __ATOMIC_RELAXED, __HIP_MEMORY_SCOPE_AGENT);
    __syncthreads();
    if (tid_() == 0) { int s = 0; for (int e = 0; e < 32; ++e) { pref[e] = s; s += (cnt[e] + 255) >> 8; } pref[32] = s; }
    __syncthreads();
    MoeTab tb; tb.pref = pref; tb.cnt = cnt; tb.ntile = __builtin_amdgcn_readfirstlane(pref[32]); return tb;
}

constexpr int N_PHASES = 18;
__global__ void __launch_bounds__(512, 2) mega_fwd(Params p_unused) {
    CP p = launder_params();
    extern __shared__ __attribute__((aligned(16))) unsigned char shm_[];
    LAS unsigned char* lds0 = (LAS unsigned char*)shm_;
    LAS unsigned char* lds = lds0 + LDS_BASE;
    if (tid_() == 0) *(LAS u32x4*)lds0 = (u32x4){0u, 0u, 0u, 0u};
    __syncthreads();
    XcdBarrier bar = xcd_barrier_post((unsigned*)(p->ws + WS_CTL), (volatile LAS unsigned*)lds0);
    int ph = 0;
#ifndef P3A
#define P3A 1
#define P3B 1
#define P3C 1
#endif
#ifndef PHMASK
#define PHMASK 0x3ff
#endif
#define PHASE_BEGIN_K(k) p = launder_params(); if (((PHMASK >> (k)) & 1) && ph >= p->ph_lo && ph < p->ph_hi) {
#define PHASE_END } ++ph; if (ph > p->ph_lo && ph < p->ph_hi) xcd_barrier(bar);
    PHASE_BEGIN_K(0) phase_prologue(p, lds); PHASE_END
    for (int l = 0; l < 2; ++l) {
        const float* modv_l = (const float*)(p->ws + WS_MODV) + (size_t)l * 9 * 6144;
        PHASE_BEGIN_K(1) phase_norm(p, l); PHASE_END
        PHASE_BEGIN_K(2) { SchedIn S; S.U = (const char*)(p->ws + WS_U); S.W = (const char*)(p->ws + WS_WINT) + (size_t)l * NPROJ * 2048; S.WF = (const char*)(p->ws + WS_WFT) + (size_t)l * 512 * 2048;
                      S.PROJ = (char*)(p->ws + WS_PROJ); S.PQT = (char*)(p->ws + WS_PQT); S.PQC = (char*)(p->ws + WS_PQC);
                      EpiIn E; E.bin = (const float*)(p->ws + WS_BIN) + l * NPROJ; E.bf = (const float*)(p->ws + WS_BF) + l * 512;
                      g8::gemm_phase<EpiIn, SchedIn, false>(lds, 1024, S, E); } PHASE_END
        PHASE_BEGIN_K(3) { if (P3A && blockIdx.x < 136) { SchedDft S; S.CM = (const char*)(p->ws + WS_CMAT); S.SM = (const char*)(p->ws + WS_SMAT); S.PQT = (const char*)(p->ws + WS_PQT); S.UU = (char*)(p->ws + WS_UU); S.VV = (char*)(p->ws + WS_VV);
                          g8::gemm_phase<EpiF32, SchedDft, false>(lds, 4096, S, EpiF32{}); }
                      else if (P3B && blockIdx.x >= 136 && blockIdx.x < 144) { SchedDftC S; S.DC = (const char*)(p->ws + WS_DFTC); S.PQC = (const char*)(p->ws + WS_PQC); S.YCX = (char*)(p->ws + WS_YCX);
                          g8::gemm_phase<EpiF32, SchedDftC, false>(lds, 512, S, EpiF32{}); }
                      else if (P3C && blockIdx.x >= 144) { const int nw = (int)gridDim.x - 144; if (nw > 0) for (int q = (int)blockIdx.x - 144; q < NCHUNK; q += nw) scan_unit<1>(p, l, q, lds); } } PHASE_END
        PHASE_BEGIN_K(4) { for (int uu = blockIdx.x; uu < 3 * NCHUNK; uu += gridDim.x) { const int kind = uu / NCHUNK, q = uu % NCHUNK;
                          if (kind == 0) scan_unit<2>(p, l, q, lds); else if (kind == 1) conformer_unit(p, l, q, lds); else pool_four_unit(p, l, q, lds); } } PHASE_END
        PHASE_BEGIN_K(5) { SchedOut S; S.Y = (const char*)(p->ws + WS_YCAT); S.W = (const char*)(p->ws + WS_WOUTT) + (size_t)l * D * 2048; S.nm = l == 0 ? 136 : 128; S.modv_l = modv_l;
                      EpiOut E; E.X = (float*)(p->ws + WS_X); E.bout = (const float*)(p->ws + WS_BOUT) + l * D; E.modv_l = modv_l;
                      g8::gemm_phase<EpiOut, SchedOut, false>(lds, 1024, S, E); } PHASE_END
        PHASE_BEGIN_K(6) phase_router(p, l, lds); PHASE_END
        PHASE_BEGIN_K(7) { MoeTab tb = moe_tables(p, l, lds);
                      SchedGu S; S.tb = tb; S.U = (const char*)(p->ws + WS_U); S.W = (const char*)(p->ws + WS_WGUT) + (size_t)l * NE * 2048 * 2048; S.ACT = (char*)(p->ws + WS_ACT); S.rasg = (const int*)(p->ws + WS_RASG);
                      EpiGu E; E.bgu = p->b_gu + (size_t)l * NE * 2048;
                      g8::gemm_phase<EpiGu, SchedGu, true>(lds, 1024, S, E); } PHASE_END
        PHASE_BEGIN_K(8) { MoeTab tb = moe_tables(p, l, lds);
                      SchedDown S; S.tb = tb; S.ACT = (const char*)(p->ws + WS_ACT); S.W = (const char*)(p->ws + WS_WDT) + (size_t)l * NE * 1024 * 2048;
                      EpiDown E; E.tb = tb; E.bd = p->b_down + (size_t)l * NE * 1024; E.rasg = (const int*)(p->ws + WS_RASG); E.gate = (const float*)(p->ws + WS_GATE); E.YS = (bf16_t*)(p->ws + WS_YS);
                      g8::gemm_phase<EpiDown, SchedDown, false>(lds, 1024, S, E); } PHASE_END
    }
    PHASE_BEGIN_K(9) phase_norm(p, 2); PHASE_END
#undef PHASE_BEGIN_K
#undef PHASE_END
}

extern "C" void kernel_launch(void* const* d_in, const int* in_sizes, int n_in, void* d_out, int out_size, void* d_ws, size_t ws_size, hipStream_t stream) {
    static int grid = 0;
    if (!grid) {
        if (n_in != 37 || ws_size < WS_END) { fprintf(stderr, "kernel_launch: expected 37 inputs and >= %zu bytes of workspace (got %d, %zu)\n", (size_t)WS_END, n_in, ws_size); }
        int dev = 0, cus = 0, per_cu = 0;
        hipGetDevice(&dev); hipDeviceGetAttribute(&cus, hipDeviceAttributeMultiprocessorCount, dev);
        hipFuncSetAttribute((const void*)mega_fwd, hipFuncAttributeMaxDynamicSharedMemorySize, LDS_BYTES);
        hipOccupancyMaxActiveBlocksPerMultiprocessor(&per_cu, (const void*)mega_fwd, 512, LDS_BYTES);
        if (per_cu < 1) fprintf(stderr, "kernel_launch: occupancy query reports %d workgroups per CU\n", per_cu);
        grid = cus > 0 ? cus : 256;
    }
    hipMemsetAsync((char*)d_ws + WS_CTL, 0, CTL_BYTES, stream);
    Params hp{};
    const float** f = (const float**)&hp;
    for (int i = 0; i < 37; ++i) f[i] = (const float*)d_in[i];
    hp.out = (float*)d_out; hp.ws = (unsigned char*)d_ws;
#if MK_N_LAUNCHES == 1
    hp.ph_lo = 0; hp.ph_hi = N_PHASES;
    hipLaunchKernelGGL(mega_fwd, dim3(grid), dim3(512), LDS_BYTES, stream, hp);
#else
    for (int ph = 0; ph < N_PHASES; ++ph) { hp.ph_lo = ph; hp.ph_hi = ph + 1; hipLaunchKernelGGL(mega_fwd, dim3(grid), dim3(512), LDS_BYTES, stream, hp); }
#endif
}
```

```cpp
#include <hip/hip_runtime.h>
#include <cstdio>
#include <cstdint>

#ifndef MK_N_LAUNCHES
#define MK_N_LAUNCHES 1
#endif

#define LAS __attribute__((address_space(3)))
typedef unsigned short bf16_t;
typedef short bf16x8 __attribute__((ext_vector_type(8)));
typedef float f32x4 __attribute__((ext_vector_type(4)));
typedef float f32x2 __attribute__((ext_vector_type(2)));
typedef unsigned u32x4 __attribute__((ext_vector_type(4)));
typedef unsigned u32x2 __attribute__((ext_vector_type(2)));

constexpr int D = 1024, NB = 8, SEQ = 4096, LCX = 256, TL = NB * SEQ, TC = NB * LCX, TT = TL + TC;
constexpr int NPROJ = 1280;
constexpr int NE = 32, NCHUNK = 544;
constexpr int NTILE_MAX = 576;

constexpr size_t AL(size_t x) { return (x + 255) & ~(size_t)255; }
constexpr size_t CTL_BYTES = 65536;
constexpr size_t WS_CTL = 0;
constexpr size_t WS_MODV = WS_CTL + CTL_BYTES;
constexpr size_t WS_X = AL(WS_MODV + (size_t)2 * 9 * 6144 * 4);
constexpr size_t WS_U = AL(WS_X + (size_t)TT * D * 4);
constexpr size_t WS_PROJ = AL(WS_U + (size_t)TT * D * 2);
constexpr size_t WS_PQT = AL(WS_PROJ + (size_t)TT * NPROJ * 2);
constexpr size_t WS_PQC = AL(WS_PQT + (size_t)4096 * 4096 * 2);
constexpr size_t WS_UU = AL(WS_PQC + (size_t)2048 * 512 * 2);
constexpr size_t WS_VV = AL(WS_UU + (size_t)2304 * 2048 * 4);
constexpr size_t WS_YCX = AL(WS_VV + (size_t)2048 * 2048 * 4);
constexpr size_t WS_YCAT = AL(WS_YCX + (size_t)256 * 2048 * 4);
constexpr size_t WS_SUMM = AL(WS_YCAT + (size_t)TT * D * 2);
constexpr size_t WS_WINT = AL(WS_SUMM + (size_t)NCHUNK * 1024 * 4);
constexpr size_t WS_WFT = AL(WS_WINT + (size_t)2 * NPROJ * D * 2);
constexpr size_t WS_BIN = AL(WS_WFT + (size_t)2 * 512 * D * 2);
constexpr size_t WS_BF = AL(WS_BIN + (size_t)2 * NPROJ * 4);
constexpr size_t WS_WOUTT = AL(WS_BF + (size_t)2 * 512 * 4);
constexpr size_t WS_BOUT = AL(WS_WOUTT + (size_t)2 * D * D * 2);
constexpr size_t WS_WGUT = AL(WS_BOUT + (size_t)2 * D * 4);
constexpr size_t WS_WDT = AL(WS_WGUT + (size_t)2 * NE * 2048 * D * 2);
constexpr size_t WS_WRT = AL(WS_WDT + (size_t)2 * NE * D * D * 2);
constexpr size_t WS_WGT = AL(WS_WRT + (size_t)2 * 2 * NE * D * 2);
constexpr size_t WS_CMAT = AL(WS_WGT + (size_t)2 * 2 * 2 * 4 * 64 * 64 * 2);
constexpr size_t WS_SMAT = AL(WS_CMAT + (size_t)2304 * 4096 * 2);
constexpr size_t WS_DFTC = AL(WS_SMAT + (size_t)2048 * 4096 * 2);
constexpr size_t WS_RASG = AL(WS_DFTC + (size_t)256 * 512 * 2);
constexpr size_t WS_GATE = AL(WS_RASG + (size_t)NE * TT * 4);
constexpr size_t WS_ACT = AL(WS_GATE + (size_t)TT * 4 * 4);
constexpr size_t WS_YS = AL(WS_ACT + (size_t)NTILE_MAX * 256 * D * 2);
constexpr size_t WS_END = AL(WS_YS + (size_t)TT * 4 * D * 2);
constexpr int CW_COUNT = 4096;

constexpr int LDS_BYTES = 147456;
constexpr int LDS_BASE = 1024;

__device__ __forceinline__ unsigned cvt_pk_bf16(float lo, float hi) { unsigned r; asm("v_cvt_pk_bf16_f32 %0, %1, %2" : "=v"(r) : "v"(lo), "v"(hi)); return r; }
__device__ __forceinline__ bf16_t f2bf(float f) { return (bf16_t)(cvt_pk_bf16(f, 0.f) & 0xffffu); }
__device__ __forceinline__ float bf2f(bf16_t b) { return __uint_as_float(((unsigned)b) << 16); }
__device__ __forceinline__ float bflo(unsigned w) { return __uint_as_float(w << 16); }
__device__ __forceinline__ float bfhi(unsigned w) { return __uint_as_float(w & 0xffff0000u); }
__device__ __forceinline__ float sigmoidf_(float x) { return 1.0f / (1.0f + __expf(-x)); }
__device__ __forceinline__ int tid_() { int t = (int)threadIdx.x; asm volatile("" : "+v"(t)); return t; }
__device__ __forceinline__ float bperm(float v, int src) { return __int_as_float(__builtin_amdgcn_ds_bpermute(src << 2, __float_as_int(v))); }
__device__ __forceinline__ float wave_sum(float v, int lane) {
#pragma unroll
    for (int o = 32; o >= 1; o >>= 1) v += bperm(v, lane ^ o);
    return v;
}
__device__ __forceinline__ void unpack8(const u32x4 w, float (&f)[8]) { f[0] = bflo(w.x); f[1] = bfhi(w.x); f[2] = bflo(w.y); f[3] = bfhi(w.y); f[4] = bflo(w.z); f[5] = bfhi(w.z); f[6] = bflo(w.w); f[7] = bfhi(w.w); }
__device__ __forceinline__ u32x4 pack8(const float (&f)[8]) { u32x4 w; w.x = cvt_pk_bf16(f[0], f[1]); w.y = cvt_pk_bf16(f[2], f[3]); w.z = cvt_pk_bf16(f[4], f[5]); w.w = cvt_pk_bf16(f[6], f[7]); return w; }

#define XB_TMO      128
#define XB_XCNT(j)  (256  + 64 * (j))
#define XB_XSUB(j)  (1280 + 64 * (j))
#define XB_XGEN(j)  (2304 + 64 * (j))
#define XB_TOP      3328
#define XB_TOPGEN   3392
#define XCD_BAR_WORDS 3456
#define XB_SPIN_CAP (1u << 18)
__device__ __forceinline__ unsigned xb_ld(unsigned* p)              { return __hip_atomic_load(p, __ATOMIC_RELAXED, __HIP_MEMORY_SCOPE_AGENT); }
__device__ __forceinline__ unsigned xb_add(unsigned* p, unsigned v) { return __hip_atomic_fetch_add(p, v, __ATOMIC_RELAXED, __HIP_MEMORY_SCOPE_AGENT); }
__device__ __forceinline__ unsigned xb_xcc_id() { return (unsigned)__builtin_amdgcn_s_getreg((3 << 11) | 20) & 0xFu; }
#define XB_SPIN(cond, bar) do { unsigned _sp = 0; while (cond) { __builtin_amdgcn_s_sleep(1); \
    if ((++_sp & 255u) == 0u) { if (xb_ld(&(bar)[XB_TMO])) break; if (_sp > XB_SPIN_CAP) { atomicAdd(&(bar)[XB_TMO], 1u); break; } } } } while (0)
struct XcdBarrier { unsigned* bar; unsigned x; volatile LAS unsigned* st; };
__device__ __forceinline__ XcdBarrier xcd_barrier_post(unsigned* bar, volatile LAS unsigned* st) {
    XcdBarrier b; b.bar = bar; b.x = xb_xcc_id(); b.st = st;
    if (threadIdx.x == 0) (void)xb_add(&bar[XB_XCNT(b.x)], 1u);
    return b;
}
__device__ __forceinline__ void xcd_barrier_complete(unsigned* bar, unsigned x, unsigned& nloc, unsigned& nx) {
    const unsigned G = gridDim.x * gridDim.y * gridDim.z;
    unsigned sum, cnt, mine, sp = 0u;
    for (;;) {
        sum = 0u; cnt = 0u; mine = 0u;
#pragma unroll
        for (unsigned j = 0; j < 16; ++j) { const unsigned c = xb_ld(&bar[XB_XCNT(j)]); sum += c; cnt += (c > 0u) ? 1u : 0u; mine = (j == x) ? c : mine; }
        if (sum == G) break;
        __builtin_amdgcn_s_sleep(1);
        if ((++sp & 255u) == 0u) { if (xb_ld(&bar[XB_TMO])) break; if (sp > XB_SPIN_CAP) { atomicAdd(&bar[XB_TMO], 1u); break; } }
    }
    nloc = mine > 0u ? mine : 1u; nx = cnt > 0u ? cnt : 1u;
}
__device__ __forceinline__ void xcd_barrier(const XcdBarrier& b) {
    asm volatile("s_waitcnt vmcnt(0)" ::: "memory");
    __syncthreads();
    if (threadIdx.x == 0) {
        unsigned* bar = b.bar;
        __builtin_amdgcn_s_waitcnt(0);
        unsigned nloc = b.st[0], nx = b.st[1];
        if (nloc == 0u) { unsigned xo = b.x; asm volatile("" : "+s"(xo)); xcd_barrier_complete(bar, xo, nloc, nx); b.st[0] = nloc; b.st[1] = nx; }
        const unsigned old = xb_add(&bar[XB_XSUB(b.x)], 1u);
        const unsigned gen = old / nloc;
        if (old + 1u == (gen + 1u) * nloc) {
            __builtin_amdgcn_fence(__ATOMIC_RELEASE, "agent");
            asm volatile("s_waitcnt vmcnt(0)" ::: "memory");
            const unsigned og = xb_add(&bar[XB_TOP], 1u);
            const unsigned tg = og / nx;
            if (og + 1u == (tg + 1u) * nx) xb_add(&bar[XB_TOPGEN], 1u);
            else XB_SPIN(xb_ld(&bar[XB_TOPGEN]) == tg, bar);
            __builtin_amdgcn_fence(__ATOMIC_ACQUIRE, "agent");
            xb_add(&bar[XB_XGEN(b.x)], 1u);
            asm volatile("s_waitcnt vmcnt(0)" ::: "memory");
        } else {
            XB_SPIN(xb_ld(&bar[XB_XGEN(b.x)]) == gen, bar);
            __builtin_amdgcn_fence(__ATOMIC_ACQUIRE, "agent");
            asm volatile("s_waitcnt vmcnt(0)" ::: "memory");
        }
    }
    __syncthreads();
}

namespace g8 {
constexpr int BM = 256, BK = 64, HALF = 128, HTB = HALF * BK * 2, STAGE_BYTES = 8 * HTB;
__device__ __forceinline__ int lds_byte(int r, int c) { const int st = (r >> 4) * 2 + (c >> 5), rr = r & 15, cc = c & 31, ob = rr * 64 + cc * 2; return st * 1024 + (ob ^ (((ob >> 9) & 1) << 5)); }
__device__ __forceinline__ void stage_rc(int b, int& R, int& C) { const int st = b / 1024, sb = b % 1024, swz = sb ^ (((sb >> 9) & 1) << 5); R = (st >> 1) * 16 + swz / 64; C = (st & 1) * 32 + (swz % 64) / 2; }
__device__ __forceinline__ int perm32(int rho) { const int n = rho >> 4, i = rho & 15; return 8 * (i >> 2) + 4 * n + (i & 3); }

struct Unit { const char* a; const char* b; char* o; int kind, pm, pn, e; };

__device__ __forceinline__ int xcd_remap(int L, int nu) { const int q = nu / 8, r = nu % 8, xcd = L % 8, off = L / 8; return (xcd < r ? xcd * (q + 1) : r * (q + 1) + (xcd - r) * q) + off; }

template <class Epi, class Sched, bool GATHER>
__device__ __forceinline__ void gemm_phase(LAS unsigned char* lds, const int K, const Sched& S, const Epi& E) {
    const int tid = tid_(), wid = __builtin_amdgcn_readfirstlane(tid >> 6), lane = tid & 63, wr = wid >> 2, wc = wid & 3, fr = lane & 15, fq = lane >> 4;
    const int nt = K / BK;
    unsigned voffA[2], voffB[2];
#pragma unroll
    for (int i = 0; i < 2; ++i) { int R, C; stage_rc(tid * 16 + i * 8192, R, C); const int Rb = Epi::PERM ? ((R & ~31) + perm32(R & 31)) : R;
        voffA[i] = (unsigned)(R * K + C) * 2u; voffB[i] = (unsigned)(Rb * K + C) * 2u; }
    const size_t kstep = (size_t)(BK * 2);
    const size_t hstep = (size_t)HALF * K * 2;
    const unsigned ldsw = (unsigned)wid * 1024u;
    const int aoff = lds_byte(wr * 64 + fr, fq * 8), boff = lds_byte(wc * 32 + fr, fq * 8);
#define G8_SA(b, h) (((b) * 2 + (h)) * HTB)
#define G8_SB(b, h) ((4 + (b) * 2 + (h)) * HTB)
#define G8_ST2(bufoff, gbase, voff) do { _Pragma("unroll") for (int _i = 0; _i < 2; ++_i) \
        __builtin_amdgcn_global_load_lds((const unsigned*)((const char*)(gbase) + (voff)[_i]), (LAS unsigned*)(lds + (bufoff) + ldsw + _i * 8192), 16, 0, 0); } while (0)
#define G8_STA_CUR(bufoff, gbase, h) do { if constexpr (GATHER) { _Pragma("unroll") for (int _i = 0; _i < 2; ++_i) { const unsigned _o = ROFF[parA * 256 + (h) * 128 + (int)(rcq[_i] & 0xffffu)] + (rcq[_i] >> 16); \
        __builtin_amdgcn_global_load_lds((const unsigned*)((const char*)(gbase) + _o), (LAS unsigned*)(lds + (bufoff) + ldsw + _i * 8192), 16, 0, 0); } } else { G8_ST2(bufoff, (gbase) + (h) * hstep, voffA); } } while (0)
#define G8_LDA(dst, b, h) do { _Pragma("unroll") for (int m = 0; m < 4; ++m) _Pragma("unroll") for (int k = 0; k < 2; ++k) dst[m][k] = *(const LAS bf16x8*)(lds + G8_SA(b, h) + aoff + m * 2048 + k * 1024); } while (0)
#define G8_LDB(dst, b, h) do { _Pragma("unroll") for (int n = 0; n < 2; ++n) _Pragma("unroll") for (int k = 0; k < 2; ++k) dst[n][k] = *(const LAS bf16x8*)(lds + G8_SB(b, h) + boff + n * 2048 + k * 1024); } while (0)
#define G8_MMA(ai, bj, At, Bt) do { __builtin_amdgcn_s_setprio(1); _Pragma("unroll") for (int m = 0; m < 4; ++m) _Pragma("unroll") for (int n = 0; n < 2; ++n) _Pragma("unroll") for (int k = 0; k < 2; ++k) \
        acc[ai][bj][m][n] = __builtin_amdgcn_mfma_f32_16x16x32_bf16(Bt[n][k], At[m][k], acc[ai][bj][m][n], 0, 0, 0); __builtin_amdgcn_s_setprio(0); } while (0)
#define G8_WAIT_V(n) asm volatile("s_waitcnt vmcnt(" #n ")" ::: "memory")
#define G8_WAIT_L(n) asm volatile("s_waitcnt lgkmcnt(" #n ")" ::: "memory")
#define G8_BAR __builtin_amdgcn_s_barrier()
#define G8_SCHED __builtin_amdgcn_sched_barrier(0)
    Unit cur, nxt; int ui = 0;
    if (!S.next(0, cur)) return;
    f32x4 acc[2][2][4][2];
#pragma unroll
    for (int a = 0; a < 2; ++a)
#pragma unroll
        for (int b = 0; b < 2; ++b)
#pragma unroll
            for (int m = 0; m < 4; ++m)
#pragma unroll
                for (int n = 0; n < 2; ++n) acc[a][b][m][n] = (f32x4){0.f, 0.f, 0.f, 0.f};
    bf16x8 At[4][2], B0[2][2], B1[2][2];
    LAS unsigned* ROFF = (LAS unsigned*)(lds + STAGE_BYTES + 1024);
    unsigned rcq[2] = {0u, 0u}, pend = 0u; int parA = 0;
    if constexpr (GATHER) {
#pragma unroll
        for (int i = 0; i < 2; ++i) { int R, C; stage_rc(tid * 16 + i * 8192, R, C); rcq[i] = (unsigned)R | ((unsigned)(C * 2) << 16); }
        if (tid < 256) ROFF[tid] = (unsigned)S.row(cur, tid) * (unsigned)(K * 2);
        asm volatile("s_waitcnt lgkmcnt(0)" ::: "memory"); __builtin_amdgcn_s_barrier(); asm volatile("" ::: "memory");
    }
    const char* cA = cur.a; const char* cB = cur.b;
    G8_ST2(G8_SB(0, 0), cB, voffB); G8_ST2(G8_SB(0, 1), cB + hstep, voffB); G8_STA_CUR(G8_SA(0, 0), cA, 0); G8_STA_CUR(G8_SA(0, 1), cA, 1);
    if (wr == 1) G8_BAR;
    G8_WAIT_V(2); G8_BAR;
    G8_ST2(G8_SB(1, 0), cB + kstep, voffB); G8_STA_CUR(G8_SA(1, 0), cA + kstep, 0); G8_ST2(G8_SB(1, 1), cB + hstep + kstep, voffB);
    G8_WAIT_V(6); G8_BAR;
    for (;;) {
        const bool has_next = S.next(ui + 1, nxt);
        const char* nA = has_next ? nxt.a : cA; const char* nB = has_next ? nxt.b : cB;
        for (int t = 0; t < nt; t += 2) {
            const bool last = (t == nt - 2);
            const char* a1 = cA + (size_t)(t + 1) * kstep;
            const char* a2 = last ? nA : cA + (size_t)(t + 2) * kstep; const char* b2 = last ? nB : cB + (size_t)(t + 2) * kstep;
            const char* a3 = a2 + kstep; const char* b3 = b2 + kstep;
            if constexpr (GATHER) {
                if (has_next && t == nt - 4 && tid < 256) pend = (unsigned)S.row(nxt, tid) * (unsigned)(K * 2);
                if (has_next && last && tid < 256) ROFF[(parA ^ 1) * 256 + tid] = pend; }
            G8_LDB(B0, 0, 0); G8_LDB(B1, 0, 1); G8_SCHED; G8_LDA(At, 0, 0); G8_STA_CUR(G8_SA(1, 1), a1, 1);
            if constexpr (GATHER) { if (has_next && last) parA ^= 1; }
            G8_WAIT_V(8); G8_WAIT_L(0); G8_BAR; G8_MMA(0, 0, At, B0); G8_MMA(0, 1, At, B1); G8_BAR; G8_SCHED;
            G8_LDA(At, 0, 1); G8_ST2(G8_SB(0, 0), b2, voffB); G8_ST2(G8_SB(0, 1), b2 + hstep, voffB); G8_STA_CUR(G8_SA(0, 0), a2, 0);
            G8_WAIT_V(8); G8_WAIT_L(0); G8_BAR; G8_MMA(1, 0, At, B0); G8_MMA(1, 1, At, B1); G8_BAR; G8_SCHED;
            G8_LDB(B0, 1, 0); G8_LDB(B1, 1, 1); G8_SCHED; G8_LDA(At, 1, 0); G8_STA_CUR(G8_SA(0, 1), a2, 1);
            G8_WAIT_V(8); G8_WAIT_L(0); G8_BAR; G8_MMA(0, 0, At, B0); G8_MMA(0, 1, At, B1); G8_BAR; G8_SCHED;
            G8_LDA(At, 1, 1); G8_ST2(G8_SB(1, 0), b3, voffB); G8_ST2(G8_SB(1, 1), b3 + hstep, voffB); G8_STA_CUR(G8_SA(1, 0), a3, 0);
            G8_WAIT_V(8); G8_WAIT_L(0); G8_BAR; G8_MMA(1, 0, At, B0); G8_MMA(1, 1, At, B1); G8_BAR; G8_SCHED;
        }
        if (wr == 0) G8_BAR;
        E(acc, cur, wr, wc, fr, fq);
        if (!has_next) break;
#pragma unroll
        for (int a = 0; a < 2; ++a)
#pragma unroll
            for (int b = 0; b < 2; ++b)
#pragma unroll
                for (int m = 0; m < 4; ++m)
#pragma unroll
                    for (int n = 0; n < 2; ++n) acc[a][b][m][n] = (f32x4){0.f, 0.f, 0.f, 0.f};
        cur = nxt; cA = nA; cB = nB; ++ui;
        if (wr == 1) G8_BAR;
    }
    G8_WAIT_V(0);
    G8_BAR;
#undef G8_SA
#undef G8_SB
#undef G8_ST2
#undef G8_STA_CUR
#undef G8_LDA
#undef G8_LDB
#undef G8_MMA
#undef G8_WAIT_V
#undef G8_WAIT_L
#undef G8_BAR
#undef G8_SCHED
}
}

struct Params {
    const float *x, *c, *ctx, *c_ctx, *w_mod, *b_mod, *norm1_g, *norm2_g, *w_in, *b_in, *conv_a_w, *conv_a_b, *w_rg_r, *b_rg_r, *w_rg_i, *b_rg_i, *rg_lambda,
        *w_pool, *b_pool, *pool_scale, *w_four, *b_four, *conv_d_w, *conv_d_b, *ln_d_g, *ln_d_b, *w_pw, *b_pw, *w_out, *b_out, *w_router, *b_router,
        *w_gu, *b_gu, *w_down, *b_down, *final_norm_g;
    float* out; unsigned char* ws; int ph_lo, ph_hi;
};
typedef const Params __attribute__((address_space(4)))* CP;
__device__ __forceinline__ CP launder_params() { CP k = (CP)__builtin_amdgcn_kernarg_segment_ptr(); asm volatile("" : "+s"(k)); return k; }
__device__ __forceinline__ int row_mb(int row) { return row < TL ? (row >> 12) : 8; }

template <class RowMap>
__device__ __forceinline__ void tr_block(const float* __restrict__ src, int spitch, int k0, int n0, bf16_t* __restrict__ dst, int dpitch, int kd0, RowMap rm, LAS unsigned char* lds) {
    LAS unsigned* T = (LAS unsigned*)lds;
    const int tid = tid_();
    __syncthreads();
#pragma unroll
    for (int it = 0; it < 4; ++it) { const int task = it * 512 + tid, q = task & 63, kp = task >> 6;
        const f32x4 v0 = *(const f32x4*)(src + (size_t)(k0 + 2 * kp) * spitch + n0 + 4 * q), v1 = *(const f32x4*)(src + (size_t)(k0 + 2 * kp + 1) * spitch + n0 + 4 * q);
        u32x4 w; w.x = cvt_pk_bf16(v0[0], v1[0]); w.y = cvt_pk_bf16(v0[1], v1[1]); w.z = cvt_pk_bf16(v0[2], v1[2]); w.w = cvt_pk_bf16(v0[3], v1[3]);
        *(LAS u32x4*)(T + kp * 260 + 4 * q) = w; }
    __syncthreads();
#pragma unroll
    for (int it = 0; it < 4; ++it) { const int task = it * 512 + tid, n = task & 255, c = task >> 8;
        u32x4 w; w.x = T[(4 * c + 0) * 260 + n]; w.y = T[(4 * c + 1) * 260 + n]; w.z = T[(4 * c + 2) * 260 + n]; w.w = T[(4 * c + 3) * 260 + n];
        *(u32x4*)(dst + (size_t)rm(n0 + n) * dpitch + kd0 + 8 * c) = w; }
}
struct RmId { int off; __device__ __forceinline__ int operator()(int n) const { return n + off; } };
struct RmGu { __device__ __forceinline__ int operator()(int n) const { const int rem = n & 1023; return 256 * (rem >> 7) + 128 * (n >> 10) + (rem & 127); } };
struct RmIn { __device__ __forceinline__ int operator()(int n) const { return n < 512 ? n : n - 1024 + 768; } };

__device__ __forceinline__ void job_mod(CP p, int l, int cb, LAS unsigned char* lds) {
    LAS float* SC = (LAS float*)lds;
    LAS float* RED = (LAS float*)(lds + 49152);
    const int tid = tid_();
    __syncthreads();
    for (int i = tid; i < 9 * 1024; i += 512) { const int b = i >> 10, k = i & 1023; const float v = b < 8 ? p->c[b * 1024 + k] : p->c_ctx[k]; SC[k * 12 + b] = v * sigmoidf_(v); }
    __syncthreads();
    const int col = cb * 64 + (tid & 63), kg = tid >> 6;
    float acc[9];
#pragma unroll
    for (int b = 0; b < 9; ++b) acc[b] = 0.f;
    const float* wp = p->w_mod + (size_t)l * 1024 * 6144 + col;
#pragma unroll 8
    for (int kk = 0; kk < 128; ++kk) { const int k = kg * 128 + kk; const float w = wp[(size_t)k * 6144];
        const f32x4 s0 = *(const LAS f32x4*)(SC + k * 12), s1 = *(const LAS f32x4*)(SC + k * 12 + 4); const float s8 = SC[k * 12 + 8];
        acc[0] += s0[0] * w; acc[1] += s0[1] * w; acc[2] += s0[2] * w; acc[3] += s0[3] * w; acc[4] += s1[0] * w; acc[5] += s1[1] * w; acc[6] += s1[2] * w; acc[7] += s1[3] * w; acc[8] += s8 * w; }
#pragma unroll
    for (int b = 0; b < 9; ++b) RED[(kg * 9 + b) * 64 + (tid & 63)] = acc[b];
    __syncthreads();
    for (int i = tid; i < 9 * 64; i += 512) { const int b = i >> 6, cc = i & 63; float s = 0.f;
#pragma unroll
        for (int g = 0; g < 8; ++g) s += RED[(g * 9 + b) * 64 + cc];
        ((float*)(p->ws + WS_MODV))[(size_t)(l * 9 + b) * 6144 + cb * 64 + cc] = s + p->b_mod[l * 6144 + cb * 64 + cc]; }
}
__device__ __forceinline__ void job_fold_out(CP p, int l, int nb, LAS unsigned char* lds) {
    LAS float* WO = (LAS float*)lds;
    LAS float* PW = (LAS float*)(lds + 65536);
    const int tid = tid_(), lane = tid & 63, w = __builtin_amdgcn_readfirstlane(tid >> 6);
    __syncthreads();
#pragma unroll
    for (int it = 0; it < 8; ++it) { const int task = it * 512 + tid, j = task >> 4, q = task & 15;
        *(LAS f32x4*)(WO + j * 64 + 4 * q) = *(const f32x4*)(p->w_out + ((size_t)l * 1024 + 768 + j) * 1024 + nb * 64 + 4 * q); }
    float acc[32];
#pragma unroll
    for (int i = 0; i < 32; ++i) acc[i] = 0.f;
    for (int jc = 0; jc < 4; ++jc) {
        __syncthreads();
#pragma unroll
        for (int it = 0; it < 8; ++it) { const int task = it * 512 + tid, i = task & 255, jq = task >> 8;
            const f32x4 v = *(const f32x4*)(p->w_pw + ((size_t)l * 256 + i) * 256 + jc * 64 + 4 * jq);
            PW[(4 * jq + 0) * 256 + i] = v[0]; PW[(4 * jq + 1) * 256 + i] = v[1]; PW[(4 * jq + 2) * 256 + i] = v[2]; PW[(4 * jq + 3) * 256 + i] = v[3]; }
        __syncthreads();
        for (int jj = 0; jj < 64; ++jj) { const float b = WO[(jc * 64 + jj) * 64 + lane];
#pragma unroll
            for (int i4 = 0; i4 < 8; ++i4) { const f32x4 a = *(const LAS f32x4*)(PW + jj * 256 + 32 * w + 4 * i4);
                acc[4 * i4 + 0] += a[0] * b; acc[4 * i4 + 1] += a[1] * b; acc[4 * i4 + 2] += a[2] * b; acc[4 * i4 + 3] += a[3] * b; } }
    }
    bf16_t* dst = (bf16_t*)(p->ws + WS_WOUTT) + ((size_t)l * 1024 + nb * 64 + lane) * 1024 + 768 + 32 * w;
#pragma unroll
    for (int c = 0; c < 4; ++c) { float f[8];
#pragma unroll
        for (int e = 0; e < 8; ++e) f[e] = acc[8 * c + e];
        *(u32x4*)(dst + 8 * c) = pack8(f); }
    if (w == 0) { float s = p->b_out[l * 1024 + nb * 64 + lane];
        for (int j = 0; j < 256; ++j) s += p->b_pw[l * 256 + j] * WO[j * 64 + lane];
        ((float*)(p->ws + WS_BOUT))[l * 1024 + nb * 64 + lane] = s; }
}
__device__ __forceinline__ void job_fold_in(CP p, int l, int f, int g, int kb, LAS unsigned char* lds) {
    LAS float* M = (LAS float*)lds;
    LAS float* WI = (LAS float*)(lds + 16384);
    const int tid = tid_();
    const int cbase = f == 0 ? 512 : 768;
    __syncthreads();
#pragma unroll
    for (int it = 0; it < 8; ++it) { const int id = it * 512 + tid, i = id >> 6, j = id & 63; float s;
        if (f == 0) s = p->w_pool[(((size_t)l * 4 + g) * 64 + i) * 64 + j];
        else { s = 0.f; for (int m = 0; m < 64; ++m) { const float ang = (float)((i * m) & 63) * (1.0f / 32.0f); const float tr = f == 1 ? cospif(ang) : sinpif(ang);
                   s += tr * p->w_four[(((size_t)l * 4 + g) * 64 + m) * 64 + j]; } }
        M[i * 64 + j] = s; }
#pragma unroll
    for (int it = 0; it < 8; ++it) { const int task = it * 512 + tid, kk = task >> 4, i4 = task & 15;
        const f32x4 v = *(const f32x4*)(p->w_in + ((size_t)l * 1024 + kb * 256 + kk) * 1536 + cbase + 64 * g + 4 * i4);
        WI[kk * 65 + 4 * i4 + 0] = v[0]; WI[kk * 65 + 4 * i4 + 1] = v[1]; WI[kk * 65 + 4 * i4 + 2] = v[2]; WI[kk * 65 + 4 * i4 + 3] = v[3]; }
    __syncthreads();
    const int kk = tid & 255, jh = tid >> 8;
    float acc[32];
#pragma unroll
    for (int j = 0; j < 32; ++j) acc[j] = 0.f;
    for (int i = 0; i < 64; ++i) { const float a = WI[kk * 65 + i];
#pragma unroll
        for (int j4 = 0; j4 < 8; ++j4) { const f32x4 m = *(const LAS f32x4*)(M + i * 64 + 32 * jh + 4 * j4);
            acc[4 * j4 + 0] += a * m[0]; acc[4 * j4 + 1] += a * m[1]; acc[4 * j4 + 2] += a * m[2]; acc[4 * j4 + 3] += a * m[3]; } }
    bf16_t* dst = f == 0 ? (bf16_t*)(p->ws + WS_WINT) + ((size_t)l * NPROJ + 512 + 64 * g) * 1024 : (bf16_t*)(p->ws + WS_WFT) + ((size_t)l * 512 + (f - 1) * 256 + 64 * g) * 1024;
#pragma unroll
    for (int j = 0; j < 32; ++j) dst[(size_t)(32 * jh + j) * 1024 + kb * 256 + kk] = f2bf(acc[j]);
    if (kb == 0 && f >= 1 && tid < 64) { float s = 0.f;
        for (int i = 0; i < 64; ++i) s += p->b_in[l * 1536 + 768 + 64 * g + i] * M[i * 64 + tid];
        ((float*)(p->ws + WS_BF))[l * 512 + (f - 1) * 256 + 64 * g + tid] = s; }
    if (kb == 0 && f == 0 && g == 0) for (int i = tid; i < NPROJ; i += 512)
        ((float*)(p->ws + WS_BIN))[l * NPROJ + i] = i < 512 ? p->b_in[l * 1536 + i] : (i < 768 ? 0.f : p->b_in[l * 1536 + i - 768 + 1024]);
}
__device__ __forceinline__ void job_small(CP p, int j) {
    const int tid = tid_();
    if (j < 32) {
        const int l = j >> 4, d = (j >> 3) & 1, gate = (j >> 2) & 1, hd = j & 3;
        const float* src = (gate ? p->w_rg_i : p->w_rg_r) + ((size_t)((l * 2 + d) * 4 + hd)) * 4096;
        bf16_t* dst = (bf16_t*)(p->ws + WS_WGT) + (size_t)j * 4096;
        for (int id = tid; id < 4096; id += 512) { const int n = id >> 6, k = id & 63; dst[id] = f2bf(src[k * 64 + n]); }
        return; }
    j -= 32;
    if (j < 2) {
        const int l = j; bf16_t* hi = (bf16_t*)(p->ws + WS_WRT) + (size_t)l * 2 * NE * 1024; bf16_t* lo = hi + NE * 1024;
        for (int id = tid; id < NE * 1024; id += 512) { const int e = id >> 10, c = id & 1023; const float v = p->w_router[((size_t)l * 1024 + c) * NE + e];
            const bf16_t h = f2bf(v); hi[id] = h; lo[id] = f2bf(v - bf2f(h)); }
        return; }
    j -= 2;
    if (j < 144 + 128) {
        const bool sn = j >= 144; const int r0 = (sn ? j - 144 : j) * 16; bf16_t* dst = (bf16_t*)(p->ws + (sn ? WS_SMAT : WS_CMAT));
        for (int id = tid; id < 16 * 4096; id += 512) { const int k = r0 + (id >> 12), t = id & 4095; const float ang = (float)((k * t) & 4095) * (1.0f / 2048.0f);
            dst[(size_t)k * 4096 + t] = f2bf(sn ? sinpif(ang) : cospif(ang)); }
        return; }
    j -= 272;
    {
        bf16_t* dst = (bf16_t*)(p->ws + WS_DFTC);
        for (int id = tid; id < 256 * 512; id += 512) { const int k = id >> 9, jj = id & 511, t = jj & 255; const float ang = (float)((k * t) & 255) * (1.0f / 128.0f);
            dst[id] = f2bf(jj < 256 ? cospif(ang) : -sinpif(ang)); }
    }
}
constexpr int J_MOD = 192, J_FOUT = 32, J_FIN = 96, J_SMALL = 32 + 2 + 272 + 1, J_TIN = 128, J_TOUT = 96, J_TGU = 8192, J_TD = 4096;
constexpr int J_TOTAL = J_MOD + J_FOUT + J_FIN + J_SMALL + J_TIN + J_TOUT + J_TGU + J_TD;
__device__ __forceinline__ void phase_prologue(CP p, LAS unsigned char* lds) {
    for (int job = blockIdx.x; job < J_TOTAL; job += gridDim.x) {
        int j = job;
        if (j < J_MOD) { job_mod(p, j / 96, j % 96, lds); continue; } j -= J_MOD;
        if (j < J_FOUT) { job_fold_out(p, j >> 4, j & 15, lds); continue; } j -= J_FOUT;
        if (j < J_FIN) { const int l = j / 48, r = j % 48; job_fold_in(p, l, r / 16, (r >> 2) & 3, r & 3, lds); continue; } j -= J_FIN;
        if (j < J_SMALL) { job_small(p, j); continue; } j -= J_SMALL;
        if (j < J_TIN) { const int l = j >> 6, r = j & 63, kb = r >> 2, q = r & 3;
            tr_block(p->w_in + (size_t)l * 1024 * 1536, 1536, kb * 64, q < 2 ? q * 256 : 1024 + (q - 2) * 256, (bf16_t*)(p->ws + WS_WINT) + (size_t)l * NPROJ * 1024, 1024, kb * 64, RmIn{}, lds); continue; } j -= J_TIN;
        if (j < J_TOUT) { const int l = j / 48, r = j % 48, kb = r >> 2, q = r & 3;
            tr_block(p->w_out + (size_t)l * 1024 * 1024, 1024, kb * 64, q * 256, (bf16_t*)(p->ws + WS_WOUTT) + (size_t)l * 1024 * 1024, 1024, kb * 64, RmId{0}, lds); continue; } j -= J_TOUT;
        if (j < J_TGU) { const int le = j >> 7, r = j & 127, kb = r >> 3, q = r & 7;
            tr_block(p->w_gu + (size_t)le * 1024 * 2048, 2048, kb * 64, q * 256, (bf16_t*)(p->ws + WS_WGUT) + (size_t)le * 2048 * 1024, 1024, kb * 64, RmGu{}, lds); continue; } j -= J_TGU;
        { const int le = j >> 6, r = j & 63, kb = r >> 2, q = r & 3;
            tr_block(p->w_down + (size_t)le * 1024 * 1024, 1024, kb * 64, q * 256, (bf16_t*)(p->ws + WS_WDT) + (size_t)le * 1024 * 1024, 1024, kb * 64, RmId{0}, lds); }
    }
}

__device__ __forceinline__ void phase_norm(CP p, int mode) {
    const int tid = tid_(), lane = tid & 63, wid = tid >> 6;
    float* X = (float*)(p->ws + WS_X); bf16_t* U = (bf16_t*)(p->ws + WS_U); const bf16_t* YS = (const bf16_t*)(p->ws + WS_YS); const float* modv = (const float*)(p->ws + WS_MODV);
    float om[4];
#pragma unroll
    for (int i = 0; i < 4; ++i) om[i] = exp2f(-(float)(4 * lane + i) * (13.287712379549449f / 256.0f));
    const int nrows = mode == 2 ? TL : TT;
    const int lprev = mode == 2 ? 1 : 0, lcur = mode == 0 ? 0 : 1;
    for (int row = blockIdx.x * 8 + wid; row < nrows; row += gridDim.x * 8) {
        const int mb = row_mb(row);
        f32x4 v[4];
        if (mode == 0) {
            if (row < TL) { const int t = row & 4095; const float pr = (float)(t >> 6), pc = (float)(t & 63);
#pragma unroll
                for (int j = 0; j < 4; ++j) { v[j] = *(const f32x4*)(p->x + (size_t)row * D + 256 * j + 4 * lane);
#pragma unroll
                    for (int i = 0; i < 4; ++i) { const float a = (j < 2 ? pr : pc) * om[i]; v[j][i] += (j & 1) ? cosf(a) : sinf(a); } }
            } else {
#pragma unroll
                for (int j = 0; j < 4; ++j) v[j] = *(const f32x4*)(p->ctx + (size_t)(row - TL) * D + 256 * j + 4 * lane);
            }
        } else {
            const float* g2 = modv + (size_t)(lprev * 9 + mb) * 6144 + 5120;
#pragma unroll
            for (int j = 0; j < 4; ++j) { v[j] = *(const f32x4*)(X + (size_t)row * D + 256 * j + 4 * lane); f32x4 s = {0.f, 0.f, 0.f, 0.f};
#pragma unroll
                for (int k = 0; k < 4; ++k) { const u32x2 w = *(const u32x2*)(YS + ((size_t)row * 4 + k) * D + 256 * j + 4 * lane); s[0] += bflo(w.x); s[1] += bfhi(w.x); s[2] += bflo(w.y); s[3] += bfhi(w.y); }
                v[j] += *(const f32x4*)(g2 + 256 * j + 4 * lane) * s; }
        }
        float ss = 0.f;
#pragma unroll
        for (int j = 0; j < 4; ++j) ss += v[j][0] * v[j][0] + v[j][1] * v[j][1] + v[j][2] * v[j][2] + v[j][3] * v[j][3];
        ss = wave_sum(ss, lane);
        const float rstd = rsqrtf(ss * (1.0f / 1024.0f) + 1e-6f);
        if (mode == 2) {
#pragma unroll
            for (int j = 0; j < 4; ++j) *(f32x4*)(p->out + (size_t)row * D + 256 * j + 4 * lane) = v[j] * rstd * *(const f32x4*)(p->final_norm_g + 256 * j + 4 * lane);
        } else {
            const float* mv = modv + (size_t)(lcur * 9 + mb) * 6144;
#pragma unroll
            for (int j = 0; j < 4; ++j) { const int col = 256 * j + 4 * lane;
                *(f32x4*)(X + (size_t)row * D + col) = v[j];
                const f32x4 g = *(const f32x4*)(p->norm1_g + lcur * D + col), sc = *(const f32x4*)(mv + 1024 + col), sh = *(const f32x4*)(mv + col);
                const f32x4 u = v[j] * rstd * g * (sc + 1.0f) + sh;
                u32x2 w; w.x = cvt_pk_bf16(u[0], u[1]); w.y = cvt_pk_bf16(u[2], u[3]); *(u32x2*)(U + (size_t)row * D + col) = w; }
        }
    }
}

constexpr int HP = 2064;
__device__ __forceinline__ void phase_router(CP p, int l, LAS unsigned char* lds) {
    LAS unsigned char* HHI = lds; LAS unsigned char* HLO = lds + 32 * HP;
    LAS float* LG = (LAS float*)(lds + 64 * HP);
    LAS int* hist = (LAS int*)(lds + 64 * HP + 8448); LAS int* basee = hist + 32;
    const int tid = tid_(), lane = tid & 63, wid = __builtin_amdgcn_readfirstlane(tid >> 6), fr = lane & 15, fq = lane >> 4;
    const float* X = (const float*)(p->ws + WS_X); bf16_t* U = (bf16_t*)(p->ws + WS_U); const float* modv = (const float*)(p->ws + WS_MODV);
    unsigned* ctl = (unsigned*)(p->ws + WS_CTL); int* rasg = (int*)(p->ws + WS_RASG); float* gate = (float*)(p->ws + WS_GATE);
    const bf16_t* wrt = (const bf16_t*)(p->ws + WS_WRT) + (size_t)l * 2 * NE * 1024;
    const int ntiles = (l == 0 ? TT : TL) / 32;
    for (int tile = blockIdx.x; tile < ntiles; tile += gridDim.x) {
        const int row0 = tile * 32, mb = row_mb(row0);
        const float* mv = modv + (size_t)(l * 9 + mb) * 6144;
        __syncthreads();
        if (tid < 32) hist[tid] = 0;
        for (int rr = 0; rr < 4; ++rr) { const int r = wid * 4 + rr, row = row0 + r;
            f32x4 v[4]; float ss = 0.f;
#pragma unroll
            for (int j = 0; j < 4; ++j) { v[j] = *(const f32x4*)(X + (size_t)row * D + 256 * j + 4 * lane); ss += v[j][0] * v[j][0] + v[j][1] * v[j][1] + v[j][2] * v[j][2] + v[j][3] * v[j][3]; }
            ss = wave_sum(ss, lane); const float rstd = rsqrtf(ss * (1.0f / 1024.0f) + 1e-6f);
#pragma unroll
            for (int j = 0; j < 4; ++j) { const int col = 256 * j + 4 * lane;
                const f32x4 g = *(const f32x4*)(p->norm2_g + l * D + col), sc = *(const f32x4*)(mv + 4096 + col), sh = *(const f32x4*)(mv + 3072 + col);
                const f32x4 h = v[j] * rstd * g * (sc + 1.0f) + sh;
                u32x2 w; w.x = cvt_pk_bf16(h[0], h[1]); w.y = cvt_pk_bf16(h[2], h[3]); *(u32x2*)(U + (size_t)row * D + col) = w;
                u32x2 wl; wl.x = cvt_pk_bf16(h[0] - bflo(w.x), h[1] - bfhi(w.x)); wl.y = cvt_pk_bf16(h[2] - bflo(w.y), h[3] - bfhi(w.y));
                *(LAS u32x2*)(HHI + r * HP + col * 2) = w; *(LAS u32x2*)(HLO + r * HP + col * 2) = wl; }
        }
        __syncthreads();
        { const int mt = wid & 1, ntl = (wid >> 1) & 1, kh = wid >> 2;
          f32x4 acc = {0.f, 0.f, 0.f, 0.f};
          const bf16_t* bh = wrt + (size_t)(16 * ntl + fr) * 1024 + kh * 512 + 8 * fq; const bf16_t* bl = bh + NE * 1024;
          const LAS unsigned char* ah = HHI + (16 * mt + fr) * HP + (kh * 512 + 8 * fq) * 2; const LAS unsigned char* al = HLO + (16 * mt + fr) * HP + (kh * 512 + 8 * fq) * 2;
#pragma unroll 4
          for (int s = 0; s < 16; ++s) { const bf16x8 Ah = *(const LAS bf16x8*)(ah + s * 64), Al = *(const LAS bf16x8*)(al + s * 64); const bf16x8 Bh = *(const bf16x8*)(bh + s * 32), Bl = *(const bf16x8*)(bl + s * 32);
              acc = __builtin_amdgcn_mfma_f32_16x16x32_bf16(Ah, Bh, acc, 0, 0, 0); acc = __builtin_amdgcn_mfma_f32_16x16x32_bf16(Ah, Bl, acc, 0, 0, 0); acc = __builtin_amdgcn_mfma_f32_16x16x32_bf16(Al, Bh, acc, 0, 0, 0); }
#pragma unroll
          for (int j = 0; j < 4; ++j) LG[(kh * 32 + 16 * mt + 4 * fq + j) * 33 + 16 * ntl + fr] = acc[j]; }
        __syncthreads();
        int ek[4] = {0, 0, 0, 0}, rk[4] = {0, 0, 0, 0}; float gk[4] = {0.f, 0.f, 0.f, 0.f};
        if (tid < 32) { float lg[32];
#pragma unroll
            for (int e = 0; e < 32; ++e) lg[e] = LG[tid * 33 + e] + LG[(32 + tid) * 33 + e] + p->b_router[l * NE + e];
            float vk[4];
#pragma unroll
            for (int k = 0; k < 4; ++k) { float best = -3.0e38f; int bi = 0;
#pragma unroll
                for (int e = 0; e < 32; ++e) if (lg[e] > best) { best = lg[e]; bi = e; }
                vk[k] = best; ek[k] = bi;
#pragma unroll
                for (int e = 0; e < 32; ++e) if (e == bi) lg[e] = -3.0e38f; }
            float sum = 0.f;
#pragma unroll
            for (int k = 0; k < 4; ++k) { gk[k] = __expf(vk[k] - vk[0]); sum += gk[k]; }
            const float inv = 1.0f / sum;
#pragma unroll
            for (int k = 0; k < 4; ++k) { gk[k] *= inv; rk[k] = __hip_atomic_fetch_add(hist + ek[k], 1, __ATOMIC_RELAXED, __HIP_MEMORY_SCOPE_WORKGROUP); } }
        __syncthreads();
        if (tid < 32) { const int h = hist[tid]; basee[tid] = h ? (int)__hip_atomic_fetch_add(ctl + CW_COUNT + (l * NE + tid) * 64, (unsigned)h, __ATOMIC_RELAXED, __HIP_MEMORY_SCOPE_AGENT) : 0; }
        __syncthreads();
        if (tid < 32) { const int tok = row0 + tid;
#pragma unroll
            for (int k = 0; k < 4; ++k) { rasg[(size_t)ek[k] * TT + basee[ek[k]] + rk[k]] = tok * 4 + k; gate[tok * 4 + k] = gk[k]; } }
    }
}

constexpr int XCP = 144;
template <int PASS>
__device__ __forceinline__ void scan_unit(CP p, int l, int q, LAS unsigned char* lds) {
    const int tid = tid_(), lane = tid & 63, wid = __builtin_amdgcn_readfirstlane(tid >> 6), d = wid >> 2, hd = wid & 3, fr = lane & 15, fq = lane >> 4;
    LAS unsigned char* XC = lds + wid * (64 * XCP);
    LAS float* CAR = (LAS float*)(lds + 8 * 64 * XCP + wid * 256);
    LAS unsigned char* HB = lds + 8 * 64 * XCP + 2048;
    const bf16_t* PROJ = (const bf16_t*)(p->ws + WS_PROJ); float* SUMM = (float*)(p->ws + WS_SUMM);
    const bool lat = q < 512; const int b = lat ? q >> 6 : (q - 512) >> 2, jc = lat ? q & 63 : (q - 512) & 3, L = lat ? SEQ : LCX, rowbase = lat ? b * SEQ : TL + b * LCX, t0 = jc * 64;
    __syncthreads();
    { const int c = 64 * hd + lane; const float* cw = p->conv_a_w + ((size_t)(l * 2 + d) * 4) * 256 + c;
      const float w0 = cw[0], w1 = cw[256], w2 = cw[512], w3 = cw[768], cb = p->conv_a_b[(l * 2 + d) * 256 + c];
      const float k0 = d ? w3 : w0, k1 = d ? w2 : w1, k2 = d ? w1 : w2, k3 = d ? w0 : w3;
      const int f0 = d ? t0 : t0 - 3;
      auto ld = [&](int tt) -> float { return (tt >= 0 && tt < L) ? bf2f(PROJ[(size_t)(rowbase + tt) * NPROJ + c]) : 0.f; };
      float xa_ = ld(f0), xb_ = ld(f0 + 1), xc_ = ld(f0 + 2);
#pragma unroll 8
      for (int t = 0; t < 64; ++t) { const float xd_ = ld(f0 + t + 3); const float v = k0 * xa_ + k1 * xb_ + k2 * xc_ + k3 * xd_ + cb;
          *(LAS bf16_t*)(XC + t * XCP + lane * 2) = f2bf(v); xa_ = xb_; xb_ = xc_; xc_ = xd_; } }
    asm volatile("" ::: "memory");
    if (PASS == 2) { const int c = 64 * hd + lane; float car = 0.f;
        auto step = [&](int qq) { const float* s = SUMM + ((size_t)qq * 2 + d) * 512; car = s[c] * car + s[256 + c]; };
        if (d == 0) { const int nc = lat ? 4 : jc; for (int j = 0; j < nc; ++j) step(512 + b * 4 + j); if (lat) for (int j = 0; j < jc; ++j) step(b * 64 + j); }
        else { const int lo = lat ? 0 : jc + 1; for (int j = 3; j >= lo; --j) step(512 + b * 4 + j); if (lat) for (int j = 63; j > jc; --j) step(b * 64 + j); }
        CAR[lane] = car; }
    float cr[4], at[4], sp[4], brr[4], bii[4];
#pragma unroll
    for (int n = 0; n < 4; ++n) { const int ch = 16 * n + fr; cr[n] = PASS == 2 ? CAR[ch] : 0.f; at[n] = 1.f;
        const float lam = p->rg_lambda[(l * 2 + d) * 256 + 64 * hd + ch]; sp[n] = log1pf(__expf(-lam));
        brr[n] = p->b_rg_r[((l * 2 + d) * 4 + hd) * 64 + ch]; bii[n] = p->b_rg_i[((l * 2 + d) * 4 + hd) * 64 + ch]; }
    const bf16_t* wg = (const bf16_t*)(p->ws + WS_WGT) + (size_t)((l * 2 + d) * 2) * 4 * 4096;
    const int src1 = d ? lane + 16 : lane - 16, src2 = d ? lane + 32 : lane - 32, srct = d ? fr : 48 + fr;
    const bool has1 = d ? fq <= 2 : fq >= 1, has2 = d ? fq <= 1 : fq >= 2;
    for (int n = 0; n < 4; ++n) {
        bf16x8 Br[2], Bi[2];
#pragma unroll
        for (int s = 0; s < 2; ++s) { Br[s] = *(const bf16x8*)(wg + ((size_t)(0 * 4 + hd) * 64 + 16 * n + fr) * 64 + 32 * s + 8 * fq); Bi[s] = *(const bf16x8*)(wg + ((size_t)(1 * 4 + hd) * 64 + 16 * n + fr) * 64 + 32 * s + 8 * fq); }
        for (int mi = 0; mi < 4; ++mi) { const int mt = d ? 3 - mi : mi;
            const bf16x8 A0 = *(const LAS bf16x8*)(XC + (16 * mt + fr) * XCP + (8 * fq) * 2), A1 = *(const LAS bf16x8*)(XC + (16 * mt + fr) * XCP + (32 + 8 * fq) * 2);
            f32x4 ar = {0.f, 0.f, 0.f, 0.f}, ai = {0.f, 0.f, 0.f, 0.f};
            ar = __builtin_amdgcn_mfma_f32_16x16x32_bf16(A0, Br[0], ar, 0, 0, 0); ar = __builtin_amdgcn_mfma_f32_16x16x32_bf16(A1, Br[1], ar, 0, 0, 0);
            ai = __builtin_amdgcn_mfma_f32_16x16x32_bf16(A0, Bi[0], ai, 0, 0, 0); ai = __builtin_amdgcn_mfma_f32_16x16x32_bf16(A1, Bi[1], ai, 0, 0, 0);
            float a_[4], b_[4];
#pragma unroll
            for (int j = 0; j < 4; ++j) { const int tok = 16 * mt + 4 * fq + j; const float xcv = bf2f(*(const LAS bf16_t*)(XC + tok * XCP + (16 * n + fr) * 2));
                const float r = sigmoidf_(ar[j] + brr[n]), ig = sigmoidf_(ai[j] + bii[n]); const float a = __expf(-8.0f * r * sp[n]);
                a_[j] = a; b_[j] = sqrtf(fmaxf(1.0f - a * a, 0.f)) * (ig * xcv); }
            float Hj[4], Aj[4];
            if (d == 0) { Hj[0] = b_[0]; Aj[0] = a_[0];
#pragma unroll
                for (int j = 1; j < 4; ++j) { Hj[j] = a_[j] * Hj[j - 1] + b_[j]; Aj[j] = a_[j] * Aj[j - 1]; } }
            else { Hj[3] = b_[3]; Aj[3] = a_[3];
#pragma unroll
                for (int j = 2; j >= 0; --j) { Hj[j] = a_[j] * Hj[j + 1] + b_[j]; Aj[j] = a_[j] * Aj[j + 1]; } }
            float iA = d ? Aj[0] : Aj[3], iH = d ? Hj[0] : Hj[3];
            { const float pA = bperm(iA, src1), pH = bperm(iH, src1); if (has1) { iH = iA * pH + iH; iA = iA * pA; } }
            { const float pA = bperm(iA, src2), pH = bperm(iH, src2); if (has2) { iH = iA * pH + iH; iA = iA * pA; } }
            float eA = bperm(iA, src1), eH = bperm(iH, src1); if (!has1) { eA = 1.f; eH = 0.f; }
            const float tA = bperm(iA, srct), tH = bperm(iH, srct);
            const float hin = eH + eA * cr[n];
            if (PASS == 2) {
#pragma unroll
                for (int j = 0; j < 4; ++j) { const int tok = 16 * mt + 4 * fq + j; *(LAS bf16_t*)(HB + ((d * 64 + tok) * 256 + 64 * hd + 16 * n + fr) * 2) = f2bf(Hj[j] + Aj[j] * hin); } }
            cr[n] = tH + tA * cr[n]; at[n] *= tA;
        }
    }
    if (PASS == 1) { if (fq == 0) {
#pragma unroll
            for (int n = 0; n < 4; ++n) { float* s = SUMM + ((size_t)q * 2 + d) * 512 + 64 * hd + 16 * n + fr; s[0] = at[n]; s[256] = cr[n]; } } }
    else {
        __syncthreads();
        bf16_t* Y = (bf16_t*)(p->ws + WS_YCAT);
#pragma unroll
        for (int it = 0; it < 4; ++it) { const int task = it * 512 + tid, tok = task >> 5, cg = task & 31; const size_t row = (size_t)rowbase + t0 + tok;
            float hf[8], hb[8], ga[8], y[8];
            unpack8(*(const LAS u32x4*)(HB + ((0 * 64 + tok) * 256 + 8 * cg) * 2), hf); unpack8(*(const LAS u32x4*)(HB + ((1 * 64 + tok) * 256 + 8 * cg) * 2), hb);
            unpack8(*(const u32x4*)(PROJ + row * NPROJ + 256 + 8 * cg), ga);
#pragma unroll
            for (int e = 0; e < 8; ++e) { const float g = ga[e]; const float tt = tanhf(0.7978845608028654f * (g + 0.044715f * g * g * g)); y[e] = (hf[e] + hb[e]) * (0.5f * g * (1.0f + tt)); }
            *(u32x4*)(Y + row * D + 8 * cg) = pack8(y); }
    }
}

__device__ __forceinline__ void pool_four_unit(CP p, int l, int q, LAS unsigned char* lds) {
    LAS float* PB = (LAS float*)lds;
    const int tid = tid_();
    const bf16_t* PROJ = (const bf16_t*)(p->ws + WS_PROJ); bf16_t* Y = (bf16_t*)(p->ws + WS_YCAT);
    const bool lat = q < 512; const int b = lat ? q >> 6 : (q - 512) >> 2, jc = lat ? q & 63 : (q - 512) & 3, L = lat ? SEQ : LCX, rowbase = lat ? b * SEQ : TL + b * LCX, t0 = jc * 64;
    __syncthreads();
    for (int task = tid; task < 80 * 32; task += 512) { const int r = task >> 5, cg = task & 31, tt = t0 - 8 + r; float f[8];
        if (tt >= 0 && tt < L) unpack8(*(const u32x4*)(PROJ + (size_t)(rowbase + tt) * NPROJ + 512 + 8 * cg), f); else {
#pragma unroll
            for (int e = 0; e < 8; ++e) f[e] = 0.f; }
        *(LAS f32x4*)(PB + r * 256 + 8 * cg) = (f32x4){f[0], f[1], f[2], f[3]}; *(LAS f32x4*)(PB + r * 256 + 8 * cg + 4) = (f32x4){f[4], f[5], f[6], f[7]}; }
    __syncthreads();
    { const int c = tid & 255, th = tid >> 8, hw = 1 << (c >> 6); const float bp = p->b_pool[l * 256 + c], ps = p->pool_scale[l * 256 + c];
      for (int o = 0; o < 32; ++o) { const int tl = 32 * th + o, t = t0 + tl; const int lo = max(t - hw, 0), hi = min(t + hw, L); float s = 0.f;
          for (int tt = lo; tt < hi; ++tt) s += PB[(tt - t0 + 8) * 256 + c];
          const float yv = (s / (float)(hi - lo) - PB[(tl + 8) * 256 + c] + bp) * ps;
          Y[(size_t)(rowbase + t) * D + 256 + c] = f2bf(yv); } }
    const float* UU = (const float*)(p->ws + WS_UU); const float* VV = (const float*)(p->ws + WS_VV); const float* YCX = (const float*)(p->ws + WS_YCX);
#pragma unroll
    for (int it = 0; it < 4; ++it) { const int task = it * 512 + tid, tl = task >> 5, cg = task & 31, t = t0 + tl; float y[8];
        f32x4 u0, u1, v0 = {0.f, 0.f, 0.f, 0.f}, v1 = {0.f, 0.f, 0.f, 0.f}; float sgn, scale;
        if (lat) { const int k = t <= 2048 ? t : 4096 - t; sgn = t <= 2048 ? -1.0f : 1.0f; scale = 1.0f / 512.0f;
            const float* up = UU + (size_t)k * 2048 + b * 256 + 8 * cg; u0 = *(const f32x4*)up; u1 = *(const f32x4*)(up + 4);
            if (k < 2048) { const float* vp = VV + (size_t)k * 2048 + b * 256 + 8 * cg; v0 = *(const f32x4*)vp; v1 = *(const f32x4*)(vp + 4); } }
        else { sgn = 0.f; scale = 1.0f / 128.0f; const float* up = YCX + (size_t)t * 2048 + b * 256 + 8 * cg; u0 = *(const f32x4*)up; u1 = *(const f32x4*)(up + 4); }
        const f32x4 bf0 = *(const f32x4*)(p->b_four + l * 256 + 8 * cg), bf1 = *(const f32x4*)(p->b_four + l * 256 + 8 * cg + 4);
        const f32x4 r0 = (u0 + v0 * sgn) * scale + bf0, r1 = (u1 + v1 * sgn) * scale + bf1;
        y[0] = r0[0]; y[1] = r0[1]; y[2] = r0[2]; y[3] = r0[3]; y[4] = r1[0]; y[5] = r1[1]; y[6] = r1[2]; y[7] = r1[3];
        *(u32x4*)(Y + (size_t)(rowbase + t) * D + 512 + 8 * cg) = pack8(y); }
}
__device__ __forceinline__ void conformer_unit(CP p, int l, int q, LAS unsigned char* lds) {
    LAS float* V = (LAS float*)lds;
    const int tid = tid_(), lane = tid & 63, wid = __builtin_amdgcn_readfirstlane(tid >> 6), hd = wid & 3, th = wid >> 2;
    const bf16_t* PROJ = (const bf16_t*)(p->ws + WS_PROJ); bf16_t* Y = (bf16_t*)(p->ws + WS_YCAT);
    const bool lat = q < 512; const int b = lat ? q >> 6 : (q - 512) >> 2, jc = lat ? q & 63 : (q - 512) & 3, L = lat ? SEQ : LCX, rowbase = lat ? b * SEQ : TL + b * LCX, t0 = jc * 64;
    __syncthreads();
    for (int task = tid; task < 94 * 32; task += 512) { const int r = task >> 5, cg = task & 31, tt = t0 - 15 + r; float f[8];
        if (tt >= 0 && tt < L) { float a[8], g[8]; const bf16_t* pr = PROJ + (size_t)(rowbase + tt) * NPROJ + 768 + 8 * cg; unpack8(*(const u32x4*)pr, a); unpack8(*(const u32x4*)(pr + 256), g);
#pragma unroll
            for (int e = 0; e < 8; ++e) f[e] = a[e] * sigmoidf_(g[e]); }
        else {
#pragma unroll
            for (int e = 0; e < 8; ++e) f[e] = 0.f; }
        *(LAS f32x4*)(V + r * 256 + 8 * cg) = (f32x4){f[0], f[1], f[2], f[3]}; *(LAS f32x4*)(V + r * 256 + 8 * cg + 4) = (f32x4){f[4], f[5], f[6], f[7]}; }
    __syncthreads();
    const int c = 64 * hd + lane;
    float wk[31];
#pragma unroll
    for (int k = 0; k < 31; ++k) wk[k] = p->conv_d_w[((size_t)l * 31 + k) * 256 + c];
    const float cb = p->conv_d_b[l * 256 + c], lg = p->ln_d_g[l * 256 + c], lb = p->ln_d_b[l * 256 + c];
    for (int blk = 0; blk < 4; ++blk) { const int tl0 = 32 * th + 8 * blk;
        float win[38];
#pragma unroll
        for (int i = 0; i < 38; ++i) win[i] = V[(tl0 + i) * 256 + c];
#pragma unroll
        for (int o = 0; o < 8; ++o) { float s = cb;
#pragma unroll
            for (int k = 0; k < 31; ++k) s += wk[k] * win[o + k];
            const float mean = wave_sum(s, lane) * (1.0f / 64.0f); const float dv = s - mean; const float var = wave_sum(dv * dv, lane) * (1.0f / 64.0f);
            float yv = dv * rsqrtf(var + 1e-6f) * lg + lb; yv = yv * sigmoidf_(yv);
            Y[(size_t)(rowbase + t0 + tl0 + o) * D + 768 + c] = f2bf(yv); } }
}

struct SchedIn { const char *U, *W, *WF; char *PROJ, *PQT, *PQC;
    __device__ __forceinline__ bool next(int i, g8::Unit& u) const { const int L = i * (int)gridDim.x + (int)blockIdx.x; if (L >= 952) return false; const int id = g8::xcd_remap(L, 952);
        if (id < 680) { u.kind = 0; u.pm = id / 5; u.pn = id % 5; u.a = U + (size_t)u.pm * 256 * 2048; u.b = W + (size_t)u.pn * 256 * 2048; u.o = PROJ; u.e = 0; }
        else { const int r = id - 680; u.kind = 1; u.pm = r & 1; u.pn = r >> 1; u.a = WF + (size_t)u.pm * 256 * 2048; u.b = U + (size_t)u.pn * 256 * 2048; u.e = 0;
            if (u.pn < 128) u.o = PQT + ((size_t)(u.pm * 2048 + (u.pn >> 4) * 256) * 4096 + (u.pn & 15) * 256) * 2; else u.o = PQC + ((size_t)((u.pn - 128) * 256) * 512 + u.pm * 256) * 2; }
        return true; } };
struct EpiIn { static constexpr bool PERM = true; const float* bin; const float* bf;
    __device__ __forceinline__ void operator()(const f32x4 (&acc)[2][2][4][2], const g8::Unit& u, int wr, int wc, int fr, int fq) const {
        asm volatile("" : "+v"(fr), "+v"(fq));
        if (u.kind == 0) { const int row0 = u.pm * 256 + wr * 64 + fr, col0 = u.pn * 256 + wc * 32 + 8 * fq; bf16_t* O = (bf16_t*)u.o;
            f32x4 bv[2][2];
#pragma unroll
            for (int bj = 0; bj < 2; ++bj)
#pragma unroll
                for (int n = 0; n < 2; ++n) bv[bj][n] = *(const f32x4*)(bin + col0 + bj * 128 + 4 * n);
#pragma unroll
            for (int ai = 0; ai < 2; ++ai)
#pragma unroll
                for (int m = 0; m < 4; ++m) { bf16_t* rowp = O + (size_t)(row0 + ai * 128 + m * 16) * NPROJ + col0;
#pragma unroll
                    for (int bj = 0; bj < 2; ++bj) { const f32x4 v0 = acc[ai][bj][m][0] + bv[bj][0], v1 = acc[ai][bj][m][1] + bv[bj][1];
                        u32x4 w; w.x = cvt_pk_bf16(v0[0], v0[1]); w.y = cvt_pk_bf16(v0[2], v0[3]); w.z = cvt_pk_bf16(v1[0], v1[1]); w.w = cvt_pk_bf16(v1[2], v1[3]); *(u32x4*)(rowp + bj * 128) = w; } }
        } else { const int pitch = u.pn < 128 ? 4096 : 512; bf16_t* O = (bf16_t*)u.o; const int col0 = wc * 32 + 8 * fq;
#pragma unroll
            for (int ai = 0; ai < 2; ++ai)
#pragma unroll
                for (int m = 0; m < 4; ++m) { const int r = ai * 128 + wr * 64 + m * 16 + fr; const float bb = bf[u.pm * 256 + r]; bf16_t* rowp = O + (size_t)r * pitch + col0;
#pragma unroll
                    for (int bj = 0; bj < 2; ++bj) { const f32x4 v0 = acc[ai][bj][m][0] + bb, v1 = acc[ai][bj][m][1] + bb;
                        u32x4 w; w.x = cvt_pk_bf16(v0[0], v0[1]); w.y = cvt_pk_bf16(v0[2], v0[3]); w.z = cvt_pk_bf16(v1[0], v1[1]); w.w = cvt_pk_bf16(v1[2], v1[3]); *(u32x4*)(rowp + bj * 128) = w; } }
        } } };
struct SchedDft { const char *CM, *SM, *PQT; char *UU, *VV;
    __device__ __forceinline__ bool next(int i, g8::Unit& u) const { const int id = (int)blockIdx.x; if (i > 0 || id >= 136) return false; u.kind = 0; u.e = 0;
        if (id < 72) { u.pm = id >> 3; u.pn = id & 7; u.a = CM + (size_t)u.pm * 256 * 8192; u.b = PQT + (size_t)u.pn * 256 * 8192; u.o = UU + ((size_t)u.pm * 256 * 2048 + u.pn * 256) * 4; }
        else { const int r = id - 72; u.pm = r >> 3; u.pn = r & 7; u.a = SM + (size_t)u.pm * 256 * 8192; u.b = PQT + (size_t)(2048 + u.pn * 256) * 8192; u.o = VV + ((size_t)u.pm * 256 * 2048 + u.pn * 256) * 4; }
        return true; } };
struct SchedDftC { const char *DC, *PQC; char* YCX;
    __device__ __forceinline__ bool next(int i, g8::Unit& u) const { const int id = (int)blockIdx.x - 136; if (i > 0 || id < 0 || id >= 8) return false; u.kind = 0; u.e = 0; u.pm = 0; u.pn = id;
        u.a = DC; u.b = PQC + (size_t)id * 256 * 1024; u.o = YCX + (size_t)id * 256 * 4; return true; } };
struct EpiF32 { static constexpr bool PERM = false;
    __device__ __forceinline__ void operator()(const f32x4 (&acc)[2][2][4][2], const g8::Unit& u, int wr, int wc, int fr, int fq) const {
        asm volatile("" : "+v"(fr), "+v"(fq));
        float* O = (float*)u.o; const int row0 = wr * 64 + fr, col0 = wc * 32 + 4 * fq;
#pragma unroll
        for (int ai = 0; ai < 2; ++ai)
#pragma unroll
            for (int m = 0; m < 4; ++m) { float* rowp = O + (size_t)(row0 + ai * 128 + m * 16) * 2048 + col0;
#pragma unroll
                for (int bj = 0; bj < 2; ++bj)
#pragma unroll
                    for (int n = 0; n < 2; ++n) *(f32x4*)(rowp + bj * 128 + n * 16) = acc[ai][bj][m][n]; } } };
struct SchedOut { const char *Y, *W; int nm; const float* modv_l;
    __device__ __forceinline__ bool next(int i, g8::Unit& u) const { const int nu = nm * 4, L = i * (int)gridDim.x + (int)blockIdx.x; if (L >= nu) return false; const int id = g8::xcd_remap(L, nu);
        u.kind = 0; u.pm = id >> 2; u.pn = id & 3; u.a = Y + (size_t)u.pm * 256 * 2048; u.b = W + (size_t)u.pn * 256 * 2048; u.o = nullptr; u.e = u.pm < 128 ? u.pm >> 4 : 8; return true; } };
struct EpiOut { static constexpr bool PERM = false; float* X; const float* bout; const float* modv_l;
    __device__ __forceinline__ void operator()(const f32x4 (&acc)[2][2][4][2], const g8::Unit& u, int wr, int wc, int fr, int fq) const {
        asm volatile("" : "+v"(fr), "+v"(fq));
        const int row0 = u.pm * 256 + wr * 64 + fr, col0 = u.pn * 256 + wc * 32 + 4 * fq; const float* g1 = modv_l + (size_t)u.e * 6144 + 2048;
        f32x4 bv[2][2], gv[2][2];
#pragma unroll
        for (int bj = 0; bj < 2; ++bj)
#pragma unroll
            for (int n = 0; n < 2; ++n) { bv[bj][n] = *(const f32x4*)(bout + col0 + bj * 128 + n * 16); gv[bj][n] = *(const f32x4*)(g1 + col0 + bj * 128 + n * 16); }
#pragma unroll
        for (int ai = 0; ai < 2; ++ai)
#pragma unroll
            for (int m = 0; m < 4; ++m) { float* rowp = X + (size_t)(row0 + ai * 128 + m * 16) * D + col0;
#pragma unroll
                for (int bj = 0; bj < 2; ++bj)
#pragma unroll
                    for (int n = 0; n < 2; ++n) { f32x4* px = (f32x4*)(rowp + bj * 128 + n * 16); *px = *px + gv[bj][n] * (acc[ai][bj][m][n] + bv[bj][n]); } } } };
struct MoeTab { const LAS int* pref; const LAS int* cnt; int ntile;
    __device__ __forceinline__ int pref_(int e) const { return __builtin_amdgcn_readfirstlane(pref[e]); }
    __device__ __forceinline__ int cnt_(int e) const { return __builtin_amdgcn_readfirstlane(cnt[e]); }
    __device__ __forceinline__ int expert_of(int pm) const { int e = 0;
        for (int k = 1; k < 32; ++k) e += (pm >= pref_(k)) ? 1 : 0; return e; } };
struct SchedGu { MoeTab tb; const char *U, *W; char* ACT; const int* rasg;
    __device__ __forceinline__ bool next(int i, g8::Unit& u) const { const int nu = tb.ntile * 8, L = i * (int)gridDim.x + (int)blockIdx.x; if (L >= nu) return false; const int id = g8::xcd_remap(L, nu);
        u.kind = 0; u.pm = id >> 3; u.pn = id & 7; u.e = tb.expert_of(u.pm); u.a = U; u.b = W + ((size_t)u.e * 2048 + u.pn * 256) * 2048; u.o = ACT + (size_t)u.pm * 256 * 2048; return true; }
    __device__ __forceinline__ int row(const g8::Unit& u, int r) const { const int v = rasg[(size_t)u.e * TT + (u.pm - tb.pref_(u.e)) * 256 + r] >> 2; return min(max(v, 0), TT - 1); } };
struct EpiGu { static constexpr bool PERM = true; const float* bgu;
    __device__ __forceinline__ void operator()(const f32x4 (&acc)[2][2][4][2], const g8::Unit& u, int wr, int wc, int fr, int fq) const {
        asm volatile("" : "+v"(fr), "+v"(fq));
        const int col0 = u.pn * 128 + wc * 32 + 8 * fq; bf16_t* O = (bf16_t*)u.o; const float* bg = bgu + (size_t)u.e * 2048 + col0;
        f32x4 bgt[2], bup[2];
#pragma unroll
        for (int n = 0; n < 2; ++n) { bgt[n] = *(const f32x4*)(bg + 4 * n); bup[n] = *(const f32x4*)(bg + 1024 + 4 * n); }
#pragma unroll
        for (int ai = 0; ai < 2; ++ai)
#pragma unroll
            for (int m = 0; m < 4; ++m) { const int r = ai * 128 + wr * 64 + m * 16 + fr; float y[8];
#pragma unroll
                for (int n = 0; n < 2; ++n) { const f32x4 g4 = acc[ai][0][m][n] + bgt[n], u4 = acc[ai][1][m][n] + bup[n];
#pragma unroll
                    for (int e = 0; e < 4; ++e) { const float gt = fminf(g4[e], 7.0f), up = fminf(fmaxf(u4[e], -7.0f), 7.0f); y[4 * n + e] = (up + 1.0f) * (gt * sigmoidf_(1.702f * gt)); } }
                *(u32x4*)(O + (size_t)r * D + col0) = pack8(y); } } };
struct SchedDown { MoeTab tb; const char *ACT, *W;
    __device__ __forceinline__ bool next(int i, g8::Unit& u) const { const int nu = tb.ntile * 4, L = i * (int)gridDim.x + (int)blockIdx.x; if (L >= nu) return false; const int id = g8::xcd_remap(L, nu);
        u.kind = 0; u.pm = id >> 2; u.pn = id & 3; u.e = tb.expert_of(u.pm); u.a = ACT + (size_t)u.pm * 256 * 2048; u.b = W + ((size_t)u.e * 1024 + u.pn * 256) * 2048; u.o = nullptr; return true; } };
struct EpiDown { static constexpr bool PERM = true; MoeTab tb; const float* bd; const int* rasg; const float* gate; bf16_t* YS;
    __device__ __forceinline__ void operator()(const f32x4 (&acc)[2][2][4][2], const g8::Unit& u, int wr, int wc, int fr, int fq) const {
        asm volatile("" : "+v"(fr), "+v"(fq));
        const int col0 = u.pn * 256 + wc * 32 + 8 * fq; const float* bp = bd + (size_t)u.e * 1024 + col0; const int rank0 = (u.pm - tb.pref_(u.e)) * 256, cnt = tb.cnt_(u.e);
        f32x4 bv[2][2];
#pragma unroll
        for (int bj = 0; bj < 2; ++bj)
#pragma unroll
            for (int n = 0; n < 2; ++n) bv[bj][n] = *(const f32x4*)(bp + bj * 128 + 4 * n);
#pragma unroll
        for (int ai = 0; ai < 2; ++ai)
#pragma unroll
            for (int m = 0; m < 4; ++m) { const int rank = rank0 + ai * 128 + wr * 64 + m * 16 + fr;
                if (rank < cnt) { const int asg = rasg[(size_t)u.e * TT + rank]; const float g = gate[asg]; bf16_t* rowp = YS + (size_t)asg * D + col0;
#pragma unroll
                    for (int bj = 0; bj < 2; ++bj) { const f32x4 v0 = (acc[ai][bj][m][0] + bv[bj][0]) * g, v1 = (acc[ai][bj][m][1] + bv[bj][1]) * g;
                        u32x4 w; w.x = cvt_pk_bf16(v0[0], v0[1]); w.y = cvt_pk_bf16(v0[2], v0[3]); w.z = cvt_pk_bf16(v1[0], v1[1]); w.w = cvt_pk_bf16(v1[2], v1[3]); *(u32x4*)(rowp + bj * 128) = w; } } } } };
__device__ __forceinline__ MoeTab moe_tables(CP p, int l, LAS unsigned char* lds) {
    LAS int* pref = (LAS int*)(lds + g8::STAGE_BYTES); LAS int* cnt = pref + 64;
    unsigned* ctl = (unsigned*)(p->ws + WS_CTL);
    __syncthreads();
    if (tid_() < 32) cnt[tid_()] = (int)__hip_atomic_load(ctl + CW_COUNT + (l * NE + tid_()) * 64, __ATOMIC_RELAXED, __HIP_MEMORY_SCOPE_AGENT);
    __syncthreads();
    if (tid_() == 0) { int s = 0; for (int e = 0; e < 32; ++e) { pref[e] = s; s += (cnt[e] + 255) >> 8; } pref[32] = s; }
    __syncthreads();
    MoeTab tb; tb.pref = pref; tb.cnt = cnt; tb.ntile = __builtin_amdgcn_readfirstlane(pref[32]); return tb;
}

constexpr int N_PHASES = 18;
__global__ void __launch_bounds__(512, 2) mega_fwd(Params p_unused) {
    CP p = launder_params();
    extern __shared__ __attribute__((aligned(16))) unsigned char shm_[];
    LAS unsigned char* lds0 = (LAS unsigned char*)shm_;
    LAS unsigned char* lds = lds0 + LDS_BASE;
    if (tid_() == 0) *(LAS u32x4*)lds0 = (u32x4){0u, 0u, 0u, 0u};
    __syncthreads();
    XcdBarrier bar = xcd_barrier_post((unsigned*)(p->ws + WS_CTL), (volatile LAS unsigned*)lds0);
    int ph = 0;
#ifndef P3A
#define P3A 1
#define P3B 1
#define P3C 1
#endif
#ifndef PHMASK
#define PHMASK 0x3ff
#endif
#define PHASE_BEGIN_K(k) p = launder_params(); if (((PHMASK >> (k)) & 1) && ph >= p->ph_lo && ph < p->ph_hi) {
#define PHASE_END } ++ph; if (ph > p->ph_lo && ph < p->ph_hi) xcd_barrier(bar);
    PHASE_BEGIN_K(0) phase_prologue(p, lds); PHASE_END
    for (int l = 0; l < 2; ++l) {
        const float* modv_l = (const float*)(p->ws + WS_MODV) + (size_t)l * 9 * 6144;
        PHASE_BEGIN_K(1) phase_norm(p, l); PHASE_END
        PHASE_BEGIN_K(2) { SchedIn S; S.U = (const char*)(p->ws + WS_U); S.W = (const char*)(p->ws + WS_WINT) + (size_t)l * NPROJ * 2048; S.WF = (const char*)(p->ws + WS_WFT) + (size_t)l * 512 * 2048;
                      S.PROJ = (char*)(p->ws + WS_PROJ); S.PQT = (char*)(p->ws + WS_PQT); S.PQC = (char*)(p->ws + WS_PQC);
                      EpiIn E; E.bin = (const float*)(p->ws + WS_BIN) + l * NPROJ; E.bf = (const float*)(p->ws + WS_BF) + l * 512;
                      g8::gemm_phase<EpiIn, SchedIn, false>(lds, 1024, S, E); } PHASE_END
        PHASE_BEGIN_K(3) { if (P3A && blockIdx.x < 136) { SchedDft S; S.CM = (const char*)(p->ws + WS_CMAT); S.SM = (const char*)(p->ws + WS_SMAT); S.PQT = (const char*)(p->ws + WS_PQT); S.UU = (char*)(p->ws + WS_UU); S.VV = (char*)(p->ws + WS_VV);
                          g8::gemm_phase<EpiF32, SchedDft, false>(lds, 4096, S, EpiF32{}); }
                      else if (P3B && blockIdx.x >= 136 && blockIdx.x < 144) { SchedDftC S; S.DC = (const char*)(p->ws + WS_DFTC); S.PQC = (const char*)(p->ws + WS_PQC); S.YCX = (char*)(p->ws + WS_YCX);
                          g8::gemm_phase<EpiF32, SchedDftC, false>(lds, 512, S, EpiF32{}); }
                      else if (P3C && blockIdx.x >= 144) { const int nw = (int)gridDim.x - 144; if (nw > 0) for (int q = (int)blockIdx.x - 144; q < NCHUNK; q += nw) scan_unit<1>(p, l, q, lds); } } PHASE_END
        PHASE_BEGIN_K(4) { for (int uu = blockIdx.x; uu < 3 * NCHUNK; uu += gridDim.x) { const int kind = uu / NCHUNK, q = uu % NCHUNK;
                          if (kind == 0) scan_unit<2>(p, l, q, lds); else if (kind == 1) conformer_unit(p, l, q, lds); else pool_four_unit(p, l, q, lds); } } PHASE_END
        PHASE_BEGIN_K(5) { SchedOut S; S.Y = (const char*)(p->ws + WS_YCAT); S.W = (const char*)(p->ws + WS_WOUTT) + (size_t)l * D * 2048; S.nm = l == 0 ? 136 : 128; S.modv_l = modv_l;
                      EpiOut E; E.X = (float*)(p->ws + WS_X); E.bout = (const float*)(p->ws + WS_BOUT) + l * D; E.modv_l = modv_l;
                      g8::gemm_phase<EpiOut, SchedOut, false>(lds, 1024, S, E); } PHASE_END
        PHASE_BEGIN_K(6) phase_router(p, l, lds); PHASE_END
        PHASE_BEGIN_K(7) { MoeTab tb = moe_tables(p, l, lds);
                      SchedGu S; S.tb = tb; S.U = (const char*)(p->ws + WS_U); S.W = (const char*)(p->ws + WS_WGUT) + (size_t)l * NE * 2048 * 2048; S.ACT = (char*)(p->ws + WS_ACT); S.rasg = (const int*)(p->ws + WS_RASG);
                      EpiGu E; E.bgu = p->b_gu + (size_t)l * NE * 2048;
                      g8::gemm_phase<EpiGu, SchedGu, true>(lds, 1024, S, E); } PHASE_END
        PHASE_BEGIN_K(8) { MoeTab tb = moe_tables(p, l, lds);
                      SchedDown S; S.tb = tb; S.ACT = (const char*)(p->ws + WS_ACT); S.W = (const char*)(p->ws + WS_WDT) + (size_t)l * NE * 1024 * 2048;
                      EpiDown E; E.tb = tb; E.bd = p->b_down + (size_t)l * NE * 1024; E.rasg = (const int*)(p->ws + WS_RASG); E.gate = (const float*)(p->ws + WS_GATE); E.YS = (bf16_t*)(p->ws + WS_YS);
                      g8::gemm_phase<EpiDown, SchedDown, false>(lds, 1024, S, E); } PHASE_END
    }
    PHASE_BEGIN_K(9) phase_norm(p, 2); PHASE_END
#undef PHASE_BEGIN_K
#undef PHASE_END
}

extern "C" void kernel_launch(void* const* d_in, const int* in_sizes, int n_in, void* d_out, int out_size, void* d_ws, size_t ws_size, hipStream_t stream) {
    static int grid = 0;
    if (!grid) {
        if (n_in != 37 || ws_size < WS_END) { fprintf(stderr, "kernel_launch: expected 37 inputs and >= %zu bytes of workspace (got %d, %zu)\n", (size_t)WS_END, n_in, ws_size); }
        int dev = 0, cus = 0, per_cu = 0;
        hipGetDevice(&dev); hipDeviceGetAttribute(&cus, hipDeviceAttributeMultiprocessorCount, dev);
        hipFuncSetAttribute((const void*)mega_fwd, hipFuncAttributeMaxDynamicSharedMemorySize, LDS_BYTES);
        hipOccupancyMaxActiveBlocksPerMultiprocessor(&per_cu, (const void*)mega_fwd, 512, LDS_BYTES);
        if (per_cu < 1) fprintf(stderr, "kernel_launch: occupancy query reports %d workgroups per CU\n", per_cu);
        grid = cus > 0 ? cus : 256;
    }
    hipMemsetAsync((char*)d_ws + WS_CTL, 0, CTL_BYTES, stream);
    Params hp{};
    const float** f = (const float**)&hp;
    for (int i = 0; i < 37; ++i) f[i] = (const float*)d_in[i];
    hp.out = (float*)d_out; hp.ws = (unsigned char*)d_ws;
#if MK_N_LAUNCHES == 1
    hp.ph_lo = 0; hp.ph_hi = N_PHASES;
    hipLaunchKernelGGL(mega_fwd, dim3(grid), dim3(512), LDS_BYTES, stream, hp);
#else
    for (int ph = 0; ph < N_PHASES; ++ph) { hp.ph_lo = ph; hp.ph_hi = ph + 1; hipLaunchKernelGGL(mega_fwd, dim3(grid), dim3(512), LDS_BYTES, stream, hp); }
#endif
}
```

```cpp
#include <hip/hip_runtime.h>
#include <cstdio>
#include <cstdint>

#ifndef MK_N_LAUNCHES
#define MK_N_LAUNCHES 1
#endif

#define LAS __attribute__((address_space(3)))
typedef unsigned short bf16_t;
typedef short bf16x8 __attribute__((ext_vector_type(8)));
typedef float f32x4 __attribute__((ext_vector_type(4)));
typedef float f32x2 __attribute__((ext_vector_type(2)));
typedef unsigned u32x4 __attribute__((ext_vector_type(4)));
typedef unsigned u32x2 __attribute__((ext_vector_type(2)));

constexpr int D = 1024, NB = 8, SEQ = 4096, LCX = 256, TL = NB * SEQ, TC = NB * LCX, TT = TL + TC;
constexpr int NPROJ = 1280;
constexpr int NE = 32, NCHUNK = 544;
constexpr int NTILE_MAX = 576;

constexpr size_t AL(size_t x) { return (x + 255) & ~(size_t)255; }
constexpr size_t CTL_BYTES = 65536;
constexpr size_t WS_CTL = 0;
constexpr size_t WS_MODV = WS_CTL + CTL_BYTES;
constexpr size_t WS_X = AL(WS_MODV + (size_t)2 * 9 * 6144 * 4);
constexpr size_t WS_U = AL(WS_X + (size_t)TT * D * 4);
constexpr size_t WS_PROJ = AL(WS_U + (size_t)TT * D * 2);
constexpr size_t WS_PQT = AL(WS_PROJ + (size_t)TT * NPROJ * 2);
constexpr size_t WS_PQC = AL(WS_PQT + (size_t)4096 * 4096 * 2);
constexpr size_t WS_UU = AL(WS_PQC + (size_t)2048 * 512 * 2);
constexpr size_t WS_VV = AL(WS_UU + (size_t)2304 * 2048 * 4);
constexpr size_t WS_YCX = AL(WS_VV + (size_t)2048 * 2048 * 4);
constexpr size_t WS_YCAT = AL(WS_YCX + (size_t)256 * 2048 * 4);
constexpr size_t WS_SUMM = AL(WS_YCAT + (size_t)TT * D * 2);
constexpr size_t WS_WINT = AL(WS_SUMM + (size_t)NCHUNK * 1024 * 4);
constexpr size_t WS_WFT = AL(WS_WINT + (size_t)2 * NPROJ * D * 2);
constexpr size_t WS_BIN = AL(WS_WFT + (size_t)2 * 512 * D * 2);
constexpr size_t WS_BF = AL(WS_BIN + (size_t)2 * NPROJ * 4);
constexpr size_t WS_WOUTT = AL(WS_BF + (size_t)2 * 512 * 4);
constexpr size_t WS_BOUT = AL(WS_WOUTT + (size_t)2 * D * D * 2);
constexpr size_t WS_WGUT = AL(WS_BOUT + (size_t)2 * D * 4);
constexpr size_t WS_WDT = AL(WS_WGUT + (size_t)2 * NE * 2048 * D * 2);
constexpr size_t WS_WRT = AL(WS_WDT + (size_t)2 * NE * D * D * 2);
constexpr size_t WS_WGT = AL(WS_WRT + (size_t)2 * 2 * NE * D * 2);
constexpr size_t WS_CMAT = AL(WS_WGT + (size_t)2 * 2 * 2 * 4 * 64 * 64 * 2);
constexpr size_t WS_SMAT = AL(WS_CMAT + (size_t)2304 * 4096 * 2);
constexpr size_t WS_DFTC = AL(WS_SMAT + (size_t)2048 * 4096 * 2);
constexpr size_t WS_RASG = AL(WS_DFTC + (size_t)256 * 512 * 2);
constexpr size_t WS_GATE = AL(WS_RASG + (size_t)NE * TT * 4);
constexpr size_t WS_ACT = AL(WS_GATE + (size_t)TT * 4 * 4);
constexpr size_t WS_YS = AL(WS_ACT + (size_t)NTILE_MAX * 256 * D * 2);
constexpr size_t WS_POS = AL(WS_YS + (size_t)TT * 4 * D * 2);
constexpr size_t WS_END = AL(WS_POS + (size_t)64 * 512 * 4);
constexpr int CW_COUNT = 4096;

constexpr int LDS_BYTES = 147456;
constexpr int LDS_BASE = 1024;

__device__ __forceinline__ unsigned cvt_pk_bf16(float lo, float hi) { unsigned r; asm("v_cvt_pk_bf16_f32 %0, %1, %2" : "=v"(r) : "v"(lo), "v"(hi)); return r; }
__device__ __forceinline__ bf16_t f2bf(float f) { return (bf16_t)(cvt_pk_bf16(f, 0.f) & 0xffffu); }
__device__ __forceinline__ float bf2f(bf16_t b) { return __uint_as_float(((unsigned)b) << 16); }
__device__ __forceinline__ float bflo(unsigned w) { return __uint_as_float(w << 16); }
__device__ __forceinline__ float bfhi(unsigned w) { return __uint_as_float(w & 0xffff0000u); }
__device__ __forceinline__ float fexp2(float x) { return __builtin_amdgcn_exp2f(x); }
__device__ __forceinline__ float frcp(float x) { return __builtin_amdgcn_rcpf(x); }
__device__ __forceinline__ float sigmoidf_(float x) { return frcp(1.0f + fexp2(-1.4426950408889634f * x)); }
__device__ __forceinline__ int tid_() { int t = (int)threadIdx.x; asm volatile("" : "+v"(t)); return t; }
__device__ __forceinline__ float bperm(float v, int src) { return __int_as_float(__builtin_amdgcn_ds_bpermute(src << 2, __float_as_int(v))); }
__device__ __forceinline__ float wave_sum(float v, int lane) {
#pragma unroll
    for (int o = 32; o >= 1; o >>= 1) v += bperm(v, lane ^ o);
    return v;
}
__device__ __forceinline__ void unpack8(const u32x4 w, float (&f)[8]) { f[0] = bflo(w.x); f[1] = bfhi(w.x); f[2] = bflo(w.y); f[3] = bfhi(w.y); f[4] = bflo(w.z); f[5] = bfhi(w.z); f[6] = bflo(w.w); f[7] = bfhi(w.w); }
__device__ __forceinline__ u32x4 pack8(const float (&f)[8]) { u32x4 w; w.x = cvt_pk_bf16(f[0], f[1]); w.y = cvt_pk_bf16(f[2], f[3]); w.z = cvt_pk_bf16(f[4], f[5]); w.w = cvt_pk_bf16(f[6], f[7]); return w; }

#define XB_TMO      128
#define XB_XCNT(j)  (256  + 64 * (j))
#define XB_XSUB(j)  (1280 + 64 * (j))
#define XB_XGEN(j)  (2304 + 64 * (j))
#define XB_TOP      3328
#define XB_TOPGEN   3392
#define XCD_BAR_WORDS 3456
#define XB_SPIN_CAP (1u << 18)
__device__ __forceinline__ unsigned xb_ld(unsigned* p)              { return __hip_atomic_load(p, __ATOMIC_RELAXED, __HIP_MEMORY_SCOPE_AGENT); }
__device__ __forceinline__ unsigned xb_add(unsigned* p, unsigned v) { return __hip_atomic_fetch_add(p, v, __ATOMIC_RELAXED, __HIP_MEMORY_SCOPE_AGENT); }
__device__ __forceinline__ unsigned xb_xcc_id() { return (unsigned)__builtin_amdgcn_s_getreg((3 << 11) | 20) & 0xFu; }
#define XB_SPIN(cond, bar) do { unsigned _sp = 0; while (cond) { __builtin_amdgcn_s_sleep(1); \
    if ((++_sp & 255u) == 0u) { if (xb_ld(&(bar)[XB_TMO])) break; if (_sp > XB_SPIN_CAP) { atomicAdd(&(bar)[XB_TMO], 1u); break; } } } } while (0)
struct XcdBarrier { unsigned* bar; unsigned x; volatile LAS unsigned* st; };
__device__ __forceinline__ XcdBarrier xcd_barrier_post(unsigned* bar, volatile LAS unsigned* st) {
    XcdBarrier b; b.bar = bar; b.x = xb_xcc_id(); b.st = st;
    if (threadIdx.x == 0) (void)xb_add(&bar[XB_XCNT(b.x)], 1u);
    return b;
}
__device__ __forceinline__ void xcd_barrier_complete(unsigned* bar, unsigned x, unsigned& nloc, unsigned& nx) {
    const unsigned G = gridDim.x * gridDim.y * gridDim.z;
    unsigned sum, cnt, mine, sp = 0u;
    for (;;) {
        sum = 0u; cnt = 0u; mine = 0u;
#pragma unroll
        for (unsigned j = 0; j < 16; ++j) { const unsigned c = xb_ld(&bar[XB_XCNT(j)]); sum += c; cnt += (c > 0u) ? 1u : 0u; mine = (j == x) ? c : mine; }
        if (sum == G) break;
        __builtin_amdgcn_s_sleep(1);
        if ((++sp & 255u) == 0u) { if (xb_ld(&bar[XB_TMO])) break; if (sp > XB_SPIN_CAP) { atomicAdd(&bar[XB_TMO], 1u); break; } }
    }
    nloc = mine > 0u ? mine : 1u; nx = cnt > 0u ? cnt : 1u;
}
__device__ __forceinline__ void xcd_barrier(const XcdBarrier& b) {
    asm volatile("s_waitcnt vmcnt(0)" ::: "memory");
    __syncthreads();
    if (threadIdx.x == 0) {
        unsigned* bar = b.bar;
        __builtin_amdgcn_s_waitcnt(0);
        unsigned nloc = b.st[0], nx = b.st[1];
        if (nloc == 0u) { unsigned xo = b.x; asm volatile("" : "+s"(xo)); xcd_barrier_complete(bar, xo, nloc, nx); b.st[0] = nloc; b.st[1] = nx; }
        const unsigned old = xb_add(&bar[XB_XSUB(b.x)], 1u);
        const unsigned gen = old / nloc;
        if (old + 1u == (gen + 1u) * nloc) {
            __builtin_amdgcn_fence(__ATOMIC_RELEASE, "agent");
            asm volatile("s_waitcnt vmcnt(0)" ::: "memory");
            const unsigned og = xb_add(&bar[XB_TOP], 1u);
            const unsigned tg = og / nx;
            if (og + 1u == (tg + 1u) * nx) xb_add(&bar[XB_TOPGEN], 1u);
            else XB_SPIN(xb_ld(&bar[XB_TOPGEN]) == tg, bar);
            __builtin_amdgcn_fence(__ATOMIC_ACQUIRE, "agent");
            xb_add(&bar[XB_XGEN(b.x)], 1u);
            asm volatile("s_waitcnt vmcnt(0)" ::: "memory");
        } else {
            XB_SPIN(xb_ld(&bar[XB_XGEN(b.x)]) == gen, bar);
            __builtin_amdgcn_fence(__ATOMIC_ACQUIRE, "agent");
            asm volatile("s_waitcnt vmcnt(0)" ::: "memory");
        }
    }
    __syncthreads();
}

namespace g8 {
constexpr int BM = 256, BK = 64, HALF = 128, HTB = HALF * BK * 2, STAGE_BYTES = 8 * HTB;
__device__ __forceinline__ int lds_byte(int r, int c) { const int st = (r >> 4) * 2 + (c >> 5), rr = r & 15, cc = c & 31, ob = rr * 64 + cc * 2; return st * 1024 + (ob ^ (((ob >> 9) & 1) << 5)); }
__device__ __forceinline__ void stage_rc(int b, int& R, int& C) { const int st = b / 1024, sb = b % 1024, swz = sb ^ (((sb >> 9) & 1) << 5); R = (st >> 1) * 16 + swz / 64; C = (st & 1) * 32 + (swz % 64) / 2; }
__device__ __forceinline__ int perm32(int rho) { const int n = rho >> 4, i = rho & 15; return 8 * (i >> 2) + 4 * n + (i & 3); }

struct Unit { const char* a; const char* b; char* o; int kind, pm, pn, e; };

__device__ __forceinline__ int xcd_remap(int L, int nu) { const int q = nu / 8, r = nu % 8, xcd = L % 8, off = L / 8; return (xcd < r ? xcd * (q + 1) : r * (q + 1) + (xcd - r) * q) + off; }

template <class Epi, class Sched, bool GATHER>
__device__ __forceinline__ void gemm_phase(LAS unsigned char* lds, const int K, const Sched& S, const Epi& E) {
    const int tid = tid_(), wid = __builtin_amdgcn_readfirstlane(tid >> 6), lane = tid & 63, wr = wid >> 2, wc = wid & 3, fr = lane & 15, fq = lane >> 4;
    const int nt = K / BK;
    unsigned voffA[2], voffB[2];
#pragma unroll
    for (int i = 0; i < 2; ++i) { int R, C; stage_rc(tid * 16 + i * 8192, R, C); const int Rb = Epi::PERM ? ((R & ~31) + perm32(R & 31)) : R;
        voffA[i] = (unsigned)(R * K + C) * 2u; voffB[i] = (unsigned)(Rb * K + C) * 2u; }
    const size_t kstep = (size_t)(BK * 2);
    const size_t hstep = (size_t)HALF * K * 2;
    const unsigned ldsw = (unsigned)wid * 1024u;
    const int aoff = lds_byte(wr * 64 + fr, fq * 8), boff = lds_byte(wc * 32 + fr, fq * 8);
#define G8_SA(b, h) (((b) * 2 + (h)) * HTB)
#define G8_SB(b, h) ((4 + (b) * 2 + (h)) * HTB)
#define G8_ST2(bufoff, gbase, voff) do { _Pragma("unroll") for (int _i = 0; _i < 2; ++_i) \
        __builtin_amdgcn_global_load_lds((const unsigned*)((const char*)(gbase) + (voff)[_i]), (LAS unsigned*)(lds + (bufoff) + ldsw + _i * 8192), 16, 0, 0); } while (0)
#define G8_STA_CUR(bufoff, gbase, h) do { if constexpr (GATHER) { _Pragma("unroll") for (int _i = 0; _i < 2; ++_i) { const unsigned _o = ROFF[parA * 256 + (h) * 128 + (int)(rcq[_i] & 0xffffu)] + (rcq[_i] >> 16); \
        __builtin_amdgcn_global_load_lds((const unsigned*)((const char*)(gbase) + _o), (LAS unsigned*)(lds + (bufoff) + ldsw + _i * 8192), 16, 0, 0); } } else { G8_ST2(bufoff, (gbase) + (h) * hstep, voffA); } } while (0)
#define G8_LDA(dst, b, h) do { _Pragma("unroll") for (int m = 0; m < 4; ++m) _Pragma("unroll") for (int k = 0; k < 2; ++k) dst[m][k] = *(const LAS bf16x8*)(lds + G8_SA(b, h) + aoff + m * 2048 + k * 1024); } while (0)
#define G8_LDB(dst, b, h) do { _Pragma("unroll") for (int n = 0; n < 2; ++n) _Pragma("unroll") for (int k = 0; k < 2; ++k) dst[n][k] = *(const LAS bf16x8*)(lds + G8_SB(b, h) + boff + n * 2048 + k * 1024); } while (0)
#define G8_MMA(ai, bj, At, Bt) do { __builtin_amdgcn_s_setprio(1); _Pragma("unroll") for (int m = 0; m < 4; ++m) _Pragma("unroll") for (int n = 0; n < 2; ++n) _Pragma("unroll") for (int k = 0; k < 2; ++k) \
        acc[ai][bj][m][n] = __builtin_amdgcn_mfma_f32_16x16x32_bf16(Bt[n][k], At[m][k], acc[ai][bj][m][n], 0, 0, 0); __builtin_amdgcn_s_setprio(0); } while (0)
#define G8_WAIT_V(n) asm volatile("s_waitcnt vmcnt(" #n ")" ::: "memory")
#define G8_WAIT_L(n) asm volatile("s_waitcnt lgkmcnt(" #n ")" ::: "memory")
#define G8_BAR __builtin_amdgcn_s_barrier()
#define G8_SCHED __builtin_amdgcn_sched_barrier(0)
    Unit cur, nxt; int ui = 0;
    if (!S.next(0, cur)) return;
    f32x4 acc[2][2][4][2];
#pragma unroll
    for (int a = 0; a < 2; ++a)
#pragma unroll
        for (int b = 0; b < 2; ++b)
#pragma unroll
            for (int m = 0; m < 4; ++m)
#pragma unroll
                for (int n = 0; n < 2; ++n) acc[a][b][m][n] = (f32x4){0.f, 0.f, 0.f, 0.f};
    bf16x8 At[4][2], B0[2][2], B1[2][2];
    LAS unsigned* ROFF = (LAS unsigned*)(lds + STAGE_BYTES + 1024);
    unsigned rcq[2] = {0u, 0u}, pend = 0u; int parA = 0;
    if constexpr (GATHER) {
#pragma unroll
        for (int i = 0; i < 2; ++i) { int R, C; stage_rc(tid * 16 + i * 8192, R, C); rcq[i] = (unsigned)R | ((unsigned)(C * 2) << 16); }
        if (tid < 256) ROFF[tid] = (unsigned)S.row(cur, tid) * (unsigned)(K * 2);
        asm volatile("s_waitcnt lgkmcnt(0)" ::: "memory"); __builtin_amdgcn_s_barrier(); asm volatile("" ::: "memory");
    }
    const char* cA = cur.a; const char* cB = cur.b;
    G8_ST2(G8_SB(0, 0), cB, voffB); G8_ST2(G8_SB(0, 1), cB + hstep, voffB); G8_STA_CUR(G8_SA(0, 0), cA, 0); G8_STA_CUR(G8_SA(0, 1), cA, 1);
    if (wr == 1) G8_BAR;
    G8_WAIT_V(2); G8_BAR;
    G8_ST2(G8_SB(1, 0), cB + kstep, voffB); G8_STA_CUR(G8_SA(1, 0), cA + kstep, 0); G8_ST2(G8_SB(1, 1), cB + hstep + kstep, voffB);
    G8_WAIT_V(6); G8_BAR;
    for (;;) {
        const bool has_next = S.next(ui + 1, nxt);
        const char* nA = has_next ? nxt.a : cA; const char* nB = has_next ? nxt.b : cB;
        for (int t = 0; t < nt; t += 2) {
            const bool last = (t == nt - 2);
            const char* a1 = cA + (size_t)(t + 1) * kstep;
            const char* a2 = last ? nA : cA + (size_t)(t + 2) * kstep; const char* b2 = last ? nB : cB + (size_t)(t + 2) * kstep;
            const char* a3 = a2 + kstep; const char* b3 = b2 + kstep;
            if constexpr (GATHER) {
                if (has_next && t == nt - 4 && tid < 256) pend = (unsigned)S.row(nxt, tid) * (unsigned)(K * 2);
                if (has_next && last && tid < 256) ROFF[(parA ^ 1) * 256 + tid] = pend; }
            G8_LDB(B0, 0, 0); G8_LDB(B1, 0, 1); G8_SCHED; G8_LDA(At, 0, 0); G8_STA_CUR(G8_SA(1, 1), a1, 1);
            if constexpr (GATHER) { if (has_next && last) parA ^= 1; }
            G8_WAIT_V(8); G8_WAIT_L(0); G8_BAR; G8_MMA(0, 0, At, B0); G8_MMA(0, 1, At, B1); G8_BAR; G8_SCHED;
            G8_LDA(At, 0, 1); G8_ST2(G8_SB(0, 0), b2, voffB); G8_ST2(G8_SB(0, 1), b2 + hstep, voffB); G8_STA_CUR(G8_SA(0, 0), a2, 0);
            G8_WAIT_V(8); G8_WAIT_L(0); G8_BAR; G8_MMA(1, 0, At, B0); G8_MMA(1, 1, At, B1); G8_BAR; G8_SCHED;
            G8_LDB(B0, 1, 0); G8_LDB(B1, 1, 1); G8_SCHED; G8_LDA(At, 1, 0); G8_STA_CUR(G8_SA(0, 1), a2, 1);
            G8_WAIT_V(8); G8_WAIT_L(0); G8_BAR; G8_MMA(0, 0, At, B0); G8_MMA(0, 1, At, B1); G8_BAR; G8_SCHED;
            G8_LDA(At, 1, 1); G8_ST2(G8_SB(1, 0), b3, voffB); G8_ST2(G8_SB(1, 1), b3 + hstep, voffB); G8_STA_CUR(G8_SA(1, 0), a3, 0);
            G8_WAIT_V(8); G8_WAIT_L(0); G8_BAR; G8_MMA(1, 0, At, B0); G8_MMA(1, 1, At, B1); G8_BAR; G8_SCHED;
        }
        if (wr == 0) G8_BAR;
        E(acc, cur, wr, wc, fr, fq);
        if (!has_next) break;
#pragma unroll
        for (int a = 0; a < 2; ++a)
#pragma unroll
            for (int b = 0; b < 2; ++b)
#pragma unroll
                for (int m = 0; m < 4; ++m)
#pragma unroll
                    for (int n = 0; n < 2; ++n) acc[a][b][m][n] = (f32x4){0.f, 0.f, 0.f, 0.f};
        cur = nxt; cA = nA; cB = nB; ++ui;
        if (wr == 1) G8_BAR;
    }
    G8_WAIT_V(0);
    G8_BAR;
#undef G8_SA
#undef G8_SB
#undef G8_ST2
#undef G8_STA_CUR
#undef G8_LDA
#undef G8_LDB
#undef G8_MMA
#undef G8_WAIT_V
#undef G8_WAIT_L
#undef G8_BAR
#undef G8_SCHED
}
}

struct Params {
    const float *x, *c, *ctx, *c_ctx, *w_mod, *b_mod, *norm1_g, *norm2_g, *w_in, *b_in, *conv_a_w, *conv_a_b, *w_rg_r, *b_rg_r, *w_rg_i, *b_rg_i, *rg_lambda,
        *w_pool, *b_pool, *pool_scale, *w_four, *b_four, *conv_d_w, *conv_d_b, *ln_d_g, *ln_d_b, *w_pw, *b_pw, *w_out, *b_out, *w_router, *b_router,
        *w_gu, *b_gu, *w_down, *b_down, *final_norm_g;
    float* out; unsigned char* ws; int ph_lo, ph_hi;
};
typedef const Params __attribute__((address_space(4)))* CP;
__device__ __forceinline__ CP launder_params() { CP k = (CP)__builtin_amdgcn_kernarg_segment_ptr(); asm volatile("" : "+s"(k)); return k; }
__device__ __forceinline__ int row_mb(int row) { return row < TL ? (row >> 12) : 8; }

template <class RowMap>
__device__ __forceinline__ void tr_block(const float* __restrict__ src, int spitch, int k0, int n0, bf16_t* __restrict__ dst, int dpitch, int kd0, RowMap rm, LAS unsigned char* lds) {
    LAS unsigned* T = (LAS unsigned*)lds;
    const int tid = tid_();
    __syncthreads();
#pragma unroll
    for (int it = 0; it < 4; ++it) { const int task = it * 512 + tid, q = task & 63, kp = task >> 6;
        const f32x4 v0 = *(const f32x4*)(src + (size_t)(k0 + 2 * kp) * spitch + n0 + 4 * q), v1 = *(const f32x4*)(src + (size_t)(k0 + 2 * kp + 1) * spitch + n0 + 4 * q);
        u32x4 w; w.x = cvt_pk_bf16(v0[0], v1[0]); w.y = cvt_pk_bf16(v0[1], v1[1]); w.z = cvt_pk_bf16(v0[2], v1[2]); w.w = cvt_pk_bf16(v0[3], v1[3]);
        *(LAS u32x4*)(T + kp * 260 + 4 * q) = w; }
    __syncthreads();
#pragma unroll
    for (int it = 0; it < 4; ++it) { const int task = it * 512 + tid, n = task & 255, c = task >> 8;
        u32x4 w; w.x = T[(4 * c + 0) * 260 + n]; w.y = T[(4 * c + 1) * 260 + n]; w.z = T[(4 * c + 2) * 260 + n]; w.w = T[(4 * c + 3) * 260 + n];
        *(u32x4*)(dst + (size_t)rm(n0 + n) * dpitch + kd0 + 8 * c) = w; }
}
struct RmId { int off; __device__ __forceinline__ int operator()(int n) const { return n + off; } };
struct RmGu { __device__ __forceinline__ int operator()(int n) const { const int rem = n & 1023; return 256 * (rem >> 7) + 128 * (n >> 10) + (rem & 127); } };
struct RmIn { __device__ __forceinline__ int operator()(int n) const { return n < 512 ? n : n - 1024 + 768; } };

__device__ __forceinline__ void job_mod(CP p, int l, int cb, LAS unsigned char* lds) {
    LAS float* SC = (LAS float*)lds;
    LAS float* RED = (LAS float*)(lds + 49152);
    const int tid = tid_();
    __syncthreads();
    for (int i = tid; i < 9 * 1024; i += 512) { const int b = i >> 10, k = i & 1023; const float v = b < 8 ? p->c[b * 1024 + k] : p->c_ctx[k]; SC[k * 12 + b] = v * sigmoidf_(v); }
    __syncthreads();
    const int col = cb * 64 + (tid & 63), kg = tid >> 6;
    float acc[9];
#pragma unroll
    for (int b = 0; b < 9; ++b) acc[b] = 0.f;
    const float* wp = p->w_mod + (size_t)l * 1024 * 6144 + col;
#pragma unroll 8
    for (int kk = 0; kk < 128; ++kk) { const int k = kg * 128 + kk; const float w = wp[(size_t)k * 6144];
        const f32x4 s0 = *(const LAS f32x4*)(SC + k * 12), s1 = *(const LAS f32x4*)(SC + k * 12 + 4); const float s8 = SC[k * 12 + 8];
        acc[0] += s0[0] * w; acc[1] += s0[1] * w; acc[2] += s0[2] * w; acc[3] += s0[3] * w; acc[4] += s1[0] * w; acc[5] += s1[1] * w; acc[6] += s1[2] * w; acc[7] += s1[3] * w; acc[8] += s8 * w; }
#pragma unroll
    for (int b = 0; b < 9; ++b) RED[(kg * 9 + b) * 64 + (tid & 63)] = acc[b];
    __syncthreads();
    for (int i = tid; i < 9 * 64; i += 512) { const int b = i >> 6, cc = i & 63; float s = 0.f;
#pragma unroll
        for (int g = 0; g < 8; ++g) s += RED[(g * 9 + b) * 64 + cc];
        ((float*)(p->ws + WS_MODV))[(size_t)(l * 9 + b) * 6144 + cb * 64 + cc] = s + p->b_mod[l * 6144 + cb * 64 + cc]; }
}
__device__ __forceinline__ void job_fold_out(CP p, int l, int nb, LAS unsigned char* lds) {
    LAS float* WO = (LAS float*)lds;
    LAS float* PW = (LAS float*)(lds + 65536);
    const int tid = tid_(), lane = tid & 63, w = __builtin_amdgcn_readfirstlane(tid >> 6);
    __syncthreads();
#pragma unroll
    for (int it = 0; it < 8; ++it) { const int task = it * 512 + tid, j = task >> 4, q = task & 15;
        *(LAS f32x4*)(WO + j * 64 + 4 * q) = *(const f32x4*)(p->w_out + ((size_t)l * 1024 + 768 + j) * 1024 + nb * 64 + 4 * q); }
    float acc[32];
#pragma unroll
    for (int i = 0; i < 32; ++i) acc[i] = 0.f;
    for (int jc = 0; jc < 4; ++jc) {
        __syncthreads();
#pragma unroll
        for (int it = 0; it < 8; ++it) { const int task = it * 512 + tid, i = task & 255, jq = task >> 8;
            const f32x4 v = *(const f32x4*)(p->w_pw + ((size_t)l * 256 + i) * 256 + jc * 64 + 4 * jq);
            PW[(4 * jq + 0) * 256 + i] = v[0]; PW[(4 * jq + 1) * 256 + i] = v[1]; PW[(4 * jq + 2) * 256 + i] = v[2]; PW[(4 * jq + 3) * 256 + i] = v[3]; }
        __syncthreads();
        for (int jj = 0; jj < 64; ++jj) { const float b = WO[(jc * 64 + jj) * 64 + lane];
#pragma unroll
            for (int i4 = 0; i4 < 8; ++i4) { const f32x4 a = *(const LAS f32x4*)(PW + jj * 256 + 32 * w + 4 * i4);
                acc[4 * i4 + 0] += a[0] * b; acc[4 * i4 + 1] += a[1] * b; acc[4 * i4 + 2] += a[2] * b; acc[4 * i4 + 3] += a[3] * b; } }
    }
    bf16_t* dst = (bf16_t*)(p->ws + WS_WOUTT) + ((size_t)l * 1024 + nb * 64 + lane) * 1024 + 768 + 32 * w;
#pragma unroll
    for (int c = 0; c < 4; ++c) { float f[8];
#pragma unroll
        for (int e = 0; e < 8; ++e) f[e] = acc[8 * c + e];
        *(u32x4*)(dst + 8 * c) = pack8(f); }
    if (w == 0) { float s = p->b_out[l * 1024 + nb * 64 + lane];
        for (int j = 0; j < 256; ++j) s += p->b_pw[l * 256 + j] * WO[j * 64 + lane];
        ((float*)(p->ws + WS_BOUT))[l * 1024 + nb * 64 + lane] = s; }
}
__device__ __forceinline__ void job_fold_in(CP p, int l, int f, int g, int kb, LAS unsigned char* lds) {
    LAS float* M = (LAS float*)lds;
    LAS float* WI = (LAS float*)(lds + 16384);
    const int tid = tid_();
    const int cbase = f == 0 ? 512 : 768;
    __syncthreads();
#pragma unroll
    for (int it = 0; it < 8; ++it) { const int id = it * 512 + tid, i = id >> 6, j = id & 63; float s;
        if (f == 0) s = p->w_pool[(((size_t)l * 4 + g) * 64 + i) * 64 + j];
        else { s = 0.f; for (int m = 0; m < 64; ++m) { const float ang = (float)((i * m) & 63) * (1.0f / 32.0f); const float tr = f == 1 ? cospif(ang) : sinpif(ang);
                   s += tr * p->w_four[(((size_t)l * 4 + g) * 64 + m) * 64 + j]; } }
        M[i * 64 + j] = s; }
#pragma unroll
    for (int it = 0; it < 8; ++it) { const int task = it * 512 + tid, kk = task >> 4, i4 = task & 15;
        const f32x4 v = *(const f32x4*)(p->w_in + ((size_t)l * 1024 + kb * 256 + kk) * 1536 + cbase + 64 * g + 4 * i4);
        WI[kk * 65 + 4 * i4 + 0] = v[0]; WI[kk * 65 + 4 * i4 + 1] = v[1]; WI[kk * 65 + 4 * i4 + 2] = v[2]; WI[kk * 65 + 4 * i4 + 3] = v[3]; }
    __syncthreads();
    const int kk = tid & 255, jh = tid >> 8;
    float acc[32];
#pragma unroll
    for (int j = 0; j < 32; ++j) acc[j] = 0.f;
    for (int i = 0; i < 64; ++i) { const float a = WI[kk * 65 + i];
#pragma unroll
        for (int j4 = 0; j4 < 8; ++j4) { const f32x4 m = *(const LAS f32x4*)(M + i * 64 + 32 * jh + 4 * j4);
            acc[4 * j4 + 0] += a * m[0]; acc[4 * j4 + 1] += a * m[1]; acc[4 * j4 + 2] += a * m[2]; acc[4 * j4 + 3] += a * m[3]; } }
    bf16_t* dst = f == 0 ? (bf16_t*)(p->ws + WS_WINT) + ((size_t)l * NPROJ + 512 + 64 * g) * 1024 : (bf16_t*)(p->ws + WS_WFT) + ((size_t)l * 512 + (f - 1) * 256 + 64 * g) * 1024;
#pragma unroll
    for (int j = 0; j < 32; ++j) dst[(size_t)(32 * jh + j) * 1024 + kb * 256 + kk] = f2bf(acc[j]);
    if (kb == 0 && f >= 1 && tid < 64) { float s = 0.f;
        for (int i = 0; i < 64; ++i) s += p->b_in[l * 1536 + 768 + 64 * g + i] * M[i * 64 + tid];
        ((float*)(p->ws + WS_BF))[l * 512 + (f - 1) * 256 + 64 * g + tid] = s; }
    if (kb == 0 && f == 0 && g == 0) for (int i = tid; i < NPROJ; i += 512)
        ((float*)(p->ws + WS_BIN))[l * NPROJ + i] = i < 512 ? p->b_in[l * 1536 + i] : (i < 768 ? 0.f : p->b_in[l * 1536 + i - 768 + 1024]);
}
__device__ __forceinline__ void job_small(CP p, int j) {
    const int tid = tid_();
    if (j < 32) {
        const int l = j >> 4, d = (j >> 3) & 1, gate = (j >> 2) & 1, hd = j & 3;
        const float* src = (gate ? p->w_rg_i : p->w_rg_r) + ((size_t)((l * 2 + d) * 4 + hd)) * 4096;
        bf16_t* dst = (bf16_t*)(p->ws + WS_WGT) + (size_t)j * 4096;
        for (int id = tid; id < 4096; id += 512) { const int n = id >> 6, k = id & 63; dst[id] = f2bf(src[k * 64 + n]); }
        return; }
    j -= 32;
    if (j < 2) {
        const int l = j; bf16_t* hi = (bf16_t*)(p->ws + WS_WRT) + (size_t)l * 2 * NE * 1024; bf16_t* lo = hi + NE * 1024;
        for (int id = tid; id < NE * 1024; id += 512) { const int e = id >> 10, c = id & 1023; const float v = p->w_router[((size_t)l * 1024 + c) * NE + e];
            const bf16_t h = f2bf(v); hi[id] = h; lo[id] = f2bf(v - bf2f(h)); }
        return; }
    j -= 2;
    if (j < 144 + 128) {
        const bool sn = j >= 144; const int r0 = (sn ? j - 144 : j) * 16; bf16_t* dst = (bf16_t*)(p->ws + (sn ? WS_SMAT : WS_CMAT));
        for (int id = tid; id < 16 * 4096; id += 512) { const int k = r0 + (id >> 12), t = id & 4095; const float ang = (float)((k * t) & 4095) * (1.0f / 2048.0f);
            dst[(size_t)k * 4096 + t] = f2bf(sn ? sinpif(ang) : cospif(ang)); }
        return; }
    j -= 272;
    if (j == 1) {
        float* dst = (float*)(p->ws + WS_POS);
        for (int id = tid; id < 64 * 512; id += 512) { const int pp = id >> 9, jj = id & 511, i = jj & 255; const float a = (float)pp * exp2f(-(float)i * (13.287712379549449f / 256.0f));
            dst[id] = jj < 256 ? sinf(a) : cosf(a); }
        return; }
    {
        bf16_t* dst = (bf16_t*)(p->ws + WS_DFTC);
        for (int id = tid; id < 256 * 512; id += 512) { const int k = id >> 9, jj = id & 511, t = jj & 255; const float ang = (float)((k * t) & 255) * (1.0f / 128.0f);
            dst[id] = f2bf(jj < 256 ? cospif(ang) : -sinpif(ang)); }
    }
}
constexpr int J_MOD = 192, J_FOUT = 32, J_FIN = 96, J_SMALL = 32 + 2 + 272 + 2, J_TIN = 128, J_TOUT = 96, J_TGU = 8192, J_TD = 4096;
constexpr int J_TOTAL = J_MOD + J_FOUT + J_FIN + J_SMALL + J_TIN + J_TOUT + J_TGU + J_TD;
__device__ __forceinline__ void phase_prologue(CP p, LAS unsigned char* lds) {
    for (int job = blockIdx.x; job < J_TOTAL; job += gridDim.x) {
        int j = job;
        if (j < J_MOD) { job_mod(p, j / 96, j % 96, lds); continue; } j -= J_MOD;
        if (j < J_FOUT) { job_fold_out(p, j >> 4, j & 15, lds); continue; } j -= J_FOUT;
        if (j < J_FIN) { const int l = j / 48, r = j % 48; job_fold_in(p, l, r / 16, (r >> 2) & 3, r & 3, lds); continue; } j -= J_FIN;
        if (j < J_SMALL) { job_small(p, j); continue; } j -= J_SMALL;
        if (j < J_TIN) { const int l = j >> 6, r = j & 63, kb = r >> 2, q = r & 3;
            tr_block(p->w_in + (size_t)l * 1024 * 1536, 1536, kb * 64, q < 2 ? q * 256 : 1024 + (q - 2) * 256, (bf16_t*)(p->ws + WS_WINT) + (size_t)l * NPROJ * 1024, 1024, kb * 64, RmIn{}, lds); continue; } j -= J_TIN;
        if (j < J_TOUT) { const int l = j / 48, r = j % 48, kb = r >> 2, q = r & 3;
            tr_block(p->w_out + (size_t)l * 1024 * 1024, 1024, kb * 64, q * 256, (bf16_t*)(p->ws + WS_WOUTT) + (size_t)l * 1024 * 1024, 1024, kb * 64, RmId{0}, lds); continue; } j -= J_TOUT;
        if (j < J_TGU) { const int le = j >> 7, r = j & 127, kb = r >> 3, q = r & 7;
            tr_block(p->w_gu + (size_t)le * 1024 * 2048, 2048, kb * 64, q * 256, (bf16_t*)(p->ws + WS_WGUT) + (size_t)le * 2048 * 1024, 1024, kb * 64, RmGu{}, lds); continue; } j -= J_TGU;
        { const int le = j >> 6, r = j & 63, kb = r >> 2, q = r & 3;
            tr_block(p->w_down + (size_t)le * 1024 * 1024, 1024, kb * 64, q * 256, (bf16_t*)(p->ws + WS_WDT) + (size_t)le * 1024 * 1024, 1024, kb * 64, RmId{0}, lds); }
    }
}

__device__ __forceinline__ void phase_norm(CP p, int mode) {
    const int tid = tid_(), lane = tid & 63, wid = tid >> 6;
    float* X = (float*)(p->ws + WS_X); bf16_t* U = (bf16_t*)(p->ws + WS_U); const bf16_t* YS = (const bf16_t*)(p->ws + WS_YS); const float* modv = (const float*)(p->ws + WS_MODV);
    const float* POS = (const float*)(p->ws + WS_POS);
    const int nrows = mode == 2 ? TL : TT;
    const int lprev = mode == 2 ? 1 : 0, lcur = mode == 0 ? 0 : 1;
    const int nw = (int)gridDim.x * 8;
    for (int rowa = blockIdx.x * 8 + wid; rowa < nrows; rowa += 2 * nw) {
        int rows[2]; bool ok[2]; f32x4 v[2][4];
#pragma unroll
        for (int rb = 0; rb < 2; ++rb) { const int r = rowa + rb * nw; ok[rb] = r < nrows; rows[rb] = ok[rb] ? r : rowa; }
        if (mode == 0) {
#pragma unroll
            for (int rb = 0; rb < 2; ++rb) { const int row = rows[rb]; const float* src = row < TL ? p->x + (size_t)row * D : p->ctx + (size_t)(row - TL) * D;
#pragma unroll
                for (int j = 0; j < 4; ++j) v[rb][j] = *(const f32x4*)(src + 256 * j + 4 * lane); }
#pragma unroll
            for (int rb = 0; rb < 2; ++rb) { const int row = rows[rb]; if (row < TL) { const int t = row & 4095;
#pragma unroll
                    for (int j = 0; j < 4; ++j) v[rb][j] += *(const f32x4*)(POS + (size_t)(j < 2 ? (t >> 6) : (t & 63)) * 512 + (j & 1) * 256 + 4 * lane); } }
        } else {
            u32x2 ys[2][4][4];
#pragma unroll
            for (int rb = 0; rb < 2; ++rb) { const int row = rows[rb];
#pragma unroll
                for (int j = 0; j < 4; ++j) { v[rb][j] = *(const f32x4*)(X + (size_t)row * D + 256 * j + 4 * lane);
#pragma unroll
                    for (int k = 0; k < 4; ++k) ys[rb][j][k] = *(const u32x2*)(YS + ((size_t)row * 4 + k) * D + 256 * j + 4 * lane); } }
#pragma unroll
            for (int rb = 0; rb < 2; ++rb) { const float* g2 = modv + (size_t)(lprev * 9 + row_mb(rows[rb])) * 6144 + 5120;
#pragma unroll
                for (int j = 0; j < 4; ++j) { f32x4 s = {0.f, 0.f, 0.f, 0.f};
#pragma unroll
                    for (int k = 0; k < 4; ++k) { const u32x2 w = ys[rb][j][k]; s[0] += bflo(w.x); s[1] += bfhi(w.x); s[2] += bflo(w.y); s[3] += bfhi(w.y); }
                    v[rb][j] += *(const f32x4*)(g2 + 256 * j + 4 * lane) * s; } }
        }
        float ss[2];
#pragma unroll
        for (int rb = 0; rb < 2; ++rb) { ss[rb] = 0.f;
#pragma unroll
            for (int j = 0; j < 4; ++j) ss[rb] += v[rb][j][0] * v[rb][j][0] + v[rb][j][1] * v[rb][j][1] + v[rb][j][2] * v[rb][j][2] + v[rb][j][3] * v[rb][j][3]; }
#pragma unroll
        for (int o = 32; o >= 1; o >>= 1) { const float t0 = bperm(ss[0], lane ^ o), t1 = bperm(ss[1], lane ^ o); ss[0] += t0; ss[1] += t1; }
#pragma unroll
        for (int rb = 0; rb < 2; ++rb) { if (!ok[rb]) continue; const int row = rows[rb]; const float rstd = __builtin_amdgcn_rsqf(ss[rb] * (1.0f / 1024.0f) + 1e-6f);
            if (mode == 2) {
#pragma unroll
                for (int j = 0; j < 4; ++j) *(f32x4*)(p->out + (size_t)row * D + 256 * j + 4 * lane) = v[rb][j] * rstd * *(const f32x4*)(p->final_norm_g + 256 * j + 4 * lane);
            } else { const float* mv = modv + (size_t)(lcur * 9 + row_mb(row)) * 6144;
#pragma unroll
                for (int j = 0; j < 4; ++j) { const int col = 256 * j + 4 * lane;
                    *(f32x4*)(X + (size_t)row * D + col) = v[rb][j];
                    const f32x4 g = *(const f32x4*)(p->norm1_g + lcur * D + col), sc = *(const f32x4*)(mv + 1024 + col), sh = *(const f32x4*)(mv + col);
                    const f32x4 u = v[rb][j] * rstd * g * (sc + 1.0f) + sh;
                    u32x2 w; w.x = cvt_pk_bf16(u[0], u[1]); w.y = cvt_pk_bf16(u[2], u[3]); *(u32x2*)(U + (size_t)row * D + col) = w; } }
        }
    }
}

constexpr int HP = 2064;
__device__ __forceinline__ void phase_router(CP p, int l, LAS unsigned char* lds) {
    LAS unsigned char* HHI = lds; LAS unsigned char* HLO = lds + 32 * HP;
    LAS float* LG = (LAS float*)(lds + 64 * HP);
    LAS int* hist = (LAS int*)(lds + 64 * HP + 8448); LAS int* basee = hist + 32;
    const int tid = tid_(), lane = tid & 63, wid = __builtin_amdgcn_readfirstlane(tid >> 6), fr = lane & 15, fq = lane >> 4;
    const float* X = (const float*)(p->ws + WS_X); bf16_t* U = (bf16_t*)(p->ws + WS_U); const float* modv = (const float*)(p->ws + WS_MODV);
    unsigned* ctl = (unsigned*)(p->ws + WS_CTL); int* rasg = (int*)(p->ws + WS_RASG); float* gate = (float*)(p->ws + WS_GATE);
    const bf16_t* wrt = (const bf16_t*)(p->ws + WS_WRT) + (size_t)l * 2 * NE * 1024;
    const int ntiles = (l == 0 ? TT : TL) / 32;
    for (int tile = blockIdx.x; tile < ntiles; tile += gridDim.x) {
        const int row0 = tile * 32, mb = row_mb(row0);
        const float* mv = modv + (size_t)(l * 9 + mb) * 6144;
        __syncthreads();
        if (tid < 32) hist[tid] = 0;
        { f32x4 v[4][4]; float ss[4];
#pragma unroll
          for (int rr = 0; rr < 4; ++rr)
#pragma unroll
              for (int j = 0; j < 4; ++j) v[rr][j] = *(const f32x4*)(X + (size_t)(row0 + wid * 4 + rr) * D + 256 * j + 4 * lane);
#pragma unroll
          for (int rr = 0; rr < 4; ++rr) { ss[rr] = 0.f;
#pragma unroll
              for (int j = 0; j < 4; ++j) ss[rr] += v[rr][j][0] * v[rr][j][0] + v[rr][j][1] * v[rr][j][1] + v[rr][j][2] * v[rr][j][2] + v[rr][j][3] * v[rr][j][3]; }
#pragma unroll
          for (int o = 32; o >= 1; o >>= 1) { float t[4];
#pragma unroll
              for (int rr = 0; rr < 4; ++rr) t[rr] = bperm(ss[rr], lane ^ o);
#pragma unroll
              for (int rr = 0; rr < 4; ++rr) ss[rr] += t[rr]; }
#pragma unroll
          for (int j = 0; j < 4; ++j) { const int col = 256 * j + 4 * lane;
              const f32x4 g = *(const f32x4*)(p->norm2_g + l * D + col), sc = *(const f32x4*)(mv + 4096 + col), sh = *(const f32x4*)(mv + 3072 + col);
#pragma unroll
              for (int rr = 0; rr < 4; ++rr) { const int r = wid * 4 + rr; const float rstd = __builtin_amdgcn_rsqf(ss[rr] * (1.0f / 1024.0f) + 1e-6f);
                  const f32x4 h = v[rr][j] * rstd * g * (sc + 1.0f) + sh;
                  u32x2 w; w.x = cvt_pk_bf16(h[0], h[1]); w.y = cvt_pk_bf16(h[2], h[3]); *(u32x2*)(U + (size_t)(row0 + r) * D + col) = w;
                  u32x2 wl; wl.x = cvt_pk_bf16(h[0] - bflo(w.x), h[1] - bfhi(w.x)); wl.y = cvt_pk_bf16(h[2] - bflo(w.y), h[3] - bfhi(w.y));
                  *(LAS u32x2*)(HHI + r * HP + col * 2) = w; *(LAS u32x2*)(HLO + r * HP + col * 2) = wl; } } }
        __syncthreads();
        { const int mt = wid & 1, ntl = (wid >> 1) & 1, kh = wid >> 2;
          f32x4 acc = {0.f, 0.f, 0.f, 0.f};
          const bf16_t* bh = wrt + (size_t)(16 * ntl + fr) * 1024 + kh * 512 + 8 * fq; const bf16_t* bl = bh + NE * 1024;
          const LAS unsigned char* ah = HHI + (16 * mt + fr) * HP + (kh * 512 + 8 * fq) * 2; const LAS unsigned char* al = HLO + (16 * mt + fr) * HP + (kh * 512 + 8 * fq) * 2;
#pragma unroll 8
          for (int s = 0; s < 16; ++s) { const bf16x8 Ah = *(const LAS bf16x8*)(ah + s * 64), Al = *(const LAS bf16x8*)(al + s * 64); const bf16x8 Bh = *(const bf16x8*)(bh + s * 32), Bl = *(const bf16x8*)(bl + s * 32);
              acc = __builtin_amdgcn_mfma_f32_16x16x32_bf16(Ah, Bh, acc, 0, 0, 0); acc = __builtin_amdgcn_mfma_f32_16x16x32_bf16(Ah, Bl, acc, 0, 0, 0); acc = __builtin_amdgcn_mfma_f32_16x16x32_bf16(Al, Bh, acc, 0, 0, 0); }
#pragma unroll
          for (int j = 0; j < 4; ++j) LG[(kh * 32 + 16 * mt + 4 * fq + j) * 33 + 16 * ntl + fr] = acc[j]; }
        __syncthreads();
        int ek[4] = {0, 0, 0, 0}, rk[4] = {0, 0, 0, 0}; float gk[4] = {0.f, 0.f, 0.f, 0.f};
        if (tid < 32) { float lg[32];
#pragma unroll
            for (int e = 0; e < 32; ++e) lg[e] = LG[tid * 33 + e] + LG[(32 + tid) * 33 + e] + p->b_router[l * NE + e];
            float vk[4];
#pragma unroll
            for (int k = 0; k < 4; ++k) { float best = -3.0e38f; int bi = 0;
#pragma unroll
                for (int e = 0; e < 32; ++e) if (lg[e] > best) { best = lg[e]; bi = e; }
                vk[k] = best; ek[k] = bi;
#pragma unroll
                for (int e = 0; e < 32; ++e) if (e == bi) lg[e] = -3.0e38f; }
            float sum = 0.f;
#pragma unroll
            for (int k = 0; k < 4; ++k) { gk[k] = fexp2(1.4426950408889634f * (vk[k] - vk[0])); sum += gk[k]; }
            const float inv = 1.0f / sum;
#pragma unroll
            for (int k = 0; k < 4; ++k) { gk[k] *= inv; rk[k] = __hip_atomic_fetch_add(hist + ek[k], 1, __ATOMIC_RELAXED, __HIP_MEMORY_SCOPE_WORKGROUP); } }
        __syncthreads();
        if (tid < 32) { const int h = hist[tid]; basee[tid] = h ? (int)__hip_atomic_fetch_add(ctl + CW_COUNT + (l * NE + tid) * 64, (unsigned)h, __ATOMIC_RELAXED, __HIP_MEMORY_SCOPE_AGENT) : 0; }
        __syncthreads();
        if (tid < 32) { const int tok = row0 + tid;
#pragma unroll
            for (int k = 0; k < 4; ++k) { rasg[(size_t)ek[k] * TT + basee[ek[k]] + rk[k]] = tok * 4 + k; gate[tok * 4 + k] = gk[k]; } }
    }
}

constexpr int XCP = 144;
constexpr int XAP = 528;
struct Seq { int b, jc, L, rowbase, t0; bool lat; };
__device__ __forceinline__ Seq seq_of(int q) { Seq s; s.lat = q < 512; s.b = s.lat ? q >> 6 : (q - 512) >> 2; s.jc = s.lat ? q & 63 : (q - 512) & 3; s.L = s.lat ? SEQ : LCX; s.rowbase = s.lat ? s.b * SEQ : TL + s.b * LCX; s.t0 = s.jc * 64; return s; }
template <int PASS>
__device__ __forceinline__ void scan_unit(CP p, int l, int q, LAS unsigned char* lds) {
    const int tid = tid_(), lane = tid & 63, wid = __builtin_amdgcn_readfirstlane(tid >> 6), d = wid >> 2, hd = wid & 3, fr = lane & 15, fq = lane >> 4;
    LAS unsigned char* XC = lds + wid * (64 * XCP);
    LAS float* CAR = (LAS float*)(lds + 8 * 64 * XCP + wid * 256);
    LAS unsigned char* HB = lds + 8 * 64 * XCP + 2048;
    LAS unsigned char* XA = HB;
    const bf16_t* PROJ = (const bf16_t*)(p->ws + WS_PROJ); float* SUMM = (float*)(p->ws + WS_SUMM);
    const Seq sq = seq_of(q); const int b = sq.b, jc = sq.jc, L = sq.L, rowbase = sq.rowbase, t0 = sq.t0; const bool lat = sq.lat;
    __syncthreads();
    { u32x4 w[5];
#pragma unroll
      for (int it = 0; it < 5; ++it) { const int task = it * 512 + tid, r = task >> 5, cg = task & 31, tt = t0 - 3 + r; w[it] = (u32x4){0u, 0u, 0u, 0u};
          if (task < 70 * 32 && tt >= 0 && tt < L) w[it] = *(const u32x4*)(PROJ + (size_t)(rowbase + tt) * NPROJ + 8 * cg); }
#pragma unroll
      for (int it = 0; it < 5; ++it) { const int task = it * 512 + tid, r = task >> 5, cg = task & 31; if (task < 70 * 32) *(LAS u32x4*)(XA + r * XAP + cg * 16) = w[it]; } }
    float car = 0.f;
    if (PASS == 2) { const int c = 64 * hd + lane;
        const int n = d == 0 ? (lat ? 4 + jc : jc) : (lat ? 4 + 63 - jc : 3 - jc);
        for (int s0 = 0; s0 < n; s0 += 16) { float A_[16], H_[16];
#pragma unroll
            for (int e = 0; e < 16; ++e) { const int s = s0 + e; int qq;
                if (d == 0) qq = (lat && s >= 4) ? b * 64 + (s - 4) : 512 + b * 4 + s; else qq = (lat && s >= 4) ? b * 64 + 63 - (s - 4) : 512 + b * 4 + 3 - s;
                A_[e] = 1.f; H_[e] = 0.f; if (s < n) { const float* sp_ = SUMM + ((size_t)qq * 2 + d) * 512; A_[e] = sp_[c]; H_[e] = sp_[256 + c]; } }
#pragma unroll
            for (int e = 0; e < 16; ++e) car = A_[e] * car + H_[e]; } }
    __syncthreads();
    { const int c = 64 * hd + lane; const float* cw = p->conv_a_w + ((size_t)(l * 2 + d) * 4) * 256 + c;
      const float w0 = cw[0], w1 = cw[256], w2 = cw[512], w3 = cw[768], cb = p->conv_a_b[(l * 2 + d) * 256 + c];
      const float k0 = d ? w3 : w0, k1 = d ? w2 : w1, k2 = d ? w1 : w2, k3 = d ? w0 : w3;
      const LAS unsigned char* xp = XA + (d ? 3 : 0) * XAP + c * 2;
      float xa_ = bf2f(*(const LAS bf16_t*)(xp)), xb_ = bf2f(*(const LAS bf16_t*)(xp + XAP)), xc_ = bf2f(*(const LAS bf16_t*)(xp + 2 * XAP));
#pragma unroll 16
      for (int t = 0; t < 64; ++t) { const float xd_ = bf2f(*(const LAS bf16_t*)(xp + (t + 3) * XAP)); const float v = k0 * xa_ + k1 * xb_ + k2 * xc_ + k3 * xd_ + cb;
          *(LAS bf16_t*)(XC + t * XCP + lane * 2) = f2bf(v); xa_ = xb_; xb_ = xc_; xc_ = xd_; } }
    if (PASS == 2) CAR[lane] = car;
    asm volatile("" ::: "memory");
    if (PASS == 2) __syncthreads();
    float cr[4], at[4], sp[4], brr[4], bii[4];
#pragma unroll
    for (int n = 0; n < 4; ++n) { const int ch = 16 * n + fr; cr[n] = PASS == 2 ? CAR[ch] : 0.f; at[n] = 1.f;
        const float lam = p->rg_lambda[(l * 2 + d) * 256 + 64 * hd + ch]; sp[n] = -8.0f * 1.4426950408889634f * log1pf(__expf(-lam));
        brr[n] = p->b_rg_r[((l * 2 + d) * 4 + hd) * 64 + ch]; bii[n] = p->b_rg_i[((l * 2 + d) * 4 + hd) * 64 + ch]; }
    const bf16_t* wg = (const bf16_t*)(p->ws + WS_WGT) + (size_t)((l * 2 + d) * 2) * 4 * 4096;
    const int src1 = d ? lane + 16 : lane - 16, src2 = d ? lane + 32 : lane - 32, srct = d ? fr : 48 + fr;
    const bool has1 = d ? fq <= 2 : fq >= 1, has2 = d ? fq <= 1 : fq >= 2;
    for (int n = 0; n < 4; ++n) {
        bf16x8 Br[2], Bi[2];
#pragma unroll
        for (int s = 0; s < 2; ++s) { Br[s] = *(const bf16x8*)(wg + ((size_t)(0 * 4 + hd) * 64 + 16 * n + fr) * 64 + 32 * s + 8 * fq); Bi[s] = *(const bf16x8*)(wg + ((size_t)(1 * 4 + hd) * 64 + 16 * n + fr) * 64 + 32 * s + 8 * fq); }
        float Hj[4][4], Aj[4][4];
#pragma unroll
        for (int mt = 0; mt < 4; ++mt) {
            const bf16x8 A0 = *(const LAS bf16x8*)(XC + (16 * mt + fr) * XCP + (8 * fq) * 2), A1 = *(const LAS bf16x8*)(XC + (16 * mt + fr) * XCP + (32 + 8 * fq) * 2);
            f32x4 ar = {0.f, 0.f, 0.f, 0.f}, ai = {0.f, 0.f, 0.f, 0.f};
            ar = __builtin_amdgcn_mfma_f32_16x16x32_bf16(A0, Br[0], ar, 0, 0, 0); ar = __builtin_amdgcn_mfma_f32_16x16x32_bf16(A1, Br[1], ar, 0, 0, 0);
            ai = __builtin_amdgcn_mfma_f32_16x16x32_bf16(A0, Bi[0], ai, 0, 0, 0); ai = __builtin_amdgcn_mfma_f32_16x16x32_bf16(A1, Bi[1], ai, 0, 0, 0);
            float a_[4], b_[4];
#pragma unroll
            for (int j = 0; j < 4; ++j) { const int tok = 16 * mt + 4 * fq + j; const float xcv = bf2f(*(const LAS bf16_t*)(XC + tok * XCP + (16 * n + fr) * 2));
                const float r = sigmoidf_(ar[j] + brr[n]), ig = sigmoidf_(ai[j] + bii[n]); const float a = fexp2(r * sp[n]);
                a_[j] = a; b_[j] = __builtin_amdgcn_sqrtf(fmaxf(1.0f - a * a, 0.f)) * (ig * xcv); }
            if (d == 0) { Hj[mt][0] = b_[0]; Aj[mt][0] = a_[0];
#pragma unroll
                for (int j = 1; j < 4; ++j) { Hj[mt][j] = a_[j] * Hj[mt][j - 1] + b_[j]; Aj[mt][j] = a_[j] * Aj[mt][j - 1]; } }
            else { Hj[mt][3] = b_[3]; Aj[mt][3] = a_[3];
#pragma unroll
                for (int j = 2; j >= 0; --j) { Hj[mt][j] = a_[j] * Hj[mt][j + 1] + b_[j]; Aj[mt][j] = a_[j] * Aj[mt][j + 1]; } }
        }
        float iA[4], iH[4], eA[4], eH[4], tA[4], tH[4];
#pragma unroll
        for (int mt = 0; mt < 4; ++mt) { iA[mt] = d ? Aj[mt][0] : Aj[mt][3]; iH[mt] = d ? Hj[mt][0] : Hj[mt][3]; }
        { float pA[4], pH[4];
#pragma unroll
          for (int mt = 0; mt < 4; ++mt) { pA[mt] = bperm(iA[mt], src1); pH[mt] = bperm(iH[mt], src1); }
#pragma unroll
          for (int mt = 0; mt < 4; ++mt) if (has1) { iH[mt] = iA[mt] * pH[mt] + iH[mt]; iA[mt] = iA[mt] * pA[mt]; }
#pragma unroll
          for (int mt = 0; mt < 4; ++mt) { pA[mt] = bperm(iA[mt], src2); pH[mt] = bperm(iH[mt], src2); }
#pragma unroll
          for (int mt = 0; mt < 4; ++mt) if (has2) { iH[mt] = iA[mt] * pH[mt] + iH[mt]; iA[mt] = iA[mt] * pA[mt]; } }
#pragma unroll
        for (int mt = 0; mt < 4; ++mt) { eA[mt] = bperm(iA[mt], src1); eH[mt] = bperm(iH[mt], src1); tA[mt] = bperm(iA[mt], srct); tH[mt] = bperm(iH[mt], srct); if (!has1) { eA[mt] = 1.f; eH[mt] = 0.f; } }
#pragma unroll
        for (int mi = 0; mi < 4; ++mi) { const int mt = d ? 3 - mi : mi;
            const float hin = eH[mt] + eA[mt] * cr[n];
            if (PASS == 2) {
#pragma unroll
                for (int j = 0; j < 4; ++j) { const int tok = 16 * mt + 4 * fq + j; *(LAS bf16_t*)(HB + ((d * 64 + tok) * 256 + 64 * hd + 16 * n + fr) * 2) = f2bf(Hj[mt][j] + Aj[mt][j] * hin); } }
            cr[n] = tH[mt] + tA[mt] * cr[n]; at[n] *= tA[mt]; }
    }
    if (PASS == 1) { if (fq == 0) {
#pragma unroll
            for (int n = 0; n < 4; ++n) { float* s = SUMM + ((size_t)q * 2 + d) * 512 + 64 * hd + 16 * n + fr; s[0] = at[n]; s[256] = cr[n]; } } }
    else {
        __syncthreads();
        bf16_t* Y = (bf16_t*)(p->ws + WS_YCAT);
        u32x4 gaw[4];
#pragma unroll
        for (int it = 0; it < 4; ++it) { const int task = it * 512 + tid, tok = task >> 5, cg = task & 31; gaw[it] = *(const u32x4*)(PROJ + ((size_t)rowbase + t0 + tok) * NPROJ + 256 + 8 * cg); }
#pragma unroll
        for (int it = 0; it < 4; ++it) { const int task = it * 512 + tid, tok = task >> 5, cg = task & 31; const size_t row = (size_t)rowbase + t0 + tok;
            float hf[8], hb[8], ga[8], y[8];
            unpack8(*(const LAS u32x4*)(HB + ((0 * 64 + tok) * 256 + 8 * cg) * 2), hf); unpack8(*(const LAS u32x4*)(HB + ((1 * 64 + tok) * 256 + 8 * cg) * 2), hb);
            unpack8(gaw[it], ga);
#pragma unroll
            for (int e = 0; e < 8; ++e) { const float g = ga[e]; y[e] = (hf[e] + hb[e]) * (g * sigmoidf_(1.5957691216057308f * (g + 0.044715f * g * g * g))); }
            *(u32x4*)(Y + row * D + 8 * cg) = pack8(y); }
    }
}

__device__ __forceinline__ void pool_unit(CP p, int l, int q, LAS unsigned char* lds) {
    LAS float* PB = (LAS float*)lds;
    const int tid = tid_();
    const bf16_t* PROJ = (const bf16_t*)(p->ws + WS_PROJ); bf16_t* Y = (bf16_t*)(p->ws + WS_YCAT);
    const Seq sq = seq_of(q); const int L = sq.L, rowbase = sq.rowbase, t0 = sq.t0;
    __syncthreads();
    { u32x4 w[5];
#pragma unroll
      for (int it = 0; it < 5; ++it) { const int task = it * 512 + tid, r = task >> 5, cg = task & 31, tt = t0 - 8 + r; w[it] = (u32x4){0u, 0u, 0u, 0u};
          if (tt >= 0 && tt < L) w[it] = *(const u32x4*)(PROJ + (size_t)(rowbase + tt) * NPROJ + 512 + 8 * cg); }
#pragma unroll
      for (int it = 0; it < 5; ++it) { const int task = it * 512 + tid, r = task >> 5, cg = task & 31; float f[8]; unpack8(w[it], f);
          *(LAS f32x4*)(PB + r * 256 + 8 * cg) = (f32x4){f[0], f[1], f[2], f[3]}; *(LAS f32x4*)(PB + r * 256 + 8 * cg + 4) = (f32x4){f[4], f[5], f[6], f[7]}; } }
    __syncthreads();
    { const int c = tid & 255, th = tid >> 8, hw = 1 << (c >> 6); const float bp = p->b_pool[l * 256 + c], ps = p->pool_scale[l * 256 + c];
#pragma unroll 4
      for (int o = 0; o < 32; ++o) { const int tl = 32 * th + o, t = t0 + tl; const int lo = max(t - hw, 0), hi = min(t + hw, L); float s = 0.f;
          for (int tt = lo; tt < hi; ++tt) s += PB[(tt - t0 + 8) * 256 + c];
          const float yv = (s * frcp((float)(hi - lo)) - PB[(tl + 8) * 256 + c] + bp) * ps;
          Y[(size_t)(rowbase + t) * D + 256 + c] = f2bf(yv); } }
}
__device__ __forceinline__ void four_unit(CP p, int l, int q) {
    const int tid = tid_();
    bf16_t* Y = (bf16_t*)(p->ws + WS_YCAT);
    const Seq sq = seq_of(q); const int b = sq.b, rowbase = sq.rowbase, t0 = sq.t0; const bool lat = sq.lat;
    const float* UU = (const float*)(p->ws + WS_UU); const float* VV = (const float*)(p->ws + WS_VV); const float* YCX = (const float*)(p->ws + WS_YCX);
#pragma unroll
    for (int it = 0; it < 4; ++it) { const int task = it * 512 + tid, tl = task >> 5, cg = task & 31, t = t0 + tl; float y[8];
        f32x4 u0, u1, v0 = {0.f, 0.f, 0.f, 0.f}, v1 = {0.f, 0.f, 0.f, 0.f}; float sgn, scale;
        if (lat) { const int k = t <= 2048 ? t : 4096 - t; sgn = t <= 2048 ? -1.0f : 1.0f; scale = 1.0f / 512.0f;
            const float* up = UU + (size_t)k * 2048 + b * 256 + 8 * cg; u0 = *(const f32x4*)up; u1 = *(const f32x4*)(up + 4);
            if (k < 2048) { const float* vp = VV + (size_t)k * 2048 + b * 256 + 8 * cg; v0 = *(const f32x4*)vp; v1 = *(const f32x4*)(vp + 4); } }
        else { sgn = 0.f; scale = 1.0f / 128.0f; const float* up = YCX + (size_t)t * 2048 + b * 256 + 8 * cg; u0 = *(const f32x4*)up; u1 = *(const f32x4*)(up + 4); }
        const f32x4 bf0 = *(const f32x4*)(p->b_four + l * 256 + 8 * cg), bf1 = *(const f32x4*)(p->b_four + l * 256 + 8 * cg + 4);
        const f32x4 r0 = (u0 + v0 * sgn) * scale + bf0, r1 = (u1 + v1 * sgn) * scale + bf1;
        y[0] = r0[0]; y[1] = r0[1]; y[2] = r0[2]; y[3] = r0[3]; y[4] = r1[0]; y[5] = r1[1]; y[6] = r1[2]; y[7] = r1[3];
        *(u32x4*)(Y + (size_t)(rowbase + t) * D + 512 + 8 * cg) = pack8(y); }
}
__device__ __forceinline__ void conformer_unit(CP p, int l, int q, LAS unsigned char* lds) {
    LAS float* V = (LAS float*)lds;
    const int tid = tid_(), lane = tid & 63, wid = __builtin_amdgcn_readfirstlane(tid >> 6);
    const bf16_t* PROJ = (const bf16_t*)(p->ws + WS_PROJ); bf16_t* Y = (bf16_t*)(p->ws + WS_YCAT);
    const Seq sq = seq_of(q); const int L = sq.L, rowbase = sq.rowbase, t0 = sq.t0;
    __syncthreads();
    { u32x4 wa[6], wg_[6];
#pragma unroll
      for (int it = 0; it < 6; ++it) { const int task = it * 512 + tid, r = task >> 5, cg = task & 31, tt = t0 - 15 + r; wa[it] = (u32x4){0u, 0u, 0u, 0u}; wg_[it] = wa[it];
          if (task < 94 * 32 && tt >= 0 && tt < L) { const bf16_t* pr = PROJ + (size_t)(rowbase + tt) * NPROJ + 768 + 8 * cg; wa[it] = *(const u32x4*)pr; wg_[it] = *(const u32x4*)(pr + 256); } }
#pragma unroll
      for (int it = 0; it < 6; ++it) { const int task = it * 512 + tid, r = task >> 5, cg = task & 31; float a[8], g[8], f[8]; unpack8(wa[it], a); unpack8(wg_[it], g);
#pragma unroll
          for (int e = 0; e < 8; ++e) f[e] = a[e] * sigmoidf_(g[e]);
          if (task < 94 * 32) { *(LAS f32x4*)(V + r * 256 + 8 * cg) = (f32x4){f[0], f[1], f[2], f[3]}; *(LAS f32x4*)(V + r * 256 + 8 * cg + 4) = (f32x4){f[4], f[5], f[6], f[7]}; } } }
    __syncthreads();
    const int hp = wid & 1, tq = wid >> 1, c0 = 128 * hp + 2 * lane;
    f32x2 wk[31];
#pragma unroll
    for (int k = 0; k < 31; ++k) wk[k] = *(const f32x2*)(p->conv_d_w + ((size_t)l * 31 + k) * 256 + c0);
    const f32x2 cb = *(const f32x2*)(p->conv_d_b + l * 256 + c0), lg = *(const f32x2*)(p->ln_d_g + l * 256 + c0), lb = *(const f32x2*)(p->ln_d_b + l * 256 + c0);
    for (int blk = 0; blk < 2; ++blk) { const int tl0 = 16 * tq + 8 * blk;
        f32x2 win[38];
#pragma unroll
        for (int i = 0; i < 38; ++i) win[i] = *(const LAS f32x2*)(V + (tl0 + i) * 256 + c0);
        f32x2 sv[8]; float m1[8], m2[8];
#pragma unroll
        for (int o = 0; o < 8; ++o) { f32x2 sacc = cb;
#pragma unroll
            for (int k = 0; k < 31; ++k) sacc += wk[k] * win[o + k];
            sv[o] = sacc; m1[o] = sacc.x + sacc.y; m2[o] = sacc.x * sacc.x + sacc.y * sacc.y; }
#pragma unroll
        for (int st = 16; st >= 1; st >>= 1) { float t1[8], t2[8];
#pragma unroll
            for (int o = 0; o < 8; ++o) { t1[o] = bperm(m1[o], lane ^ st); t2[o] = bperm(m2[o], lane ^ st); }
#pragma unroll
            for (int o = 0; o < 8; ++o) { m1[o] += t1[o]; m2[o] += t2[o]; } }
#pragma unroll
        for (int o = 0; o < 8; ++o) { const float mean = m1[o] * (1.0f / 64.0f); const float var = fmaxf(m2[o] * (1.0f / 64.0f) - mean * mean, 0.f); const float rs = __builtin_amdgcn_rsqf(var + 1e-6f);
            f32x2 yv = (sv[o] - mean) * rs * lg + lb; yv.x = yv.x * sigmoidf_(yv.x); yv.y = yv.y * sigmoidf_(yv.y);
            *(unsigned*)(Y + (size_t)(rowbase + t0 + tl0 + o) * D + 768 + c0) = cvt_pk_bf16(yv.x, yv.y); } }
}

struct SchedIn { const char *U, *W, *WF; char *PROJ, *PQT, *PQC;
    __device__ __forceinline__ bool next(int i, g8::Unit& u) const { const int L = i * (int)gridDim.x + (int)blockIdx.x; if (L >= 952) return false; const int id = g8::xcd_remap(L, 952);
        if (id < 680) { u.kind = 0; u.pm = id / 5; u.pn = id % 5; u.a = U + (size_t)u.pm * 256 * 2048; u.b = W + (size_t)u.pn * 256 * 2048; u.o = PROJ; u.e = 0; }
        else { const int r = id - 680; u.kind = 1; u.pm = r & 1; u.pn = r >> 1; u.a = WF + (size_t)u.pm * 256 * 2048; u.b = U + (size_t)u.pn * 256 * 2048; u.e = 0;
            if (u.pn < 128) u.o = PQT + ((size_t)(u.pm * 2048 + (u.pn >> 4) * 256) * 4096 + (u.pn & 15) * 256) * 2; else u.o = PQC + ((size_t)((u.pn - 128) * 256) * 512 + u.pm * 256) * 2; }
        return true; } };
struct EpiIn { static constexpr bool PERM = true; const float* bin; const float* bf;
    __device__ __forceinline__ void operator()(const f32x4 (&acc)[2][2][4][2], const g8::Unit& u, int wr, int wc, int fr, int fq) const {
        asm volatile("" : "+v"(fr), "+v"(fq));
        if (u.kind == 0) { const int row0 = u.pm * 256 + wr * 64 + fr, col0 = u.pn * 256 + wc * 32 + 8 * fq; bf16_t* O = (bf16_t*)u.o;
            f32x4 bv[2][2];
#pragma unroll
            for (int bj = 0; bj < 2; ++bj)
#pragma unroll
                for (int n = 0; n < 2; ++n) bv[bj][n] = *(const f32x4*)(bin + col0 + bj * 128 + 4 * n);
#pragma unroll
            for (int ai = 0; ai < 2; ++ai)
#pragma unroll
                for (int m = 0; m < 4; ++m) { bf16_t* rowp = O + (size_t)(row0 + ai * 128 + m * 16) * NPROJ + col0;
#pragma unroll
                    for (int bj = 0; bj < 2; ++bj) { const f32x4 v0 = acc[ai][bj][m][0] + bv[bj][0], v1 = acc[ai][bj][m][1] + bv[bj][1];
                        u32x4 w; w.x = cvt_pk_bf16(v0[0], v0[1]); w.y = cvt_pk_bf16(v0[2], v0[3]); w.z = cvt_pk_bf16(v1[0], v1[1]); w.w = cvt_pk_bf16(v1[2], v1[3]); *(u32x4*)(rowp + bj * 128) = w; } }
        } else { const int pitch = u.pn < 128 ? 4096 : 512; bf16_t* O = (bf16_t*)u.o; const int col0 = wc * 32 + 8 * fq;
#pragma unroll
            for (int ai = 0; ai < 2; ++ai)
#pragma unroll
                for (int m = 0; m < 4; ++m) { const int r = ai * 128 + wr * 64 + m * 16 + fr; const float bb = bf[u.pm * 256 + r]; bf16_t* rowp = O + (size_t)r * pitch + col0;
#pragma unroll
                    for (int bj = 0; bj < 2; ++bj) { const f32x4 v0 = acc[ai][bj][m][0] + bb, v1 = acc[ai][bj][m][1] + bb;
                        u32x4 w; w.x = cvt_pk_bf16(v0[0], v0[1]); w.y = cvt_pk_bf16(v0[2], v0[3]); w.z = cvt_pk_bf16(v1[0], v1[1]); w.w = cvt_pk_bf16(v1[2], v1[3]); *(u32x4*)(rowp + bj * 128) = w; } }
        } } };
struct SchedDft { const char *CM, *SM, *PQT; char *UU, *VV;
    __device__ __forceinline__ bool next(int i, g8::Unit& u) const { const int id = (int)blockIdx.x; if (i > 0 || id >= 136) return false; u.kind = 0; u.e = 0;
        if (id < 72) { u.pm = id >> 3; u.pn = id & 7; u.a = CM + (size_t)u.pm * 256 * 8192; u.b = PQT + (size_t)u.pn * 256 * 8192; u.o = UU + ((size_t)u.pm * 256 * 2048 + u.pn * 256) * 4; }
        else { const int r = id - 72; u.pm = r >> 3; u.pn = r & 7; u.a = SM + (size_t)u.pm * 256 * 8192; u.b = PQT + (size_t)(2048 + u.pn * 256) * 8192; u.o = VV + ((size_t)u.pm * 256 * 2048 + u.pn * 256) * 4; }
        return true; } };
struct SchedDftC { const char *DC, *PQC; char* YCX;
    __device__ __forceinline__ bool next(int i, g8::Unit& u) const { const int id = (int)blockIdx.x - 136; if (i > 0 || id < 0 || id >= 8) return false; u.kind = 0; u.e = 0; u.pm = 0; u.pn = id;
        u.a = DC; u.b = PQC + (size_t)id * 256 * 1024; u.o = YCX + (size_t)id * 256 * 4; return true; } };
struct EpiF32 { static constexpr bool PERM = false;
    __device__ __forceinline__ void operator()(const f32x4 (&acc)[2][2][4][2], const g8::Unit& u, int wr, int wc, int fr, int fq) const {
        asm volatile("" : "+v"(fr), "+v"(fq));
        float* O = (float*)u.o; const int row0 = wr * 64 + fr, col0 = wc * 32 + 4 * fq;
#pragma unroll
        for (int ai = 0; ai < 2; ++ai)
#pragma unroll
            for (int m = 0; m < 4; ++m) { float* rowp = O + (size_t)(row0 + ai * 128 + m * 16) * 2048 + col0;
#pragma unroll
                for (int bj = 0; bj < 2; ++bj)
#pragma unroll
                    for (int n = 0; n < 2; ++n) *(f32x4*)(rowp + bj * 128 + n * 16) = acc[ai][bj][m][n]; } } };
struct SchedOut { const char *Y, *W; int nm; const float* modv_l;
    __device__ __forceinline__ bool next(int i, g8::Unit& u) const { const int nu = nm * 4, L = i * (int)gridDim.x + (int)blockIdx.x; if (L >= nu) return false; const int id = g8::xcd_remap(L, nu);
        u.kind = 0; u.pm = id >> 2; u.pn = id & 3; u.a = Y + (size_t)u.pm * 256 * 2048; u.b = W + (size_t)u.pn * 256 * 2048; u.o = nullptr; u.e = u.pm < 128 ? u.pm >> 4 : 8; return true; } };
struct EpiOut { static constexpr bool PERM = false; float* X; const float* bout; const float* modv_l;
    __device__ __forceinline__ void operator()(const f32x4 (&acc)[2][2][4][2], const g8::Unit& u, int wr, int wc, int fr, int fq) const {
        asm volatile("" : "+v"(fr), "+v"(fq));
        const int row0 = u.pm * 256 + wr * 64 + fr, col0 = u.pn * 256 + wc * 32 + 4 * fq; const float* g1 = modv_l + (size_t)u.e * 6144 + 2048;
        f32x4 bv[2][2], gv[2][2];
#pragma unroll
        for (int bj = 0; bj < 2; ++bj)
#pragma unroll
            for (int n = 0; n < 2; ++n) { bv[bj][n] = *(const f32x4*)(bout + col0 + bj * 128 + n * 16); gv[bj][n] = *(const f32x4*)(g1 + col0 + bj * 128 + n * 16); }
#pragma unroll
        for (int ai = 0; ai < 2; ++ai)
#pragma unroll
            for (int m = 0; m < 4; ++m) { float* rowp = X + (size_t)(row0 + ai * 128 + m * 16) * D + col0;
#pragma unroll
                for (int bj = 0; bj < 2; ++bj)
#pragma unroll
                    for (int n = 0; n < 2; ++n) { f32x4* px = (f32x4*)(rowp + bj * 128 + n * 16); *px = *px + gv[bj][n] * (acc[ai][bj][m][n] + bv[bj][n]); } } } };
struct MoeTab { const LAS int* pref; const LAS int* cnt; int ntile;
    __device__ __forceinline__ int pref_(int e) const { return __builtin_amdgcn_readfirstlane(pref[e]); }
    __device__ __forceinline__ int cnt_(int e) const { return __builtin_amdgcn_readfirstlane(cnt[e]); }
    __device__ __forceinline__ int expert_of(int pm) const { int e = 0;
        for (int k = 1; k < 32; ++k) e += (pm >= pref_(k)) ? 1 : 0; return e; } };
struct SchedGu { MoeTab tb; const char *U, *W; char* ACT; const int* rasg;
    __device__ __forceinline__ bool next(int i, g8::Unit& u) const { const int nu = tb.ntile * 8, L = i * (int)gridDim.x + (int)blockIdx.x; if (L >= nu) return false; const int id = g8::xcd_remap(L, nu);
        u.kind = 0; u.pm = id >> 3; u.pn = id & 7; u.e = tb.expert_of(u.pm); u.a = U; u.b = W + ((size_t)u.e * 2048 + u.pn * 256) * 2048; u.o = ACT + (size_t)u.pm * 256 * 2048; return true; }
    __device__ __forceinline__ int row(const g8::Unit& u, int r) const { const int v = rasg[(size_t)u.e * TT + (u.pm - tb.pref_(u.e)) * 256 + r] >> 2; return min(max(v, 0), TT - 1); } };
struct EpiGu { static constexpr bool PERM = true; const float* bgu;
    __device__ __forceinline__ void operator()(const f32x4 (&acc)[2][2][4][2], const g8::Unit& u, int wr, int wc, int fr, int fq) const {
        asm volatile("" : "+v"(fr), "+v"(fq));
        const int col0 = u.pn * 128 + wc * 32 + 8 * fq; bf16_t* O = (bf16_t*)u.o; const float* bg = bgu + (size_t)u.e * 2048 + col0;
        f32x4 bgt[2], bup[2];
#pragma unroll
        for (int n = 0; n < 2; ++n) { bgt[n] = *(const f32x4*)(bg + 4 * n); bup[n] = *(const f32x4*)(bg + 1024 + 4 * n); }
#pragma unroll
        for (int ai = 0; ai < 2; ++ai)
#pragma unroll
            for (int m = 0; m < 4; ++m) { const int r = ai * 128 + wr * 64 + m * 16 + fr; float y[8];
#pragma unroll
                for (int n = 0; n < 2; ++n) { const f32x4 g4 = acc[ai][0][m][n] + bgt[n], u4 = acc[ai][1][m][n] + bup[n];
#pragma unroll
                    for (int e = 0; e < 4; ++e) { const float gt = fminf(g4[e], 7.0f), up = fminf(fmaxf(u4[e], -7.0f), 7.0f); y[4 * n + e] = (up + 1.0f) * (gt * sigmoidf_(1.702f * gt)); } }
                *(u32x4*)(O + (size_t)r * D + col0) = pack8(y); } } };
struct SchedDown { MoeTab tb; const char *ACT, *W;
    __device__ __forceinline__ bool next(int i, g8::Unit& u) const { const int nu = tb.ntile * 4, L = i * (int)gridDim.x + (int)blockIdx.x; if (L >= nu) return false; const int id = g8::xcd_remap(L, nu);
        u.kind = 0; u.pm = id >> 2; u.pn = id & 3; u.e = tb.expert_of(u.pm); u.a = ACT + (size_t)u.pm * 256 * 2048; u.b = W + ((size_t)u.e * 1024 + u.pn * 256) * 2048; u.o = nullptr; return true; } };
struct EpiDown { static constexpr bool PERM = true; MoeTab tb; const float* bd; const int* rasg; const float* gate; bf16_t* YS;
    __device__ __forceinline__ void operator()(const f32x4 (&acc)[2][2][4][2], const g8::Unit& u, int wr, int wc, int fr, int fq) const {
        asm volatile("" : "+v"(fr), "+v"(fq));
        const int col0 = u.pn * 256 + wc * 32 + 8 * fq; const float* bp = bd + (size_t)u.e * 1024 + col0; const int rank0 = (u.pm - tb.pref_(u.e)) * 256, cnt = tb.cnt_(u.e);
        f32x4 bv[2][2];
#pragma unroll
        for (int bj = 0; bj < 2; ++bj)
#pragma unroll
            for (int n = 0; n < 2; ++n) bv[bj][n] = *(const f32x4*)(bp + bj * 128 + 4 * n);
#pragma unroll
        for (int ai = 0; ai < 2; ++ai)
#pragma unroll
            for (int m = 0; m < 4; ++m) { const int rank = rank0 + ai * 128 + wr * 64 + m * 16 + fr;
                if (rank < cnt) { const int asg = rasg[(size_t)u.e * TT + rank]; const float g = gate[asg]; bf16_t* rowp = YS + (size_t)asg * D + col0;
#pragma unroll
                    for (int bj = 0; bj < 2; ++bj) { const f32x4 v0 = (acc[ai][bj][m][0] + bv[bj][0]) * g, v1 = (acc[ai][bj][m][1] + bv[bj][1]) * g;
                        u32x4 w; w.x = cvt_pk_bf16(v0[0], v0[1]); w.y = cvt_pk_bf16(v0[2], v0[3]); w.z = cvt_pk_bf16(v1[0], v1[1]); w.w = cvt_pk_bf16(v1[2], v1[3]); *(u32x4*)(rowp + bj * 128) = w; } } } } };
__device__ __forceinline__ MoeTab moe_tables(CP p, int l, LAS unsigned char* lds) {
    LAS int* pref = (LAS int*)(lds + g8::STAGE_BYTES); LAS int* cnt = pref + 64;
    unsigned* ctl = (unsigned*)(p->ws + WS_CTL);
    __syncthreads();
    if (tid_() < 32) cnt[tid_()] = (int)__hip_atomic_load(ctl + CW_COUNT + (l * NE + tid_()) * 64, __ATOMIC_RELAXED, __HIP_MEMORY_SCOPE_AGENT);
    __syncthreads();
    if (tid_() == 0) { int s = 0; for (int e = 0; e < 32; ++e) { pref[e] = s; s += (cnt[e] + 255) >> 8; } pref[32] = s; }
    __syncthreads();
    MoeTab tb; tb.pref = pref; tb.cnt = cnt; tb.ntile = __builtin_amdgcn_readfirstlane(pref[32]); return tb;
}

constexpr int N_PHASES = 18;
__global__ void __launch_bounds__(512, 2) mega_fwd(Params p_unused) {
    CP p = launder_params();
    extern __shared__ __attribute__((aligned(16))) unsigned char shm_[];
    LAS unsigned char* lds0 = (LAS unsigned char*)shm_;
    LAS unsigned char* lds = lds0 + LDS_BASE;
    if (tid_() == 0) *(LAS u32x4*)lds0 = (u32x4){0u, 0u, 0u, 0u};
    __syncthreads();
    XcdBarrier bar = xcd_barrier_post((unsigned*)(p->ws + WS_CTL), (volatile LAS unsigned*)lds0);
    int ph = 0;
#ifndef P3A
#define P3A 1
#define P3B 1
#define P3C 1
#endif
#ifndef PHMASK
#define PHMASK 0x3ff
#endif
#ifndef REPMASK
#define REPMASK 0
#endif
#define PHASE_BEGIN_K(k) p = launder_params(); if (((PHMASK >> (k)) & 1) && ph >= p->ph_lo && ph < p->ph_hi) for (int rep_ = 0; rep_ < ((((REPMASK) >> (k)) & 1) ? 2 : 1); ++rep_) {
#define PHASE_END } ++ph; if (ph > p->ph_lo && ph < p->ph_hi) xcd_barrier(bar);
    PHASE_BEGIN_K(0) phase_prologue(p, lds); PHASE_END
    for (int l = 0; l < 2; ++l) {
        const float* modv_l = (const float*)(p->ws + WS_MODV) + (size_t)l * 9 * 6144;
        PHASE_BEGIN_K(1) phase_norm(p, l); PHASE_END
        PHASE_BEGIN_K(2) { SchedIn S; S.U = (const char*)(p->ws + WS_U); S.W = (const char*)(p->ws + WS_WINT) + (size_t)l * NPROJ * 2048; S.WF = (const char*)(p->ws + WS_WFT) + (size_t)l * 512 * 2048;
                      S.PROJ = (char*)(p->ws + WS_PROJ); S.PQT = (char*)(p->ws + WS_PQT); S.PQC = (char*)(p->ws + WS_PQC);
                      EpiIn E; E.bin = (const float*)(p->ws + WS_BIN) + l * NPROJ; E.bf = (const float*)(p->ws + WS_BF) + l * 512;
                      g8::gemm_phase<EpiIn, SchedIn, false>(lds, 1024, S, E); } PHASE_END
        PHASE_BEGIN_K(3) { if (blockIdx.x < 136) { SchedDft S; S.CM = (const char*)(p->ws + WS_CMAT); S.SM = (const char*)(p->ws + WS_SMAT); S.PQT = (const char*)(p->ws + WS_PQT); S.UU = (char*)(p->ws + WS_UU); S.VV = (char*)(p->ws + WS_VV);
                          g8::gemm_phase<EpiF32, SchedDft, false>(lds, 4096, S, EpiF32{}); }
                      else { if (blockIdx.x < 144) { SchedDftC S; S.DC = (const char*)(p->ws + WS_DFTC); S.PQC = (const char*)(p->ws + WS_PQC); S.YCX = (char*)(p->ws + WS_YCX);
                                 g8::gemm_phase<EpiF32, SchedDftC, false>(lds, 512, S, EpiF32{}); }
                             const int nw = (int)gridDim.x - 136;
                             for (int uu = (int)blockIdx.x - 136; uu < 3 * NCHUNK; uu += nw) { const int kind = uu / NCHUNK, q = uu % NCHUNK;
                                 if (kind == 0) scan_unit<1>(p, l, q, lds); else if (kind == 1) conformer_unit(p, l, q, lds); else pool_unit(p, l, q, lds); } } } PHASE_END
        PHASE_BEGIN_K(4) { for (int q = blockIdx.x; q < NCHUNK; q += gridDim.x) { scan_unit<2>(p, l, q, lds); four_unit(p, l, q); } } PHASE_END
        PHASE_BEGIN_K(5) { SchedOut S; S.Y = (const char*)(p->ws + WS_YCAT); S.W = (const char*)(p->ws + WS_WOUTT) + (size_t)l * D * 2048; S.nm = l == 0 ? 136 : 128; S.modv_l = modv_l;
                      EpiOut E; E.X = (float*)(p->ws + WS_X); E.bout = (const float*)(p->ws + WS_BOUT) + l * D; E.modv_l = modv_l;
                      g8::gemm_phase<EpiOut, SchedOut, false>(lds, 1024, S, E); } PHASE_END
        PHASE_BEGIN_K(6) phase_router(p, l, lds); PHASE_END
        PHASE_BEGIN_K(7) { MoeTab tb = moe_tables(p, l, lds);
                      SchedGu S; S.tb = tb; S.U = (const char*)(p->ws + WS_U); S.W = (const char*)(p->ws + WS_WGUT) + (size_t)l * NE * 2048 * 2048; S.ACT = (char*)(p->ws + WS_ACT); S.rasg = (const int*)(p->ws + WS_RASG);
                      EpiGu E; E.bgu = p->b_gu + (size_t)l * NE * 2048;
                      g8::gemm_phase<EpiGu, SchedGu, true>(lds, 1024, S, E); } PHASE_END
        PHASE_BEGIN_K(8) { MoeTab tb = moe_tables(p, l, lds);
                      SchedDown S; S.tb = tb; S.ACT = (const char*)(p->ws + WS_ACT); S.W = (const char*)(p->ws + WS_WDT) + (size_t)l * NE * 1024 * 2048;
                      EpiDown E; E.tb = tb; E.bd = p->b_down + (size_t)l * NE * 1024; E.rasg = (const int*)(p->ws + WS_RASG); E.gate = (const float*)(p->ws + WS_GATE); E.YS = (bf16_t*)(p->ws + WS_YS);
                      g8::gemm_phase<EpiDown, SchedDown, false>(lds, 1024, S, E); } PHASE_END
    }
    PHASE_BEGIN_K(9) phase_norm(p, 2); PHASE_END
#undef PHASE_BEGIN_K
#undef PHASE_END
}

extern "C" void kernel_launch(void* const* d_in, const int* in_sizes, int n_in, void* d_out, int out_size, void* d_ws, size_t ws_size, hipStream_t stream) {
    static int grid = 0;
    if (!grid) {
        if (n_in != 37 || ws_size < WS_END) { fprintf(stderr, "kernel_launch: expected 37 inputs and >= %zu bytes of workspace (got %d, %zu)\n", (size_t)WS_END, n_in, ws_size); }
        int dev = 0, cus = 0, per_cu = 0;
        hipGetDevice(&dev); hipDeviceGetAttribute(&cus, hipDeviceAttributeMultiprocessorCount, dev);
        hipFuncSetAttribute((const void*)mega_fwd, hipFuncAttributeMaxDynamicSharedMemorySize, LDS_BYTES);
        hipOccupancyMaxActiveBlocksPerMultiprocessor(&per_cu, (const void*)mega_fwd, 512, LDS_BYTES);
        if (per_cu < 1) fprintf(stderr, "kernel_launch: occupancy query reports %d workgroups per CU\n", per_cu);
        grid = cus > 0 ? cus : 256;
    }
    hipMemsetAsync((char*)d_ws + WS_CTL, 0, CTL_BYTES, stream);
    Params hp{};
    const float** f = (const float**)&hp;
    for (int i = 0; i < 37; ++i) f[i] = (const float*)d_in[i];
    hp.out = (float*)d_out; hp.ws = (unsigned char*)d_ws;
#if MK_N_LAUNCHES == 1
    hp.ph_lo = 0; hp.ph_hi = N_PHASES;
    hipLaunchKernelGGL(mega_fwd, dim3(grid), dim3(512), LDS_BYTES, stream, hp);
#else
    for (int ph = 0; ph < N_PHASES; ++ph) { hp.ph_lo = ph; hp.ph_hi = ph + 1; hipLaunchKernelGGL(mega_fwd, dim3(grid), dim3(512), LDS_BYTES, stream, hp); }
#endif
}
```

```cpp
#include <hip/hip_runtime.h>
#include <cstdio>
#include <cstdint>

#ifndef MK_N_LAUNCHES
#define MK_N_LAUNCHES 1
#endif

#ifndef FP8_FROM
#define FP8_FROM 0
#endif
#define LAS __attribute__((address_space(3)))
typedef unsigned short bf16_t;
typedef short bf16x8 __attribute__((ext_vector_type(8)));
typedef float f32x4 __attribute__((ext_vector_type(4)));
typedef float f32x2 __attribute__((ext_vector_type(2)));
typedef unsigned u32x4 __attribute__((ext_vector_type(4)));
typedef unsigned u32x2 __attribute__((ext_vector_type(2)));
typedef int i32x4 __attribute__((ext_vector_type(4)));
typedef int i32x8 __attribute__((ext_vector_type(8)));

constexpr int D = 1024, NB = 8, SEQ = 4096, LCX = 256, TL = NB * SEQ, TC = NB * LCX, TT = TL + TC;
constexpr int NPROJ = 1280;
constexpr int NE = 32, NCHUNK = 544;
constexpr int NTILE_MAX = 576;

constexpr size_t AL(size_t x) { return (x + 255) & ~(size_t)255; }
constexpr size_t CTL_BYTES = 65536;
constexpr size_t WS_CTL = 0;
constexpr size_t WS_MODV = WS_CTL + CTL_BYTES;
constexpr size_t WS_X = AL(WS_MODV + (size_t)2 * 9 * 6144 * 4);
constexpr size_t WS_U = AL(WS_X + (size_t)TT * D * 4);
constexpr size_t WS_PROJ = AL(WS_U + (size_t)TT * D * 2);
constexpr size_t WS_PQT = AL(WS_PROJ + (size_t)TT * NPROJ * 2);
constexpr size_t WS_PQC = AL(WS_PQT + (size_t)4096 * 4096 * 2);
constexpr size_t WS_UU = AL(WS_PQC + (size_t)2048 * 512 * 2);
constexpr size_t WS_VV = AL(WS_UU + (size_t)2304 * 2048 * 4);
constexpr size_t WS_YCX = AL(WS_VV + (size_t)2048 * 2048 * 4);
constexpr size_t WS_YCAT = AL(WS_YCX + (size_t)256 * 2048 * 4);
constexpr size_t WS_SUMM = AL(WS_YCAT + (size_t)TT * D * 2);
constexpr size_t WS_WINT = AL(WS_SUMM + (size_t)NCHUNK * 1024 * 4);
constexpr size_t WS_WFT = AL(WS_WINT + (size_t)2 * NPROJ * D * 2);
constexpr size_t WS_BIN = AL(WS_WFT + (size_t)2 * 512 * D * 2);
constexpr size_t WS_BF = AL(WS_BIN + (size_t)2 * NPROJ * 4);
constexpr size_t WS_WOUTT = AL(WS_BF + (size_t)2 * 512 * 4);
constexpr size_t WS_BOUT = AL(WS_WOUTT + (size_t)2 * D * D * 2);
constexpr size_t WS_WGUT = AL(WS_BOUT + (size_t)2 * D * 4);
constexpr size_t WS_WDT = AL(WS_WGUT + (size_t)2 * NE * 2048 * D * 2);
constexpr size_t WS_WRT = AL(WS_WDT + (size_t)2 * NE * D * D * 2);
constexpr size_t WS_WGT = AL(WS_WRT + (size_t)2 * 2 * NE * D * 2);
constexpr size_t WS_CMAT = AL(WS_WGT + (size_t)2 * 2 * 2 * 4 * 64 * 64 * 2);
constexpr size_t WS_SMAT = AL(WS_CMAT + (size_t)2304 * 4096 * 2);
constexpr size_t WS_DFTC = AL(WS_SMAT + (size_t)2048 * 4096 * 2);
constexpr size_t WS_RASG = AL(WS_DFTC + (size_t)256 * 512 * 2);
constexpr size_t WS_GATE = AL(WS_RASG + (size_t)NE * TT * 4);
constexpr size_t WS_ACT = AL(WS_GATE + (size_t)TT * 4 * 4);
constexpr size_t WS_YS = AL(WS_ACT + (size_t)NTILE_MAX * 256 * D * 2);
constexpr size_t WS_POS = AL(WS_YS + (size_t)TT * 4 * D * 2);
constexpr size_t WS_AB = AL(WS_POS + (size_t)64 * 512 * 4);
constexpr size_t WS_U8 = AL(WS_AB + (size_t)NCHUNK * 8 * 16 * 64 * 16);
constexpr size_t WS_END = AL(WS_U8 + (size_t)TT * D);
constexpr int CW_QUEUE = 12288;
constexpr int CW_COUNT = 4096;

constexpr int LDS_BYTES = 147456;
constexpr int LDS_BASE = 1024;

__device__ __forceinline__ unsigned cvt_pk_bf16(float lo, float hi) { unsigned r; asm("v_cvt_pk_bf16_f32 %0, %1, %2" : "=v"(r) : "v"(lo), "v"(hi)); return r; }
__device__ __forceinline__ bf16_t f2bf(float f) { return (bf16_t)(cvt_pk_bf16(f, 0.f) & 0xffffu); }
__device__ __forceinline__ unsigned pk4_fp8(float a, float b, float c, float d) { int w = 0; w = __builtin_amdgcn_cvt_pk_fp8_f32(a, b, w, false); w = __builtin_amdgcn_cvt_pk_fp8_f32(c, d, w, true); return (unsigned)w; }
__device__ __forceinline__ float bf2f(bf16_t b) { return __uint_as_float(((unsigned)b) << 16); }
__device__ __forceinline__ float bflo(unsigned w) { return __uint_as_float(w << 16); }
__device__ __forceinline__ float bfhi(unsigned w) { return __uint_as_float(w & 0xffff0000u); }
__device__ __forceinline__ float fexp2(float x) { return __builtin_amdgcn_exp2f(x); }
__device__ __forceinline__ float frcp(float x) { return __builtin_amdgcn_rcpf(x); }
__device__ __forceinline__ float sigmoidf_(float x) { return frcp(1.0f + fexp2(-1.4426950408889634f * x)); }
__device__ __forceinline__ int tid_() { int t = (int)threadIdx.x; asm volatile("" : "+v"(t)); return t; }
__device__ __forceinline__ float bperm(float v, int src) { return __int_as_float(__builtin_amdgcn_ds_bpermute(src << 2, __float_as_int(v))); }
__device__ __forceinline__ float wave_sum(float v, int lane) {
#pragma unroll
    for (int o = 32; o >= 1; o >>= 1) v += bperm(v, lane ^ o);
    return v;
}
__device__ __forceinline__ void unpack8(const u32x4 w, float (&f)[8]) { f[0] = bflo(w.x); f[1] = bfhi(w.x); f[2] = bflo(w.y); f[3] = bfhi(w.y); f[4] = bflo(w.z); f[5] = bfhi(w.z); f[6] = bflo(w.w); f[7] = bfhi(w.w); }
__device__ __forceinline__ u32x4 pack8(const float (&f)[8]) { u32x4 w; w.x = cvt_pk_bf16(f[0], f[1]); w.y = cvt_pk_bf16(f[2], f[3]); w.z = cvt_pk_bf16(f[4], f[5]); w.w = cvt_pk_bf16(f[6], f[7]); return w; }

#define XB_TMO      128
#define XB_XCNT(j)  (256  + 64 * (j))
#define XB_XSUB(j)  (1280 + 64 * (j))
#define XB_XGEN(j)  (2304 + 64 * (j))
#define XB_TOP      3328
#define XB_TOPGEN   3392
#define XCD_BAR_WORDS 3456
#define XB_SPIN_CAP (1u << 18)
__device__ __forceinline__ unsigned xb_ld(unsigned* p)              { return __hip_atomic_load(p, __ATOMIC_RELAXED, __HIP_MEMORY_SCOPE_AGENT); }
__device__ __forceinline__ unsigned xb_add(unsigned* p, unsigned v) { return __hip_atomic_fetch_add(p, v, __ATOMIC_RELAXED, __HIP_MEMORY_SCOPE_AGENT); }
__device__ __forceinline__ unsigned xb_xcc_id() { return (unsigned)__builtin_amdgcn_s_getreg((3 << 11) | 20) & 0xFu; }
#define XB_SPIN(cond, bar) do { unsigned _sp = 0; while (cond) { __builtin_amdgcn_s_sleep(1); \
    if ((++_sp & 255u) == 0u) { if (xb_ld(&(bar)[XB_TMO])) break; if (_sp > XB_SPIN_CAP) { atomicAdd(&(bar)[XB_TMO], 1u); break; } } } } while (0)
struct XcdBarrier { unsigned* bar; unsigned x; volatile LAS unsigned* st; };
__device__ __forceinline__ XcdBarrier xcd_barrier_post(unsigned* bar, volatile LAS unsigned* st) {
    XcdBarrier b; b.bar = bar; b.x = xb_xcc_id(); b.st = st;
    if (threadIdx.x == 0) (void)xb_add(&bar[XB_XCNT(b.x)], 1u);
    return b;
}
__device__ __forceinline__ void xcd_barrier_complete(unsigned* bar, unsigned x, unsigned& nloc, unsigned& nx) {
    const unsigned G = gridDim.x * gridDim.y * gridDim.z;
    unsigned sum, cnt, mine, sp = 0u;
    for (;;) {
        sum = 0u; cnt = 0u; mine = 0u;
#pragma unroll
        for (unsigned j = 0; j < 16; ++j) { const unsigned c = xb_ld(&bar[XB_XCNT(j)]); sum += c; cnt += (c > 0u) ? 1u : 0u; mine = (j == x) ? c : mine; }
        if (sum == G) break;
        __builtin_amdgcn_s_sleep(1);
        if ((++sp & 255u) == 0u) { if (xb_ld(&bar[XB_TMO])) break; if (sp > XB_SPIN_CAP) { atomicAdd(&bar[XB_TMO], 1u); break; } }
    }
    nloc = mine > 0u ? mine : 1u; nx = cnt > 0u ? cnt : 1u;
}
__device__ __forceinline__ void xcd_barrier(const XcdBarrier& b) {
    asm volatile("s_waitcnt vmcnt(0)" ::: "memory");
    __syncthreads();
    if (threadIdx.x == 0) {
        unsigned* bar = b.bar;
        __builtin_amdgcn_s_waitcnt(0);
        unsigned nloc = b.st[0], nx = b.st[1];
        if (nloc == 0u) { unsigned xo = b.x; asm volatile("" : "+s"(xo)); xcd_barrier_complete(bar, xo, nloc, nx); b.st[0] = nloc; b.st[1] = nx; }
        const unsigned old = xb_add(&bar[XB_XSUB(b.x)], 1u);
        const unsigned gen = old / nloc;
        if (old + 1u == (gen + 1u) * nloc) {
            __builtin_amdgcn_fence(__ATOMIC_RELEASE, "agent");
            asm volatile("s_waitcnt vmcnt(0)" ::: "memory");
            const unsigned og = xb_add(&bar[XB_TOP], 1u);
            const unsigned tg = og / nx;
            if (og + 1u == (tg + 1u) * nx) xb_add(&bar[XB_TOPGEN], 1u);
            else XB_SPIN(xb_ld(&bar[XB_TOPGEN]) == tg, bar);
            __builtin_amdgcn_fence(__ATOMIC_ACQUIRE, "agent");
            xb_add(&bar[XB_XGEN(b.x)], 1u);
            asm volatile("s_waitcnt vmcnt(0)" ::: "memory");
        } else {
            XB_SPIN(xb_ld(&bar[XB_XGEN(b.x)]) == gen, bar);
            __builtin_amdgcn_fence(__ATOMIC_ACQUIRE, "agent");
            asm volatile("s_waitcnt vmcnt(0)" ::: "memory");
        }
    }
    __syncthreads();
}

namespace g8 {
constexpr int BM = 256, BK = 64, HALF = 128, HTB = HALF * BK * 2, STAGE_BYTES = 8 * HTB;
__device__ __forceinline__ int lds_byte(int r, int c) { const int st = (r >> 4) * 2 + (c >> 5), rr = r & 15, cc = c & 31, ob = rr * 64 + cc * 2; return st * 1024 + (ob ^ (((ob >> 9) & 1) << 5)); }
__device__ __forceinline__ void stage_rc(int b, int& R, int& C) { const int st = b / 1024, sb = b % 1024, swz = sb ^ (((sb >> 9) & 1) << 5); R = (st >> 1) * 16 + swz / 64; C = (st & 1) * 32 + (swz % 64) / 2; }
__device__ __forceinline__ int perm32(int rho) { const int n = rho >> 4, i = rho & 15; return 8 * (i >> 2) + 4 * n + (i & 3); }

struct Unit { const char* a; const char* b; char* o; int kind, pm, pn, e; };

__device__ __forceinline__ int xcd_remap(int L, int nu) { const int q = nu / 8, r = nu % 8, xcd = L % 8, off = L / 8; return (xcd < r ? xcd * (q + 1) : r * (q + 1) + (xcd - r) * q) + off; }

template <class Epi, class Sched, bool GATHER, bool FP8 = false>
__device__ __forceinline__ void gemm_phase(LAS unsigned char* lds, const int K, const Sched& S, const Epi& E) {
    const int tid = tid_(), wid = __builtin_amdgcn_readfirstlane(tid >> 6), lane = tid & 63, wr = wid >> 2, wc = wid & 3, fr = lane & 15, fq = lane >> 4;
    const int nt = K / BK;
    { u32x4 vo4;
      { int R, C; stage_rc(tid * 16, R, C); const int Rb = Epi::PERM ? ((R & ~31) + perm32(R & 31)) : R; vo4.x = (unsigned)(R * K + C) * 2u; vo4.z = (unsigned)(Rb * K + C) * 2u; }
      { int R, C; stage_rc(tid * 16 + 8192, R, C); const int Rb = Epi::PERM ? ((R & ~31) + perm32(R & 31)) : R; vo4.y = (unsigned)(R * K + C) * 2u; vo4.w = (unsigned)(Rb * K + C) * 2u; }
      *(LAS u32x4*)(lds + STAGE_BYTES + 4096 + tid * 16) = vo4; asm volatile("s_waitcnt lgkmcnt(0)" ::: "memory"); }
    const size_t kstep = (size_t)(BK * 2);
    const size_t hstep = (size_t)HALF * K * 2;
    const unsigned ldsw = (unsigned)wid * 1024u;
    const int aoff = lds_byte(wr * 64 + fr, fq * 8), boff = lds_byte(wc * 32 + fr, fq * 8);
#define G8_SA(b, h) (((b) * 2 + (h)) * HTB)
#define G8_SB(b, h) ((4 + (b) * 2 + (h)) * HTB)
#define G8_ST2(bufoff, gbase, isb) do { const u32x2 _v2 = *(const LAS u32x2*)(lds + STAGE_BYTES + 4096 + tid_() * 16 + (isb) * 8); _Pragma("unroll") for (int _i = 0; _i < 2; ++_i) { unsigned _vo = _i ? _v2.y : _v2.x; asm volatile("" : "+v"(_vo)); \
        __builtin_amdgcn_global_load_lds((const unsigned*)((const char*)(gbase) + _vo), (LAS unsigned*)(lds + (bufoff) + ldsw + _i * 8192), 16, 0, 0); } } while (0)
#define G8_STA_CUR(bufoff, gbase, h) do { if constexpr (GATHER) { const int _t = tid_(); _Pragma("unroll") for (int _i = 0; _i < 2; ++_i) { int _R, _C; stage_rc(_t * 16 + _i * 8192, _R, _C); unsigned _o = ROFF[parA * 256 + (h) * 128 + _R] + (unsigned)(_C * 2); asm volatile("" : "+v"(_o)); \
        __builtin_amdgcn_global_load_lds((const unsigned*)((const char*)(gbase) + _o), (LAS unsigned*)(lds + (bufoff) + ldsw + _i * 8192), 16, 0, 0); } } else { G8_ST2(bufoff, (gbase) + (h) * hstep, 0); } } while (0)
#define G8_LDA(dst, dst8, b, h) do { _Pragma("unroll") for (int m = 0; m < 4; ++m) { if constexpr (FP8) { const i32x4 lo_ = *(const LAS i32x4*)(lds + G8_SA(b, h) + aoff + m * 2048), hi_ = *(const LAS i32x4*)(lds + G8_SA(b, h) + aoff + m * 2048 + 1024); dst8[m] = __builtin_shufflevector(lo_, hi_, 0, 1, 2, 3, 4, 5, 6, 7); } \
        else { _Pragma("unroll") for (int k = 0; k < 2; ++k) dst[m][k] = *(const LAS bf16x8*)(lds + G8_SA(b, h) + aoff + m * 2048 + k * 1024); } } } while (0)
#define G8_LDB(dst, dst8, b, h) do { _Pragma("unroll") for (int n = 0; n < 2; ++n) { if constexpr (FP8) { const i32x4 lo_ = *(const LAS i32x4*)(lds + G8_SB(b, h) + boff + n * 2048), hi_ = *(const LAS i32x4*)(lds + G8_SB(b, h) + boff + n * 2048 + 1024); dst8[n] = __builtin_shufflevector(lo_, hi_, 0, 1, 2, 3, 4, 5, 6, 7); } \
        else { _Pragma("unroll") for (int k = 0; k < 2; ++k) dst[n][k] = *(const LAS bf16x8*)(lds + G8_SB(b, h) + boff + n * 2048 + k * 1024); } } } while (0)
#define G8_MMA(ai, bj, At, At8, Bt, Bt8) do { __builtin_amdgcn_s_setprio(1); _Pragma("unroll") for (int m = 0; m < 4; ++m) _Pragma("unroll") for (int n = 0; n < 2; ++n) { \
        if constexpr (FP8) acc[ai][bj][m][n] = __builtin_amdgcn_mfma_scale_f32_16x16x128_f8f6f4(Bt8[n], At8[m], acc[ai][bj][m][n], 0, 0, 0, 0, 0, 0);     \
        else { _Pragma("unroll") for (int k = 0; k < 2; ++k) acc[ai][bj][m][n] = __builtin_amdgcn_mfma_f32_16x16x32_bf16(Bt[n][k], At[m][k], acc[ai][bj][m][n], 0, 0, 0); } } __builtin_amdgcn_s_setprio(0); } while (0)
#define G8_WAIT_V(n) asm volatile("s_waitcnt vmcnt(" #n ")" ::: "memory")
#define G8_WAIT_L(n) asm volatile("s_waitcnt lgkmcnt(" #n ")" ::: "memory")
#define G8_BAR __builtin_amdgcn_s_barrier()
#define G8_SCHED __builtin_amdgcn_sched_barrier(0)
    Unit cur, nxt; int ui = 0;
    if (!S.next(0, cur)) return;
    f32x4 acc[2][2][4][2];
#pragma unroll
    for (int a = 0; a < 2; ++a)
#pragma unroll
        for (int b = 0; b < 2; ++b)
#pragma unroll
            for (int m = 0; m < 4; ++m)
#pragma unroll
                for (int n = 0; n < 2; ++n) acc[a][b][m][n] = (f32x4){0.f, 0.f, 0.f, 0.f};
    bf16x8 At[4][2], B0[2][2], B1[2][2]; i32x8 At8[4], B08[2], B18[2];
    LAS unsigned* ROFF = (LAS unsigned*)(lds + STAGE_BYTES + 1024);
    unsigned pend = 0u; int parA = 0;
    if constexpr (GATHER) {
        if (tid < 256) ROFF[tid] = (unsigned)S.row(cur, tid) * (unsigned)(K * 2);
        asm volatile("s_waitcnt lgkmcnt(0)" ::: "memory"); __builtin_amdgcn_s_barrier(); asm volatile("" ::: "memory");
    }
    const char* cA = cur.a; const char* cB = cur.b;
    G8_ST2(G8_SB(0, 0), cB, 1); G8_ST2(G8_SB(0, 1), cB + hstep, 1); G8_STA_CUR(G8_SA(0, 0), cA, 0); G8_STA_CUR(G8_SA(0, 1), cA, 1);
    if (wr == 1) G8_BAR;
    G8_WAIT_V(2); G8_BAR;
    G8_ST2(G8_SB(1, 0), cB + kstep, 1); G8_STA_CUR(G8_SA(1, 0), cA + kstep, 0); G8_ST2(G8_SB(1, 1), cB + hstep + kstep, 1);
    G8_WAIT_V(6); G8_BAR;
    for (;;) {
        const bool has_next = S.next(ui + 1, nxt);
        const char* nA = has_next ? nxt.a : cA; const char* nB = has_next ? nxt.b : cB;
#pragma clang loop unroll(disable)
        for (int t = 0; t < nt; t += 2) {
            const bool last = (t == nt - 2);
            int to = t; asm volatile("" : "+s"(to));
            const char* a1 = cA + (size_t)(to + 1) * kstep;
            const char* a2 = last ? nA : cA + (size_t)(to + 2) * kstep; const char* b2 = last ? nB : cB + (size_t)(to + 2) * kstep;
            const char* a3 = a2 + kstep; const char* b3 = b2 + kstep;
            if constexpr (GATHER) {
                const int t_ = tid_();
                if (has_next && t == nt - 4 && t_ < 256) pend = (unsigned)S.row(nxt, t_) * (unsigned)(K * 2);
                if (has_next && last && t_ < 256) ROFF[(parA ^ 1) * 256 + t_] = pend; }
            G8_LDB(B0, B08, 0, 0); G8_LDB(B1, B18, 0, 1); G8_SCHED; G8_LDA(At, At8, 0, 0); G8_STA_CUR(G8_SA(1, 1), a1, 1);
            if constexpr (GATHER) { if (has_next && last) parA ^= 1; }
            G8_WAIT_V(8); G8_WAIT_L(0); G8_BAR; G8_MMA(0, 0, At, At8, B0, B08); G8_MMA(0, 1, At, At8, B1, B18); G8_BAR; G8_SCHED;
            G8_LDA(At, At8, 0, 1); G8_ST2(G8_SB(0, 0), b2, 1); G8_ST2(G8_SB(0, 1), b2 + hstep, 1); G8_STA_CUR(G8_SA(0, 0), a2, 0);
            G8_WAIT_V(8); G8_WAIT_L(0); G8_BAR; G8_MMA(1, 0, At, At8, B0, B08); G8_MMA(1, 1, At, At8, B1, B18); G8_BAR; G8_SCHED;
            G8_LDB(B0, B08, 1, 0); G8_LDB(B1, B18, 1, 1); G8_SCHED; G8_LDA(At, At8, 1, 0); G8_STA_CUR(G8_SA(0, 1), a2, 1);
            G8_WAIT_V(8); G8_WAIT_L(0); G8_BAR; G8_MMA(0, 0, At, At8, B0, B08); G8_MMA(0, 1, At, At8, B1, B18); G8_BAR; G8_SCHED;
            G8_LDA(At, At8, 1, 1); G8_ST2(G8_SB(1, 0), b3, 1); G8_ST2(G8_SB(1, 1), b3 + hstep, 1); G8_STA_CUR(G8_SA(1, 0), a3, 0);
            G8_WAIT_V(8); G8_WAIT_L(0); G8_BAR; G8_MMA(1, 0, At, At8, B0, B08); G8_MMA(1, 1, At, At8, B1, B18); G8_BAR; G8_SCHED;
        }
        if (wr == 0) G8_BAR;
        E(acc, cur, wr, wc, fr, fq);
        if (!has_next) break;
#pragma unroll
        for (int a = 0; a < 2; ++a)
#pragma unroll
            for (int b = 0; b < 2; ++b)
#pragma unroll
                for (int m = 0; m < 4; ++m)
#pragma unroll
                    for (int n = 0; n < 2; ++n) acc[a][b][m][n] = (f32x4){0.f, 0.f, 0.f, 0.f};
        cur = nxt; cA = nA; cB = nB; ++ui;
        if (wr == 1) G8_BAR;
    }
    G8_WAIT_V(0);
    G8_BAR;
#undef G8_SA
#undef G8_SB
#undef G8_ST2
#undef G8_STA_CUR
#undef G8_LDA
#undef G8_LDB
#undef G8_MMA
#undef G8_WAIT_V
#undef G8_WAIT_L
#undef G8_BAR
#undef G8_SCHED
}
}

struct Params {
    const float *x, *c, *ctx, *c_ctx, *w_mod, *b_mod, *norm1_g, *norm2_g, *w_in, *b_in, *conv_a_w, *conv_a_b, *w_rg_r, *b_rg_r, *w_rg_i, *b_rg_i, *rg_lambda,
        *w_pool, *b_pool, *pool_scale, *w_four, *b_four, *conv_d_w, *conv_d_b, *ln_d_g, *ln_d_b, *w_pw, *b_pw, *w_out, *b_out, *w_router, *b_router,
        *w_gu, *b_gu, *w_down, *b_down, *final_norm_g;
    float* out; unsigned char* ws; int ph_lo, ph_hi;
};
typedef const Params __attribute__((address_space(4)))* CP;
__device__ __forceinline__ CP launder_params() { CP k = (CP)__builtin_amdgcn_kernarg_segment_ptr(); asm volatile("" : "+s"(k)); return k; }
__device__ __forceinline__ int row_mb(int row) { return row < TL ? (row >> 12) : 8; }

template <class RowMap>
__device__ __forceinline__ void tr_block(const float* __restrict__ src, int spitch, int k0, int n0, bf16_t* __restrict__ dst, int dpitch, int kd0, RowMap rm, LAS unsigned char* lds) {
    LAS unsigned* T = (LAS unsigned*)lds;
    const int tid = tid_();
    __syncthreads();
#pragma unroll
    for (int it = 0; it < 4; ++it) { const int task = it * 512 + tid, q = task & 63, kp = task >> 6;
        const f32x4 v0 = *(const f32x4*)(src + (size_t)(k0 + 2 * kp) * spitch + n0 + 4 * q), v1 = *(const f32x4*)(src + (size_t)(k0 + 2 * kp + 1) * spitch + n0 + 4 * q);
        u32x4 w; w.x = cvt_pk_bf16(v0[0], v1[0]); w.y = cvt_pk_bf16(v0[1], v1[1]); w.z = cvt_pk_bf16(v0[2], v1[2]); w.w = cvt_pk_bf16(v0[3], v1[3]);
        *(LAS u32x4*)(T + kp * 260 + 4 * q) = w; }
    __syncthreads();
#pragma unroll
    for (int it = 0; it < 4; ++it) { const int task = it * 512 + tid, n = task & 255, c = task >> 8;
        u32x4 w; w.x = T[(4 * c + 0) * 260 + n]; w.y = T[(4 * c + 1) * 260 + n]; w.z = T[(4 * c + 2) * 260 + n]; w.w = T[(4 * c + 3) * 260 + n];
        *(u32x4*)(dst + (size_t)rm(n0 + n) * dpitch + kd0 + 8 * c) = w; }
}
template <class RowMap>
__device__ __forceinline__ void tr_block8(const float* __restrict__ src, int spitch, int k0, int n0, unsigned char* __restrict__ dst, int dpitch, int kd0, RowMap rm, LAS unsigned char* lds) {
    LAS unsigned* T = (LAS unsigned*)lds;
    const int tid = tid_();
    __syncthreads();
#pragma unroll
    for (int it = 0; it < 4; ++it) { const int task = it * 512 + tid, q = task & 63, kq = task >> 6; f32x4 v[4];
#pragma unroll
        for (int r = 0; r < 4; ++r) v[r] = *(const f32x4*)(src + (size_t)(k0 + 4 * kq + r) * spitch + n0 + 4 * q) * 64.0f;
        u32x4 w; w.x = pk4_fp8(v[0][0], v[1][0], v[2][0], v[3][0]); w.y = pk4_fp8(v[0][1], v[1][1], v[2][1], v[3][1]); w.z = pk4_fp8(v[0][2], v[1][2], v[2][2], v[3][2]); w.w = pk4_fp8(v[0][3], v[1][3], v[2][3], v[3][3]);
        *(LAS u32x4*)(T + kq * 260 + 4 * q) = w; }
    __syncthreads();
#pragma unroll
    for (int it = 0; it < 4; ++it) { const int task = it * 512 + tid, n = task & 255, c = task >> 8;
        u32x4 w; w.x = T[(4 * c + 0) * 260 + n]; w.y = T[(4 * c + 1) * 260 + n]; w.z = T[(4 * c + 2) * 260 + n]; w.w = T[(4 * c + 3) * 260 + n];
        *(u32x4*)(dst + (size_t)rm(n0 + n) * dpitch + kd0 + 16 * c) = w; }
}
struct RmId { int off; __device__ __forceinline__ int operator()(int n) const { return n + off; } };
struct RmGu { __device__ __forceinline__ int operator()(int n) const { const int rem = n & 1023; return 256 * (rem >> 7) + 128 * (n >> 10) + (rem & 127); } };
struct RmIn { __device__ __forceinline__ int operator()(int n) const { return n < 512 ? n : n - 1024 + 768; } };

__device__ __forceinline__ void job_mod(CP p, int l, int cb, LAS unsigned char* lds) {
    LAS float* SC = (LAS float*)lds;
    LAS float* RED = (LAS float*)(lds + 49152);
    const int tid = tid_();
    __syncthreads();
    for (int i = tid; i < 9 * 1024; i += 512) { const int b = i >> 10, k = i & 1023; const float v = b < 8 ? p->c[b * 1024 + k] : p->c_ctx[k]; SC[k * 12 + b] = v * sigmoidf_(v); }
    __syncthreads();
    const int col = cb * 64 + (tid & 63), kg = tid >> 6;
    float acc[9];
#pragma unroll
    for (int b = 0; b < 9; ++b) acc[b] = 0.f;
    const float* wp = p->w_mod + (size_t)l * 1024 * 6144 + col;
#pragma unroll 8
    for (int kk = 0; kk < 128; ++kk) { const int k = kg * 128 + kk; const float w = wp[(size_t)k * 6144];
        const f32x4 s0 = *(const LAS f32x4*)(SC + k * 12), s1 = *(const LAS f32x4*)(SC + k * 12 + 4); const float s8 = SC[k * 12 + 8];
        acc[0] += s0[0] * w; acc[1] += s0[1] * w; acc[2] += s0[2] * w; acc[3] += s0[3] * w; acc[4] += s1[0] * w; acc[5] += s1[1] * w; acc[6] += s1[2] * w; acc[7] += s1[3] * w; acc[8] += s8 * w; }
#pragma unroll
    for (int b = 0; b < 9; ++b) RED[(kg * 9 + b) * 64 + (tid & 63)] = acc[b];
    __syncthreads();
    for (int i = tid; i < 9 * 64; i += 512) { const int b = i >> 6, cc = i & 63; float s = 0.f;
#pragma unroll
        for (int g = 0; g < 8; ++g) s += RED[(g * 9 + b) * 64 + cc];
        ((float*)(p->ws + WS_MODV))[(size_t)(l * 9 + b) * 6144 + cb * 64 + cc] = s + p->b_mod[l * 6144 + cb * 64 + cc]; }
}
__device__ __forceinline__ void job_fold_out(CP p, int l, int nb, LAS unsigned char* lds) {
    LAS float* WO = (LAS float*)lds;
    LAS float* PW = (LAS float*)(lds + 65536);
    const int tid = tid_(), lane = tid & 63, w = __builtin_amdgcn_readfirstlane(tid >> 6);
    __syncthreads();
#pragma unroll
    for (int it = 0; it < 8; ++it) { const int task = it * 512 + tid, j = task >> 4, q = task & 15;
        *(LAS f32x4*)(WO + j * 64 + 4 * q) = *(const f32x4*)(p->w_out + ((size_t)l * 1024 + 768 + j) * 1024 + nb * 64 + 4 * q); }
    float acc[32];
#pragma unroll
    for (int i = 0; i < 32; ++i) acc[i] = 0.f;
    for (int jc = 0; jc < 4; ++jc) {
        __syncthreads();
#pragma unroll
        for (int it = 0; it < 8; ++it) { const int task = it * 512 + tid, i = task & 255, jq = task >> 8;
            const f32x4 v = *(const f32x4*)(p->w_pw + ((size_t)l * 256 + i) * 256 + jc * 64 + 4 * jq);
            PW[(4 * jq + 0) * 256 + i] = v[0]; PW[(4 * jq + 1) * 256 + i] = v[1]; PW[(4 * jq + 2) * 256 + i] = v[2]; PW[(4 * jq + 3) * 256 + i] = v[3]; }
        __syncthreads();
        for (int jj = 0; jj < 64; ++jj) { const float b = WO[(jc * 64 + jj) * 64 + lane];
#pragma unroll
            for (int i4 = 0; i4 < 8; ++i4) { const f32x4 a = *(const LAS f32x4*)(PW + jj * 256 + 32 * w + 4 * i4);
                acc[4 * i4 + 0] += a[0] * b; acc[4 * i4 + 1] += a[1] * b; acc[4 * i4 + 2] += a[2] * b; acc[4 * i4 + 3] += a[3] * b; } }
    }
    bf16_t* dst = (bf16_t*)(p->ws + WS_WOUTT) + ((size_t)l * 1024 + nb * 64 + lane) * 1024 + 768 + 32 * w;
#pragma unroll
    for (int c = 0; c < 4; ++c) { float f[8];
#pragma unroll
        for (int e = 0; e < 8; ++e) f[e] = acc[8 * c + e];
        *(u32x4*)(dst + 8 * c) = pack8(f); }
    if (w == 0) { float s = p->b_out[l * 1024 + nb * 64 + lane];
        for (int j = 0; j < 256; ++j) s += p->b_pw[l * 256 + j] * WO[j * 64 + lane];
        ((float*)(p->ws + WS_BOUT))[l * 1024 + nb * 64 + lane] = s; }
}
__device__ __forceinline__ void job_fold_in(CP p, int l, int f, int g, int kb, LAS unsigned char* lds) {
    LAS float* M = (LAS float*)lds;
    LAS float* WI = (LAS float*)(lds + 16384);
    const int tid = tid_();
    const int cbase = f == 0 ? 512 : 768;
    __syncthreads();
#pragma unroll
    for (int it = 0; it < 8; ++it) { const int id = it * 512 + tid, i = id >> 6, j = id & 63; float s;
        if (f == 0) s = p->w_pool[(((size_t)l * 4 + g) * 64 + i) * 64 + j];
        else { s = 0.f; for (int m = 0; m < 64; ++m) { const float ang = (float)((i * m) & 63) * (1.0f / 32.0f); const float tr = f == 1 ? cospif(ang) : sinpif(ang);
                   s += tr * p->w_four[(((size_t)l * 4 + g) * 64 + m) * 64 + j]; } }
        M[i * 64 + j] = s; }
#pragma unroll
    for (int it = 0; it < 8; ++it) { const int task = it * 512 + tid, kk = task >> 4, i4 = task & 15;
        const f32x4 v = *(const f32x4*)(p->w_in + ((size_t)l * 1024 + kb * 256 + kk) * 1536 + cbase + 64 * g + 4 * i4);
        WI[kk * 65 + 4 * i4 + 0] = v[0]; WI[kk * 65 + 4 * i4 + 1] = v[1]; WI[kk * 65 + 4 * i4 + 2] = v[2]; WI[kk * 65 + 4 * i4 + 3] = v[3]; }
    __syncthreads();
    const int kk = tid & 255, jh = tid >> 8;
    float acc[32];
#pragma unroll
    for (int j = 0; j < 32; ++j) acc[j] = 0.f;
    for (int i = 0; i < 64; ++i) { const float a = WI[kk * 65 + i];
#pragma unroll
        for (int j4 = 0; j4 < 8; ++j4) { const f32x4 m = *(const LAS f32x4*)(M + i * 64 + 32 * jh + 4 * j4);
            acc[4 * j4 + 0] += a * m[0]; acc[4 * j4 + 1] += a * m[1]; acc[4 * j4 + 2] += a * m[2]; acc[4 * j4 + 3] += a * m[3]; } }
    bf16_t* dst = f == 0 ? (bf16_t*)(p->ws + WS_WINT) + ((size_t)l * NPROJ + 512 + 64 * g) * 1024 : (bf16_t*)(p->ws + WS_WFT) + ((size_t)l * 512 + (f - 1) * 256 + 64 * g) * 1024;
#pragma unroll
    for (int j = 0; j < 32; ++j) dst[(size_t)(32 * jh + j) * 1024 + kb * 256 + kk] = f2bf(acc[j]);
    if (kb == 0 && f >= 1 && tid < 64) { float s = 0.f;
        for (int i = 0; i < 64; ++i) s += p->b_in[l * 1536 + 768 + 64 * g + i] * M[i * 64 + tid];
        ((float*)(p->ws + WS_BF))[l * 512 + (f - 1) * 256 + 64 * g + tid] = s; }
    if (kb == 0 && f == 0 && g == 0) for (int i = tid; i < NPROJ; i += 512)
        ((float*)(p->ws + WS_BIN))[l * NPROJ + i] = i < 512 ? p->b_in[l * 1536 + i] : (i < 768 ? 0.f : p->b_in[l * 1536 + i - 768 + 1024]);
}
__device__ __forceinline__ void job_small(CP p, int j) {
    const int tid = tid_();
    if (j < 32) {
        const int l = j >> 4, d = (j >> 3) & 1, gate = (j >> 2) & 1, hd = j & 3;
        const float* src = (gate ? p->w_rg_i : p->w_rg_r) + ((size_t)((l * 2 + d) * 4 + hd)) * 4096;
        bf16_t* dst = (bf16_t*)(p->ws + WS_WGT) + (size_t)j * 4096;
        for (int id = tid; id < 4096; id += 512) { const int n = id >> 6, k = id & 63; dst[id] = f2bf(src[k * 64 + n]); }
        return; }
    j -= 32;
    if (j < 2) {
        const int l = j; bf16_t* hi = (bf16_t*)(p->ws + WS_WRT) + (size_t)l * 2 * NE * 1024; bf16_t* lo = hi + NE * 1024;
        for (int id = tid; id < NE * 1024; id += 512) { const int e = id >> 10, c = id & 1023; const float v = p->w_router[((size_t)l * 1024 + c) * NE + e];
            const bf16_t h = f2bf(v); hi[id] = h; lo[id] = f2bf(v - bf2f(h)); }
        return; }
    j -= 2;
    if (j < 144 + 128) {
        const bool sn = j >= 144; const int r0 = (sn ? j - 144 : j) * 16; bf16_t* dst = (bf16_t*)(p->ws + (sn ? WS_SMAT : WS_CMAT));
        for (int id = tid; id < 16 * 4096; id += 512) { const int k = r0 + (id >> 12), t = id & 4095; const float ang = (float)((k * t) & 4095) * (1.0f / 2048.0f);
            dst[(size_t)k * 4096 + t] = f2bf(sn ? sinpif(ang) : cospif(ang)); }
        return; }
    j -= 272;
    if (j == 1) {
        float* dst = (float*)(p->ws + WS_POS);
        for (int id = tid; id < 64 * 512; id += 512) { const int pp = id >> 9, jj = id & 511, i = jj & 255; const float a = (float)pp * exp2f(-(float)i * (13.287712379549449f / 256.0f));
            dst[id] = jj < 256 ? sinf(a) : cosf(a); }
        return; }
    {
        bf16_t* dst = (bf16_t*)(p->ws + WS_DFTC);
        for (int id = tid; id < 256 * 512; id += 512) { const int k = id >> 9, jj = id & 511, t = jj & 255; const float ang = (float)((k * t) & 255) * (1.0f / 128.0f);
            dst[id] = f2bf(jj < 256 ? cospif(ang) : -sinpif(ang)); }
    }
}
constexpr bool fp8_layer(int l) { return l >= FP8_FROM; }
constexpr int J_TGU_L(int l) { return fp8_layer(l) ? 32 * 8 * 8 : 32 * 16 * 8; }
constexpr int J_TD_L(int l) { return fp8_layer(l) ? 32 * 8 * 4 : 32 * 16 * 4; }
constexpr int J_MOD = 192, J_FOUT = 32, J_FIN = 96, J_SMALL = 32 + 2 + 272 + 2, J_TIN = 128, J_TOUT = 96, J_TGU = J_TGU_L(0) + J_TGU_L(1), J_TD = J_TD_L(0) + J_TD_L(1);
constexpr int J_TOTAL = J_MOD + J_FOUT + J_FIN + J_SMALL + J_TIN + J_TOUT + J_TGU + J_TD;
__device__ __forceinline__ void phase_prologue(CP p, LAS unsigned char* lds) {
    for (int job = blockIdx.x; job < J_TOTAL; job += gridDim.x) {
        int j = job;
        if (j < J_MOD) { job_mod(p, j / 96, j % 96, lds); continue; } j -= J_MOD;
        if (j < J_FOUT) { job_fold_out(p, j >> 4, j & 15, lds); continue; } j -= J_FOUT;
        if (j < J_FIN) { const int l = j / 48, r = j % 48; job_fold_in(p, l, r / 16, (r >> 2) & 3, r & 3, lds); continue; } j -= J_FIN;
        if (j < J_SMALL) { job_small(p, j); continue; } j -= J_SMALL;
        if (j < J_TIN) { const int l = j >> 6, r = j & 63, kb = r >> 2, q = r & 3;
            tr_block(p->w_in + (size_t)l * 1024 * 1536, 1536, kb * 64, q < 2 ? q * 256 : 1024 + (q - 2) * 256, (bf16_t*)(p->ws + WS_WINT) + (size_t)l * NPROJ * 1024, 1024, kb * 64, RmIn{}, lds); continue; } j -= J_TIN;
        if (j < J_TOUT) { const int l = j / 48, r = j % 48, kb = r >> 2, q = r & 3;
            tr_block(p->w_out + (size_t)l * 1024 * 1024, 1024, kb * 64, q * 256, (bf16_t*)(p->ws + WS_WOUTT) + (size_t)l * 1024 * 1024, 1024, kb * 64, RmId{0}, lds); continue; } j -= J_TOUT;
        if (j < J_TGU) { const int l = j >= J_TGU_L(0) ? 1 : 0; const int jj = j - (l ? J_TGU_L(0) : 0); const float* src = p->w_gu + (size_t)l * NE * 1024 * 2048; unsigned char* dstb = p->ws + WS_WGUT + (size_t)l * NE * 2048 * 2048;
            if (fp8_layer(l)) { const int e = jj >> 6, r = jj & 63, kb = r >> 3, q = r & 7; tr_block8(src + (size_t)e * 1024 * 2048, 2048, kb * 128, q * 256, dstb + (size_t)e * 2048 * 1024, 1024, kb * 128, RmGu{}, lds); }
            else { const int e = jj >> 7, r = jj & 127, kb = r >> 3, q = r & 7; tr_block(src + (size_t)e * 1024 * 2048, 2048, kb * 64, q * 256, (bf16_t*)dstb + (size_t)e * 2048 * 1024, 1024, kb * 64, RmGu{}, lds); }
            continue; } j -= J_TGU;
        { const int l = j >= J_TD_L(0) ? 1 : 0; const int jj = j - (l ? J_TD_L(0) : 0); const float* src = p->w_down + (size_t)l * NE * 1024 * 1024; unsigned char* dstb = p->ws + WS_WDT + (size_t)l * NE * 1024 * 2048;
            if (fp8_layer(l)) { const int e = jj >> 5, r = jj & 31, kb = r >> 2, q = r & 3; tr_block8(src + (size_t)e * 1024 * 1024, 1024, kb * 128, q * 256, dstb + (size_t)e * 1024 * 1024, 1024, kb * 128, RmId{0}, lds); }
            else { const int e = jj >> 6, r = jj & 63, kb = r >> 2, q = r & 3; tr_block(src + (size_t)e * 1024 * 1024, 1024, kb * 64, q * 256, (bf16_t*)dstb + (size_t)e * 1024 * 1024, 1024, kb * 64, RmId{0}, lds); } }
    }
}

__device__ __forceinline__ void phase_norm(CP p, int mode) {
    const int tid = tid_(), lane = tid & 63, wid = tid >> 6;
    float* X = (float*)(p->ws + WS_X); bf16_t* U = (bf16_t*)(p->ws + WS_U); const bf16_t* YS = (const bf16_t*)(p->ws + WS_YS); const float* modv = (const float*)(p->ws + WS_MODV);
    const float* POS = (const float*)(p->ws + WS_POS);
    const int nrows = mode == 2 ? TL : TT;
    const int lprev = mode == 2 ? 1 : 0, lcur = mode == 0 ? 0 : 1;
    const int nw = (int)gridDim.x * 8;
    for (int rowa = blockIdx.x * 8 + wid; rowa < nrows; rowa += 2 * nw) {
        int rows[2]; bool ok[2]; f32x4 v[2][4];
#pragma unroll
        for (int rb = 0; rb < 2; ++rb) { const int r = rowa + rb * nw; ok[rb] = r < nrows; rows[rb] = ok[rb] ? r : rowa; }
        if (mode == 0) {
#pragma unroll
            for (int rb = 0; rb < 2; ++rb) { const int row = rows[rb]; const float* src = row < TL ? p->x + (size_t)row * D : p->ctx + (size_t)(row - TL) * D;
#pragma unroll
                for (int j = 0; j < 4; ++j) v[rb][j] = *(const f32x4*)(src + 256 * j + 4 * lane); }
#pragma unroll
            for (int rb = 0; rb < 2; ++rb) { const int row = rows[rb]; if (row < TL) { const int t = row & 4095;
#pragma unroll
                    for (int j = 0; j < 4; ++j) v[rb][j] += *(const f32x4*)(POS + (size_t)(j < 2 ? (t >> 6) : (t & 63)) * 512 + (j & 1) * 256 + 4 * lane); } }
        } else {
            u32x2 ys[2][4][4];
#pragma unroll
            for (int rb = 0; rb < 2; ++rb) { const int row = rows[rb];
#pragma unroll
                for (int j = 0; j < 4; ++j) { v[rb][j] = *(const f32x4*)(X + (size_t)row * D + 256 * j + 4 * lane);
#pragma unroll
                    for (int k = 0; k < 4; ++k) ys[rb][j][k] = *(const u32x2*)(YS + ((size_t)row * 4 + k) * D + 256 * j + 4 * lane); } }
#pragma unroll
            for (int rb = 0; rb < 2; ++rb) { const float* g2 = modv + (size_t)(lprev * 9 + row_mb(rows[rb])) * 6144 + 5120;
#pragma unroll
                for (int j = 0; j < 4; ++j) { f32x4 s = {0.f, 0.f, 0.f, 0.f};
#pragma unroll
                    for (int k = 0; k < 4; ++k) { const u32x2 w = ys[rb][j][k]; s[0] += bflo(w.x); s[1] += bfhi(w.x); s[2] += bflo(w.y); s[3] += bfhi(w.y); }
                    v[rb][j] += *(const f32x4*)(g2 + 256 * j + 4 * lane) * s; } }
        }
        float ss[2];
#pragma unroll
        for (int rb = 0; rb < 2; ++rb) { ss[rb] = 0.f;
#pragma unroll
            for (int j = 0; j < 4; ++j) ss[rb] += v[rb][j][0] * v[rb][j][0] + v[rb][j][1] * v[rb][j][1] + v[rb][j][2] * v[rb][j][2] + v[rb][j][3] * v[rb][j][3]; }
#pragma unroll
        for (int o = 32; o >= 1; o >>= 1) { const float t0 = bperm(ss[0], lane ^ o), t1 = bperm(ss[1], lane ^ o); ss[0] += t0; ss[1] += t1; }
#pragma unroll
        for (int rb = 0; rb < 2; ++rb) { if (!ok[rb]) continue; const int row = rows[rb]; const float rstd = __builtin_amdgcn_rsqf(ss[rb] * (1.0f / 1024.0f) + 1e-6f);
            if (mode == 2) {
#pragma unroll
                for (int j = 0; j < 4; ++j) *(f32x4*)(p->out + (size_t)row * D + 256 * j + 4 * lane) = v[rb][j] * rstd * *(const f32x4*)(p->final_norm_g + 256 * j + 4 * lane);
            } else { const float* mv = modv + (size_t)(lcur * 9 + row_mb(row)) * 6144;
#pragma unroll
                for (int j = 0; j < 4; ++j) { const int col = 256 * j + 4 * lane;
                    *(f32x4*)(X + (size_t)row * D + col) = v[rb][j];
                    const f32x4 g = *(const f32x4*)(p->norm1_g + lcur * D + col), sc = *(const f32x4*)(mv + 1024 + col), sh = *(const f32x4*)(mv + col);
                    const f32x4 u = v[rb][j] * rstd * g * (sc + 1.0f) + sh;
                    u32x2 w; w.x = cvt_pk_bf16(u[0], u[1]); w.y = cvt_pk_bf16(u[2], u[3]); *(u32x2*)(U + (size_t)row * D + col) = w; } }
        }
    }
}

constexpr int HP = 2064;
__device__ __forceinline__ void phase_router(CP p, int l, LAS unsigned char* lds, int rep) {
    LAS unsigned char* HHI = lds; LAS unsigned char* HLO = lds + 32 * HP;
    LAS float* LG = (LAS float*)(lds + 64 * HP);
    LAS int* hist = (LAS int*)(lds + 64 * HP + 8448); LAS int* basee = hist + 32;
    const int tid = tid_(), lane = tid & 63, wid = __builtin_amdgcn_readfirstlane(tid >> 6), fr = lane & 15, fq = lane >> 4;
    const float* X = (const float*)(p->ws + WS_X); bf16_t* U = (bf16_t*)(p->ws + (rep ? WS_ACT : WS_U)); const float* modv = (const float*)(p->ws + WS_MODV);
    unsigned char* U8 = p->ws + (rep ? WS_ACT : WS_U8);
    unsigned* ctl = (unsigned*)(p->ws + WS_CTL) + (rep ? 4096 : 0); int* rasg = (int*)(p->ws + (rep ? WS_YS : WS_RASG)); float* gate = (float*)(p->ws + (rep ? WS_YS + (size_t)NE * TT * 4 : WS_GATE));
    const bf16_t* wrt = (const bf16_t*)(p->ws + WS_WRT) + (size_t)l * 2 * NE * 1024;
    const int ntiles = (l == 0 ? TT : TL) / 32;
    for (int tile = blockIdx.x; tile < ntiles; tile += gridDim.x) {
        const int row0 = tile * 32, mb = row_mb(row0);
        const float* mv = modv + (size_t)(l * 9 + mb) * 6144;
        __syncthreads();
        if (tid < 32) hist[tid] = 0;
        { f32x4 v[4][4]; float ss[4];
#pragma unroll
          for (int rr = 0; rr < 4; ++rr)
#pragma unroll
              for (int j = 0; j < 4; ++j) v[rr][j] = *(const f32x4*)(X + (size_t)(row0 + wid * 4 + rr) * D + 256 * j + 4 * lane);
#pragma unroll
          for (int rr = 0; rr < 4; ++rr) { ss[rr] = 0.f;
#pragma unroll
              for (int j = 0; j < 4; ++j) ss[rr] += v[rr][j][0] * v[rr][j][0] + v[rr][j][1] * v[rr][j][1] + v[rr][j][2] * v[rr][j][2] + v[rr][j][3] * v[rr][j][3]; }
#pragma unroll
          for (int o = 32; o >= 1; o >>= 1) { float t[4];
#pragma unroll
              for (int rr = 0; rr < 4; ++rr) t[rr] = bperm(ss[rr], lane ^ o);
#pragma unroll
              for (int rr = 0; rr < 4; ++rr) ss[rr] += t[rr]; }
#pragma unroll
          for (int j = 0; j < 4; ++j) { const int col = 256 * j + 4 * lane;
              const f32x4 g = *(const f32x4*)(p->norm2_g + l * D + col), sc = *(const f32x4*)(mv + 4096 + col), sh = *(const f32x4*)(mv + 3072 + col);
#pragma unroll
              for (int rr = 0; rr < 4; ++rr) { const int r = wid * 4 + rr; const float rstd = __builtin_amdgcn_rsqf(ss[rr] * (1.0f / 1024.0f) + 1e-6f);
                  const f32x4 h = v[rr][j] * rstd * g * (sc + 1.0f) + sh;
                  u32x2 w; w.x = cvt_pk_bf16(h[0], h[1]); w.y = cvt_pk_bf16(h[2], h[3]);
                  if (fp8_layer(l)) *(unsigned*)(U8 + (size_t)(row0 + r) * D + col) = pk4_fp8(h[0], h[1], h[2], h[3]); else *(u32x2*)(U + (size_t)(row0 + r) * D + col) = w;
                  u32x2 wl; wl.x = cvt_pk_bf16(h[0] - bflo(w.x), h[1] - bfhi(w.x)); wl.y = cvt_pk_bf16(h[2] - bflo(w.y), h[3] - bfhi(w.y));
                  *(LAS u32x2*)(HHI + r * HP + col * 2) = w; *(LAS u32x2*)(HLO + r * HP + col * 2) = wl; } } }
        __syncthreads();
        { const int mt = wid & 1, ntl = (wid >> 1) & 1, kh = wid >> 2;
          f32x4 acc = {0.f, 0.f, 0.f, 0.f};
          const bf16_t* bh = wrt + (size_t)(16 * ntl + fr) * 1024 + kh * 512 + 8 * fq; const bf16_t* bl = bh + NE * 1024;
          const LAS unsigned char* ah = HHI + (16 * mt + fr) * HP + (kh * 512 + 8 * fq) * 2; const LAS unsigned char* al = HLO + (16 * mt + fr) * HP + (kh * 512 + 8 * fq) * 2;
#pragma unroll 8
          for (int s = 0; s < 16; ++s) { const bf16x8 Ah = *(const LAS bf16x8*)(ah + s * 64), Al = *(const LAS bf16x8*)(al + s * 64); const bf16x8 Bh = *(const bf16x8*)(bh + s * 32), Bl = *(const bf16x8*)(bl + s * 32);
              acc = __builtin_amdgcn_mfma_f32_16x16x32_bf16(Ah, Bh, acc, 0, 0, 0); acc = __builtin_amdgcn_mfma_f32_16x16x32_bf16(Ah, Bl, acc, 0, 0, 0); acc = __builtin_amdgcn_mfma_f32_16x16x32_bf16(Al, Bh, acc, 0, 0, 0); }
#pragma unroll
          for (int j = 0; j < 4; ++j) LG[(kh * 32 + 16 * mt + 4 * fq + j) * 33 + 16 * ntl + fr] = acc[j]; }
        __syncthreads();
        int ek[4] = {0, 0, 0, 0}, rk[4] = {0, 0, 0, 0}; float gk[4] = {0.f, 0.f, 0.f, 0.f};
        if (tid < 32) { float lg[32];
#pragma unroll
            for (int e = 0; e < 32; ++e) lg[e] = LG[tid * 33 + e] + LG[(32 + tid) * 33 + e] + p->b_router[l * NE + e];
            float vk[4];
#pragma unroll
            for (int k = 0; k < 4; ++k) { float best = -3.0e38f; int bi = 0;
#pragma unroll
                for (int e = 0; e < 32; ++e) if (lg[e] > best) { best = lg[e]; bi = e; }
                vk[k] = best; ek[k] = bi;
#pragma unroll
                for (int e = 0; e < 32; ++e) if (e == bi) lg[e] = -3.0e38f; }
            float sum = 0.f;
#pragma unroll
            for (int k = 0; k < 4; ++k) { gk[k] = fexp2(1.4426950408889634f * (vk[k] - vk[0])); sum += gk[k]; }
            const float inv = 1.0f / sum;
#pragma unroll
            for (int k = 0; k < 4; ++k) { gk[k] *= inv; rk[k] = __hip_atomic_fetch_add(hist + ek[k], 1, __ATOMIC_RELAXED, __HIP_MEMORY_SCOPE_WORKGROUP); } }
        __syncthreads();
        if (tid < 32) { const int h = hist[tid]; basee[tid] = h ? (int)__hip_atomic_fetch_add(ctl + CW_COUNT + (l * NE + tid) * 64, (unsigned)h, __ATOMIC_RELAXED, __HIP_MEMORY_SCOPE_AGENT) : 0; }
        __syncthreads();
        if (tid < 32) { const int tok = row0 + tid;
#pragma unroll
            for (int k = 0; k < 4; ++k) { rasg[(size_t)ek[k] * TT + basee[ek[k]] + rk[k]] = tok * 4 + k; gate[tok * 4 + k] = gk[k]; } }
    }
}

constexpr int XCP = 144;
constexpr int XAP = 528;
struct Seq { int b, jc, L, rowbase, t0; bool lat; };
__device__ __forceinline__ Seq seq_of(int q) { Seq s; s.lat = q < 512; s.b = s.lat ? q >> 6 : (q - 512) >> 2; s.jc = s.lat ? q & 63 : (q - 512) & 3; s.L = s.lat ? SEQ : LCX; s.rowbase = s.lat ? s.b * SEQ : TL + s.b * LCX; s.t0 = s.jc * 64; return s; }
template <int PASS>
__device__ __forceinline__ void scan_unit(CP p, int l, int q, LAS unsigned char* lds) {
    const int tid = tid_(), lane = tid & 63, wid = __builtin_amdgcn_readfirstlane(tid >> 6), d = wid >> 2, hd = wid & 3, fr = lane & 15, fq = lane >> 4;
    LAS unsigned char* XC = lds + wid * (64 * XCP);
    LAS float* CAR = (LAS float*)(lds + 8 * 64 * XCP + wid * 256);
    LAS unsigned char* HB = lds + 8 * 64 * XCP + 2048;
    LAS unsigned char* XA = HB;
    const bf16_t* PROJ = (const bf16_t*)(p->ws + WS_PROJ); float* SUMM = (float*)(p->ws + WS_SUMM);
    const Seq sq = seq_of(q); const int b = sq.b, jc = sq.jc, L = sq.L, rowbase = sq.rowbase, t0 = sq.t0; const bool lat = sq.lat;
    __syncthreads();
    { u32x4 w[5];
#pragma unroll
      for (int it = 0; it < 5; ++it) { const int task = it * 512 + tid, r = task >> 5, cg = task & 31, tt = t0 - 3 + r; w[it] = (u32x4){0u, 0u, 0u, 0u};
          if (task < 70 * 32 && tt >= 0 && tt < L) w[it] = *(const u32x4*)(PROJ + (size_t)(rowbase + tt) * NPROJ + 8 * cg); }
#pragma unroll
      for (int it = 0; it < 5; ++it) { const int task = it * 512 + tid, r = task >> 5, cg = task & 31; if (task < 70 * 32) *(LAS u32x4*)(XA + r * XAP + cg * 16) = w[it]; } }
    float car = 0.f;
    if (PASS == 2) { const int c = 64 * hd + lane;
        const int n = d == 0 ? (lat ? 4 + jc : jc) : (lat ? 4 + 63 - jc : 3 - jc);
        for (int s0 = 0; s0 < n; s0 += 16) { float A_[16], H_[16];
#pragma unroll
            for (int e = 0; e < 16; ++e) { const int s = s0 + e; int qq;
                if (d == 0) qq = (lat && s >= 4) ? b * 64 + (s - 4) : 512 + b * 4 + s; else qq = (lat && s >= 4) ? b * 64 + 63 - (s - 4) : 512 + b * 4 + 3 - s;
                A_[e] = 1.f; H_[e] = 0.f; if (s < n) { const float* sp_ = SUMM + ((size_t)qq * 2 + d) * 512; A_[e] = sp_[c]; H_[e] = sp_[256 + c]; } }
#pragma unroll
            for (int e = 0; e < 16; ++e) car = A_[e] * car + H_[e]; } }
    __syncthreads();
    { const int c = 64 * hd + lane; const float* cw = p->conv_a_w + ((size_t)(l * 2 + d) * 4) * 256 + c;
      const float w0 = cw[0], w1 = cw[256], w2 = cw[512], w3 = cw[768], cb = p->conv_a_b[(l * 2 + d) * 256 + c];
      const float k0 = d ? w3 : w0, k1 = d ? w2 : w1, k2 = d ? w1 : w2, k3 = d ? w0 : w3;
      const LAS unsigned char* xp = XA + (d ? 3 : 0) * XAP + c * 2;
      float xa_ = bf2f(*(const LAS bf16_t*)(xp)), xb_ = bf2f(*(const LAS bf16_t*)(xp + XAP)), xc_ = bf2f(*(const LAS bf16_t*)(xp + 2 * XAP));
#pragma unroll 16
      for (int t = 0; t < 64; ++t) { const float xd_ = bf2f(*(const LAS bf16_t*)(xp + (t + 3) * XAP)); const float v = k0 * xa_ + k1 * xb_ + k2 * xc_ + k3 * xd_ + cb;
          *(LAS bf16_t*)(XC + t * XCP + lane * 2) = f2bf(v); xa_ = xb_; xb_ = xc_; xc_ = xd_; } }
    if (PASS == 2) CAR[lane] = car;
    asm volatile("" ::: "memory");
    if (PASS == 2) __syncthreads();
    float cr[4], at[4], sp[4], brr[4], bii[4];
#pragma unroll
    for (int n = 0; n < 4; ++n) { const int ch = 16 * n + fr; cr[n] = PASS == 2 ? CAR[ch] : 0.f; at[n] = 1.f;
        const float lam = p->rg_lambda[(l * 2 + d) * 256 + 64 * hd + ch]; sp[n] = -8.0f * 1.4426950408889634f * log1pf(__expf(-lam));
        brr[n] = p->b_rg_r[((l * 2 + d) * 4 + hd) * 64 + ch]; bii[n] = p->b_rg_i[((l * 2 + d) * 4 + hd) * 64 + ch]; }
    const bf16_t* wg = (const bf16_t*)(p->ws + WS_WGT) + (size_t)((l * 2 + d) * 2) * 4 * 4096;
    u32x4* ABo = (u32x4*)(p->ws + WS_AB) + ((size_t)q * 8 + wid) * 16 * 64 + lane;
    const int src1 = d ? lane + 16 : lane - 16, src2 = d ? lane + 32 : lane - 32, srct = d ? fr : 48 + fr;
    const bool has1 = d ? fq <= 2 : fq >= 1, has2 = d ? fq <= 1 : fq >= 2;
    for (int n = 0; n < 4; ++n) {
        bf16x8 Br[2], Bi[2];
#pragma unroll
        for (int s = 0; s < 2; ++s) { Br[s] = *(const bf16x8*)(wg + ((size_t)(0 * 4 + hd) * 64 + 16 * n + fr) * 64 + 32 * s + 8 * fq); Bi[s] = *(const bf16x8*)(wg + ((size_t)(1 * 4 + hd) * 64 + 16 * n + fr) * 64 + 32 * s + 8 * fq); }
        float Hj[4][4], Aj[4][4];
#pragma unroll
        for (int mt = 0; mt < 4; ++mt) {
            const bf16x8 A0 = *(const LAS bf16x8*)(XC + (16 * mt + fr) * XCP + (8 * fq) * 2), A1 = *(const LAS bf16x8*)(XC + (16 * mt + fr) * XCP + (32 + 8 * fq) * 2);
            f32x4 ar = {0.f, 0.f, 0.f, 0.f}, ai = {0.f, 0.f, 0.f, 0.f};
            ar = __builtin_amdgcn_mfma_f32_16x16x32_bf16(A0, Br[0], ar, 0, 0, 0); ar = __builtin_amdgcn_mfma_f32_16x16x32_bf16(A1, Br[1], ar, 0, 0, 0);
            ai = __builtin_amdgcn_mfma_f32_16x16x32_bf16(A0, Bi[0], ai, 0, 0, 0); ai = __builtin_amdgcn_mfma_f32_16x16x32_bf16(A1, Bi[1], ai, 0, 0, 0);
            float a_[4], b_[4], la_[4];
#pragma unroll
            for (int j = 0; j < 4; ++j) { const float r = sigmoidf_(ar[j] + brr[n]); la_[j] = r * sp[n]; }
            u32x4 w; w.x = cvt_pk_bf16(la_[0], la_[1]); w.y = cvt_pk_bf16(la_[2], la_[3]);
            la_[0] = bflo(w.x); la_[1] = bfhi(w.x); la_[2] = bflo(w.y); la_[3] = bfhi(w.y);
#pragma unroll
            for (int j = 0; j < 4; ++j) { const int tok = 16 * mt + 4 * fq + j; const float xcv = bf2f(*(const LAS bf16_t*)(XC + tok * XCP + (16 * n + fr) * 2));
                const float ig = sigmoidf_(ai[j] + bii[n]); const float a = fexp2(la_[j]);
                a_[j] = a; b_[j] = __builtin_amdgcn_sqrtf(fmaxf(1.0f - a * a, 0.f)) * (ig * xcv); }
            w.z = cvt_pk_bf16(b_[0], b_[1]); w.w = cvt_pk_bf16(b_[2], b_[3]);
            b_[0] = bflo(w.z); b_[1] = bfhi(w.z); b_[2] = bflo(w.w); b_[3] = bfhi(w.w);
            ABo[(size_t)((n * 4 + mt) * 64)] = w;
            if (d == 0) { Hj[mt][0] = b_[0]; Aj[mt][0] = a_[0];
#pragma unroll
                for (int j = 1; j < 4; ++j) { Hj[mt][j] = a_[j] * Hj[mt][j - 1] + b_[j]; Aj[mt][j] = a_[j] * Aj[mt][j - 1]; } }
            else { Hj[mt][3] = b_[3]; Aj[mt][3] = a_[3];
#pragma unroll
                for (int j = 2; j >= 0; --j) { Hj[mt][j] = a_[j] * Hj[mt][j + 1] + b_[j]; Aj[mt][j] = a_[j] * Aj[mt][j + 1]; } }
        }
        float iA[4], iH[4], eA[4], eH[4], tA[4], tH[4];
#pragma unroll
        for (int mt = 0; mt < 4; ++mt) { iA[mt] = d ? Aj[mt][0] : Aj[mt][3]; iH[mt] = d ? Hj[mt][0] : Hj[mt][3]; }
        { float pA[4], pH[4];
#pragma unroll
          for (int mt = 0; mt < 4; ++mt) { pA[mt] = bperm(iA[mt], src1); pH[mt] = bperm(iH[mt], src1); }
#pragma unroll
          for (int mt = 0; mt < 4; ++mt) if (has1) { iH[mt] = iA[mt] * pH[mt] + iH[mt]; iA[mt] = iA[mt] * pA[mt]; }
#pragma unroll
          for (int mt = 0; mt < 4; ++mt) { pA[mt] = bperm(iA[mt], src2); pH[mt] = bperm(iH[mt], src2); }
#pragma unroll
          for (int mt = 0; mt < 4; ++mt) if (has2) { iH[mt] = iA[mt] * pH[mt] + iH[mt]; iA[mt] = iA[mt] * pA[mt]; } }
#pragma unroll
        for (int mt = 0; mt < 4; ++mt) { eA[mt] = bperm(iA[mt], src1); eH[mt] = bperm(iH[mt], src1); tA[mt] = bperm(iA[mt], srct); tH[mt] = bperm(iH[mt], srct); if (!has1) { eA[mt] = 1.f; eH[mt] = 0.f; } }
#pragma unroll
        for (int mi = 0; mi < 4; ++mi) { const int mt = d ? 3 - mi : mi;
            const float hin = eH[mt] + eA[mt] * cr[n];
            if (PASS == 2) {
#pragma unroll
                for (int j = 0; j < 4; ++j) { const int tok = 16 * mt + 4 * fq + j; *(LAS bf16_t*)(HB + ((d * 64 + tok) * 256 + 64 * hd + 16 * n + fr) * 2) = f2bf(Hj[mt][j] + Aj[mt][j] * hin); } }
            cr[n] = tH[mt] + tA[mt] * cr[n]; at[n] *= tA[mt]; }
    }
    if (PASS == 1) { if (fq == 0) {
#pragma unroll
            for (int n = 0; n < 4; ++n) { float* s = SUMM + ((size_t)q * 2 + d) * 512 + 64 * hd + 16 * n + fr; s[0] = at[n]; s[256] = cr[n]; } } }
    else {
        __syncthreads();
        bf16_t* Y = (bf16_t*)(p->ws + WS_YCAT);
        u32x4 gaw[4];
#pragma unroll
        for (int it = 0; it < 4; ++it) { const int task = it * 512 + tid, tok = task >> 5, cg = task & 31; gaw[it] = *(const u32x4*)(PROJ + ((size_t)rowbase + t0 + tok) * NPROJ + 256 + 8 * cg); }
#pragma unroll
        for (int it = 0; it < 4; ++it) { const int task = it * 512 + tid, tok = task >> 5, cg = task & 31; const size_t row = (size_t)rowbase + t0 + tok;
            float hf[8], hb[8], ga[8], y[8];
            unpack8(*(const LAS u32x4*)(HB + ((0 * 64 + tok) * 256 + 8 * cg) * 2), hf); unpack8(*(const LAS u32x4*)(HB + ((1 * 64 + tok) * 256 + 8 * cg) * 2), hb);
            unpack8(gaw[it], ga);
#pragma unroll
            for (int e = 0; e < 8; ++e) { const float g = ga[e]; y[e] = (hf[e] + hb[e]) * (g * sigmoidf_(1.5957691216057308f * (g + 0.044715f * g * g * g))); }
            *(u32x4*)(Y + row * D + 8 * cg) = pack8(y); }
    }
}

__device__ __forceinline__ void scan2_unit(CP p, int l, int q, LAS unsigned char* lds) {
    const int tid = tid_(), lane = tid & 63, wid = __builtin_amdgcn_readfirstlane(tid >> 6), d = wid >> 2, hd = wid & 3, fr = lane & 15, fq = lane >> 4;
    LAS float* CAR = (LAS float*)(lds + wid * 256);
    LAS unsigned char* HB = lds + 2048;
    const bf16_t* PROJ = (const bf16_t*)(p->ws + WS_PROJ); const float* SUMM = (const float*)(p->ws + WS_SUMM);
    const Seq sq = seq_of(q); const int b = sq.b, jc = sq.jc, rowbase = sq.rowbase, t0 = sq.t0; const bool lat = sq.lat;
    __syncthreads();
    u32x4 ab[4][4];
    { const u32x4* ABi = (const u32x4*)(p->ws + WS_AB) + ((size_t)q * 8 + wid) * 16 * 64 + lane;
#pragma unroll
      for (int n = 0; n < 4; ++n)
#pragma unroll
          for (int mt = 0; mt < 4; ++mt) ab[n][mt] = ABi[(size_t)((n * 4 + mt) * 64)]; }
    u32x4 gaw[4];
#pragma unroll
    for (int it = 0; it < 4; ++it) { const int task = it * 512 + tid, tok = task >> 5, cg = task & 31; gaw[it] = *(const u32x4*)(PROJ + ((size_t)rowbase + t0 + tok) * NPROJ + 256 + 8 * cg); }
    { float car = 0.f; const int c = 64 * hd + lane;
      const int n = d == 0 ? (lat ? 4 + jc : jc) : (lat ? 4 + 63 - jc : 3 - jc);
      for (int s0 = 0; s0 < n; s0 += 16) { float A_[16], H_[16];
#pragma unroll
          for (int e = 0; e < 16; ++e) { const int s = s0 + e; int qq;
              if (d == 0) qq = (lat && s >= 4) ? b * 64 + (s - 4) : 512 + b * 4 + s; else qq = (lat && s >= 4) ? b * 64 + 63 - (s - 4) : 512 + b * 4 + 3 - s;
              A_[e] = 1.f; H_[e] = 0.f; if (s < n) { const float* sp_ = SUMM + ((size_t)qq * 2 + d) * 512; A_[e] = sp_[c]; H_[e] = sp_[256 + c]; } }
#pragma unroll
          for (int e = 0; e < 16; ++e) car = A_[e] * car + H_[e]; }
      CAR[lane] = car; }
    asm volatile("" ::: "memory");
    const int src1 = d ? lane + 16 : lane - 16, src2 = d ? lane + 32 : lane - 32, srct = d ? fr : 48 + fr;
    const bool has1 = d ? fq <= 2 : fq >= 1, has2 = d ? fq <= 1 : fq >= 2;
#pragma unroll
    for (int n = 0; n < 4; ++n) { float cr = CAR[16 * n + fr];
        float Hj[4][4], Aj[4][4];
#pragma unroll
        for (int mt = 0; mt < 4; ++mt) { const u32x4 w = ab[n][mt];
            const float a_[4] = {fexp2(bflo(w.x)), fexp2(bfhi(w.x)), fexp2(bflo(w.y)), fexp2(bfhi(w.y))}, b_[4] = {bflo(w.z), bfhi(w.z), bflo(w.w), bfhi(w.w)};
            if (d == 0) { Hj[mt][0] = b_[0]; Aj[mt][0] = a_[0];
#pragma unroll
                for (int j = 1; j < 4; ++j) { Hj[mt][j] = a_[j] * Hj[mt][j - 1] + b_[j]; Aj[mt][j] = a_[j] * Aj[mt][j - 1]; } }
            else { Hj[mt][3] = b_[3]; Aj[mt][3] = a_[3];
#pragma unroll
                for (int j = 2; j >= 0; --j) { Hj[mt][j] = a_[j] * Hj[mt][j + 1] + b_[j]; Aj[mt][j] = a_[j] * Aj[mt][j + 1]; } } }
        float iA[4], iH[4], eA[4], eH[4], tA[4], tH[4];
#pragma unroll
        for (int mt = 0; mt < 4; ++mt) { iA[mt] = d ? Aj[mt][0] : Aj[mt][3]; iH[mt] = d ? Hj[mt][0] : Hj[mt][3]; }
        { float pA[4], pH[4];
#pragma unroll
          for (int mt = 0; mt < 4; ++mt) { pA[mt] = bperm(iA[mt], src1); pH[mt] = bperm(iH[mt], src1); }
#pragma unroll
          for (int mt = 0; mt < 4; ++mt) if (has1) { iH[mt] = iA[mt] * pH[mt] + iH[mt]; iA[mt] = iA[mt] * pA[mt]; }
#pragma unroll
          for (int mt = 0; mt < 4; ++mt) { pA[mt] = bperm(iA[mt], src2); pH[mt] = bperm(iH[mt], src2); }
#pragma unroll
          for (int mt = 0; mt < 4; ++mt) if (has2) { iH[mt] = iA[mt] * pH[mt] + iH[mt]; iA[mt] = iA[mt] * pA[mt]; } }
#pragma unroll
        for (int mt = 0; mt < 4; ++mt) { eA[mt] = bperm(iA[mt], src1); eH[mt] = bperm(iH[mt], src1); tA[mt] = bperm(iA[mt], srct); tH[mt] = bperm(iH[mt], srct); if (!has1) { eA[mt] = 1.f; eH[mt] = 0.f; } }
#pragma unroll
        for (int mi = 0; mi < 4; ++mi) { const int mt = d ? 3 - mi : mi;
            const float hin = eH[mt] + eA[mt] * cr;
#pragma unroll
            for (int j = 0; j < 4; j += 2) { const int tok = 16 * mt + 4 * fq + j; const LAS unsigned char* dummy = HB; (void)dummy;
                *(LAS bf16_t*)(HB + ((d * 64 + tok) * 256 + 64 * hd + 16 * n + fr) * 2) = f2bf(Hj[mt][j] + Aj[mt][j] * hin);
                *(LAS bf16_t*)(HB + ((d * 64 + tok + 1) * 256 + 64 * hd + 16 * n + fr) * 2) = f2bf(Hj[mt][j + 1] + Aj[mt][j + 1] * hin); }
            cr = tH[mt] + tA[mt] * cr; } }
    __syncthreads();
    bf16_t* Y = (bf16_t*)(p->ws + WS_YCAT);
#pragma unroll
    for (int it = 0; it < 4; ++it) { const int task = it * 512 + tid, tok = task >> 5, cg = task & 31; const size_t row = (size_t)rowbase + t0 + tok;
        float hf[8], hb[8], ga[8], y[8];
        unpack8(*(const LAS u32x4*)(HB + ((0 * 64 + tok) * 256 + 8 * cg) * 2), hf); unpack8(*(const LAS u32x4*)(HB + ((1 * 64 + tok) * 256 + 8 * cg) * 2), hb);
        unpack8(gaw[it], ga);
#pragma unroll
        for (int e = 0; e < 8; ++e) { const float g = ga[e]; y[e] = (hf[e] + hb[e]) * (g * sigmoidf_(1.5957691216057308f * (g + 0.044715f * g * g * g))); }
        *(u32x4*)(Y + row * D + 8 * cg) = pack8(y); }
}

__device__ __forceinline__ void pool_unit(CP p, int l, int q, LAS unsigned char* lds) {
    LAS float* PB = (LAS float*)lds;
    const int tid = tid_();
    const bf16_t* PROJ = (const bf16_t*)(p->ws + WS_PROJ); bf16_t* Y = (bf16_t*)(p->ws + WS_YCAT);
    const Seq sq = seq_of(q); const int L = sq.L, rowbase = sq.rowbase, t0 = sq.t0;
    __syncthreads();
    { u32x4 w[5];
#pragma unroll
      for (int it = 0; it < 5; ++it) { const int task = it * 512 + tid, r = task >> 5, cg = task & 31, tt = t0 - 8 + r; w[it] = (u32x4){0u, 0u, 0u, 0u};
          if (tt >= 0 && tt < L) w[it] = *(const u32x4*)(PROJ + (size_t)(rowbase + tt) * NPROJ + 512 + 8 * cg); }
#pragma unroll
      for (int it = 0; it < 5; ++it) { const int task = it * 512 + tid, r = task >> 5, cg = task & 31; float f[8]; unpack8(w[it], f);
          *(LAS f32x4*)(PB + r * 256 + 8 * cg) = (f32x4){f[0], f[1], f[2], f[3]}; *(LAS f32x4*)(PB + r * 256 + 8 * cg + 4) = (f32x4){f[4], f[5], f[6], f[7]}; } }
    __syncthreads();
    { const int c = tid & 255, th = tid >> 8, hw = 1 << (c >> 6); const float bp = p->b_pool[l * 256 + c], ps = p->pool_scale[l * 256 + c];
#pragma unroll 4
      for (int o = 0; o < 32; ++o) { const int tl = 32 * th + o, t = t0 + tl; const int lo = max(t - hw, 0), hi = min(t + hw, L); float s = 0.f;
          for (int tt = lo; tt < hi; ++tt) s += PB[(tt - t0 + 8) * 256 + c];
          const float yv = (s * frcp((float)(hi - lo)) - PB[(tl + 8) * 256 + c] + bp) * ps;
          Y[(size_t)(rowbase + t) * D + 256 + c] = f2bf(yv); } }
}
__device__ __forceinline__ void four_unit(CP p, int l, int q) {
    const int tid = tid_();
    bf16_t* Y = (bf16_t*)(p->ws + WS_YCAT);
    const Seq sq = seq_of(q); const int b = sq.b, rowbase = sq.rowbase, t0 = sq.t0; const bool lat = sq.lat;
    const float* UU = (const float*)(p->ws + WS_UU); const float* VV = (const float*)(p->ws + WS_VV); const float* YCX = (const float*)(p->ws + WS_YCX);
#pragma unroll
    for (int it = 0; it < 4; ++it) { const int task = it * 512 + tid, tl = task >> 5, cg = task & 31, t = t0 + tl; float y[8];
        f32x4 u0, u1, v0 = {0.f, 0.f, 0.f, 0.f}, v1 = {0.f, 0.f, 0.f, 0.f}; float sgn, scale;
        if (lat) { const int k = t <= 2048 ? t : 4096 - t; sgn = t <= 2048 ? -1.0f : 1.0f; scale = 1.0f / 512.0f;
            const float* up = UU + (size_t)k * 2048 + b * 256 + 8 * cg; u0 = *(const f32x4*)up; u1 = *(const f32x4*)(up + 4);
            if (k < 2048) { const float* vp = VV + (size_t)k * 2048 + b * 256 + 8 * cg; v0 = *(const f32x4*)vp; v1 = *(const f32x4*)(vp + 4); } }
        else { sgn = 0.f; scale = 1.0f / 128.0f; const float* up = YCX + (size_t)t * 2048 + b * 256 + 8 * cg; u0 = *(const f32x4*)up; u1 = *(const f32x4*)(up + 4); }
        const f32x4 bf0 = *(const f32x4*)(p->b_four + l * 256 + 8 * cg), bf1 = *(const f32x4*)(p->b_four + l * 256 + 8 * cg + 4);
        const f32x4 r0 = (u0 + v0 * sgn) * scale + bf0, r1 = (u1 + v1 * sgn) * scale + bf1;
        y[0] = r0[0]; y[1] = r0[1]; y[2] = r0[2]; y[3] = r0[3]; y[4] = r1[0]; y[5] = r1[1]; y[6] = r1[2]; y[7] = r1[3];
        *(u32x4*)(Y + (size_t)(rowbase + t) * D + 512 + 8 * cg) = pack8(y); }
}
__device__ __forceinline__ void conformer_unit(CP p, int l, int q, LAS unsigned char* lds) {
    LAS float* V = (LAS float*)lds;
    const int tid = tid_(), lane = tid & 63, wid = __builtin_amdgcn_readfirstlane(tid >> 6);
    const bf16_t* PROJ = (const bf16_t*)(p->ws + WS_PROJ); bf16_t* Y = (bf16_t*)(p->ws + WS_YCAT);
    const Seq sq = seq_of(q); const int L = sq.L, rowbase = sq.rowbase, t0 = sq.t0;
    __syncthreads();
    { u32x4 wa[6], wg_[6];
#pragma unroll
      for (int it = 0; it < 6; ++it) { const int task = it * 512 + tid, r = task >> 5, cg = task & 31, tt = t0 - 15 + r; wa[it] = (u32x4){0u, 0u, 0u, 0u}; wg_[it] = wa[it];
          if (task < 94 * 32 && tt >= 0 && tt < L) { const bf16_t* pr = PROJ + (size_t)(rowbase + tt) * NPROJ + 768 + 8 * cg; wa[it] = *(const u32x4*)pr; wg_[it] = *(const u32x4*)(pr + 256); } }
#pragma unroll
      for (int it = 0; it < 6; ++it) { const int task = it * 512 + tid, r = task >> 5, cg = task & 31; float a[8], g[8], f[8]; unpack8(wa[it], a); unpack8(wg_[it], g);
#pragma unroll
          for (int e = 0; e < 8; ++e) f[e] = a[e] * sigmoidf_(g[e]);
          if (task < 94 * 32) { *(LAS f32x4*)(V + r * 256 + 8 * cg) = (f32x4){f[0], f[1], f[2], f[3]}; *(LAS f32x4*)(V + r * 256 + 8 * cg + 4) = (f32x4){f[4], f[5], f[6], f[7]}; } } }
    __syncthreads();
    const int hp = wid & 1, tq = wid >> 1, c0 = 128 * hp + 2 * lane;
    f32x2 wk[31];
#pragma unroll
    for (int k = 0; k < 31; ++k) wk[k] = *(const f32x2*)(p->conv_d_w + ((size_t)l * 31 + k) * 256 + c0);
    const f32x2 cb = *(const f32x2*)(p->conv_d_b + l * 256 + c0), lg = *(const f32x2*)(p->ln_d_g + l * 256 + c0), lb = *(const f32x2*)(p->ln_d_b + l * 256 + c0);
    for (int blk = 0; blk < 2; ++blk) { const int tl0 = 16 * tq + 8 * blk;
        f32x2 win[38];
#pragma unroll
        for (int i = 0; i < 38; ++i) win[i] = *(const LAS f32x2*)(V + (tl0 + i) * 256 + c0);
        f32x2 sv[8]; float m1[8], m2[8];
#pragma unroll
        for (int o = 0; o < 8; ++o) { f32x2 sacc = cb;
#pragma unroll
            for (int k = 0; k < 31; ++k) sacc += wk[k] * win[o + k];
            sv[o] = sacc; m1[o] = sacc.x + sacc.y; m2[o] = sacc.x * sacc.x + sacc.y * sacc.y; }
#pragma unroll
        for (int st = 16; st >= 1; st >>= 1) { float t1[8], t2[8];
#pragma unroll
            for (int o = 0; o < 8; ++o) { t1[o] = bperm(m1[o], lane ^ st); t2[o] = bperm(m2[o], lane ^ st); }
#pragma unroll
            for (int o = 0; o < 8; ++o) { m1[o] += t1[o]; m2[o] += t2[o]; } }
#pragma unroll
        for (int o = 0; o < 8; ++o) { const float mean = m1[o] * (1.0f / 64.0f); const float var = fmaxf(m2[o] * (1.0f / 64.0f) - mean * mean, 0.f); const float rs = __builtin_amdgcn_rsqf(var + 1e-6f);
            f32x2 yv = (sv[o] - mean) * rs * lg + lb; yv.x = yv.x * sigmoidf_(yv.x); yv.y = yv.y * sigmoidf_(yv.y);
            *(unsigned*)(Y + (size_t)(rowbase + t0 + tl0 + o) * D + 768 + c0) = cvt_pk_bf16(yv.x, yv.y); } }
}

struct SchedIn { const char *U, *W, *WF; char *PROJ, *PQT, *PQC;
    __device__ __forceinline__ bool next(int i, g8::Unit& u) const { const int L = i * (int)gridDim.x + (int)blockIdx.x; if (L >= 952) return false; const int id = g8::xcd_remap(L, 952);
        if (id < 680) { u.kind = 0; u.pm = id / 5; u.pn = id % 5; u.a = U + (size_t)u.pm * 256 * 2048; u.b = W + (size_t)u.pn * 256 * 2048; u.o = PROJ; u.e = 0; }
        else { const int r = id - 680; u.kind = 1; u.pm = r & 1; u.pn = r >> 1; u.a = WF + (size_t)u.pm * 256 * 2048; u.b = U + (size_t)u.pn * 256 * 2048; u.e = 0;
            if (u.pn < 128) u.o = PQT + ((size_t)(u.pm * 2048 + (u.pn >> 4) * 256) * 4096 + (u.pn & 15) * 256) * 2; else u.o = PQC + ((size_t)((u.pn - 128) * 256) * 512 + u.pm * 256) * 2; }
        return true; } };
struct EpiIn { static constexpr bool PERM = true; const float* bin; const float* bf;
    __device__ __forceinline__ void operator()(const f32x4 (&acc)[2][2][4][2], const g8::Unit& u, int wr, int wc, int fr, int fq) const {
        { const int ln_ = tid_() & 63; fr = ln_ & 15; fq = ln_ >> 4; }
        if (u.kind == 0) { const int row0 = u.pm * 256 + wr * 64 + fr, col0 = u.pn * 256 + wc * 32 + 8 * fq; bf16_t* O = (bf16_t*)u.o;
            f32x4 bv[2][2];
#pragma unroll
            for (int bj = 0; bj < 2; ++bj)
#pragma unroll
                for (int n = 0; n < 2; ++n) bv[bj][n] = *(const f32x4*)(bin + col0 + bj * 128 + 4 * n);
#pragma unroll
            for (int ai = 0; ai < 2; ++ai)
#pragma unroll
                for (int m = 0; m < 4; ++m) { bf16_t* rowp = O + (size_t)(row0 + ai * 128 + m * 16) * NPROJ + col0;
#pragma unroll
                    for (int bj = 0; bj < 2; ++bj) { const f32x4 v0 = acc[ai][bj][m][0] + bv[bj][0], v1 = acc[ai][bj][m][1] + bv[bj][1];
                        u32x4 w; w.x = cvt_pk_bf16(v0[0], v0[1]); w.y = cvt_pk_bf16(v0[2], v0[3]); w.z = cvt_pk_bf16(v1[0], v1[1]); w.w = cvt_pk_bf16(v1[2], v1[3]); *(u32x4*)(rowp + bj * 128) = w; } }
        } else { const int pitch = u.pn < 128 ? 4096 : 512; bf16_t* O = (bf16_t*)u.o; const int col0 = wc * 32 + 8 * fq;
#pragma unroll
            for (int ai = 0; ai < 2; ++ai)
#pragma unroll
                for (int m = 0; m < 4; ++m) { const int r = ai * 128 + wr * 64 + m * 16 + fr; const float bb = bf[u.pm * 256 + r]; bf16_t* rowp = O + (size_t)r * pitch + col0;
#pragma unroll
                    for (int bj = 0; bj < 2; ++bj) { const f32x4 v0 = acc[ai][bj][m][0] + bb, v1 = acc[ai][bj][m][1] + bb;
                        u32x4 w; w.x = cvt_pk_bf16(v0[0], v0[1]); w.y = cvt_pk_bf16(v0[2], v0[3]); w.z = cvt_pk_bf16(v1[0], v1[1]); w.w = cvt_pk_bf16(v1[2], v1[3]); *(u32x4*)(rowp + bj * 128) = w; } }
        } } };
struct SchedDft { const char *CM, *SM, *PQT; char *UU, *VV;
    __device__ __forceinline__ bool next(int i, g8::Unit& u) const { const int id = (int)blockIdx.x; if (i > 0 || id >= 136) return false; u.kind = 0; u.e = 0;
        if (id < 72) { u.pm = id >> 3; u.pn = id & 7; u.a = CM + (size_t)u.pm * 256 * 8192; u.b = PQT + (size_t)u.pn * 256 * 8192; u.o = UU + ((size_t)u.pm * 256 * 2048 + u.pn * 256) * 4; }
        else { const int r = id - 72; u.pm = r >> 3; u.pn = r & 7; u.a = SM + (size_t)u.pm * 256 * 8192; u.b = PQT + (size_t)(2048 + u.pn * 256) * 8192; u.o = VV + ((size_t)u.pm * 256 * 2048 + u.pn * 256) * 4; }
        return true; } };
struct SchedOne { g8::Unit u; __device__ __forceinline__ bool next(int i, g8::Unit& o) const { if (i > 0) return false; o = u; return true; } };
struct SchedDftC { const char *DC, *PQC; char* YCX;
    __device__ __forceinline__ bool next(int i, g8::Unit& u) const { const int id = (int)blockIdx.x - 136; if (i > 0 || id < 0 || id >= 8) return false; u.kind = 0; u.e = 0; u.pm = 0; u.pn = id;
        u.a = DC; u.b = PQC + (size_t)id * 256 * 1024; u.o = YCX + (size_t)id * 256 * 4; return true; } };
struct EpiF32 { static constexpr bool PERM = false;
    __device__ __forceinline__ void operator()(const f32x4 (&acc)[2][2][4][2], const g8::Unit& u, int wr, int wc, int fr, int fq) const {
        { const int ln_ = tid_() & 63; fr = ln_ & 15; fq = ln_ >> 4; }
        float* O = (float*)u.o; const int row0 = wr * 64 + fr, col0 = wc * 32 + 4 * fq;
#pragma unroll
        for (int ai = 0; ai < 2; ++ai)
#pragma unroll
            for (int m = 0; m < 4; ++m) { float* rowp = O + (size_t)(row0 + ai * 128 + m * 16) * 2048 + col0;
#pragma unroll
                for (int bj = 0; bj < 2; ++bj)
#pragma unroll
                    for (int n = 0; n < 2; ++n) *(f32x4*)(rowp + bj * 128 + n * 16) = acc[ai][bj][m][n]; } } };
struct SchedOut { const char *Y, *W; int nm; const float* modv_l;
    __device__ __forceinline__ bool next(int i, g8::Unit& u) const { const int nu = nm * 4, L = i * (int)gridDim.x + (int)blockIdx.x; if (L >= nu) return false; const int id = g8::xcd_remap(L, nu);
        u.kind = 0; u.pm = id >> 2; u.pn = id & 3; u.a = Y + (size_t)u.pm * 256 * 2048; u.b = W + (size_t)u.pn * 256 * 2048; u.o = nullptr; u.e = u.pm < 128 ? u.pm >> 4 : 8; return true; } };
struct EpiOut { static constexpr bool PERM = false; float* X; float* Xo; const float* bout; const float* modv_l;
    __device__ __forceinline__ void operator()(const f32x4 (&acc)[2][2][4][2], const g8::Unit& u, int wr, int wc, int fr, int fq) const {
        { const int ln_ = tid_() & 63; fr = ln_ & 15; fq = ln_ >> 4; }
        const int row0 = u.pm * 256 + wr * 64 + fr, col0 = u.pn * 256 + wc * 32 + 4 * fq; const float* g1 = modv_l + (size_t)u.e * 6144 + 2048;
        f32x4 bv[2][2], gv[2][2];
#pragma unroll
        for (int bj = 0; bj < 2; ++bj)
#pragma unroll
            for (int n = 0; n < 2; ++n) { bv[bj][n] = *(const f32x4*)(bout + col0 + bj * 128 + n * 16); gv[bj][n] = *(const f32x4*)(g1 + col0 + bj * 128 + n * 16); }
#pragma unroll
        for (int ai = 0; ai < 2; ++ai)
#pragma unroll
            for (int m = 0; m < 4; ++m) { float* rowp = X + (size_t)(row0 + ai * 128 + m * 16) * D + col0;
#pragma unroll
                for (int bj = 0; bj < 2; ++bj)
#pragma unroll
                    for (int n = 0; n < 2; ++n) { const f32x4* px = (const f32x4*)(rowp + bj * 128 + n * 16); *(f32x4*)(Xo + (px - (const f32x4*)X) * 4) = *px + gv[bj][n] * (acc[ai][bj][m][n] + bv[bj][n]); } } } };
struct MoeTab { const LAS int* pref; const LAS int* cnt; int ntile;
    __device__ __forceinline__ int pref_(int e) const { return __builtin_amdgcn_readfirstlane(pref[e]); }
    __device__ __forceinline__ int cnt_(int e) const { return __builtin_amdgcn_readfirstlane(cnt[e]); }
    __device__ __forceinline__ int expert_of(int pm) const { int e = 0;
        for (int k = 1; k < 32; ++k) e += (pm >= pref_(k)) ? 1 : 0; return e; } };
struct SchedGu { MoeTab tb; const char *U, *W; char* ACT; const int* rasg; int rb;
    __device__ __forceinline__ bool next(int i, g8::Unit& u) const { const int nu = tb.ntile * 8, L = i * (int)gridDim.x + (int)blockIdx.x; if (L >= nu) return false; const int id = g8::xcd_remap(L, nu);
        u.kind = 0; u.pm = id >> 3; u.pn = id & 7; u.e = tb.expert_of(u.pm); u.a = U; u.b = W + ((size_t)u.e * 2048 + u.pn * 256) * rb; u.o = ACT + (size_t)u.pm * 256 * rb; return true; }
    __device__ __forceinline__ int row(const g8::Unit& u, int r) const { const int v = rasg[(size_t)u.e * TT + (u.pm - tb.pref_(u.e)) * 256 + r] >> 2; return min(max(v, 0), TT - 1); } };
template <bool F8> struct EpiGu { static constexpr bool PERM = true; const float* bgu;
    __device__ __forceinline__ void operator()(const f32x4 (&acc)[2][2][4][2], const g8::Unit& u, int wr, int wc, int fr, int fq) const {
        { const int ln_ = tid_() & 63; fr = ln_ & 15; fq = ln_ >> 4; }
        const int col0 = u.pn * 128 + wc * 32 + 8 * fq; const float* bg = bgu + (size_t)u.e * 2048 + col0; const float sc = F8 ? (1.0f / 64.0f) : 1.0f;
        f32x4 bgt[2], bup[2];
#pragma unroll
        for (int n = 0; n < 2; ++n) { bgt[n] = *(const f32x4*)(bg + 4 * n); bup[n] = *(const f32x4*)(bg + 1024 + 4 * n); }
#pragma unroll
        for (int ai = 0; ai < 2; ++ai)
#pragma unroll
            for (int m = 0; m < 4; ++m) { const int r = ai * 128 + wr * 64 + m * 16 + fr; float y[8];
#pragma unroll
                for (int n = 0; n < 2; ++n) { const f32x4 g4 = acc[ai][0][m][n] * sc + bgt[n], u4 = acc[ai][1][m][n] * sc + bup[n];
#pragma unroll
                    for (int e = 0; e < 4; ++e) { const float gt = fminf(g4[e], 7.0f), up = fminf(fmaxf(u4[e], -7.0f), 7.0f); y[4 * n + e] = (up + 1.0f) * (gt * sigmoidf_(1.702f * gt)); } }
                if constexpr (F8) { u32x2 w; w.x = pk4_fp8(y[0], y[1], y[2], y[3]); w.y = pk4_fp8(y[4], y[5], y[6], y[7]); *(u32x2*)((unsigned char*)u.o + (size_t)r * D + col0) = w; }
                else *(u32x4*)((bf16_t*)u.o + (size_t)r * D + col0) = pack8(y); } } };
struct SchedDown { MoeTab tb; const char *ACT, *W; int rb;
    __device__ __forceinline__ bool next(int i, g8::Unit& u) const { const int nu = tb.ntile * 4, L = i * (int)gridDim.x + (int)blockIdx.x; if (L >= nu) return false; const int id = g8::xcd_remap(L, nu);
        u.kind = 0; u.pm = id >> 2; u.pn = id & 3; u.e = tb.expert_of(u.pm); u.a = ACT + (size_t)u.pm * 256 * rb; u.b = W + ((size_t)u.e * 1024 + u.pn * 256) * rb; u.o = nullptr; return true; } };
struct EpiDown { static constexpr bool PERM = true; MoeTab tb; const float* bd; const int* rasg; const float* gate; bf16_t* YS; float sc;
    __device__ __forceinline__ void operator()(const f32x4 (&acc)[2][2][4][2], const g8::Unit& u, int wr, int wc, int fr, int fq) const {
        { const int ln_ = tid_() & 63; fr = ln_ & 15; fq = ln_ >> 4; }
        const int col0 = u.pn * 256 + wc * 32 + 8 * fq; const float* bp = bd + (size_t)u.e * 1024 + col0; const int rank0 = (u.pm - tb.pref_(u.e)) * 256, cnt = tb.cnt_(u.e);
        f32x4 bv[2][2];
#pragma unroll
        for (int bj = 0; bj < 2; ++bj)
#pragma unroll
            for (int n = 0; n < 2; ++n) bv[bj][n] = *(const f32x4*)(bp + bj * 128 + 4 * n);
#pragma unroll
        for (int ai = 0; ai < 2; ++ai)
#pragma unroll
            for (int m = 0; m < 4; ++m) { const int rank = rank0 + ai * 128 + wr * 64 + m * 16 + fr;
                if (rank < cnt) { const int asg = rasg[(size_t)u.e * TT + rank]; const float g = gate[asg]; bf16_t* rowp = YS + (size_t)asg * D + col0;
#pragma unroll
                    for (int bj = 0; bj < 2; ++bj) { const f32x4 v0 = (acc[ai][bj][m][0] * sc + bv[bj][0]) * g, v1 = (acc[ai][bj][m][1] * sc + bv[bj][1]) * g;
                        u32x4 w; w.x = cvt_pk_bf16(v0[0], v0[1]); w.y = cvt_pk_bf16(v0[2], v0[3]); w.z = cvt_pk_bf16(v1[0], v1[1]); w.w = cvt_pk_bf16(v1[2], v1[3]); *(u32x4*)(rowp + bj * 128) = w; } } } } };
__device__ __forceinline__ MoeTab moe_tables(CP p, int l, LAS unsigned char* lds) {
    LAS int* pref = (LAS int*)(lds + g8::STAGE_BYTES); LAS int* cnt = pref + 64;
    unsigned* ctl = (unsigned*)(p->ws + WS_CTL);
    __syncthreads();
    if (tid_() < 32) cnt[tid_()] = (int)__hip_atomic_load(ctl + CW_COUNT + (l * NE + tid_()) * 64, __ATOMIC_RELAXED, __HIP_MEMORY_SCOPE_AGENT);
    __syncthreads();
    if (tid_() == 0) { int s = 0; for (int e = 0; e < 32; ++e) { pref[e] = s; s += (cnt[e] + 255) >> 8; } pref[32] = s; }
    __syncthreads();
    MoeTab tb; tb.pref = pref; tb.cnt = cnt; tb.ntile = __builtin_amdgcn_readfirstlane(pref[32]); return tb;
}

constexpr int N_PHASES = 18;
__global__ void __launch_bounds__(512, 2) mega_fwd(Params p_unused) {
    CP p = launder_params();
    extern __shared__ __attribute__((aligned(16))) unsigned char shm_[];
    LAS unsigned char* lds0 = (LAS unsigned char*)shm_;
    LAS unsigned char* lds = lds0 + LDS_BASE;
    if (tid_() == 0) *(LAS u32x4*)lds0 = (u32x4){0u, 0u, 0u, 0u};
    __syncthreads();
    XcdBarrier bar = xcd_barrier_post((unsigned*)(p->ws + WS_CTL), (volatile LAS unsigned*)lds0);
    int ph = 0;
#ifndef P3A
#define P3A 1
#define P3B 1
#define P3C 1
#endif
#ifndef PHMASK
#define PHMASK 0x3ff
#endif
#ifndef REPMASK
#define REPMASK 0
#endif
#define PHASE_BEGIN_K(k) p = launder_params(); if (((PHMASK >> (k)) & 1) && ph >= p->ph_lo && ph < p->ph_hi) for (int rep_ = 0; rep_ < ((((REPMASK) >> (k)) & 1) ? 2 : 1); ++rep_) {
#define PHASE_END } ++ph; if (ph > p->ph_lo && ph < p->ph_hi) xcd_barrier(bar);
    PHASE_BEGIN_K(0) phase_prologue(p, lds); PHASE_END
    for (int l = 0; l < 2; ++l) {
        const float* modv_l = (const float*)(p->ws + WS_MODV) + (size_t)l * 9 * 6144;
        PHASE_BEGIN_K(1) phase_norm(p, l); PHASE_END
        PHASE_BEGIN_K(2) { SchedIn S; S.U = (const char*)(p->ws + WS_U); S.W = (const char*)(p->ws + WS_WINT) + (size_t)l * NPROJ * 2048; S.WF = (const char*)(p->ws + WS_WFT) + (size_t)l * 512 * 2048;
                      S.PROJ = (char*)(p->ws + WS_PROJ); S.PQT = (char*)(p->ws + WS_PQT); S.PQC = (char*)(p->ws + WS_PQC);
                      EpiIn E; E.bin = (const float*)(p->ws + WS_BIN) + l * NPROJ; E.bf = (const float*)(p->ws + WS_BF) + l * 512;
                      g8::gemm_phase<EpiIn, SchedIn, false>(lds, 1024, S, E); } PHASE_END
        PHASE_BEGIN_K(3) {
                      unsigned* qhead = (unsigned*)(p->ws + WS_CTL) + CW_QUEUE + (l * 2 + rep_) * 64; LAS int* qslot = (LAS int*)(lds - LDS_BASE + 64);
                      for (;;) { __syncthreads(); if (tid_() == 0) *qslot = (int)__hip_atomic_fetch_add(qhead, 1u, __ATOMIC_RELAXED, __HIP_MEMORY_SCOPE_AGENT); __syncthreads();
                          const int id = __builtin_amdgcn_readfirstlane(*qslot); if (id >= 144 + 3 * NCHUNK) break;
                          if (id < 136) { SchedOne S; S.u.kind = 0; S.u.e = 0;
                              if (id < 72) { S.u.pm = id >> 3; S.u.pn = id & 7; S.u.a = (const char*)(p->ws + WS_CMAT) + (size_t)S.u.pm * 256 * 8192; S.u.b = (const char*)(p->ws + WS_PQT) + (size_t)S.u.pn * 256 * 8192; S.u.o = (char*)(p->ws + WS_UU) + ((size_t)S.u.pm * 256 * 2048 + S.u.pn * 256) * 4; }
                              else { const int r = id - 72; S.u.pm = r >> 3; S.u.pn = r & 7; S.u.a = (const char*)(p->ws + WS_SMAT) + (size_t)S.u.pm * 256 * 8192; S.u.b = (const char*)(p->ws + WS_PQT) + (size_t)(2048 + S.u.pn * 256) * 8192; S.u.o = (char*)(p->ws + WS_VV) + ((size_t)S.u.pm * 256 * 2048 + S.u.pn * 256) * 4; }
                              g8::gemm_phase<EpiF32, SchedOne, false>(lds, 4096, S, EpiF32{}); }
                          else if (id < 144) { SchedOne S; S.u.kind = 0; S.u.e = 0; S.u.pm = 0; S.u.pn = id - 136; S.u.a = (const char*)(p->ws + WS_DFTC); S.u.b = (const char*)(p->ws + WS_PQC) + (size_t)S.u.pn * 256 * 1024; S.u.o = (char*)(p->ws + WS_YCX) + (size_t)S.u.pn * 256 * 4;
                              g8::gemm_phase<EpiF32, SchedOne, false>(lds, 512, S, EpiF32{}); }
                          else { const int uu = id - 144, kind = uu / NCHUNK, q = uu % NCHUNK;
                              if (kind == 0) scan_unit<1>(p, l, q, lds); else if (kind == 1) conformer_unit(p, l, q, lds); else pool_unit(p, l, q, lds); } } } PHASE_END
        PHASE_BEGIN_K(4) { for (int q = blockIdx.x; q < NCHUNK; q += gridDim.x) { scan2_unit(p, l, q, lds); four_unit(p, l, q); } } PHASE_END
        PHASE_BEGIN_K(5) { SchedOut S; S.Y = (const char*)(p->ws + WS_YCAT); S.W = (const char*)(p->ws + WS_WOUTT) + (size_t)l * D * 2048; S.nm = l == 0 ? 136 : 128; S.modv_l = modv_l;
                      EpiOut E; E.X = (float*)(p->ws + WS_X); E.Xo = rep_ ? (float*)(p->ws + WS_ACT) : E.X; E.bout = (const float*)(p->ws + WS_BOUT) + l * D; E.modv_l = modv_l;
                      g8::gemm_phase<EpiOut, SchedOut, false>(lds, 1024, S, E); } PHASE_END
        PHASE_BEGIN_K(6) phase_router(p, l, lds, rep_); PHASE_END
        PHASE_BEGIN_K(7) { MoeTab tb = moe_tables(p, l, lds);
                      SchedGu S; S.tb = tb; S.W = (const char*)(p->ws + WS_WGUT) + (size_t)l * NE * 2048 * 2048; S.ACT = (char*)(p->ws + WS_ACT); S.rasg = (const int*)(p->ws + WS_RASG);
                      if (fp8_layer(l)) { S.U = (const char*)(p->ws + WS_U8); S.rb = 1024; EpiGu<true> E; E.bgu = p->b_gu + (size_t)l * NE * 2048; g8::gemm_phase<EpiGu<true>, SchedGu, true, true>(lds, 512, S, E); }
                      else { S.U = (const char*)(p->ws + WS_U); S.rb = 2048; EpiGu<false> E; E.bgu = p->b_gu + (size_t)l * NE * 2048; g8::gemm_phase<EpiGu<false>, SchedGu, true, false>(lds, 1024, S, E); } } PHASE_END
        PHASE_BEGIN_K(8) { MoeTab tb = moe_tables(p, l, lds);
                      SchedDown S; S.tb = tb; S.ACT = (const char*)(p->ws + WS_ACT); S.W = (const char*)(p->ws + WS_WDT) + (size_t)l * NE * 1024 * 2048;
                      EpiDown E; E.tb = tb; E.bd = p->b_down + (size_t)l * NE * 1024; E.rasg = (const int*)(p->ws + WS_RASG); E.gate = (const float*)(p->ws + WS_GATE); E.YS = (bf16_t*)(p->ws + WS_YS);
                      if (fp8_layer(l)) { S.rb = 1024; E.sc = 1.0f / 64.0f; g8::gemm_phase<EpiDown, SchedDown, false, true>(lds, 512, S, E); }
                      else { S.rb = 2048; E.sc = 1.0f; g8::gemm_phase<EpiDown, SchedDown, false, false>(lds, 1024, S, E); } } PHASE_END
    }
    PHASE_BEGIN_K(9) phase_norm(p, 2); PHASE_END
#undef PHASE_BEGIN_K
#undef PHASE_END
}

extern "C" void kernel_launch(void* const* d_in, const int* in_sizes, int n_in, void* d_out, int out_size, void* d_ws, size_t ws_size, hipStream_t stream) {
    static int grid = 0;
    if (!grid) {
        if (n_in != 37 || ws_size < WS_END) { fprintf(stderr, "kernel_launch: expected 37 inputs and >= %zu bytes of workspace (got %d, %zu)\n", (size_t)WS_END, n_in, ws_size); }
        int dev = 0, cus = 0, per_cu = 0;
        hipGetDevice(&dev); hipDeviceGetAttribute(&cus, hipDeviceAttributeMultiprocessorCount, dev);
        hipFuncSetAttribute((const void*)mega_fwd, hipFuncAttributeMaxDynamicSharedMemorySize, LDS_BYTES);
        hipOccupancyMaxActiveBlocksPerMultiprocessor(&per_cu, (const void*)mega_fwd, 512, LDS_BYTES);
        if (per_cu < 1) fprintf(stderr, "kernel_launch: occupancy query reports %d workgroups per CU\n", per_cu);
        grid = cus > 0 ? cus : 256;
    }
    hipMemsetAsync((char*)d_ws + WS_CTL, 0, CTL_BYTES, stream);
    Params hp{};
    const float** f = (const float**)&hp;
    for (int i = 0; i < 37; ++i) f[i] = (const float*)d_in[i];
    hp.out = (float*)d_out; hp.ws = (unsigned char*)d_ws;
#if MK_N_LAUNCHES == 1
    hp.ph_lo = 0; hp.ph_hi = N_PHASES;
    hipLaunchKernelGGL(mega_fwd, dim3(grid), dim3(512), LDS_BYTES, stream, hp);
#else
    for (int ph = 0; ph < N_PHASES; ++ph) { hp.ph_lo = ph; hp.ph_hi = ph + 1; hipLaunchKernelGGL(mega_fwd, dim3(grid), dim3(512), LDS_BYTES, stream, hp); }
#endif
}
```

```cpp
#include <hip/hip_runtime.h>
#include <cstdio>
#include <cstdint>

#ifndef MK_N_LAUNCHES
#define MK_N_LAUNCHES 1
#endif

#ifndef FP8_FROM
#define FP8_FROM 0
#endif
#define LAS __attribute__((address_space(3)))
typedef unsigned short bf16_t;
typedef short bf16x8 __attribute__((ext_vector_type(8)));
typedef float f32x4 __attribute__((ext_vector_type(4)));
typedef float f32x2 __attribute__((ext_vector_type(2)));
typedef unsigned u32x4 __attribute__((ext_vector_type(4)));
typedef unsigned u32x2 __attribute__((ext_vector_type(2)));
typedef int i32x4 __attribute__((ext_vector_type(4)));
typedef int i32x8 __attribute__((ext_vector_type(8)));

constexpr int D = 1024, NB = 8, SEQ = 4096, LCX = 256, TL = NB * SEQ, TC = NB * LCX, TT = TL + TC;
constexpr int NPROJ = 1280;
constexpr int NE = 32, NCHUNK = 544;
constexpr int NTILE_MAX = 576;

constexpr size_t AL(size_t x) { return (x + 255) & ~(size_t)255; }
constexpr size_t CTL_BYTES = 65536;
constexpr size_t WS_CTL = 0;
constexpr size_t WS_MODV = WS_CTL + CTL_BYTES;
constexpr size_t WS_X = AL(WS_MODV + (size_t)2 * 9 * 6144 * 4);
constexpr size_t WS_U = AL(WS_X + (size_t)TT * D * 4);
constexpr size_t WS_PROJ = AL(WS_U + (size_t)TT * D * 2);
constexpr size_t WS_PQT = AL(WS_PROJ + (size_t)TT * NPROJ * 2);
constexpr size_t WS_PQC = AL(WS_PQT + (size_t)4096 * 4096 * 2);
constexpr size_t WS_UU = AL(WS_PQC + (size_t)2048 * 512 * 2);
constexpr size_t WS_VV = AL(WS_UU + (size_t)2304 * 2048 * 4);
constexpr size_t WS_YCX = AL(WS_VV + (size_t)2048 * 2048 * 4);
constexpr size_t WS_YCAT = AL(WS_YCX + (size_t)256 * 2048 * 4);
constexpr size_t WS_SUMM = AL(WS_YCAT + (size_t)TT * D * 2);
constexpr size_t WS_WINT = AL(WS_SUMM + (size_t)NCHUNK * 1024 * 4);
constexpr size_t WS_WFT = AL(WS_WINT + (size_t)2 * NPROJ * D * 2);
constexpr size_t WS_BIN = AL(WS_WFT + (size_t)2 * 512 * D * 2);
constexpr size_t WS_BF = AL(WS_BIN + (size_t)2 * NPROJ * 4);
constexpr size_t WS_WOUTT = AL(WS_BF + (size_t)2 * 512 * 4);
constexpr size_t WS_BOUT = AL(WS_WOUTT + (size_t)2 * D * D * 2);
constexpr size_t WS_WGUT = AL(WS_BOUT + (size_t)2 * D * 4);
constexpr size_t WS_WDT = AL(WS_WGUT + (size_t)2 * NE * 2048 * D * 2);
constexpr size_t WS_WRT = AL(WS_WDT + (size_t)2 * NE * D * D * 2);
constexpr size_t WS_WGT = AL(WS_WRT + (size_t)2 * 2 * NE * D * 2);
constexpr size_t WS_CMAT = AL(WS_WGT + (size_t)2 * 2 * 2 * 4 * 64 * 64 * 2);
constexpr size_t WS_SMAT = AL(WS_CMAT + (size_t)2304 * 4096 * 2);
constexpr size_t WS_DFTC = AL(WS_SMAT + (size_t)2048 * 4096 * 2);
constexpr size_t WS_RASG = AL(WS_DFTC + (size_t)256 * 512 * 2);
constexpr size_t WS_GATE = AL(WS_RASG + (size_t)NE * TT * 4);
constexpr size_t WS_ACT = AL(WS_GATE + (size_t)TT * 4 * 4);
constexpr size_t WS_YS = AL(WS_ACT + (size_t)NTILE_MAX * 256 * D * 2);
constexpr size_t WS_POS = AL(WS_YS + (size_t)TT * 4 * D * 2);
constexpr size_t WS_AB = AL(WS_POS + (size_t)64 * 512 * 4);
constexpr size_t WS_U8 = AL(WS_AB + (size_t)NCHUNK * 8 * 16 * 64 * 16);
constexpr size_t WS_END = AL(WS_U8 + (size_t)TT * D);
constexpr int CW_QUEUE = 12288;
constexpr int CW_COUNT = 4096;

constexpr int LDS_BYTES = 159744;
constexpr int LDS_BASE = 1024;

__device__ __forceinline__ unsigned cvt_pk_bf16(float lo, float hi) { unsigned r; asm("v_cvt_pk_bf16_f32 %0, %1, %2" : "=v"(r) : "v"(lo), "v"(hi)); return r; }
__device__ __forceinline__ bf16_t f2bf(float f) { return (bf16_t)(cvt_pk_bf16(f, 0.f) & 0xffffu); }
__device__ __forceinline__ unsigned pk4_fp8(float a, float b, float c, float d) { int w = 0; w = __builtin_amdgcn_cvt_pk_fp8_f32(a, b, w, false); w = __builtin_amdgcn_cvt_pk_fp8_f32(c, d, w, true); return (unsigned)w; }
__device__ __forceinline__ float bf2f(bf16_t b) { return __uint_as_float(((unsigned)b) << 16); }
__device__ __forceinline__ float bflo(unsigned w) { return __uint_as_float(w << 16); }
__device__ __forceinline__ float bfhi(unsigned w) { return __uint_as_float(w & 0xffff0000u); }
__device__ __forceinline__ float fexp2(float x) { return __builtin_amdgcn_exp2f(x); }
__device__ __forceinline__ float frcp(float x) { return __builtin_amdgcn_rcpf(x); }
__device__ __forceinline__ float sigmoidf_(float x) { return frcp(1.0f + fexp2(-1.4426950408889634f * x)); }
__device__ __forceinline__ int tid_() { int t = (int)threadIdx.x; asm volatile("" : "+v"(t)); return t; }
__device__ __forceinline__ float bperm(float v, int src) { return __int_as_float(__builtin_amdgcn_ds_bpermute(src << 2, __float_as_int(v))); }
__device__ __forceinline__ float wave_sum(float v, int lane) {
#pragma unroll
    for (int o = 32; o >= 1; o >>= 1) v += bperm(v, lane ^ o);
    return v;
}
__device__ __forceinline__ void unpack8(const u32x4 w, float (&f)[8]) { f[0] = bflo(w.x); f[1] = bfhi(w.x); f[2] = bflo(w.y); f[3] = bfhi(w.y); f[4] = bflo(w.z); f[5] = bfhi(w.z); f[6] = bflo(w.w); f[7] = bfhi(w.w); }
__device__ __forceinline__ u32x4 pack8(const float (&f)[8]) { u32x4 w; w.x = cvt_pk_bf16(f[0], f[1]); w.y = cvt_pk_bf16(f[2], f[3]); w.z = cvt_pk_bf16(f[4], f[5]); w.w = cvt_pk_bf16(f[6], f[7]); return w; }

#define XB_TMO      128
#define XB_XCNT(j)  (256  + 64 * (j))
#define XB_XSUB(j)  (1280 + 64 * (j))
#define XB_XGEN(j)  (2304 + 64 * (j))
#define XB_TOP      3328
#define XB_TOPGEN   3392
#define XCD_BAR_WORDS 3456
#define XB_SPIN_CAP (1u << 18)
__device__ __forceinline__ unsigned xb_ld(unsigned* p)              { return __hip_atomic_load(p, __ATOMIC_RELAXED, __HIP_MEMORY_SCOPE_AGENT); }
__device__ __forceinline__ unsigned xb_add(unsigned* p, unsigned v) { return __hip_atomic_fetch_add(p, v, __ATOMIC_RELAXED, __HIP_MEMORY_SCOPE_AGENT); }
__device__ __forceinline__ unsigned xb_xcc_id() { return (unsigned)__builtin_amdgcn_s_getreg((3 << 11) | 20) & 0xFu; }
#define XB_SPIN(cond, bar) do { unsigned _sp = 0; while (cond) { __builtin_amdgcn_s_sleep(1); \
    if ((++_sp & 255u) == 0u) { if (xb_ld(&(bar)[XB_TMO])) break; if (_sp > XB_SPIN_CAP) { atomicAdd(&(bar)[XB_TMO], 1u); break; } } } } while (0)
struct XcdBarrier { unsigned* bar; unsigned x; volatile LAS unsigned* st; };
__device__ __forceinline__ XcdBarrier xcd_barrier_post(unsigned* bar, volatile LAS unsigned* st) {
    XcdBarrier b; b.bar = bar; b.x = xb_xcc_id(); b.st = st;
    if (threadIdx.x == 0) (void)xb_add(&bar[XB_XCNT(b.x)], 1u);
    return b;
}
__device__ __forceinline__ void xcd_barrier_complete(unsigned* bar, unsigned x, unsigned& nloc, unsigned& nx) {
    const unsigned G = gridDim.x * gridDim.y * gridDim.z;
    unsigned sum, cnt, mine, sp = 0u;
    for (;;) {
        sum = 0u; cnt = 0u; mine = 0u;
#pragma unroll
        for (unsigned j = 0; j < 16; ++j) { const unsigned c = xb_ld(&bar[XB_XCNT(j)]); sum += c; cnt += (c > 0u) ? 1u : 0u; mine = (j == x) ? c : mine; }
        if (sum == G) break;
        __builtin_amdgcn_s_sleep(1);
        if ((++sp & 255u) == 0u) { if (xb_ld(&bar[XB_TMO])) break; if (sp > XB_SPIN_CAP) { atomicAdd(&bar[XB_TMO], 1u); break; } }
    }
    nloc = mine > 0u ? mine : 1u; nx = cnt > 0u ? cnt : 1u;
}
__device__ __forceinline__ void xcd_barrier(const XcdBarrier& b) {
    asm volatile("s_waitcnt vmcnt(0)" ::: "memory");
    __syncthreads();
    if (threadIdx.x == 0) {
        unsigned* bar = b.bar;
        __builtin_amdgcn_s_waitcnt(0);
        unsigned nloc = b.st[0], nx = b.st[1];
        if (nloc == 0u) { unsigned xo = b.x; asm volatile("" : "+s"(xo)); xcd_barrier_complete(bar, xo, nloc, nx); b.st[0] = nloc; b.st[1] = nx; }
        const unsigned old = xb_add(&bar[XB_XSUB(b.x)], 1u);
        const unsigned gen = old / nloc;
        if (old + 1u == (gen + 1u) * nloc) {
            __builtin_amdgcn_fence(__ATOMIC_RELEASE, "agent");
            asm volatile("s_waitcnt vmcnt(0)" ::: "memory");
            const unsigned og = xb_add(&bar[XB_TOP], 1u);
            const unsigned tg = og / nx;
            if (og + 1u == (tg + 1u) * nx) xb_add(&bar[XB_TOPGEN], 1u);
            else XB_SPIN(xb_ld(&bar[XB_TOPGEN]) == tg, bar);
            __builtin_amdgcn_fence(__ATOMIC_ACQUIRE, "agent");
            xb_add(&bar[XB_XGEN(b.x)], 1u);
            asm volatile("s_waitcnt vmcnt(0)" ::: "memory");
        } else {
            XB_SPIN(xb_ld(&bar[XB_XGEN(b.x)]) == gen, bar);
            __builtin_amdgcn_fence(__ATOMIC_ACQUIRE, "agent");
            asm volatile("s_waitcnt vmcnt(0)" ::: "memory");
        }
    }
    __syncthreads();
}

namespace g8 {
constexpr int BM = 256, BK = 64, HALF = 128, HTB = HALF * BK * 2, STAGE_BYTES = 8 * HTB;
__device__ __forceinline__ int lds_byte(int r, int c) { const int st = (r >> 4) * 2 + (c >> 5), rr = r & 15, cc = c & 31, ob = rr * 64 + cc * 2; return st * 1024 + (ob ^ (((ob >> 9) & 1) << 5)); }
__device__ __forceinline__ void stage_rc(int b, int& R, int& C) { const int st = b / 1024, sb = b % 1024, swz = sb ^ (((sb >> 9) & 1) << 5); R = (st >> 1) * 16 + swz / 64; C = (st & 1) * 32 + (swz % 64) / 2; }
__device__ __forceinline__ int perm32(int rho) { const int n = rho >> 4, i = rho & 15; return 8 * (i >> 2) + 4 * n + (i & 3); }

struct Unit { const char* a; const char* b; char* o; int kind, pm, pn, e; };

__device__ __forceinline__ int xcd_remap(int L, int nu) { const int q = nu / 8, r = nu % 8, xcd = L % 8, off = L / 8; return (xcd < r ? xcd * (q + 1) : r * (q + 1) + (xcd - r) * q) + off; }

template <class Epi, class Sched, bool GATHER, bool FP8 = false>
__device__ __forceinline__ void gemm_phase(LAS unsigned char* lds, const int K, const Sched& S, const Epi& E) {
    const int tid = tid_(), wid = __builtin_amdgcn_readfirstlane(tid >> 6), lane = tid & 63, wr = wid >> 2, wc = wid & 3, fr = lane & 15, fq = lane >> 4;
    const int nt = K / BK;
    { u32x4 vo4;
      { int R, C; stage_rc(tid * 16, R, C); const int Rb = Epi::PERM ? ((R & ~31) + perm32(R & 31)) : R; vo4.x = (unsigned)(R * K + C) * 2u; vo4.z = (unsigned)(Rb * K + C) * 2u; }
      { int R, C; stage_rc(tid * 16 + 8192, R, C); const int Rb = Epi::PERM ? ((R & ~31) + perm32(R & 31)) : R; vo4.y = (unsigned)(R * K + C) * 2u; vo4.w = (unsigned)(Rb * K + C) * 2u; }
      *(LAS u32x4*)(lds + STAGE_BYTES + 4096 + tid * 16) = vo4; asm volatile("s_waitcnt lgkmcnt(0)" ::: "memory"); }
    const size_t kstep = (size_t)(BK * 2);
    const size_t hstep = (size_t)HALF * K * 2;
    const unsigned ldsw = (unsigned)wid * 1024u;
    const int aoff = lds_byte(wr * 64 + fr, fq * 8), boff = lds_byte(wc * 32 + fr, fq * 8);
#define G8_SA(b, h) (((b) * 2 + (h)) * HTB)
#define G8_SB(b, h) ((4 + (b) * 2 + (h)) * HTB)
#define G8_ST2(bufoff, gbase, isb) do { const u32x2 _v2 = *(const LAS u32x2*)(lds + STAGE_BYTES + 4096 + tid_() * 16 + (isb) * 8); _Pragma("unroll") for (int _i = 0; _i < 2; ++_i) { unsigned _vo = _i ? _v2.y : _v2.x; asm volatile("" : "+v"(_vo)); \
        __builtin_amdgcn_global_load_lds((const unsigned*)((const char*)(gbase) + _vo), (LAS unsigned*)(lds + (bufoff) + ldsw + _i * 8192), 16, 0, 0); } } while (0)
#define G8_STA_CUR(bufoff, gbase, h) do { if constexpr (GATHER) { const int _t = tid_(); _Pragma("unroll") for (int _i = 0; _i < 2; ++_i) { int _R, _C; stage_rc(_t * 16 + _i * 8192, _R, _C); unsigned _o = ROFF[parA * 256 + (h) * 128 + _R] + (unsigned)(_C * 2); asm volatile("" : "+v"(_o)); \
        __builtin_amdgcn_global_load_lds((const unsigned*)((const char*)(gbase) + _o), (LAS unsigned*)(lds + (bufoff) + ldsw + _i * 8192), 16, 0, 0); } } else { G8_ST2(bufoff, (gbase) + (h) * hstep, 0); } } while (0)
#define G8_LDA(dst, dst8, b, h) do { _Pragma("unroll") for (int m = 0; m < 4; ++m) { if constexpr (FP8) { const i32x4 lo_ = *(const LAS i32x4*)(lds + G8_SA(b, h) + aoff + m * 2048), hi_ = *(const LAS i32x4*)(lds + G8_SA(b, h) + aoff + m * 2048 + 1024); dst8[m] = __builtin_shufflevector(lo_, hi_, 0, 1, 2, 3, 4, 5, 6, 7); } \
        else { _Pragma("unroll") for (int k = 0; k < 2; ++k) dst[m][k] = *(const LAS bf16x8*)(lds + G8_SA(b, h) + aoff + m * 2048 + k * 1024); } } } while (0)
#define G8_LDB(dst, dst8, b, h) do { _Pragma("unroll") for (int n = 0; n < 2; ++n) { if constexpr (FP8) { const i32x4 lo_ = *(const LAS i32x4*)(lds + G8_SB(b, h) + boff + n * 2048), hi_ = *(const LAS i32x4*)(lds + G8_SB(b, h) + boff + n * 2048 + 1024); dst8[n] = __builtin_shufflevector(lo_, hi_, 0, 1, 2, 3, 4, 5, 6, 7); } \
        else { _Pragma("unroll") for (int k = 0; k < 2; ++k) dst[n][k] = *(const LAS bf16x8*)(lds + G8_SB(b, h) + boff + n * 2048 + k * 1024); } } } while (0)
#define G8_MMA(ai, bj, At, At8, Bt, Bt8) do { __builtin_amdgcn_s_setprio(1); _Pragma("unroll") for (int m = 0; m < 4; ++m) _Pragma("unroll") for (int n = 0; n < 2; ++n) { \
        if constexpr (FP8) acc[ai][bj][m][n] = __builtin_amdgcn_mfma_scale_f32_16x16x128_f8f6f4(Bt8[n], At8[m], acc[ai][bj][m][n], 0, 0, 0, 0, 0, 0);     \
        else { _Pragma("unroll") for (int k = 0; k < 2; ++k) acc[ai][bj][m][n] = __builtin_amdgcn_mfma_f32_16x16x32_bf16(Bt[n][k], At[m][k], acc[ai][bj][m][n], 0, 0, 0); } } __builtin_amdgcn_s_setprio(0); } while (0)
#define G8_WAIT_V(n) asm volatile("s_waitcnt vmcnt(" #n ")" ::: "memory")
#define G8_WAIT_L(n) asm volatile("s_waitcnt lgkmcnt(" #n ")" ::: "memory")
#define G8_BAR __builtin_amdgcn_s_barrier()
#define G8_SCHED __builtin_amdgcn_sched_barrier(0)
    Unit cur, nxt; int ui = 0;
    if (!S.next(0, cur)) return;
    f32x4 acc[2][2][4][2];
#pragma unroll
    for (int a = 0; a < 2; ++a)
#pragma unroll
        for (int b = 0; b < 2; ++b)
#pragma unroll
            for (int m = 0; m < 4; ++m)
#pragma unroll
                for (int n = 0; n < 2; ++n) acc[a][b][m][n] = (f32x4){0.f, 0.f, 0.f, 0.f};
    bf16x8 At[4][2], B0[2][2], B1[2][2]; i32x8 At8[4], B08[2], B18[2];
    LAS unsigned* ROFF = (LAS unsigned*)(lds + STAGE_BYTES + 1024);
    LAS unsigned* SIDE = (LAS unsigned*)(lds + STAGE_BYTES + 12288);
    unsigned sv0 = 0u, sv1 = 0u, sv2 = 0u;
    unsigned pend = 0u; int parA = 0;
    if constexpr (GATHER) {
        if (tid < 256) ROFF[tid] = (unsigned)S.row(cur, tid) * (unsigned)(K * 2);
        asm volatile("s_waitcnt lgkmcnt(0)" ::: "memory"); __builtin_amdgcn_s_barrier(); asm volatile("" ::: "memory");
    }
    const char* cA = cur.a; const char* cB = cur.b;
    G8_ST2(G8_SB(0, 0), cB, 1); G8_ST2(G8_SB(0, 1), cB + hstep, 1); G8_STA_CUR(G8_SA(0, 0), cA, 0); G8_STA_CUR(G8_SA(0, 1), cA, 1);
    if (wr == 1) G8_BAR;
    G8_WAIT_V(2); G8_BAR;
    G8_ST2(G8_SB(1, 0), cB + kstep, 1); G8_STA_CUR(G8_SA(1, 0), cA + kstep, 0); G8_ST2(G8_SB(1, 1), cB + hstep + kstep, 1);
    G8_WAIT_V(6); G8_BAR;
    for (;;) {
        const bool has_next = S.next(ui + 1, nxt);
        const char* nA = has_next ? nxt.a : cA; const char* nB = has_next ? nxt.b : cB;
#pragma clang loop unroll(disable)
        for (int t = 0; t < nt; t += 2) {
            const bool last = (t == nt - 2);
            int to = t; asm volatile("" : "+s"(to));
            const char* a1 = cA + (size_t)(to + 1) * kstep;
            const char* a2 = last ? nA : cA + (size_t)(to + 2) * kstep; const char* b2 = last ? nB : cB + (size_t)(to + 2) * kstep;
            const char* a3 = a2 + kstep; const char* b3 = b2 + kstep;
            { const int ts_ = tid_(); if (ts_ < 256) { if (t == 0) E.side0(cur, ts_, sv0, sv1, sv2); else if (t == 2) E.side1(cur, ts_, sv0, sv1, sv2);
                  else if (t == 4) { LAS unsigned* sd_ = SIDE + (ui & 1) * 768; sd_[ts_] = sv0; sd_[256 + ts_] = sv1; sd_[512 + ts_] = sv2; } } }
            if constexpr (GATHER) {
                const int t_ = tid_();
                if (has_next && t == nt - 4 && t_ < 256) pend = (unsigned)S.row(nxt, t_) * (unsigned)(K * 2);
                if (has_next && last && t_ < 256) ROFF[(parA ^ 1) * 256 + t_] = pend; }
            G8_LDB(B0, B08, 0, 0); G8_LDB(B1, B18, 0, 1); G8_SCHED; G8_LDA(At, At8, 0, 0); G8_STA_CUR(G8_SA(1, 1), a1, 1);
            if constexpr (GATHER) { if (has_next && last) parA ^= 1; }
            G8_WAIT_V(8); G8_WAIT_L(0); G8_BAR; G8_MMA(0, 0, At, At8, B0, B08); G8_MMA(0, 1, At, At8, B1, B18); G8_BAR; G8_SCHED;
            G8_LDA(At, At8, 0, 1); G8_ST2(G8_SB(0, 0), b2, 1); G8_ST2(G8_SB(0, 1), b2 + hstep, 1); G8_STA_CUR(G8_SA(0, 0), a2, 0);
            G8_WAIT_V(8); G8_WAIT_L(0); G8_BAR; G8_MMA(1, 0, At, At8, B0, B08); G8_MMA(1, 1, At, At8, B1, B18); G8_BAR; G8_SCHED;
            G8_LDB(B0, B08, 1, 0); G8_LDB(B1, B18, 1, 1); G8_SCHED; G8_LDA(At, At8, 1, 0); G8_STA_CUR(G8_SA(0, 1), a2, 1);
            G8_WAIT_V(8); G8_WAIT_L(0); G8_BAR; G8_MMA(0, 0, At, At8, B0, B08); G8_MMA(0, 1, At, At8, B1, B18); G8_BAR; G8_SCHED;
            G8_LDA(At, At8, 1, 1); G8_ST2(G8_SB(1, 0), b3, 1); G8_ST2(G8_SB(1, 1), b3 + hstep, 1); G8_STA_CUR(G8_SA(1, 0), a3, 0);
            G8_WAIT_V(8); G8_WAIT_L(0); G8_BAR; G8_MMA(1, 0, At, At8, B0, B08); G8_MMA(1, 1, At, At8, B1, B18); G8_BAR; G8_SCHED;
        }
        if (wr == 0) G8_BAR;
        E(acc, cur, wr, wc, fr, fq, (const LAS unsigned*)(SIDE + (ui & 1) * 768));
        if (!has_next) break;
#pragma unroll
        for (int a = 0; a < 2; ++a)
#pragma unroll
            for (int b = 0; b < 2; ++b)
#pragma unroll
                for (int m = 0; m < 4; ++m)
#pragma unroll
                    for (int n = 0; n < 2; ++n) acc[a][b][m][n] = (f32x4){0.f, 0.f, 0.f, 0.f};
        cur = nxt; cA = nA; cB = nB; ++ui;
        if (wr == 1) G8_BAR;
    }
    G8_WAIT_V(0);
    G8_BAR;
#undef G8_SA
#undef G8_SB
#undef G8_ST2
#undef G8_STA_CUR
#undef G8_LDA
#undef G8_LDB
#undef G8_MMA
#undef G8_WAIT_V
#undef G8_WAIT_L
#undef G8_BAR
#undef G8_SCHED
}
}

struct Params {
    const float *x, *c, *ctx, *c_ctx, *w_mod, *b_mod, *norm1_g, *norm2_g, *w_in, *b_in, *conv_a_w, *conv_a_b, *w_rg_r, *b_rg_r, *w_rg_i, *b_rg_i, *rg_lambda,
        *w_pool, *b_pool, *pool_scale, *w_four, *b_four, *conv_d_w, *conv_d_b, *ln_d_g, *ln_d_b, *w_pw, *b_pw, *w_out, *b_out, *w_router, *b_router,
        *w_gu, *b_gu, *w_down, *b_down, *final_norm_g;
    float* out; unsigned char* ws; int ph_lo, ph_hi;
};
typedef const Params __attribute__((address_space(4)))* CP;
__device__ __forceinline__ CP launder_params() { CP k = (CP)__builtin_amdgcn_kernarg_segment_ptr(); asm volatile("" : "+s"(k)); return k; }
__device__ __forceinline__ int row_mb(int row) { return row < TL ? (row >> 12) : 8; }

template <class RowMap>
__device__ __forceinline__ void tr_block(const float* __restrict__ src, int spitch, int k0, int n0, bf16_t* __restrict__ dst, int dpitch, int kd0, RowMap rm, LAS unsigned char* lds) {
    LAS unsigned* T = (LAS unsigned*)lds;
    const int tid = tid_();
    __syncthreads();
#pragma unroll
    for (int it = 0; it < 4; ++it) { const int task = it * 512 + tid, q = task & 63, kp = task >> 6;
        const f32x4 v0 = *(const f32x4*)(src + (size_t)(k0 + 2 * kp) * spitch + n0 + 4 * q), v1 = *(const f32x4*)(src + (size_t)(k0 + 2 * kp + 1) * spitch + n0 + 4 * q);
        u32x4 w; w.x = cvt_pk_bf16(v0[0], v1[0]); w.y = cvt_pk_bf16(v0[1], v1[1]); w.z = cvt_pk_bf16(v0[2], v1[2]); w.w = cvt_pk_bf16(v0[3], v1[3]);
        *(LAS u32x4*)(T + kp * 260 + 4 * q) = w; }
    __syncthreads();
#pragma unroll
    for (int it = 0; it < 4; ++it) { const int n = tid & 255, c = (tid >> 8) * 4 + it;
        u32x4 w; w.x = T[(4 * c + 0) * 260 + n]; w.y = T[(4 * c + 1) * 260 + n]; w.z = T[(4 * c + 2) * 260 + n]; w.w = T[(4 * c + 3) * 260 + n];
        *(u32x4*)(dst + (size_t)rm(n0 + n) * dpitch + kd0 + 8 * c) = w; }
}
template <class RowMap>
__device__ __forceinline__ void tr_block8(const float* __restrict__ src, int spitch, int k0, int n0, unsigned char* __restrict__ dst, int dpitch, int kd0, RowMap rm, LAS unsigned char* lds) {
    LAS unsigned* T = (LAS unsigned*)lds;
    const int tid = tid_();
    __syncthreads();
#pragma unroll
    for (int it = 0; it < 4; ++it) { const int task = it * 512 + tid, q = task & 63, kq = task >> 6; f32x4 v[4];
#pragma unroll
        for (int r = 0; r < 4; ++r) v[r] = *(const f32x4*)(src + (size_t)(k0 + 4 * kq + r) * spitch + n0 + 4 * q) * 64.0f;
        u32x4 w; w.x = pk4_fp8(v[0][0], v[1][0], v[2][0], v[3][0]); w.y = pk4_fp8(v[0][1], v[1][1], v[2][1], v[3][1]); w.z = pk4_fp8(v[0][2], v[1][2], v[2][2], v[3][2]); w.w = pk4_fp8(v[0][3], v[1][3], v[2][3], v[3][3]);
        *(LAS u32x4*)(T + kq * 260 + 4 * q) = w; }
    __syncthreads();
#pragma unroll
    for (int it = 0; it < 4; ++it) { const int n = tid & 255, c = (tid >> 8) * 4 + it;
        u32x4 w; w.x = T[(4 * c + 0) * 260 + n]; w.y = T[(4 * c + 1) * 260 + n]; w.z = T[(4 * c + 2) * 260 + n]; w.w = T[(4 * c + 3) * 260 + n];
        *(u32x4*)(dst + (size_t)rm(n0 + n) * dpitch + kd0 + 16 * c) = w; }
}
struct RmId { int off; __device__ __forceinline__ int operator()(int n) const { return n + off; } };
struct RmGu { __device__ __forceinline__ int operator()(int n) const { const int rem = n & 1023; return 256 * (rem >> 7) + 128 * (n >> 10) + (rem & 127); } };
struct RmIn { __device__ __forceinline__ int operator()(int n) const { return n < 512 ? n : n - 1024 + 768; } };

__device__ __forceinline__ void job_mod(CP p, int l, int cb, LAS unsigned char* lds) {
    LAS float* SC = (LAS float*)lds;
    LAS float* RED = (LAS float*)(lds + 49152);
    const int tid = tid_();
    __syncthreads();
    for (int i = tid; i < 9 * 1024; i += 512) { const int b = i >> 10, k = i & 1023; const float v = b < 8 ? p->c[b * 1024 + k] : p->c_ctx[k]; SC[k * 12 + b] = v * sigmoidf_(v); }
    __syncthreads();
    const int col = cb * 64 + (tid & 63), kg = tid >> 6;
    float acc[9];
#pragma unroll
    for (int b = 0; b < 9; ++b) acc[b] = 0.f;
    const float* wp = p->w_mod + (size_t)l * 1024 * 6144 + col;
#pragma unroll 8
    for (int kk = 0; kk < 128; ++kk) { const int k = kg * 128 + kk; const float w = wp[(size_t)k * 6144];
        const f32x4 s0 = *(const LAS f32x4*)(SC + k * 12), s1 = *(const LAS f32x4*)(SC + k * 12 + 4); const float s8 = SC[k * 12 + 8];
        acc[0] += s0[0] * w; acc[1] += s0[1] * w; acc[2] += s0[2] * w; acc[3] += s0[3] * w; acc[4] += s1[0] * w; acc[5] += s1[1] * w; acc[6] += s1[2] * w; acc[7] += s1[3] * w; acc[8] += s8 * w; }
#pragma unroll
    for (int b = 0; b < 9; ++b) RED[(kg * 9 + b) * 64 + (tid & 63)] = acc[b];
    __syncthreads();
    for (int i = tid; i < 9 * 64; i += 512) { const int b = i >> 6, cc = i & 63; float s = 0.f;
#pragma unroll
        for (int g = 0; g < 8; ++g) s += RED[(g * 9 + b) * 64 + cc];
        ((float*)(p->ws + WS_MODV))[(size_t)(l * 9 + b) * 6144 + cb * 64 + cc] = s + p->b_mod[l * 6144 + cb * 64 + cc]; }
}
__device__ __forceinline__ void job_fold_out(CP p, int l, int nb, LAS unsigned char* lds) {
    LAS float* WO = (LAS float*)lds;
    LAS float* PW = (LAS float*)(lds + 65536);
    const int tid = tid_(), lane = tid & 63, w = __builtin_amdgcn_readfirstlane(tid >> 6);
    __syncthreads();
#pragma unroll
    for (int it = 0; it < 8; ++it) { const int task = it * 512 + tid, j = task >> 4, q = task & 15;
        *(LAS f32x4*)(WO + j * 64 + 4 * q) = *(const f32x4*)(p->w_out + ((size_t)l * 1024 + 768 + j) * 1024 + nb * 64 + 4 * q); }
    float acc[32];
#pragma unroll
    for (int i = 0; i < 32; ++i) acc[i] = 0.f;
    for (int jc = 0; jc < 4; ++jc) {
        __syncthreads();
#pragma unroll
        for (int it = 0; it < 8; ++it) { const int task = it * 512 + tid, i = task & 255, jq = task >> 8;
            const f32x4 v = *(const f32x4*)(p->w_pw + ((size_t)l * 256 + i) * 256 + jc * 64 + 4 * jq);
            PW[(4 * jq + 0) * 256 + i] = v[0]; PW[(4 * jq + 1) * 256 + i] = v[1]; PW[(4 * jq + 2) * 256 + i] = v[2]; PW[(4 * jq + 3) * 256 + i] = v[3]; }
        __syncthreads();
        for (int jj = 0; jj < 64; ++jj) { const float b = WO[(jc * 64 + jj) * 64 + lane];
#pragma unroll
            for (int i4 = 0; i4 < 8; ++i4) { const f32x4 a = *(const LAS f32x4*)(PW + jj * 256 + 32 * w + 4 * i4);
                acc[4 * i4 + 0] += a[0] * b; acc[4 * i4 + 1] += a[1] * b; acc[4 * i4 + 2] += a[2] * b; acc[4 * i4 + 3] += a[3] * b; } }
    }
    bf16_t* dst = (bf16_t*)(p->ws + WS_WOUTT) + ((size_t)l * 1024 + nb * 64 + lane) * 1024 + 768 + 32 * w;
#pragma unroll
    for (int c = 0; c < 4; ++c) { float f[8];
#pragma unroll
        for (int e = 0; e < 8; ++e) f[e] = acc[8 * c + e];
        *(u32x4*)(dst + 8 * c) = pack8(f); }
    if (w == 0) { float s = p->b_out[l * 1024 + nb * 64 + lane];
        for (int j = 0; j < 256; ++j) s += p->b_pw[l * 256 + j] * WO[j * 64 + lane];
        ((float*)(p->ws + WS_BOUT))[l * 1024 + nb * 64 + lane] = s; }
}
__device__ __forceinline__ void job_fold_in(CP p, int l, int f, int g, int kb, LAS unsigned char* lds) {
    LAS float* M = (LAS float*)lds;
    LAS float* WI = (LAS float*)(lds + 16384);
    const int tid = tid_();
    const int cbase = f == 0 ? 512 : 768;
    LAS float* TRG = (LAS float*)(lds + 16384 + 256 * 65 * 4);
    __syncthreads();
    if (tid < 64) TRG[tid] = f == 2 ? sinpif((float)tid * (1.0f / 32.0f)) : cospif((float)tid * (1.0f / 32.0f));
    __syncthreads();
#pragma unroll
    for (int it = 0; it < 8; ++it) { const int id = it * 512 + tid, i = id >> 6, j = id & 63; float s;
        if (f == 0) s = p->w_pool[(((size_t)l * 4 + g) * 64 + i) * 64 + j];
        else { s = 0.f; for (int m = 0; m < 64; ++m) s += TRG[(i * m) & 63] * p->w_four[(((size_t)l * 4 + g) * 64 + m) * 64 + j]; }
        M[i * 64 + j] = s; }
#pragma unroll
    for (int it = 0; it < 8; ++it) { const int task = it * 512 + tid, kk = task >> 4, i4 = task & 15;
        const f32x4 v = *(const f32x4*)(p->w_in + ((size_t)l * 1024 + kb * 256 + kk) * 1536 + cbase + 64 * g + 4 * i4);
        WI[kk * 65 + 4 * i4 + 0] = v[0]; WI[kk * 65 + 4 * i4 + 1] = v[1]; WI[kk * 65 + 4 * i4 + 2] = v[2]; WI[kk * 65 + 4 * i4 + 3] = v[3]; }
    __syncthreads();
    const int kk = tid & 255, jh = tid >> 8;
    float acc[32];
#pragma unroll
    for (int j = 0; j < 32; ++j) acc[j] = 0.f;
    for (int i = 0; i < 64; ++i) { const float a = WI[kk * 65 + i];
#pragma unroll
        for (int j4 = 0; j4 < 8; ++j4) { const f32x4 m = *(const LAS f32x4*)(M + i * 64 + 32 * jh + 4 * j4);
            acc[4 * j4 + 0] += a * m[0]; acc[4 * j4 + 1] += a * m[1]; acc[4 * j4 + 2] += a * m[2]; acc[4 * j4 + 3] += a * m[3]; } }
    bf16_t* dst = f == 0 ? (bf16_t*)(p->ws + WS_WINT) + ((size_t)l * NPROJ + 512 + 64 * g) * 1024 : (bf16_t*)(p->ws + WS_WFT) + ((size_t)l * 512 + (f - 1) * 256 + 64 * g) * 1024;
#pragma unroll
    for (int j = 0; j < 32; ++j) dst[(size_t)(32 * jh + j) * 1024 + kb * 256 + kk] = f2bf(acc[j]);
    if (kb == 0 && f >= 1 && tid < 64) { float s = 0.f;
        for (int i = 0; i < 64; ++i) s += p->b_in[l * 1536 + 768 + 64 * g + i] * M[i * 64 + tid];
        ((float*)(p->ws + WS_BF))[l * 512 + (f - 1) * 256 + 64 * g + tid] = s; }
    if (kb == 0 && f == 0 && g == 0) for (int i = tid; i < NPROJ; i += 512)
        ((float*)(p->ws + WS_BIN))[l * NPROJ + i] = i < 512 ? p->b_in[l * 1536 + i] : (i < 768 ? 0.f : p->b_in[l * 1536 + i - 768 + 1024]);
}
__device__ __forceinline__ void job_small(CP p, int j) {
    const int tid = tid_();
    if (j < 32) {
        const int l = j >> 4, d = (j >> 3) & 1, gate = (j >> 2) & 1, hd = j & 3;
        const float* src = (gate ? p->w_rg_i : p->w_rg_r) + ((size_t)((l * 2 + d) * 4 + hd)) * 4096;
        bf16_t* dst = (bf16_t*)(p->ws + WS_WGT) + (size_t)j * 4096;
        for (int id = tid; id < 4096; id += 512) { const int n = id >> 6, k = id & 63; dst[id] = f2bf(src[k * 64 + n]); }
        return; }
    j -= 32;
    if (j < 2) {
        const int l = j; bf16_t* hi = (bf16_t*)(p->ws + WS_WRT) + (size_t)l * 2 * NE * 1024; bf16_t* lo = hi + NE * 1024;
        for (int id = tid; id < NE * 1024; id += 512) { const int e = id >> 10, c = id & 1023; const float v = p->w_router[((size_t)l * 1024 + c) * NE + e];
            const bf16_t h = f2bf(v); hi[id] = h; lo[id] = f2bf(v - bf2f(h)); }
        return; }
    j -= 2;
    if (j < 144 + 128) {
        const bool sn = j >= 144; const int r0 = (sn ? j - 144 : j) * 16; bf16_t* dst = (bf16_t*)(p->ws + (sn ? WS_SMAT : WS_CMAT));
        for (int id = tid; id < 16 * 4096; id += 512) { const int k = r0 + (id >> 12), t = id & 4095; const float ang = (float)((k * t) & 4095) * (1.0f / 2048.0f);
            dst[(size_t)k * 4096 + t] = f2bf(sn ? sinpif(ang) : cospif(ang)); }
        return; }
    j -= 272;
    if (j == 1) {
        float* dst = (float*)(p->ws + WS_POS);
        for (int id = tid; id < 64 * 512; id += 512) { const int pp = id >> 9, jj = id & 511, i = jj & 255; const float a = (float)pp * exp2f(-(float)i * (13.287712379549449f / 256.0f));
            dst[id] = jj < 256 ? sinf(a) : cosf(a); }
        return; }
    {
        bf16_t* dst = (bf16_t*)(p->ws + WS_DFTC);
        for (int id = tid; id < 256 * 512; id += 512) { const int k = id >> 9, jj = id & 511, t = jj & 255; const float ang = (float)((k * t) & 255) * (1.0f / 128.0f);
            dst[id] = f2bf(jj < 256 ? cospif(ang) : -sinpif(ang)); }
    }
}
#ifndef MOE_W_IN_QUEUE
#define MOE_W_IN_QUEUE 0
#endif
constexpr bool fp8_layer(int l) { return l >= FP8_FROM; }
constexpr int J_TGU_L(int l) { return fp8_layer(l) ? 32 * 8 * 8 : 32 * 16 * 8; }
constexpr int J_TD_L(int l) { return fp8_layer(l) ? 32 * 8 * 4 : 32 * 16 * 4; }
constexpr int J_MOD = 192, J_FOUT = 32, J_FIN = 96, J_SMALL = 32 + 2 + 272 + 2, J_TIN = 128, J_TOUT = 96, J_TGU = J_TGU_L(0) + J_TGU_L(1), J_TD = J_TD_L(0) + J_TD_L(1);
static_assert(!MOE_W_IN_QUEUE || (J_TGU_L(0) + J_TD_L(0) <= 6 * NCHUNK && J_TGU_L(1) + J_TD_L(1) <= 6 * NCHUNK), "the phase-3 queue interleaves at most 2 weight jobs per compute unit: needs fp8 expert weights in both layers");
constexpr int J_TOTAL = J_MOD + J_FOUT + J_FIN + J_SMALL + J_TIN + J_TOUT + (MOE_W_IN_QUEUE ? 0 : J_TGU + J_TD);
template <class RowMap>
__device__ __forceinline__ void tr8_slab(const float* __restrict__ src, int spitch, int k0, int n4, unsigned char* __restrict__ dst, int dpitch, RowMap rm) {
    f32x4 v[16];
#pragma unroll
    for (int r = 0; r < 16; ++r) v[r] = *(const f32x4*)(src + (size_t)(k0 + r) * spitch + n4) * 64.0f;
#pragma unroll
    for (int j = 0; j < 4; ++j) { u32x4 w; w.x = pk4_fp8(v[0][j], v[1][j], v[2][j], v[3][j]); w.y = pk4_fp8(v[4][j], v[5][j], v[6][j], v[7][j]); w.z = pk4_fp8(v[8][j], v[9][j], v[10][j], v[11][j]); w.w = pk4_fp8(v[12][j], v[13][j], v[14][j], v[15][j]);
        *(u32x4*)(dst + (size_t)rm(n4 + j) * dpitch + k0) = w; }
}
struct W8Job { const float* src; unsigned char* dst; int spitch, gu; };
__device__ __forceinline__ bool w8_job(CP p, int jm, W8Job& J, int& n0) {
    constexpr int PER_L = 32 * 64 + 32 * 32; if (jm >= 2 * PER_L) return false;
    const int l = jm / PER_L; int jj = jm - l * PER_L;
    if (jj < 32 * 64) { const int e = jj >> 6, r = jj & 63, kb = r >> 3, q = r & 7; J.spitch = 2048; J.gu = 1; n0 = q * 256;
        J.src = p->w_gu + ((size_t)(l * NE + e) * 1024 + kb * 128) * 2048 + n0; J.dst = p->ws + WS_WGUT + (size_t)l * NE * 2048 * 2048 + (size_t)e * 2048 * 1024 + kb * 128; }
    else { jj -= 32 * 64; const int e = jj >> 5, r = jj & 31, kb = r >> 2, q = r & 3; J.spitch = 1024; J.gu = 0; n0 = q * 256;
        J.src = p->w_down + ((size_t)(l * NE + e) * 1024 + kb * 128) * 1024 + n0; J.dst = p->ws + WS_WDT + (size_t)l * NE * 1024 * 2048 + (size_t)e * 1024 * 1024 + kb * 128; }
    return true;
}
__device__ __forceinline__ void w8_load(const W8Job& J, int tid, f32x4 (&v)[4][4]) {
#pragma unroll
    for (int it = 0; it < 4; ++it) { const int task = it * 512 + tid, q = task & 63, kq = task >> 6;
#pragma unroll
        for (int r = 0; r < 4; ++r) v[it][r] = *(const f32x4*)(J.src + (size_t)(4 * kq + r) * J.spitch + 4 * q); }
}
__device__ __forceinline__ void w8_finish(const W8Job& J, int n0, int tid, const f32x4 (&v)[4][4], LAS unsigned char* lds) {
    LAS unsigned* T = (LAS unsigned*)lds;
    __syncthreads();
#pragma unroll
    for (int it = 0; it < 4; ++it) { const int task = it * 512 + tid, q = task & 63, kq = task >> 6;
        u32x4 w; w.x = pk4_fp8(v[it][0][0] * 64.f, v[it][1][0] * 64.f, v[it][2][0] * 64.f, v[it][3][0] * 64.f); w.y = pk4_fp8(v[it][0][1] * 64.f, v[it][1][1] * 64.f, v[it][2][1] * 64.f, v[it][3][1] * 64.f);
        w.z = pk4_fp8(v[it][0][2] * 64.f, v[it][1][2] * 64.f, v[it][2][2] * 64.f, v[it][3][2] * 64.f); w.w = pk4_fp8(v[it][0][3] * 64.f, v[it][1][3] * 64.f, v[it][2][3] * 64.f, v[it][3][3] * 64.f);
        *(LAS u32x4*)(T + kq * 260 + 4 * q) = w; }
    __syncthreads();
    if (tid < 256) {
        const int n = tid, nn = n0 + n; const int row = J.gu ? RmGu{}(nn) : nn; u32x4 w[8];
#pragma unroll
        for (int c = 0; c < 8; ++c) { w[c].x = T[(4 * c + 0) * 260 + n]; w[c].y = T[(4 * c + 1) * 260 + n]; w[c].z = T[(4 * c + 2) * 260 + n]; w[c].w = T[(4 * c + 3) * 260 + n]; }
#pragma unroll
        for (int c = 0; c < 8; ++c) *(u32x4*)(J.dst + (size_t)row * 1024 + 16 * c) = w[c]; }
}
__device__ __forceinline__ void moe_weight_job(CP p, int l, int jj, LAS unsigned char* lds) {
    const bool f8 = l >= FP8_FROM;
    if (jj < (f8 ? 32 * 8 * 8 : 32 * 16 * 8)) { const float* src = p->w_gu + (size_t)l * NE * 1024 * 2048; unsigned char* dstb = p->ws + WS_WGUT + (size_t)l * NE * 2048 * 2048;
        if (f8) { const int e = jj >> 6, r = jj & 63, kb = r >> 3, q = r & 7; tr_block8(src + (size_t)e * 1024 * 2048, 2048, kb * 128, q * 256, dstb + (size_t)e * 2048 * 1024, 1024, kb * 128, RmGu{}, lds); }
        else { const int e = jj >> 7, r = jj & 127, kb = r >> 3, q = r & 7; tr_block(src + (size_t)e * 1024 * 2048, 2048, kb * 64, q * 256, (bf16_t*)dstb + (size_t)e * 2048 * 1024, 1024, kb * 64, RmGu{}, lds); }
        return; }
    jj -= (f8 ? 32 * 8 * 8 : 32 * 16 * 8);
    { const float* src = p->w_down + (size_t)l * NE * 1024 * 1024; unsigned char* dstb = p->ws + WS_WDT + (size_t)l * NE * 1024 * 2048;
        if (f8) { const int e = jj >> 5, r = jj & 31, kb = r >> 2, q = r & 3; tr_block8(src + (size_t)e * 1024 * 1024, 1024, kb * 128, q * 256, dstb + (size_t)e * 1024 * 1024, 1024, kb * 128, RmId{0}, lds); }
        else { const int e = jj >> 6, r = jj & 63, kb = r >> 2, q = r & 3; tr_block(src + (size_t)e * 1024 * 1024, 1024, kb * 64, q * 256, (bf16_t*)dstb + (size_t)e * 1024 * 1024, 1024, kb * 64, RmId{0}, lds); } }
}
constexpr bool W8_PIPE = (FP8_FROM == 0) && !MOE_W_IN_QUEUE;
__device__ __forceinline__ void phase_prologue(CP p, LAS unsigned char* lds, int rep) {
    if (W8_PIPE) { const int tid = tid_(); W8Job Jc, Jn; int nc = 0, nn_ = 0; f32x4 va[4][4], vb[4][4];
        int jm = blockIdx.x; bool okc = w8_job(p, jm, Jc, nc); if (okc) w8_load(Jc, tid, va);
        while (okc) {
            bool okn = w8_job(p, jm + (int)gridDim.x, Jn, nn_); if (okn) w8_load(Jn, tid, vb);
            w8_finish(Jc, nc, tid, va, lds);
            if (!okn) break;
            jm += 2 * (int)gridDim.x; okc = w8_job(p, jm, Jc, nc); if (okc) w8_load(Jc, tid, va);
            w8_finish(Jn, nn_, tid, vb, lds); } }
    unsigned* qhead = (unsigned*)(p->ws + WS_CTL) + CW_QUEUE + (4 + rep) * 64; LAS int* qslot = (LAS int*)(lds - LDS_BASE + 64);
    const int njobs = J_TOTAL - (W8_PIPE ? J_TGU + J_TD : 0);
    for (;;) { __syncthreads(); if (tid_() == 0) *qslot = (int)__hip_atomic_fetch_add(qhead, 1u, __ATOMIC_RELAXED, __HIP_MEMORY_SCOPE_AGENT); __syncthreads();
        int j = __builtin_amdgcn_readfirstlane(*qslot); if (j >= njobs) break;
        if (j < J_FIN) { const int l = j / 48, r = j % 48; job_fold_in(p, l, r / 16, (r >> 2) & 3, r & 3, lds); continue; } j -= J_FIN;
        if (j < J_FOUT) { job_fold_out(p, j >> 4, j & 15, lds); continue; } j -= J_FOUT;
        if (j < J_MOD) { job_mod(p, j / 96, j % 96, lds); continue; } j -= J_MOD;
        if (j < J_SMALL) { job_small(p, j); continue; } j -= J_SMALL;
        if (j < J_TIN) { const int l = j >> 6, r = j & 63, kb = r >> 2, q = r & 3;
            tr_block(p->w_in + (size_t)l * 1024 * 1536, 1536, kb * 64, q < 2 ? q * 256 : 1024 + (q - 2) * 256, (bf16_t*)(p->ws + WS_WINT) + (size_t)l * NPROJ * 1024, 1024, kb * 64, RmIn{}, lds); continue; } j -= J_TIN;
        if (j < J_TOUT) { const int l = j / 48, r = j % 48, kb = r >> 2, q = r & 3;
            tr_block(p->w_out + (size_t)l * 1024 * 1024, 1024, kb * 64, q * 256, (bf16_t*)(p->ws + WS_WOUTT) + (size_t)l * 1024 * 1024, 1024, kb * 64, RmId{0}, lds); continue; } j -= J_TOUT;
        moe_weight_job(p, j < J_TGU_L(0) + J_TD_L(0) ? 0 : 1, j < J_TGU_L(0) + J_TD_L(0) ? j : j - J_TGU_L(0) - J_TD_L(0), lds);
    }
}

__device__ __forceinline__ void phase_norm(CP p, int mode) {
    const int tid = tid_(), lane = tid & 63, wid = tid >> 6;
    float* X = (float*)(p->ws + WS_X); bf16_t* U = (bf16_t*)(p->ws + WS_U); const bf16_t* YS = (const bf16_t*)(p->ws + WS_YS); const float* modv = (const float*)(p->ws + WS_MODV);
    const float* POS = (const float*)(p->ws + WS_POS);
    const int nrows = mode == 2 ? TL : TT;
    const int lprev = mode == 2 ? 1 : 0, lcur = mode == 0 ? 0 : 1;
    const int nw = (int)gridDim.x * 8;
    for (int rowa = blockIdx.x * 8 + wid; rowa < nrows; rowa += 2 * nw) {
        int rows[2]; bool ok[2]; f32x4 v[2][4];
#pragma unroll
        for (int rb = 0; rb < 2; ++rb) { const int r = rowa + rb * nw; ok[rb] = r < nrows; rows[rb] = ok[rb] ? r : rowa; }
        if (mode == 0) {
#pragma unroll
            for (int rb = 0; rb < 2; ++rb) { const int row = rows[rb]; const float* src = row < TL ? p->x + (size_t)row * D : p->ctx + (size_t)(row - TL) * D;
#pragma unroll
                for (int j = 0; j < 4; ++j) v[rb][j] = *(const f32x4*)(src + 256 * j + 4 * lane); }
#pragma unroll
            for (int rb = 0; rb < 2; ++rb) { const int row = rows[rb]; if (row < TL) { const int t = row & 4095;
#pragma unroll
                    for (int j = 0; j < 4; ++j) v[rb][j] += *(const f32x4*)(POS + (size_t)(j < 2 ? (t >> 6) : (t & 63)) * 512 + (j & 1) * 256 + 4 * lane); } }
        } else {
            u32x2 ys[2][4][4];
#pragma unroll
            for (int rb = 0; rb < 2; ++rb) { const int row = rows[rb];
#pragma unroll
                for (int j = 0; j < 4; ++j) { v[rb][j] = *(const f32x4*)(X + (size_t)row * D + 256 * j + 4 * lane);
#pragma unroll
                    for (int k = 0; k < 4; ++k) ys[rb][j][k] = *(const u32x2*)(YS + ((size_t)row * 4 + k) * D + 256 * j + 4 * lane); } }
#pragma unroll
            for (int rb = 0; rb < 2; ++rb) { const float* g2 = modv + (size_t)(lprev * 9 + row_mb(rows[rb])) * 6144 + 5120;
#pragma unroll
                for (int j = 0; j < 4; ++j) { f32x4 s = {0.f, 0.f, 0.f, 0.f};
#pragma unroll
                    for (int k = 0; k < 4; ++k) { const u32x2 w = ys[rb][j][k]; s[0] += bflo(w.x); s[1] += bfhi(w.x); s[2] += bflo(w.y); s[3] += bfhi(w.y); }
                    v[rb][j] += *(const f32x4*)(g2 + 256 * j + 4 * lane) * s; } }
        }
        float ss[2];
#pragma unroll
        for (int rb = 0; rb < 2; ++rb) { ss[rb] = 0.f;
#pragma unroll
            for (int j = 0; j < 4; ++j) ss[rb] += v[rb][j][0] * v[rb][j][0] + v[rb][j][1] * v[rb][j][1] + v[rb][j][2] * v[rb][j][2] + v[rb][j][3] * v[rb][j][3]; }
#pragma unroll
        for (int o = 32; o >= 1; o >>= 1) { const float t0 = bperm(ss[0], lane ^ o), t1 = bperm(ss[1], lane ^ o); ss[0] += t0; ss[1] += t1; }
#pragma unroll
        for (int rb = 0; rb < 2; ++rb) { if (!ok[rb]) continue; const int row = rows[rb]; const float rstd = __builtin_amdgcn_rsqf(ss[rb] * (1.0f / 1024.0f) + 1e-6f);
            if (mode == 2) {
#pragma unroll
                for (int j = 0; j < 4; ++j) *(f32x4*)(p->out + (size_t)row * D + 256 * j + 4 * lane) = v[rb][j] * rstd * *(const f32x4*)(p->final_norm_g + 256 * j + 4 * lane);
            } else { const float* mv = modv + (size_t)(lcur * 9 + row_mb(row)) * 6144;
#pragma unroll
                for (int j = 0; j < 4; ++j) { const int col = 256 * j + 4 * lane;
                    *(f32x4*)(X + (size_t)row * D + col) = v[rb][j];
                    const f32x4 g = *(const f32x4*)(p->norm1_g + lcur * D + col), sc = *(const f32x4*)(mv + 1024 + col), sh = *(const f32x4*)(mv + col);
                    const f32x4 u = v[rb][j] * rstd * g * (sc + 1.0f) + sh;
                    u32x2 w; w.x = cvt_pk_bf16(u[0], u[1]); w.y = cvt_pk_bf16(u[2], u[3]); *(u32x2*)(U + (size_t)row * D + col) = w; } }
        }
    }
}

constexpr int HP = 2064;
__device__ __forceinline__ void phase_router(CP p, int l, LAS unsigned char* lds, int rep) {
    LAS unsigned char* HHI = lds; LAS unsigned char* HLO = lds + 32 * HP;
    LAS float* LG = (LAS float*)(lds + 64 * HP);
    LAS int* hist = (LAS int*)(lds + 64 * HP + 8448); LAS int* basee = hist + 32;
    const int tid = tid_(), lane = tid & 63, wid = __builtin_amdgcn_readfirstlane(tid >> 6), fr = lane & 15, fq = lane >> 4;
    const float* X = (const float*)(p->ws + WS_X); bf16_t* U = (bf16_t*)(p->ws + (rep ? WS_ACT : WS_U)); const float* modv = (const float*)(p->ws + WS_MODV);
    unsigned char* U8 = p->ws + (rep ? WS_ACT : WS_U8);
    unsigned* ctl = (unsigned*)(p->ws + WS_CTL) + (rep ? 4096 : 0); int* rasg = (int*)(p->ws + (rep ? WS_YS : WS_RASG)); float* gate = (float*)(p->ws + (rep ? WS_YS + (size_t)NE * TT * 4 : WS_GATE));
    const bf16_t* wrt = (const bf16_t*)(p->ws + WS_WRT) + (size_t)l * 2 * NE * 1024;
    const int ntiles = (l == 0 ? TT : TL) / 32;
    for (int tile = blockIdx.x; tile < ntiles; tile += gridDim.x) {
        const int row0 = tile * 32, mb = row_mb(row0);
        const float* mv = modv + (size_t)(l * 9 + mb) * 6144;
        __syncthreads();
        if (tid < 32) hist[tid] = 0;
        { f32x4 v[4][4]; float ss[4];
#pragma unroll
          for (int rr = 0; rr < 4; ++rr)
#pragma unroll
              for (int j = 0; j < 4; ++j) v[rr][j] = *(const f32x4*)(X + (size_t)(row0 + wid * 4 + rr) * D + 256 * j + 4 * lane);
#pragma unroll
          for (int rr = 0; rr < 4; ++rr) { ss[rr] = 0.f;
#pragma unroll
              for (int j = 0; j < 4; ++j) ss[rr] += v[rr][j][0] * v[rr][j][0] + v[rr][j][1] * v[rr][j][1] + v[rr][j][2] * v[rr][j][2] + v[rr][j][3] * v[rr][j][3]; }
#pragma unroll
          for (int o = 32; o >= 1; o >>= 1) { float t[4];
#pragma unroll
              for (int rr = 0; rr < 4; ++rr) t[rr] = bperm(ss[rr], lane ^ o);
#pragma unroll
              for (int rr = 0; rr < 4; ++rr) ss[rr] += t[rr]; }
#pragma unroll
          for (int j = 0; j < 4; ++j) { const int col = 256 * j + 4 * lane;
              const f32x4 g = *(const f32x4*)(p->norm2_g + l * D + col), sc = *(const f32x4*)(mv + 4096 + col), sh = *(const f32x4*)(mv + 3072 + col);
#pragma unroll
              for (int rr = 0; rr < 4; ++rr) { const int r = wid * 4 + rr; const float rstd = __builtin_amdgcn_rsqf(ss[rr] * (1.0f / 1024.0f) + 1e-6f);
                  const f32x4 h = v[rr][j] * rstd * g * (sc + 1.0f) + sh;
                  u32x2 w; w.x = cvt_pk_bf16(h[0], h[1]); w.y = cvt_pk_bf16(h[2], h[3]);
                  if (fp8_layer(l)) *(unsigned*)(U8 + (size_t)(row0 + r) * D + col) = pk4_fp8(h[0], h[1], h[2], h[3]); else *(u32x2*)(U + (size_t)(row0 + r) * D + col) = w;
                  u32x2 wl; wl.x = cvt_pk_bf16(h[0] - bflo(w.x), h[1] - bfhi(w.x)); wl.y = cvt_pk_bf16(h[2] - bflo(w.y), h[3] - bfhi(w.y));
                  *(LAS u32x2*)(HHI + r * HP + col * 2) = w; *(LAS u32x2*)(HLO + r * HP + col * 2) = wl; } } }
        __syncthreads();
        { const int mt = wid & 1, ntl = (wid >> 1) & 1, kh = wid >> 2;
          f32x4 acc = {0.f, 0.f, 0.f, 0.f};
          const bf16_t* bh = wrt + (size_t)(16 * ntl + fr) * 1024 + kh * 512 + 8 * fq; const bf16_t* bl = bh + NE * 1024;
          const LAS unsigned char* ah = HHI + (16 * mt + fr) * HP + (kh * 512 + 8 * fq) * 2; const LAS unsigned char* al = HLO + (16 * mt + fr) * HP + (kh * 512 + 8 * fq) * 2;
#pragma unroll 8
          for (int s = 0; s < 16; ++s) { const bf16x8 Ah = *(const LAS bf16x8*)(ah + s * 64), Al = *(const LAS bf16x8*)(al + s * 64); const bf16x8 Bh = *(const bf16x8*)(bh + s * 32), Bl = *(const bf16x8*)(bl + s * 32);
              acc = __builtin_amdgcn_mfma_f32_16x16x32_bf16(Ah, Bh, acc, 0, 0, 0); acc = __builtin_amdgcn_mfma_f32_16x16x32_bf16(Ah, Bl, acc, 0, 0, 0); acc = __builtin_amdgcn_mfma_f32_16x16x32_bf16(Al, Bh, acc, 0, 0, 0); }
#pragma unroll
          for (int j = 0; j < 4; ++j) LG[(kh * 32 + 16 * mt + 4 * fq + j) * 33 + 16 * ntl + fr] = acc[j]; }
        __syncthreads();
        int ek[4] = {0, 0, 0, 0}, rk[4] = {0, 0, 0, 0}; float gk[4] = {0.f, 0.f, 0.f, 0.f};
        if (tid < 32) { float lg[32];
#pragma unroll
            for (int e = 0; e < 32; ++e) lg[e] = LG[tid * 33 + e] + LG[(32 + tid) * 33 + e] + p->b_router[l * NE + e];
            float vk[4];
#pragma unroll
            for (int k = 0; k < 4; ++k) { float best = -3.0e38f; int bi = 0;
#pragma unroll
                for (int e = 0; e < 32; ++e) if (lg[e] > best) { best = lg[e]; bi = e; }
                vk[k] = best; ek[k] = bi;
#pragma unroll
                for (int e = 0; e < 32; ++e) if (e == bi) lg[e] = -3.0e38f; }
            float sum = 0.f;
#pragma unroll
            for (int k = 0; k < 4; ++k) { gk[k] = fexp2(1.4426950408889634f * (vk[k] - vk[0])); sum += gk[k]; }
            const float inv = 1.0f / sum;
#pragma unroll
            for (int k = 0; k < 4; ++k) { gk[k] *= inv; rk[k] = __hip_atomic_fetch_add(hist + ek[k], 1, __ATOMIC_RELAXED, __HIP_MEMORY_SCOPE_WORKGROUP); } }
        __syncthreads();
        if (tid < 32) { const int h = hist[tid]; basee[tid] = h ? (int)__hip_atomic_fetch_add(ctl + CW_COUNT + (l * NE + tid) * 64, (unsigned)h, __ATOMIC_RELAXED, __HIP_MEMORY_SCOPE_AGENT) : 0; }
        __syncthreads();
        if (tid < 32) { const int tok = row0 + tid;
#pragma unroll
            for (int k = 0; k < 4; ++k) { rasg[(size_t)ek[k] * TT + basee[ek[k]] + rk[k]] = tok * 4 + k; gate[tok * 4 + k] = gk[k]; } }
    }
}

constexpr int XCP = 144;
constexpr int XAP = 528;
struct Seq { int b, jc, L, rowbase, t0; bool lat; };
__device__ __forceinline__ Seq seq_of(int q) { Seq s; s.lat = q < 512; s.b = s.lat ? q >> 6 : (q - 512) >> 2; s.jc = s.lat ? q & 63 : (q - 512) & 3; s.L = s.lat ? SEQ : LCX; s.rowbase = s.lat ? s.b * SEQ : TL + s.b * LCX; s.t0 = s.jc * 64; return s; }
template <int PASS>
__device__ __forceinline__ void scan_unit(CP p, int l, int q, LAS unsigned char* lds) {
    const int tid = tid_(), lane = tid & 63, wid = __builtin_amdgcn_readfirstlane(tid >> 6), d = wid >> 2, hd = wid & 3, fr = lane & 15, fq = lane >> 4;
    LAS unsigned char* XC = lds + wid * (64 * XCP);
    LAS float* CAR = (LAS float*)(lds + 8 * 64 * XCP + wid * 256);
    LAS unsigned char* HB = lds + 8 * 64 * XCP + 2048;
    LAS unsigned char* XA = HB;
    const bf16_t* PROJ = (const bf16_t*)(p->ws + WS_PROJ); float* SUMM = (float*)(p->ws + WS_SUMM);
    const Seq sq = seq_of(q); const int b = sq.b, jc = sq.jc, L = sq.L, rowbase = sq.rowbase, t0 = sq.t0; const bool lat = sq.lat;
    __syncthreads();
    { u32x4 w[5];
#pragma unroll
      for (int it = 0; it < 5; ++it) { const int task = it * 512 + tid, r = task >> 5, cg = task & 31, tt = t0 - 3 + r; w[it] = (u32x4){0u, 0u, 0u, 0u};
          if (task < 70 * 32 && tt >= 0 && tt < L) w[it] = *(const u32x4*)(PROJ + (size_t)(rowbase + tt) * NPROJ + 8 * cg); }
#pragma unroll
      for (int it = 0; it < 5; ++it) { const int task = it * 512 + tid, r = task >> 5, cg = task & 31; if (task < 70 * 32) *(LAS u32x4*)(XA + r * XAP + cg * 16) = w[it]; } }
    float car = 0.f;
    if (PASS == 2) { const int c = 64 * hd + lane;
        const int n = d == 0 ? (lat ? 4 + jc : jc) : (lat ? 4 + 63 - jc : 3 - jc);
        for (int s0 = 0; s0 < n; s0 += 16) { float A_[16], H_[16];
#pragma unroll
            for (int e = 0; e < 16; ++e) { const int s = s0 + e; int qq;
                if (d == 0) qq = (lat && s >= 4) ? b * 64 + (s - 4) : 512 + b * 4 + s; else qq = (lat && s >= 4) ? b * 64 + 63 - (s - 4) : 512 + b * 4 + 3 - s;
                A_[e] = 1.f; H_[e] = 0.f; if (s < n) { const float* sp_ = SUMM + ((size_t)qq * 2 + d) * 512; A_[e] = sp_[c]; H_[e] = sp_[256 + c]; } }
#pragma unroll
            for (int e = 0; e < 16; ++e) car = A_[e] * car + H_[e]; } }
    __syncthreads();
    { const int c = 64 * hd + lane; const float* cw = p->conv_a_w + ((size_t)(l * 2 + d) * 4) * 256 + c;
      const float w0 = cw[0], w1 = cw[256], w2 = cw[512], w3 = cw[768], cb = p->conv_a_b[(l * 2 + d) * 256 + c];
      const float k0 = d ? w3 : w0, k1 = d ? w2 : w1, k2 = d ? w1 : w2, k3 = d ? w0 : w3;
      const LAS unsigned char* xp = XA + (d ? 3 : 0) * XAP + c * 2;
      float xa_ = bf2f(*(const LAS bf16_t*)(xp)), xb_ = bf2f(*(const LAS bf16_t*)(xp + XAP)), xc_ = bf2f(*(const LAS bf16_t*)(xp + 2 * XAP));
#pragma unroll 16
      for (int t = 0; t < 64; ++t) { const float xd_ = bf2f(*(const LAS bf16_t*)(xp + (t + 3) * XAP)); const float v = k0 * xa_ + k1 * xb_ + k2 * xc_ + k3 * xd_ + cb;
          *(LAS bf16_t*)(XC + t * XCP + lane * 2) = f2bf(v); xa_ = xb_; xb_ = xc_; xc_ = xd_; } }
    if (PASS == 2) CAR[lane] = car;
    asm volatile("" ::: "memory");
    if (PASS == 2) __syncthreads();
    float cr[4], at[4], sp[4], brr[4], bii[4];
#pragma unroll
    for (int n = 0; n < 4; ++n) { const int ch = 16 * n + fr; cr[n] = PASS == 2 ? CAR[ch] : 0.f; at[n] = 1.f;
        const float lam = p->rg_lambda[(l * 2 + d) * 256 + 64 * hd + ch]; sp[n] = -8.0f * 1.4426950408889634f * log1pf(__expf(-lam));
        brr[n] = p->b_rg_r[((l * 2 + d) * 4 + hd) * 64 + ch]; bii[n] = p->b_rg_i[((l * 2 + d) * 4 + hd) * 64 + ch]; }
    const bf16_t* wg = (const bf16_t*)(p->ws + WS_WGT) + (size_t)((l * 2 + d) * 2) * 4 * 4096;
    u32x4* ABo = (u32x4*)(p->ws + WS_AB) + ((size_t)q * 8 + wid) * 16 * 64 + lane;
    const int src1 = d ? lane + 16 : lane - 16, src2 = d ? lane + 32 : lane - 32, srct = d ? fr : 48 + fr;
    const bool has1 = d ? fq <= 2 : fq >= 1, has2 = d ? fq <= 1 : fq >= 2;
    for (int n = 0; n < 4; ++n) {
        bf16x8 Br[2], Bi[2];
#pragma unroll
        for (int s = 0; s < 2; ++s) { Br[s] = *(const bf16x8*)(wg + ((size_t)(0 * 4 + hd) * 64 + 16 * n + fr) * 64 + 32 * s + 8 * fq); Bi[s] = *(const bf16x8*)(wg + ((size_t)(1 * 4 + hd) * 64 + 16 * n + fr) * 64 + 32 * s + 8 * fq); }
        float Hj[4][4], Aj[4][4];
#pragma unroll
        for (int mt = 0; mt < 4; ++mt) {
            const bf16x8 A0 = *(const LAS bf16x8*)(XC + (16 * mt + fr) * XCP + (8 * fq) * 2), A1 = *(const LAS bf16x8*)(XC + (16 * mt + fr) * XCP + (32 + 8 * fq) * 2);
            f32x4 ar = {0.f, 0.f, 0.f, 0.f}, ai = {0.f, 0.f, 0.f, 0.f};
            ar = __builtin_amdgcn_mfma_f32_16x16x32_bf16(A0, Br[0], ar, 0, 0, 0); ar = __builtin_amdgcn_mfma_f32_16x16x32_bf16(A1, Br[1], ar, 0, 0, 0);
            ai = __builtin_amdgcn_mfma_f32_16x16x32_bf16(A0, Bi[0], ai, 0, 0, 0); ai = __builtin_amdgcn_mfma_f32_16x16x32_bf16(A1, Bi[1], ai, 0, 0, 0);
            float a_[4], b_[4], la_[4];
#pragma unroll
            for (int j = 0; j < 4; ++j) { const float r = sigmoidf_(ar[j] + brr[n]); la_[j] = r * sp[n]; }
            u32x4 w; w.x = cvt_pk_bf16(la_[0], la_[1]); w.y = cvt_pk_bf16(la_[2], la_[3]);
            la_[0] = bflo(w.x); la_[1] = bfhi(w.x); la_[2] = bflo(w.y); la_[3] = bfhi(w.y);
#pragma unroll
            for (int j = 0; j < 4; ++j) { const int tok = 16 * mt + 4 * fq + j; const float xcv = bf2f(*(const LAS bf16_t*)(XC + tok * XCP + (16 * n + fr) * 2));
                const float ig = sigmoidf_(ai[j] + bii[n]); const float a = fexp2(la_[j]);
                a_[j] = a; b_[j] = __builtin_amdgcn_sqrtf(fmaxf(1.0f - a * a, 0.f)) * (ig * xcv); }
            w.z = cvt_pk_bf16(b_[0], b_[1]); w.w = cvt_pk_bf16(b_[2], b_[3]);
            b_[0] = bflo(w.z); b_[1] = bfhi(w.z); b_[2] = bflo(w.w); b_[3] = bfhi(w.w);
            ABo[(size_t)((n * 4 + mt) * 64)] = w;
            if (d == 0) { Hj[mt][0] = b_[0]; Aj[mt][0] = a_[0];
#pragma unroll
                for (int j = 1; j < 4; ++j) { Hj[mt][j] = a_[j] * Hj[mt][j - 1] + b_[j]; Aj[mt][j] = a_[j] * Aj[mt][j - 1]; } }
            else { Hj[mt][3] = b_[3]; Aj[mt][3] = a_[3];
#pragma unroll
                for (int j = 2; j >= 0; --j) { Hj[mt][j] = a_[j] * Hj[mt][j + 1] + b_[j]; Aj[mt][j] = a_[j] * Aj[mt][j + 1]; } }
        }
        float iA[4], iH[4], eA[4], eH[4], tA[4], tH[4];
#pragma unroll
        for (int mt = 0; mt < 4; ++mt) { iA[mt] = d ? Aj[mt][0] : Aj[mt][3]; iH[mt] = d ? Hj[mt][0] : Hj[mt][3]; }
        { float pA[4], pH[4];
#pragma unroll
          for (int mt = 0; mt < 4; ++mt) { pA[mt] = bperm(iA[mt], src1); pH[mt] = bperm(iH[mt], src1); }
#pragma unroll
          for (int mt = 0; mt < 4; ++mt) if (has1) { iH[mt] = iA[mt] * pH[mt] + iH[mt]; iA[mt] = iA[mt] * pA[mt]; }
#pragma unroll
          for (int mt = 0; mt < 4; ++mt) { pA[mt] = bperm(iA[mt], src2); pH[mt] = bperm(iH[mt], src2); }
#pragma unroll
          for (int mt = 0; mt < 4; ++mt) if (has2) { iH[mt] = iA[mt] * pH[mt] + iH[mt]; iA[mt] = iA[mt] * pA[mt]; } }
#pragma unroll
        for (int mt = 0; mt < 4; ++mt) { eA[mt] = bperm(iA[mt], src1); eH[mt] = bperm(iH[mt], src1); tA[mt] = bperm(iA[mt], srct); tH[mt] = bperm(iH[mt], srct); if (!has1) { eA[mt] = 1.f; eH[mt] = 0.f; } }
#pragma unroll
        for (int mi = 0; mi < 4; ++mi) { const int mt = d ? 3 - mi : mi;
            const float hin = eH[mt] + eA[mt] * cr[n];
            if (PASS == 2) {
#pragma unroll
                for (int j = 0; j < 4; ++j) { const int tok = 16 * mt + 4 * fq + j; *(LAS bf16_t*)(HB + ((d * 64 + tok) * 256 + 64 * hd + 16 * n + fr) * 2) = f2bf(Hj[mt][j] + Aj[mt][j] * hin); } }
            cr[n] = tH[mt] + tA[mt] * cr[n]; at[n] *= tA[mt]; }
    }
    if (PASS == 1) { if (fq == 0) {
#pragma unroll
            for (int n = 0; n < 4; ++n) { float* s = SUMM + ((size_t)q * 2 + d) * 512 + 64 * hd + 16 * n + fr; s[0] = at[n]; s[256] = cr[n]; } } }
    else {
        __syncthreads();
        bf16_t* Y = (bf16_t*)(p->ws + WS_YCAT);
        u32x4 gaw[4];
#pragma unroll
        for (int it = 0; it < 4; ++it) { const int task = it * 512 + tid, tok = task >> 5, cg = task & 31; gaw[it] = *(const u32x4*)(PROJ + ((size_t)rowbase + t0 + tok) * NPROJ + 256 + 8 * cg); }
#pragma unroll
        for (int it = 0; it < 4; ++it) { const int task = it * 512 + tid, tok = task >> 5, cg = task & 31; const size_t row = (size_t)rowbase + t0 + tok;
            float hf[8], hb[8], ga[8], y[8];
            unpack8(*(const LAS u32x4*)(HB + ((0 * 64 + tok) * 256 + 8 * cg) * 2), hf); unpack8(*(const LAS u32x4*)(HB + ((1 * 64 + tok) * 256 + 8 * cg) * 2), hb);
            unpack8(gaw[it], ga);
#pragma unroll
            for (int e = 0; e < 8; ++e) { const float g = ga[e]; y[e] = (hf[e] + hb[e]) * (g * sigmoidf_(1.5957691216057308f * (g + 0.044715f * g * g * g))); }
            *(u32x4*)(Y + row * D + 8 * cg) = pack8(y); }
    }
}

__device__ __forceinline__ void scan2_unit(CP p, int l, int q, LAS unsigned char* lds) {
    const int tid = tid_(), lane = tid & 63, wid = __builtin_amdgcn_readfirstlane(tid >> 6), d = wid >> 2, hd = wid & 3, fr = lane & 15, fq = lane >> 4;
    LAS float* CAR = (LAS float*)(lds + wid * 256);
    LAS unsigned char* HB = lds + 2048;
    const bf16_t* PROJ = (const bf16_t*)(p->ws + WS_PROJ); const float* SUMM = (const float*)(p->ws + WS_SUMM);
    const Seq sq = seq_of(q); const int b = sq.b, jc = sq.jc, rowbase = sq.rowbase, t0 = sq.t0; const bool lat = sq.lat;
    __syncthreads();
    u32x4 ab[4][4];
    { const u32x4* ABi = (const u32x4*)(p->ws + WS_AB) + ((size_t)q * 8 + wid) * 16 * 64 + lane;
#pragma unroll
      for (int n = 0; n < 4; ++n)
#pragma unroll
          for (int mt = 0; mt < 4; ++mt) ab[n][mt] = ABi[(size_t)((n * 4 + mt) * 64)]; }
    u32x4 gaw[4];
#pragma unroll
    for (int it = 0; it < 4; ++it) { const int task = it * 512 + tid, tok = task >> 5, cg = task & 31; gaw[it] = *(const u32x4*)(PROJ + ((size_t)rowbase + t0 + tok) * NPROJ + 256 + 8 * cg); }
    { float car = 0.f; const int c = 64 * hd + lane;
      const int n = d == 0 ? (lat ? 4 + jc : jc) : (lat ? 4 + 63 - jc : 3 - jc);
      for (int s0 = 0; s0 < n; s0 += 16) { float A_[16], H_[16];
#pragma unroll
          for (int e = 0; e < 16; ++e) { const int s = s0 + e; int qq;
              if (d == 0) qq = (lat && s >= 4) ? b * 64 + (s - 4) : 512 + b * 4 + s; else qq = (lat && s >= 4) ? b * 64 + 63 - (s - 4) : 512 + b * 4 + 3 - s;
              A_[e] = 1.f; H_[e] = 0.f; if (s < n) { const float* sp_ = SUMM + ((size_t)qq * 2 + d) * 512; A_[e] = sp_[c]; H_[e] = sp_[256 + c]; } }
#pragma unroll
          for (int e = 0; e < 16; ++e) car = A_[e] * car + H_[e]; }
      CAR[lane] = car; }
    asm volatile("" ::: "memory");
    const int src1 = d ? lane + 16 : lane - 16, src2 = d ? lane + 32 : lane - 32, srct = d ? fr : 48 + fr;
    const bool has1 = d ? fq <= 2 : fq >= 1, has2 = d ? fq <= 1 : fq >= 2;
#pragma unroll
    for (int n = 0; n < 4; ++n) { float cr = CAR[16 * n + fr];
        float Hj[4][4], Aj[4][4];
#pragma unroll
        for (int mt = 0; mt < 4; ++mt) { const u32x4 w = ab[n][mt];
            const float a_[4] = {fexp2(bflo(w.x)), fexp2(bfhi(w.x)), fexp2(bflo(w.y)), fexp2(bfhi(w.y))}, b_[4] = {bflo(w.z), bfhi(w.z), bflo(w.w), bfhi(w.w)};
            if (d == 0) { Hj[mt][0] = b_[0]; Aj[mt][0] = a_[0];
#pragma unroll
                for (int j = 1; j < 4; ++j) { Hj[mt][j] = a_[j] * Hj[mt][j - 1] + b_[j]; Aj[mt][j] = a_[j] * Aj[mt][j - 1]; } }
            else { Hj[mt][3] = b_[3]; Aj[mt][3] = a_[3];
#pragma unroll
                for (int j = 2; j >= 0; --j) { Hj[mt][j] = a_[j] * Hj[mt][j + 1] + b_[j]; Aj[mt][j] = a_[j] * Aj[mt][j + 1]; } } }
        float iA[4], iH[4], eA[4], eH[4], tA[4], tH[4];
#pragma unroll
        for (int mt = 0; mt < 4; ++mt) { iA[mt] = d ? Aj[mt][0] : Aj[mt][3]; iH[mt] = d ? Hj[mt][0] : Hj[mt][3]; }
        { float pA[4], pH[4];
#pragma unroll
          for (int mt = 0; mt < 4; ++mt) { pA[mt] = bperm(iA[mt], src1); pH[mt] = bperm(iH[mt], src1); }
#pragma unroll
          for (int mt = 0; mt < 4; ++mt) if (has1) { iH[mt] = iA[mt] * pH[mt] + iH[mt]; iA[mt] = iA[mt] * pA[mt]; }
#pragma unroll
          for (int mt = 0; mt < 4; ++mt) { pA[mt] = bperm(iA[mt], src2); pH[mt] = bperm(iH[mt], src2); }
#pragma unroll
          for (int mt = 0; mt < 4; ++mt) if (has2) { iH[mt] = iA[mt] * pH[mt] + iH[mt]; iA[mt] = iA[mt] * pA[mt]; } }
#pragma unroll
        for (int mt = 0; mt < 4; ++mt) { eA[mt] = bperm(iA[mt], src1); eH[mt] = bperm(iH[mt], src1); tA[mt] = bperm(iA[mt], srct); tH[mt] = bperm(iH[mt], srct); if (!has1) { eA[mt] = 1.f; eH[mt] = 0.f; } }
#pragma unroll
        for (int mi = 0; mi < 4; ++mi) { const int mt = d ? 3 - mi : mi;
            const float hin = eH[mt] + eA[mt] * cr;
#pragma unroll
            for (int j = 0; j < 4; j += 2) { const int tok = 16 * mt + 4 * fq + j; const LAS unsigned char* dummy = HB; (void)dummy;
                *(LAS bf16_t*)(HB + ((d * 64 + tok) * 256 + 64 * hd + 16 * n + fr) * 2) = f2bf(Hj[mt][j] + Aj[mt][j] * hin);
                *(LAS bf16_t*)(HB + ((d * 64 + tok + 1) * 256 + 64 * hd + 16 * n + fr) * 2) = f2bf(Hj[mt][j + 1] + Aj[mt][j + 1] * hin); }
            cr = tH[mt] + tA[mt] * cr; } }
    __syncthreads();
    bf16_t* Y = (bf16_t*)(p->ws + WS_YCAT);
#pragma unroll
    for (int it = 0; it < 4; ++it) { const int task = it * 512 + tid, tok = task >> 5, cg = task & 31; const size_t row = (size_t)rowbase + t0 + tok;
        float hf[8], hb[8], ga[8], y[8];
        unpack8(*(const LAS u32x4*)(HB + ((0 * 64 + tok) * 256 + 8 * cg) * 2), hf); unpack8(*(const LAS u32x4*)(HB + ((1 * 64 + tok) * 256 + 8 * cg) * 2), hb);
        unpack8(gaw[it], ga);
#pragma unroll
        for (int e = 0; e < 8; ++e) { const float g = ga[e]; y[e] = (hf[e] + hb[e]) * (g * sigmoidf_(1.5957691216057308f * (g + 0.044715f * g * g * g))); }
        *(u32x4*)(Y + row * D + 8 * cg) = pack8(y); }
}

__device__ __forceinline__ void pool_unit(CP p, int l, int q, LAS unsigned char* lds) {
    LAS float* PB = (LAS float*)lds;
    const int tid = tid_();
    const bf16_t* PROJ = (const bf16_t*)(p->ws + WS_PROJ); bf16_t* Y = (bf16_t*)(p->ws + WS_YCAT);
    const Seq sq = seq_of(q); const int L = sq.L, rowbase = sq.rowbase, t0 = sq.t0;
    __syncthreads();
    { u32x4 w[5];
#pragma unroll
      for (int it = 0; it < 5; ++it) { const int task = it * 512 + tid, r = task >> 5, cg = task & 31, tt = t0 - 8 + r; w[it] = (u32x4){0u, 0u, 0u, 0u};
          if (tt >= 0 && tt < L) w[it] = *(const u32x4*)(PROJ + (size_t)(rowbase + tt) * NPROJ + 512 + 8 * cg); }
#pragma unroll
      for (int it = 0; it < 5; ++it) { const int task = it * 512 + tid, r = task >> 5, cg = task & 31; float f[8]; unpack8(w[it], f);
          *(LAS f32x4*)(PB + r * 256 + 8 * cg) = (f32x4){f[0], f[1], f[2], f[3]}; *(LAS f32x4*)(PB + r * 256 + 8 * cg + 4) = (f32x4){f[4], f[5], f[6], f[7]}; } }
    __syncthreads();
    { const int c = tid & 255, th = tid >> 8, hw = 1 << (c >> 6); const float bp = p->b_pool[l * 256 + c], ps = p->pool_scale[l * 256 + c];
#pragma unroll 4
      for (int o = 0; o < 32; ++o) { const int tl = 32 * th + o, t = t0 + tl; const int lo = max(t - hw, 0), hi = min(t + hw, L); float s = 0.f;
          for (int tt = lo; tt < hi; ++tt) s += PB[(tt - t0 + 8) * 256 + c];
          const float yv = (s * frcp((float)(hi - lo)) - PB[(tl + 8) * 256 + c] + bp) * ps;
          Y[(size_t)(rowbase + t) * D + 256 + c] = f2bf(yv); } }
}
__device__ __forceinline__ void four_unit(CP p, int l, int q) {
    const int tid = tid_();
    bf16_t* Y = (bf16_t*)(p->ws + WS_YCAT);
    const Seq sq = seq_of(q); const int b = sq.b, rowbase = sq.rowbase, t0 = sq.t0; const bool lat = sq.lat;
    const float* UU = (const float*)(p->ws + WS_UU); const float* VV = (const float*)(p->ws + WS_VV); const float* YCX = (const float*)(p->ws + WS_YCX);
#pragma unroll
    for (int it = 0; it < 4; ++it) { const int task = it * 512 + tid, tl = task >> 5, cg = task & 31, t = t0 + tl; float y[8];
        f32x4 u0, u1, v0 = {0.f, 0.f, 0.f, 0.f}, v1 = {0.f, 0.f, 0.f, 0.f}; float sgn, scale;
        if (lat) { const int k = t <= 2048 ? t : 4096 - t; sgn = t <= 2048 ? -1.0f : 1.0f; scale = 1.0f / 512.0f;
            const float* up = UU + (size_t)k * 2048 + b * 256 + 8 * cg; u0 = *(const f32x4*)up; u1 = *(const f32x4*)(up + 4);
            if (k < 2048) { const float* vp = VV + (size_t)k * 2048 + b * 256 + 8 * cg; v0 = *(const f32x4*)vp; v1 = *(const f32x4*)(vp + 4); } }
        else { sgn = 0.f; scale = 1.0f / 128.0f; const float* up = YCX + (size_t)t * 2048 + b * 256 + 8 * cg; u0 = *(const f32x4*)up; u1 = *(const f32x4*)(up + 4); }
        const f32x4 bf0 = *(const f32x4*)(p->b_four + l * 256 + 8 * cg), bf1 = *(const f32x4*)(p->b_four + l * 256 + 8 * cg + 4);
        const f32x4 r0 = (u0 + v0 * sgn) * scale + bf0, r1 = (u1 + v1 * sgn) * scale + bf1;
        y[0] = r0[0]; y[1] = r0[1]; y[2] = r0[2]; y[3] = r0[3]; y[4] = r1[0]; y[5] = r1[1]; y[6] = r1[2]; y[7] = r1[3];
        *(u32x4*)(Y + (size_t)(rowbase + t) * D + 512 + 8 * cg) = pack8(y); }
}
__device__ __forceinline__ void conformer_unit(CP p, int l, int q, LAS unsigned char* lds) {
    LAS float* V = (LAS float*)lds;
    const int tid = tid_(), lane = tid & 63, wid = __builtin_amdgcn_readfirstlane(tid >> 6);
    const bf16_t* PROJ = (const bf16_t*)(p->ws + WS_PROJ); bf16_t* Y = (bf16_t*)(p->ws + WS_YCAT);
    const Seq sq = seq_of(q); const int L = sq.L, rowbase = sq.rowbase, t0 = sq.t0;
    __syncthreads();
    { u32x4 wa[6], wg_[6];
#pragma unroll
      for (int it = 0; it < 6; ++it) { const int task = it * 512 + tid, r = task >> 5, cg = task & 31, tt = t0 - 15 + r; wa[it] = (u32x4){0u, 0u, 0u, 0u}; wg_[it] = wa[it];
          if (task < 94 * 32 && tt >= 0 && tt < L) { const bf16_t* pr = PROJ + (size_t)(rowbase + tt) * NPROJ + 768 + 8 * cg; wa[it] = *(const u32x4*)pr; wg_[it] = *(const u32x4*)(pr + 256); } }
#pragma unroll
      for (int it = 0; it < 6; ++it) { const int task = it * 512 + tid, r = task >> 5, cg = task & 31; float a[8], g[8], f[8]; unpack8(wa[it], a); unpack8(wg_[it], g);
#pragma unroll
          for (int e = 0; e < 8; ++e) f[e] = a[e] * sigmoidf_(g[e]);
          if (task < 94 * 32) { *(LAS f32x4*)(V + r * 256 + 8 * cg) = (f32x4){f[0], f[1], f[2], f[3]}; *(LAS f32x4*)(V + r * 256 + 8 * cg + 4) = (f32x4){f[4], f[5], f[6], f[7]}; } } }
    __syncthreads();
    const int hp = wid & 1, tq = wid >> 1, c0 = 128 * hp + 2 * lane;
    f32x2 wk[31];
#pragma unroll
    for (int k = 0; k < 31; ++k) wk[k] = *(const f32x2*)(p->conv_d_w + ((size_t)l * 31 + k) * 256 + c0);
    const f32x2 cb = *(const f32x2*)(p->conv_d_b + l * 256 + c0), lg = *(const f32x2*)(p->ln_d_g + l * 256 + c0), lb = *(const f32x2*)(p->ln_d_b + l * 256 + c0);
    for (int blk = 0; blk < 2; ++blk) { const int tl0 = 16 * tq + 8 * blk;
        f32x2 win[38];
#pragma unroll
        for (int i = 0; i < 38; ++i) win[i] = *(const LAS f32x2*)(V + (tl0 + i) * 256 + c0);
        f32x2 sv[8]; float m1[8], m2[8];
#pragma unroll
        for (int o = 0; o < 8; ++o) { f32x2 sacc = cb;
#pragma unroll
            for (int k = 0; k < 31; ++k) sacc += wk[k] * win[o + k];
            sv[o] = sacc; m1[o] = sacc.x + sacc.y; m2[o] = sacc.x * sacc.x + sacc.y * sacc.y; }
#pragma unroll
        for (int st = 16; st >= 1; st >>= 1) { float t1[8], t2[8];
#pragma unroll
            for (int o = 0; o < 8; ++o) { t1[o] = bperm(m1[o], lane ^ st); t2[o] = bperm(m2[o], lane ^ st); }
#pragma unroll
            for (int o = 0; o < 8; ++o) { m1[o] += t1[o]; m2[o] += t2[o]; } }
#pragma unroll
        for (int o = 0; o < 8; ++o) { const float mean = m1[o] * (1.0f / 64.0f); const float var = fmaxf(m2[o] * (1.0f / 64.0f) - mean * mean, 0.f); const float rs = __builtin_amdgcn_rsqf(var + 1e-6f);
            f32x2 yv = (sv[o] - mean) * rs * lg + lb; yv.x = yv.x * sigmoidf_(yv.x); yv.y = yv.y * sigmoidf_(yv.y);
            *(unsigned*)(Y + (size_t)(rowbase + t0 + tl0 + o) * D + 768 + c0) = cvt_pk_bf16(yv.x, yv.y); } }
}

struct SchedIn { const char *U, *W, *WF; char *PROJ, *PQT, *PQC;
    __device__ __forceinline__ bool next(int i, g8::Unit& u) const { const int L = i * (int)gridDim.x + (int)blockIdx.x; if (L >= 952) return false; const int id = g8::xcd_remap(L, 952);
        if (id < 680) { u.kind = 0; u.pm = id / 5; u.pn = id % 5; u.a = U + (size_t)u.pm * 256 * 2048; u.b = W + (size_t)u.pn * 256 * 2048; u.o = PROJ; u.e = 0; }
        else { const int r = id - 680; u.kind = 1; u.pm = r & 1; u.pn = r >> 1; u.a = WF + (size_t)u.pm * 256 * 2048; u.b = U + (size_t)u.pn * 256 * 2048; u.e = 0;
            if (u.pn < 128) u.o = PQT + ((size_t)(u.pm * 2048 + (u.pn >> 4) * 256) * 4096 + (u.pn & 15) * 256) * 2; else u.o = PQC + ((size_t)((u.pn - 128) * 256) * 512 + u.pm * 256) * 2; }
        return true; } };
struct EpiIn { static constexpr bool PERM = true; const float* bin; const float* bf;
    __device__ __forceinline__ void side0(const g8::Unit& u, int t, unsigned& a, unsigned& b, unsigned& c) const { a = __float_as_uint(u.kind == 0 ? bin[u.pn * 256 + t] : bf[u.pm * 256 + t]); }
    __device__ __forceinline__ void side1(const g8::Unit&, int, unsigned&, unsigned&, unsigned&) const {}
    __device__ __forceinline__ void operator()(const f32x4 (&acc)[2][2][4][2], const g8::Unit& u, int wr, int wc, int fr, int fq, const LAS unsigned* sd) const {
        { const int ln_ = tid_() & 63; fr = ln_ & 15; fq = ln_ >> 4; }
        if (u.kind == 0) { const int row0 = u.pm * 256 + wr * 64 + fr, col0 = u.pn * 256 + wc * 32 + 8 * fq; bf16_t* O = (bf16_t*)u.o;
            f32x4 bv[2][2];
#pragma unroll
            for (int bj = 0; bj < 2; ++bj)
#pragma unroll
                for (int n = 0; n < 2; ++n) bv[bj][n] = *(const LAS f32x4*)(sd + wc * 32 + 8 * fq + bj * 128 + 4 * n);
#pragma unroll
            for (int ai = 0; ai < 2; ++ai)
#pragma unroll
                for (int m = 0; m < 4; ++m) { bf16_t* rowp = O + (size_t)(row0 + ai * 128 + m * 16) * NPROJ + col0;
#pragma unroll
                    for (int bj = 0; bj < 2; ++bj) { const f32x4 v0 = acc[ai][bj][m][0] + bv[bj][0], v1 = acc[ai][bj][m][1] + bv[bj][1];
                        u32x4 w; w.x = cvt_pk_bf16(v0[0], v0[1]); w.y = cvt_pk_bf16(v0[2], v0[3]); w.z = cvt_pk_bf16(v1[0], v1[1]); w.w = cvt_pk_bf16(v1[2], v1[3]); *(u32x4*)(rowp + bj * 128) = w; } }
        } else { const int pitch = u.pn < 128 ? 4096 : 512; bf16_t* O = (bf16_t*)u.o; const int col0 = wc * 32 + 8 * fq;
#pragma unroll
            for (int ai = 0; ai < 2; ++ai)
#pragma unroll
                for (int m = 0; m < 4; ++m) { const int r = ai * 128 + wr * 64 + m * 16 + fr; const float bb = __uint_as_float(sd[r]); bf16_t* rowp = O + (size_t)r * pitch + col0;
#pragma unroll
                    for (int bj = 0; bj < 2; ++bj) { const f32x4 v0 = acc[ai][bj][m][0] + bb, v1 = acc[ai][bj][m][1] + bb;
                        u32x4 w; w.x = cvt_pk_bf16(v0[0], v0[1]); w.y = cvt_pk_bf16(v0[2], v0[3]); w.z = cvt_pk_bf16(v1[0], v1[1]); w.w = cvt_pk_bf16(v1[2], v1[3]); *(u32x4*)(rowp + bj * 128) = w; } }
        } } };
struct SchedDft { const char *CM, *SM, *PQT; char *UU, *VV;
    __device__ __forceinline__ bool next(int i, g8::Unit& u) const { const int id = (int)blockIdx.x; if (i > 0 || id >= 136) return false; u.kind = 0; u.e = 0;
        if (id < 72) { u.pm = id >> 3; u.pn = id & 7; u.a = CM + (size_t)u.pm * 256 * 8192; u.b = PQT + (size_t)u.pn * 256 * 8192; u.o = UU + ((size_t)u.pm * 256 * 2048 + u.pn * 256) * 4; }
        else { const int r = id - 72; u.pm = r >> 3; u.pn = r & 7; u.a = SM + (size_t)u.pm * 256 * 8192; u.b = PQT + (size_t)(2048 + u.pn * 256) * 8192; u.o = VV + ((size_t)u.pm * 256 * 2048 + u.pn * 256) * 4; }
        return true; } };
struct SchedOne { g8::Unit u; __device__ __forceinline__ bool next(int i, g8::Unit& o) const { if (i > 0) return false; o = u; return true; } };
struct SchedDftC { const char *DC, *PQC; char* YCX;
    __device__ __forceinline__ bool next(int i, g8::Unit& u) const { const int id = (int)blockIdx.x - 136; if (i > 0 || id < 0 || id >= 8) return false; u.kind = 0; u.e = 0; u.pm = 0; u.pn = id;
        u.a = DC; u.b = PQC + (size_t)id * 256 * 1024; u.o = YCX + (size_t)id * 256 * 4; return true; } };
struct EpiF32 { static constexpr bool PERM = false;
    __device__ __forceinline__ void side0(const g8::Unit&, int, unsigned&, unsigned&, unsigned&) const {}
    __device__ __forceinline__ void side1(const g8::Unit&, int, unsigned&, unsigned&, unsigned&) const {}
    __device__ __forceinline__ void operator()(const f32x4 (&acc)[2][2][4][2], const g8::Unit& u, int wr, int wc, int fr, int fq, const LAS unsigned* sd) const {
        { const int ln_ = tid_() & 63; fr = ln_ & 15; fq = ln_ >> 4; }
        float* O = (float*)u.o; const int row0 = wr * 64 + fr, col0 = wc * 32 + 4 * fq;
#pragma unroll
        for (int ai = 0; ai < 2; ++ai)
#pragma unroll
            for (int m = 0; m < 4; ++m) { float* rowp = O + (size_t)(row0 + ai * 128 + m * 16) * 2048 + col0;
#pragma unroll
                for (int bj = 0; bj < 2; ++bj)
#pragma unroll
                    for (int n = 0; n < 2; ++n) *(f32x4*)(rowp + bj * 128 + n * 16) = acc[ai][bj][m][n]; } } };
struct SchedOut { const char *Y, *W; int nm; const float* modv_l;
    __device__ __forceinline__ bool next(int i, g8::Unit& u) const { const int nu = nm * 4, L = i * (int)gridDim.x + (int)blockIdx.x; if (L >= nu) return false; const int id = g8::xcd_remap(L, nu);
        u.kind = 0; u.pm = id >> 2; u.pn = id & 3; u.a = Y + (size_t)u.pm * 256 * 2048; u.b = W + (size_t)u.pn * 256 * 2048; u.o = nullptr; u.e = u.pm < 128 ? u.pm >> 4 : 8; return true; } };
struct EpiOut { static constexpr bool PERM = false; float* X; float* Xo; const float* bout; const float* modv_l;
    __device__ __forceinline__ void side0(const g8::Unit& u, int t, unsigned& a, unsigned& b, unsigned& c) const { a = __float_as_uint(bout[u.pn * 256 + t]); b = __float_as_uint(modv_l[(size_t)u.e * 6144 + 2048 + u.pn * 256 + t]); }
    __device__ __forceinline__ void side1(const g8::Unit&, int, unsigned&, unsigned&, unsigned&) const {}
    __device__ __forceinline__ void operator()(const f32x4 (&acc)[2][2][4][2], const g8::Unit& u, int wr, int wc, int fr, int fq, const LAS unsigned* sd) const {
        { const int ln_ = tid_() & 63; fr = ln_ & 15; fq = ln_ >> 4; }
        const int row0 = u.pm * 256 + wr * 64 + fr, col0 = u.pn * 256 + wc * 32 + 4 * fq;
        f32x4 bv[2][2], gv[2][2];
#pragma unroll
        for (int bj = 0; bj < 2; ++bj)
#pragma unroll
            for (int n = 0; n < 2; ++n) { bv[bj][n] = *(const LAS f32x4*)(sd + wc * 32 + 4 * fq + bj * 128 + n * 16); gv[bj][n] = *(const LAS f32x4*)(sd + 256 + wc * 32 + 4 * fq + bj * 128 + n * 16); }
#pragma unroll
        for (int ai = 0; ai < 2; ++ai)
#pragma unroll
            for (int m = 0; m < 4; ++m) { float* rowp = X + (size_t)(row0 + ai * 128 + m * 16) * D + col0;
#pragma unroll
                for (int bj = 0; bj < 2; ++bj)
#pragma unroll
                    for (int n = 0; n < 2; ++n) { const f32x4* px = (const f32x4*)(rowp + bj * 128 + n * 16); *(f32x4*)(Xo + (px - (const f32x4*)X) * 4) = *px + gv[bj][n] * (acc[ai][bj][m][n] + bv[bj][n]); } } } };
struct MoeTab { const LAS int* pref; const LAS int* cnt; const LAS unsigned char* t2e; int ntile;
    __device__ __forceinline__ int pref_(int e) const { return __builtin_amdgcn_readfirstlane(pref[e]); }
    __device__ __forceinline__ int cnt_(int e) const { return __builtin_amdgcn_readfirstlane(cnt[e]); }
    __device__ __forceinline__ int expert_of(int pm) const { return __builtin_amdgcn_readfirstlane((int)t2e[pm]); } };
struct SchedGu { MoeTab tb; const char *U, *W; char* ACT; const int* rasg; int rb;
    __device__ __forceinline__ bool next(int i, g8::Unit& u) const { const int nu = tb.ntile * 8, L = i * (int)gridDim.x + (int)blockIdx.x; if (L >= nu) return false; const int id = g8::xcd_remap(L, nu);
        u.kind = 0; u.pm = id >> 3; u.pn = id & 7; u.e = tb.expert_of(u.pm); u.a = U; u.b = W + ((size_t)u.e * 2048 + u.pn * 256) * rb; u.o = ACT + (size_t)u.pm * 256 * rb; return true; }
    __device__ __forceinline__ int row(const g8::Unit& u, int r) const { const int v = rasg[(size_t)u.e * TT + (u.pm - tb.pref_(u.e)) * 256 + r] >> 2; return min(max(v, 0), TT - 1); } };
template <bool F8> struct EpiGu { static constexpr bool PERM = true; const float* bgu;
    __device__ __forceinline__ void side0(const g8::Unit& u, int t, unsigned& a, unsigned& b, unsigned& c) const { a = __float_as_uint(bgu[(size_t)u.e * 2048 + (t < 128 ? 0 : 1024 - 128) + u.pn * 128 + t]); }
    __device__ __forceinline__ void side1(const g8::Unit&, int, unsigned&, unsigned&, unsigned&) const {}
    __device__ __forceinline__ void operator()(const f32x4 (&acc)[2][2][4][2], const g8::Unit& u, int wr, int wc, int fr, int fq, const LAS unsigned* sd) const {
        { const int ln_ = tid_() & 63; fr = ln_ & 15; fq = ln_ >> 4; }
        const int col0 = u.pn * 128 + wc * 32 + 8 * fq; const float sc = F8 ? (1.0f / 64.0f) : 1.0f;
        f32x4 bgt[2], bup[2];
#pragma unroll
        for (int n = 0; n < 2; ++n) { bgt[n] = *(const LAS f32x4*)(sd + wc * 32 + 8 * fq + 4 * n); bup[n] = *(const LAS f32x4*)(sd + 128 + wc * 32 + 8 * fq + 4 * n); }
#pragma unroll
        for (int ai = 0; ai < 2; ++ai)
#pragma unroll
            for (int m = 0; m < 4; ++m) { const int r = ai * 128 + wr * 64 + m * 16 + fr; float y[8];
#pragma unroll
                for (int n = 0; n < 2; ++n) { const f32x4 g4 = acc[ai][0][m][n] * sc + bgt[n], u4 = acc[ai][1][m][n] * sc + bup[n];
#pragma unroll
                    for (int e = 0; e < 4; ++e) { const float gt = fminf(g4[e], 7.0f), up = fminf(fmaxf(u4[e], -7.0f), 7.0f); y[4 * n + e] = (up + 1.0f) * (gt * sigmoidf_(1.702f * gt)); } }
                if constexpr (F8) { u32x2 w; w.x = pk4_fp8(y[0], y[1], y[2], y[3]); w.y = pk4_fp8(y[4], y[5], y[6], y[7]); *(u32x2*)((unsigned char*)u.o + (size_t)r * D + col0) = w; }
                else *(u32x4*)((bf16_t*)u.o + (size_t)r * D + col0) = pack8(y); } } };
struct SchedDown { MoeTab tb; const char *ACT, *W; int rb;
    __device__ __forceinline__ bool next(int i, g8::Unit& u) const { const int nu = tb.ntile * 4, L = i * (int)gridDim.x + (int)blockIdx.x; if (L >= nu) return false; const int id = g8::xcd_remap(L, nu);
        u.kind = 0; u.pm = id >> 2; u.pn = id & 3; u.e = tb.expert_of(u.pm); u.a = ACT + (size_t)u.pm * 256 * rb; u.b = W + ((size_t)u.e * 1024 + u.pn * 256) * rb; u.o = nullptr; return true; } };
struct EpiDown { static constexpr bool PERM = true; MoeTab tb; const float* bd; const int* rasg; const float* gate; bf16_t* YS; float sc;
    __device__ __forceinline__ void side0(const g8::Unit& u, int t, unsigned& a, unsigned& b, unsigned& c) const { const int rank = (u.pm - tb.pref_(u.e)) * 256 + t;
        a = rank < tb.cnt_(u.e) ? (unsigned)rasg[(size_t)u.e * TT + rank] : 0xffffffffu; c = __float_as_uint(bd[(size_t)u.e * 1024 + u.pn * 256 + t]); }
    __device__ __forceinline__ void side1(const g8::Unit&, int, unsigned& a, unsigned& b, unsigned&) const { b = (int)a >= 0 ? __float_as_uint(gate[(int)a]) : 0u; }
    __device__ __forceinline__ void operator()(const f32x4 (&acc)[2][2][4][2], const g8::Unit& u, int wr, int wc, int fr, int fq, const LAS unsigned* sd) const {
        { const int ln_ = tid_() & 63; fr = ln_ & 15; fq = ln_ >> 4; }
        const int col0 = u.pn * 256 + wc * 32 + 8 * fq;
        f32x4 bv[2][2];
#pragma unroll
        for (int bj = 0; bj < 2; ++bj)
#pragma unroll
            for (int n = 0; n < 2; ++n) bv[bj][n] = *(const LAS f32x4*)(sd + 512 + wc * 32 + 8 * fq + bj * 128 + 4 * n);
#pragma unroll
        for (int ai = 0; ai < 2; ++ai)
#pragma unroll
            for (int m = 0; m < 4; ++m) { const int r = ai * 128 + wr * 64 + m * 16 + fr; const int asg = (int)sd[r]; const float g = __uint_as_float(sd[256 + r]);
                if (asg >= 0) { bf16_t* rowp = YS + (size_t)asg * D + col0;
#pragma unroll
                    for (int bj = 0; bj < 2; ++bj) { const f32x4 v0 = (acc[ai][bj][m][0] * sc + bv[bj][0]) * g, v1 = (acc[ai][bj][m][1] * sc + bv[bj][1]) * g;
                        u32x4 w; w.x = cvt_pk_bf16(v0[0], v0[1]); w.y = cvt_pk_bf16(v0[2], v0[3]); w.z = cvt_pk_bf16(v1[0], v1[1]); w.w = cvt_pk_bf16(v1[2], v1[3]); *(u32x4*)(rowp + bj * 128) = w; } } } } };
__device__ __forceinline__ MoeTab moe_tables(CP p, int l, LAS unsigned char* lds) {
    LAS int* pref = (LAS int*)(lds + g8::STAGE_BYTES); LAS int* cnt = pref + 64; LAS unsigned char* t2e = (LAS unsigned char*)(lds + g8::STAGE_BYTES + 384);
    unsigned* ctl = (unsigned*)(p->ws + WS_CTL);
    const int tid = tid_();
    __syncthreads();
    if (tid < 32) cnt[tid] = (int)__hip_atomic_load(ctl + CW_COUNT + (l * NE + tid) * 64, __ATOMIC_RELAXED, __HIP_MEMORY_SCOPE_AGENT);
    __syncthreads();
    if (tid == 0) { int s = 0; for (int e = 0; e < 32; ++e) { pref[e] = s; s += (cnt[e] + 255) >> 8; } pref[32] = s; }
    __syncthreads();
    for (int pm = tid; pm < NTILE_MAX; pm += 512) { int e = 0; for (int k = 1; k < 32; ++k) e += (pm >= pref[k]) ? 1 : 0; t2e[pm] = (unsigned char)e; }
    __syncthreads();
    MoeTab tb; tb.pref = pref; tb.cnt = cnt; tb.t2e = t2e; tb.ntile = __builtin_amdgcn_readfirstlane(pref[32]); return tb;
}

constexpr int N_PHASES = 18;
__global__ void __launch_bounds__(512, 2) mega_fwd(Params p_unused) {
    CP p = launder_params();
    extern __shared__ __attribute__((aligned(16))) unsigned char shm_[];
    LAS unsigned char* lds0 = (LAS unsigned char*)shm_;
    LAS unsigned char* lds = lds0 + LDS_BASE;
    if (tid_() == 0) *(LAS u32x4*)lds0 = (u32x4){0u, 0u, 0u, 0u};
    __syncthreads();
    XcdBarrier bar = xcd_barrier_post((unsigned*)(p->ws + WS_CTL), (volatile LAS unsigned*)lds0);
    int ph = 0;
#ifndef P3A
#define P3A 1
#define P3B 1
#define P3C 1
#endif
#ifndef PHMASK
#define PHMASK 0x3ff
#endif
#ifndef REPMASK
#define REPMASK 0
#endif
#define PHASE_BEGIN_K(k) p = launder_params(); if (((PHMASK >> (k)) & 1) && ph >= p->ph_lo && ph < p->ph_hi) for (int rep_ = 0; rep_ < ((((REPMASK) >> (k)) & 1) ? 2 : 1); ++rep_) {
#define PHASE_END } ++ph; if (ph > p->ph_lo && ph < p->ph_hi) xcd_barrier(bar);
    PHASE_BEGIN_K(0) phase_prologue(p, lds, rep_); PHASE_END
    for (int l = 0; l < 2; ++l) {
        const float* modv_l = (const float*)(p->ws + WS_MODV) + (size_t)l * 9 * 6144;
        PHASE_BEGIN_K(1) phase_norm(p, l); PHASE_END
        PHASE_BEGIN_K(2) { SchedIn S; S.U = (const char*)(p->ws + WS_U); S.W = (const char*)(p->ws + WS_WINT) + (size_t)l * NPROJ * 2048; S.WF = (const char*)(p->ws + WS_WFT) + (size_t)l * 512 * 2048;
                      S.PROJ = (char*)(p->ws + WS_PROJ); S.PQT = (char*)(p->ws + WS_PQT); S.PQC = (char*)(p->ws + WS_PQC);
                      EpiIn E; E.bin = (const float*)(p->ws + WS_BIN) + l * NPROJ; E.bf = (const float*)(p->ws + WS_BF) + l * 512;
                      g8::gemm_phase<EpiIn, SchedIn, false>(lds, 1024, S, E); } PHASE_END
        PHASE_BEGIN_K(3) {
                      unsigned* qhead = (unsigned*)(p->ws + WS_CTL) + CW_QUEUE + (l * 2 + rep_) * 64; LAS int* qslot = (LAS int*)(lds - LDS_BASE + 64);
                      for (;;) { __syncthreads(); if (tid_() == 0) *qslot = (int)__hip_atomic_fetch_add(qhead, 1u, __ATOMIC_RELAXED, __HIP_MEMORY_SCOPE_AGENT); __syncthreads();
                          const int id = __builtin_amdgcn_readfirstlane(*qslot); const int nwj = MOE_W_IN_QUEUE ? (l == 0 ? J_TGU_L(0) + J_TD_L(0) : J_TGU_L(1) + J_TD_L(1)) : 0;
                          if (id >= 144 + 9 * NCHUNK) break;
                          int small = -1;
                          if (id >= 144) { const int r = id - 144, g = r / 3, k = r - 3 * g; if (k == 0) small = g; else { const int wj = 2 * g + (k - 1); if (wj < nwj) moe_weight_job(p, l, wj, lds); continue; } }
                          if (id < 136) { SchedOne S; S.u.kind = 0; S.u.e = 0;
                              if (id < 72) { S.u.pm = id >> 3; S.u.pn = id & 7; S.u.a = (const char*)(p->ws + WS_CMAT) + (size_t)S.u.pm * 256 * 8192; S.u.b = (const char*)(p->ws + WS_PQT) + (size_t)S.u.pn * 256 * 8192; S.u.o = (char*)(p->ws + WS_UU) + ((size_t)S.u.pm * 256 * 2048 + S.u.pn * 256) * 4; }
                              else { const int r = id - 72; S.u.pm = r >> 3; S.u.pn = r & 7; S.u.a = (const char*)(p->ws + WS_SMAT) + (size_t)S.u.pm * 256 * 8192; S.u.b = (const char*)(p->ws + WS_PQT) + (size_t)(2048 + S.u.pn * 256) * 8192; S.u.o = (char*)(p->ws + WS_VV) + ((size_t)S.u.pm * 256 * 2048 + S.u.pn * 256) * 4; }
                              g8::gemm_phase<EpiF32, SchedOne, false>(lds, 4096, S, EpiF32{}); }
                          else if (id < 144) { SchedOne S; S.u.kind = 0; S.u.e = 0; S.u.pm = 0; S.u.pn = id - 136; S.u.a = (const char*)(p->ws + WS_DFTC); S.u.b = (const char*)(p->ws + WS_PQC) + (size_t)S.u.pn * 256 * 1024; S.u.o = (char*)(p->ws + WS_YCX) + (size_t)S.u.pn * 256 * 4;
                              g8::gemm_phase<EpiF32, SchedOne, false>(lds, 512, S, EpiF32{}); }
                          else { const int uu = small, kind = uu / NCHUNK, q = uu % NCHUNK;
                              if (kind == 0) scan_unit<1>(p, l, q, lds); else if (kind == 1) conformer_unit(p, l, q, lds); else pool_unit(p, l, q, lds); } } } PHASE_END
        PHASE_BEGIN_K(4) { for (int q = blockIdx.x; q < NCHUNK; q += gridDim.x) { scan2_unit(p, l, q, lds); four_unit(p, l, q); } } PHASE_END
        PHASE_BEGIN_K(5) { SchedOut S; S.Y = (const char*)(p->ws + WS_YCAT); S.W = (const char*)(p->ws + WS_WOUTT) + (size_t)l * D * 2048; S.nm = l == 0 ? 136 : 128; S.modv_l = modv_l;
                      EpiOut E; E.X = (float*)(p->ws + WS_X); E.Xo = rep_ ? (float*)(p->ws + WS_ACT) : E.X; E.bout = (const float*)(p->ws + WS_BOUT) + l * D; E.modv_l = modv_l;
                      g8::gemm_phase<EpiOut, SchedOut, false>(lds, 1024, S, E); } PHASE_END
        PHASE_BEGIN_K(6) phase_router(p, l, lds, rep_); PHASE_END
        PHASE_BEGIN_K(7) { MoeTab tb = moe_tables(p, l, lds);
                      SchedGu S; S.tb = tb; S.W = (const char*)(p->ws + WS_WGUT) + (size_t)l * NE * 2048 * 2048; S.ACT = (char*)(p->ws + WS_ACT); S.rasg = (const int*)(p->ws + WS_RASG);
                      if (fp8_layer(l)) { S.U = (const char*)(p->ws + WS_U8); S.rb = 1024; EpiGu<true> E; E.bgu = p->b_gu + (size_t)l * NE * 2048; g8::gemm_phase<EpiGu<true>, SchedGu, true, true>(lds, 512, S, E); }
                      else { S.U = (const char*)(p->ws + WS_U); S.rb = 2048; EpiGu<false> E; E.bgu = p->b_gu + (size_t)l * NE * 2048; g8::gemm_phase<EpiGu<false>, SchedGu, true, false>(lds, 1024, S, E); } } PHASE_END
        PHASE_BEGIN_K(8) { MoeTab tb = moe_tables(p, l, lds);
                      SchedDown S; S.tb = tb; S.ACT = (const char*)(p->ws + WS_ACT); S.W = (const char*)(p->ws + WS_WDT) + (size_t)l * NE * 1024 * 2048;
                      EpiDown E; E.tb = tb; E.bd = p->b_down + (size_t)l * NE * 1024; E.rasg = (const int*)(p->ws + WS_RASG); E.gate = (const float*)(p->ws + WS_GATE); E.YS = (bf16_t*)(p->ws + WS_YS);
                      if (fp8_layer(l)) { S.rb = 1024; E.sc = 1.0f / 64.0f; g8::gemm_phase<EpiDown, SchedDown, false, true>(lds, 512, S, E); }
                      else { S.rb = 2048; E.sc = 1.0f; g8::gemm_phase<EpiDown, SchedDown, false, false>(lds, 1024, S, E); } } PHASE_END
    }
    PHASE_BEGIN_K(9) phase_norm(p, 2); PHASE_END
#undef PHASE_BEGIN_K
#undef PHASE_END
}

extern "C" void kernel_launch(void* const* d_in, const int* in_sizes, int n_in, void* d_out, int out_size, void* d_ws, size_t ws_size, hipStream_t stream) {
    static int grid = 0;
    if (!grid) {
        if (n_in != 37 || ws_size < WS_END) { fprintf(stderr, "kernel_launch: expected 37 inputs and >= %zu bytes of workspace (got %d, %zu)\n", (size_t)WS_END, n_in, ws_size); }
        int dev = 0, cus = 0, per_cu = 0;
        hipGetDevice(&dev); hipDeviceGetAttribute(&cus, hipDeviceAttributeMultiprocessorCount, dev);
        hipFuncSetAttribute((const void*)mega_fwd, hipFuncAttributeMaxDynamicSharedMemorySize, LDS_BYTES);
        hipOccupancyMaxActiveBlocksPerMultiprocessor(&per_cu, (const void*)mega_fwd, 512, LDS_BYTES);
        if (per_cu < 1) fprintf(stderr, "kernel_launch: occupancy query reports %d workgroups per CU\n", per_cu);
        grid = cus > 0 ? cus : 256;
    }
    hipMemsetAsync((char*)d_ws + WS_CTL, 0, CTL_BYTES, stream);
    Params hp{};
    const float** f = (const float**)&hp;
    for (int i = 0; i < 37; ++i) f[i] = (const float*)d_in[i];
    hp.out = (float*)d_out; hp.ws = (unsigned char*)d_ws;
#if MK_N_LAUNCHES == 1
    hp.ph_lo = 0; hp.ph_hi = N_PHASES;
    hipLaunchKernelGGL(mega_fwd, dim3(grid), dim3(512), LDS_BYTES, stream, hp);
#else
    for (int ph = 0; ph < N_PHASES; ++ph) { hp.ph_lo = ph; hp.ph_hi = ph + 1; hipLaunchKernelGGL(mega_fwd, dim3(grid), dim3(512), LDS_BYTES, stream, hp); }
#endif
}
```

```cpp
#include <hip/hip_runtime.h>
#include <cstdio>
#include <cstdint>

#ifndef MK_N_LAUNCHES
#define MK_N_LAUNCHES 1
#endif

#ifndef FP8_FROM
#define FP8_FROM 0
#endif
#define LAS __attribute__((address_space(3)))
typedef unsigned short bf16_t;
typedef short bf16x8 __attribute__((ext_vector_type(8)));
typedef float f32x4 __attribute__((ext_vector_type(4)));
typedef float f32x2 __attribute__((ext_vector_type(2)));
typedef unsigned u32x4 __attribute__((ext_vector_type(4)));
typedef unsigned u32x2 __attribute__((ext_vector_type(2)));
typedef int i32x4 __attribute__((ext_vector_type(4)));
typedef int i32x8 __attribute__((ext_vector_type(8)));

constexpr int D = 1024, NB = 8, SEQ = 4096, LCX = 256, TL = NB * SEQ, TC = NB * LCX, TT = TL + TC;
constexpr int NPROJ = 1280;
constexpr int NE = 32, NCHUNK = 544;
constexpr int NTILE_MAX = 576;

constexpr size_t AL(size_t x) { return (x + 255) & ~(size_t)255; }
constexpr size_t CTL_BYTES = 65536;
constexpr size_t WS_CTL = 0;
constexpr size_t WS_MODV = WS_CTL + CTL_BYTES;
constexpr size_t WS_X = AL(WS_MODV + (size_t)2 * 9 * 6144 * 4);
constexpr size_t WS_U = AL(WS_X + (size_t)TT * D * 4);
constexpr size_t WS_PROJ = AL(WS_U + (size_t)TT * D * 2);
constexpr size_t WS_PQT = AL(WS_PROJ + (size_t)TT * NPROJ * 2);
constexpr size_t WS_PQC = AL(WS_PQT + (size_t)4096 * 4096 * 2);
constexpr size_t WS_UU = AL(WS_PQC + (size_t)2048 * 512 * 2);
constexpr size_t WS_VV = AL(WS_UU + (size_t)2304 * 2048 * 4);
constexpr size_t WS_YCX = AL(WS_VV + (size_t)2048 * 2048 * 4);
constexpr size_t WS_YCAT = AL(WS_YCX + (size_t)256 * 2048 * 4);
constexpr size_t WS_SUMM = AL(WS_YCAT + (size_t)TT * D * 2);
constexpr size_t WS_WINT = AL(WS_SUMM + (size_t)NCHUNK * 1024 * 4);
constexpr size_t WS_WFT = AL(WS_WINT + (size_t)2 * NPROJ * D * 2);
constexpr size_t WS_BIN = AL(WS_WFT + (size_t)2 * 512 * D * 2);
constexpr size_t WS_BF = AL(WS_BIN + (size_t)2 * NPROJ * 4);
constexpr size_t WS_WOUTT = AL(WS_BF + (size_t)2 * 512 * 4);
constexpr size_t WS_BOUT = AL(WS_WOUTT + (size_t)2 * D * D * 2);
constexpr size_t WS_WGUT = AL(WS_BOUT + (size_t)2 * D * 4);
constexpr size_t WS_WDT = AL(WS_WGUT + (size_t)2 * NE * 2048 * D * 2);
constexpr size_t WS_WRT = AL(WS_WDT + (size_t)2 * NE * D * D * 2);
constexpr size_t WS_WGT = AL(WS_WRT + (size_t)2 * 2 * NE * D * 2);
constexpr size_t WS_CMAT = AL(WS_WGT + (size_t)2 * 2 * 2 * 4 * 64 * 64 * 2);
constexpr size_t WS_SMAT = AL(WS_CMAT + (size_t)2304 * 4096 * 2);
constexpr size_t WS_DFTC = AL(WS_SMAT + (size_t)2048 * 4096 * 2);
constexpr size_t WS_RASG = AL(WS_DFTC + (size_t)256 * 512 * 2);
constexpr size_t WS_GATE = AL(WS_RASG + (size_t)NE * TT * 4);
constexpr size_t WS_ACT = AL(WS_GATE + (size_t)TT * 4 * 4);
constexpr size_t WS_YS = AL(WS_ACT + (size_t)NTILE_MAX * 256 * D * 2);
constexpr size_t WS_POS = AL(WS_YS + (size_t)TT * 4 * D * 2);
constexpr size_t WS_AB = AL(WS_POS + (size_t)64 * 512 * 4);
constexpr size_t WS_U8 = AL(WS_AB + (size_t)NCHUNK * 8 * 16 * 64 * 16);
constexpr size_t WS_END = AL(WS_U8 + (size_t)TT * D);
constexpr int CW_QUEUE = 12288;
constexpr int CW_COUNT = 4096;

constexpr int LDS_BYTES = 159744;
constexpr int LDS_BASE = 1024;

__device__ __forceinline__ unsigned cvt_pk_bf16(float lo, float hi) { unsigned r; asm("v_cvt_pk_bf16_f32 %0, %1, %2" : "=v"(r) : "v"(lo), "v"(hi)); return r; }
__device__ __forceinline__ bf16_t f2bf(float f) { return (bf16_t)(cvt_pk_bf16(f, 0.f) & 0xffffu); }
__device__ __forceinline__ unsigned pk4_fp8(float a, float b, float c, float d) { int w = 0; w = __builtin_amdgcn_cvt_pk_fp8_f32(a, b, w, false); w = __builtin_amdgcn_cvt_pk_fp8_f32(c, d, w, true); return (unsigned)w; }
__device__ __forceinline__ float bf2f(bf16_t b) { return __uint_as_float(((unsigned)b) << 16); }
__device__ __forceinline__ float bflo(unsigned w) { return __uint_as_float(w << 16); }
__device__ __forceinline__ float bfhi(unsigned w) { return __uint_as_float(w & 0xffff0000u); }
__device__ __forceinline__ float fexp2(float x) { return __builtin_amdgcn_exp2f(x); }
__device__ __forceinline__ float frcp(float x) { return __builtin_amdgcn_rcpf(x); }
__device__ __forceinline__ float sigmoidf_(float x) { return frcp(1.0f + fexp2(-1.4426950408889634f * x)); }
__device__ __forceinline__ int tid_() { int t = (int)threadIdx.x; asm volatile("" : "+v"(t)); return t; }
__device__ __forceinline__ float bperm(float v, int src) { return __int_as_float(__builtin_amdgcn_ds_bpermute(src << 2, __float_as_int(v))); }
__device__ __forceinline__ float wave_sum(float v, int lane) {
#pragma unroll
    for (int o = 32; o >= 1; o >>= 1) v += bperm(v, lane ^ o);
    return v;
}
__device__ __forceinline__ void unpack8(const u32x4 w, float (&f)[8]) { f[0] = bflo(w.x); f[1] = bfhi(w.x); f[2] = bflo(w.y); f[3] = bfhi(w.y); f[4] = bflo(w.z); f[5] = bfhi(w.z); f[6] = bflo(w.w); f[7] = bfhi(w.w); }
__device__ __forceinline__ u32x4 pack8(const float (&f)[8]) { u32x4 w; w.x = cvt_pk_bf16(f[0], f[1]); w.y = cvt_pk_bf16(f[2], f[3]); w.z = cvt_pk_bf16(f[4], f[5]); w.w = cvt_pk_bf16(f[6], f[7]); return w; }

#define XB_TMO      128
#define XB_XCNT(j)  (256  + 64 * (j))
#define XB_XSUB(j)  (1280 + 64 * (j))
#define XB_XGEN(j)  (2304 + 64 * (j))
#define XB_TOP      3328
#define XB_TOPGEN   3392
#define XCD_BAR_WORDS 3456
#define XB_SPIN_CAP (1u << 18)
__device__ __forceinline__ unsigned xb_ld(unsigned* p)              { return __hip_atomic_load(p, __ATOMIC_RELAXED, __HIP_MEMORY_SCOPE_AGENT); }
__device__ __forceinline__ unsigned xb_add(unsigned* p, unsigned v) { return __hip_atomic_fetch_add(p, v, __ATOMIC_RELAXED, __HIP_MEMORY_SCOPE_AGENT); }
__device__ __forceinline__ unsigned xb_xcc_id() { return (unsigned)__builtin_amdgcn_s_getreg((3 << 11) | 20) & 0xFu; }
#define XB_SPIN(cond, bar) do { unsigned _sp = 0; while (cond) { __builtin_amdgcn_s_sleep(1); \
    if ((++_sp & 255u) == 0u) { if (xb_ld(&(bar)[XB_TMO])) break; if (_sp > XB_SPIN_CAP) { atomicAdd(&(bar)[XB_TMO], 1u); break; } } } } while (0)
struct XcdBarrier { unsigned* bar; unsigned x; volatile LAS unsigned* st; };
__device__ __forceinline__ XcdBarrier xcd_barrier_post(unsigned* bar, volatile LAS unsigned* st) {
    XcdBarrier b; b.bar = bar; b.x = xb_xcc_id(); b.st = st;
    if (threadIdx.x == 0) (void)xb_add(&bar[XB_XCNT(b.x)], 1u);
    return b;
}
__device__ __forceinline__ void xcd_barrier_complete(unsigned* bar, unsigned x, unsigned& nloc, unsigned& nx) {
    const unsigned G = gridDim.x * gridDim.y * gridDim.z;
    unsigned sum, cnt, mine, sp = 0u;
    for (;;) {
        sum = 0u; cnt = 0u; mine = 0u;
#pragma unroll
        for (unsigned j = 0; j < 16; ++j) { const unsigned c = xb_ld(&bar[XB_XCNT(j)]); sum += c; cnt += (c > 0u) ? 1u : 0u; mine = (j == x) ? c : mine; }
        if (sum == G) break;
        __builtin_amdgcn_s_sleep(1);
        if ((++sp & 255u) == 0u) { if (xb_ld(&bar[XB_TMO])) break; if (sp > XB_SPIN_CAP) { atomicAdd(&bar[XB_TMO], 1u); break; } }
    }
    nloc = mine > 0u ? mine : 1u; nx = cnt > 0u ? cnt : 1u;
}
__device__ __forceinline__ void xcd_barrier(const XcdBarrier& b) {
    asm volatile("s_waitcnt vmcnt(0)" ::: "memory");
    __syncthreads();
    if (threadIdx.x == 0) {
        unsigned* bar = b.bar;
        __builtin_amdgcn_s_waitcnt(0);
        unsigned nloc = b.st[0], nx = b.st[1];
        if (nloc == 0u) { unsigned xo = b.x; asm volatile("" : "+s"(xo)); xcd_barrier_complete(bar, xo, nloc, nx); b.st[0] = nloc; b.st[1] = nx; }
        const unsigned old = xb_add(&bar[XB_XSUB(b.x)], 1u);
        const unsigned gen = old / nloc;
        if (old + 1u == (gen + 1u) * nloc) {
            __builtin_amdgcn_fence(__ATOMIC_RELEASE, "agent");
            asm volatile("s_waitcnt vmcnt(0)" ::: "memory");
            const unsigned og = xb_add(&bar[XB_TOP], 1u);
            const unsigned tg = og / nx;
            if (og + 1u == (tg + 1u) * nx) xb_add(&bar[XB_TOPGEN], 1u);
            else XB_SPIN(xb_ld(&bar[XB_TOPGEN]) == tg, bar);
            __builtin_amdgcn_fence(__ATOMIC_ACQUIRE, "agent");
            xb_add(&bar[XB_XGEN(b.x)], 1u);
            asm volatile("s_waitcnt vmcnt(0)" ::: "memory");
        } else {
            XB_SPIN(xb_ld(&bar[XB_XGEN(b.x)]) == gen, bar);
            __builtin_amdgcn_fence(__ATOMIC_ACQUIRE, "agent");
            asm volatile("s_waitcnt vmcnt(0)" ::: "memory");
        }
    }
    __syncthreads();
}

namespace g8 {
constexpr int BM = 256, BK = 64, HALF = 128, HTB = HALF * BK * 2, STAGE_BYTES = 8 * HTB;
__device__ __forceinline__ int lds_byte(int r, int c) { const int st = (r >> 4) * 2 + (c >> 5), rr = r & 15, cc = c & 31, ob = rr * 64 + cc * 2; return st * 1024 + (ob ^ (((ob >> 9) & 1) << 5)); }
__device__ __forceinline__ void stage_rc(int b, int& R, int& C) { const int st = b / 1024, sb = b % 1024, swz = sb ^ (((sb >> 9) & 1) << 5); R = (st >> 1) * 16 + swz / 64; C = (st & 1) * 32 + (swz % 64) / 2; }
__device__ __forceinline__ int perm32(int rho) { const int n = rho >> 4, i = rho & 15; return 8 * (i >> 2) + 4 * n + (i & 3); }

struct Unit { const char* a; const char* b; char* o; int kind, pm, pn, e; };

__device__ __forceinline__ int xcd_remap(int L, int nu) { const int q = nu / 8, r = nu % 8, xcd = L % 8, off = L / 8; return (xcd < r ? xcd * (q + 1) : r * (q + 1) + (xcd - r) * q) + off; }

template <class Epi, class Sched, bool GATHER, bool FP8 = false>
__device__ __forceinline__ void gemm_phase(LAS unsigned char* lds, const int K, const Sched& S, const Epi& E) {
    const int tid = tid_(), wid = __builtin_amdgcn_readfirstlane(tid >> 6), lane = tid & 63, wr = wid >> 2, wc = wid & 3, fr = lane & 15, fq = lane >> 4;
    const int nt = K / BK;
    { u32x4 vo4;
      { int R, C; stage_rc(tid * 16, R, C); const int Rb = Epi::PERM ? ((R & ~31) + perm32(R & 31)) : R; vo4.x = (unsigned)(R * K + C) * 2u; vo4.z = (unsigned)(Rb * K + C) * 2u; }
      { int R, C; stage_rc(tid * 16 + 8192, R, C); const int Rb = Epi::PERM ? ((R & ~31) + perm32(R & 31)) : R; vo4.y = (unsigned)(R * K + C) * 2u; vo4.w = (unsigned)(Rb * K + C) * 2u; }
      *(LAS u32x4*)(lds + STAGE_BYTES + 4096 + tid * 16) = vo4; asm volatile("s_waitcnt lgkmcnt(0)" ::: "memory"); }
    const size_t kstep = (size_t)(BK * 2);
    const size_t hstep = (size_t)HALF * K * 2;
    const unsigned ldsw = (unsigned)wid * 1024u;
    const int aoff = lds_byte(wr * 64 + fr, fq * 8), boff = lds_byte(wc * 32 + fr, fq * 8);
#define G8_SA(b, h) (((b) * 2 + (h)) * HTB)
#define G8_SB(b, h) ((4 + (b) * 2 + (h)) * HTB)
#define G8_ST2(bufoff, gbase, isb) do { const u32x2 _v2 = *(const LAS u32x2*)(lds + STAGE_BYTES + 4096 + tid_() * 16 + (isb) * 8); _Pragma("unroll") for (int _i = 0; _i < 2; ++_i) { unsigned _vo = _i ? _v2.y : _v2.x; asm volatile("" : "+v"(_vo)); \
        __builtin_amdgcn_global_load_lds((const unsigned*)((const char*)(gbase) + _vo), (LAS unsigned*)(lds + (bufoff) + ldsw + _i * 8192), 16, 0, 0); } } while (0)
#define G8_STA_CUR(bufoff, gbase, h) do { if constexpr (GATHER) { const int _t = tid_(); _Pragma("unroll") for (int _i = 0; _i < 2; ++_i) { int _R, _C; stage_rc(_t * 16 + _i * 8192, _R, _C); unsigned _o = ROFF[parA * 256 + (h) * 128 + _R] + (unsigned)(_C * 2); asm volatile("" : "+v"(_o)); \
        __builtin_amdgcn_global_load_lds((const unsigned*)((const char*)(gbase) + _o), (LAS unsigned*)(lds + (bufoff) + ldsw + _i * 8192), 16, 0, 0); } } else { G8_ST2(bufoff, (gbase) + (h) * hstep, 0); } } while (0)
#define G8_LDA(dst, dst8, b, h) do { _Pragma("unroll") for (int m = 0; m < 4; ++m) { if constexpr (FP8) { const i32x4 lo_ = *(const LAS i32x4*)(lds + G8_SA(b, h) + aoff + m * 2048), hi_ = *(const LAS i32x4*)(lds + G8_SA(b, h) + aoff + m * 2048 + 1024); dst8[m] = __builtin_shufflevector(lo_, hi_, 0, 1, 2, 3, 4, 5, 6, 7); } \
        else { _Pragma("unroll") for (int k = 0; k < 2; ++k) dst[m][k] = *(const LAS bf16x8*)(lds + G8_SA(b, h) + aoff + m * 2048 + k * 1024); } } } while (0)
#define G8_LDB(dst, dst8, b, h) do { _Pragma("unroll") for (int n = 0; n < 2; ++n) { if constexpr (FP8) { const i32x4 lo_ = *(const LAS i32x4*)(lds + G8_SB(b, h) + boff + n * 2048), hi_ = *(const LAS i32x4*)(lds + G8_SB(b, h) + boff + n * 2048 + 1024); dst8[n] = __builtin_shufflevector(lo_, hi_, 0, 1, 2, 3, 4, 5, 6, 7); } \
        else { _Pragma("unroll") for (int k = 0; k < 2; ++k) dst[n][k] = *(const LAS bf16x8*)(lds + G8_SB(b, h) + boff + n * 2048 + k * 1024); } } } while (0)
#define G8_MMA(ai, bj, At, At8, Bt, Bt8) do { __builtin_amdgcn_s_setprio(1); _Pragma("unroll") for (int m = 0; m < 4; ++m) _Pragma("unroll") for (int n = 0; n < 2; ++n) { \
        if constexpr (FP8) acc[ai][bj][m][n] = __builtin_amdgcn_mfma_scale_f32_16x16x128_f8f6f4(Bt8[n], At8[m], acc[ai][bj][m][n], 0, 0, 0, 0, 0, 0);     \
        else { _Pragma("unroll") for (int k = 0; k < 2; ++k) acc[ai][bj][m][n] = __builtin_amdgcn_mfma_f32_16x16x32_bf16(Bt[n][k], At[m][k], acc[ai][bj][m][n], 0, 0, 0); } } __builtin_amdgcn_s_setprio(0); } while (0)
#define G8_WAIT_V(n) asm volatile("s_waitcnt vmcnt(" #n ")" ::: "memory")
#define G8_WAIT_L(n) asm volatile("s_waitcnt lgkmcnt(" #n ")" ::: "memory")
#define G8_BAR __builtin_amdgcn_s_barrier()
#define G8_SCHED __builtin_amdgcn_sched_barrier(0)
    Unit cur, nxt; int ui = 0;
    if (!S.next(0, cur)) return;
    f32x4 acc[2][2][4][2];
#pragma unroll
    for (int a = 0; a < 2; ++a)
#pragma unroll
        for (int b = 0; b < 2; ++b)
#pragma unroll
            for (int m = 0; m < 4; ++m)
#pragma unroll
                for (int n = 0; n < 2; ++n) acc[a][b][m][n] = (f32x4){0.f, 0.f, 0.f, 0.f};
    bf16x8 At[4][2], B0[2][2], B1[2][2]; i32x8 At8[4], B08[2], B18[2];
    LAS unsigned* ROFF = (LAS unsigned*)(lds + STAGE_BYTES + 1024);
    LAS unsigned* SIDE = (LAS unsigned*)(lds + STAGE_BYTES + 12288);
    unsigned sv0 = 0u, sv1 = 0u, sv2 = 0u;
    unsigned pend = 0u; int parA = 0;
    if constexpr (GATHER) {
        if (tid < 256) ROFF[tid] = (unsigned)S.row(cur, tid) * (unsigned)(K * 2);
        asm volatile("s_waitcnt lgkmcnt(0)" ::: "memory"); __builtin_amdgcn_s_barrier(); asm volatile("" ::: "memory");
    }
    const char* cA = cur.a; const char* cB = cur.b;
    G8_ST2(G8_SB(0, 0), cB, 1); G8_ST2(G8_SB(0, 1), cB + hstep, 1); G8_STA_CUR(G8_SA(0, 0), cA, 0); G8_STA_CUR(G8_SA(0, 1), cA, 1);
    if (wr == 1) G8_BAR;
    G8_WAIT_V(2); G8_BAR;
    G8_ST2(G8_SB(1, 0), cB + kstep, 1); G8_STA_CUR(G8_SA(1, 0), cA + kstep, 0); G8_ST2(G8_SB(1, 1), cB + hstep + kstep, 1);
    G8_WAIT_V(6); G8_BAR;
    for (;;) {
        const bool has_next = S.next(ui + 1, nxt);
        const char* nA = has_next ? nxt.a : cA; const char* nB = has_next ? nxt.b : cB;
#pragma clang loop unroll(disable)
        for (int t = 0; t < nt; t += 2) {
            const bool last = (t == nt - 2);
            int to = t; asm volatile("" : "+s"(to));
            const char* a1 = cA + (size_t)(to + 1) * kstep;
            const char* a2 = last ? nA : cA + (size_t)(to + 2) * kstep; const char* b2 = last ? nB : cB + (size_t)(to + 2) * kstep;
            const char* a3 = a2 + kstep; const char* b3 = b2 + kstep;
            { const int ts_ = tid_(); if (ts_ < 256) { if (t == 0) E.side0(cur, ts_, sv0, sv1, sv2); else if (t == 2) E.side1(cur, ts_, sv0, sv1, sv2);
                  else if (t == 4) { LAS unsigned* sd_ = SIDE + (ui & 1) * 768; sd_[ts_] = sv0; sd_[256 + ts_] = sv1; sd_[512 + ts_] = sv2; } } }
            if constexpr (GATHER) {
                const int t_ = tid_();
                if (has_next && t == nt - 4 && t_ < 256) pend = (unsigned)S.row(nxt, t_) * (unsigned)(K * 2);
                if (has_next && last && t_ < 256) ROFF[(parA ^ 1) * 256 + t_] = pend; }
            G8_LDB(B0, B08, 0, 0); G8_LDB(B1, B18, 0, 1); G8_SCHED; G8_LDA(At, At8, 0, 0); G8_STA_CUR(G8_SA(1, 1), a1, 1);
            if constexpr (GATHER) { if (has_next && last) parA ^= 1; }
            G8_WAIT_V(8); G8_WAIT_L(0); G8_BAR; G8_MMA(0, 0, At, At8, B0, B08); G8_MMA(0, 1, At, At8, B1, B18); G8_BAR; G8_SCHED;
            G8_LDA(At, At8, 0, 1); G8_ST2(G8_SB(0, 0), b2, 1); G8_ST2(G8_SB(0, 1), b2 + hstep, 1); G8_STA_CUR(G8_SA(0, 0), a2, 0);
            G8_WAIT_V(8); G8_WAIT_L(0); G8_BAR; G8_MMA(1, 0, At, At8, B0, B08); G8_MMA(1, 1, At, At8, B1, B18); G8_BAR; G8_SCHED;
            G8_LDB(B0, B08, 1, 0); G8_LDB(B1, B18, 1, 1); G8_SCHED; G8_LDA(At, At8, 1, 0); G8_STA_CUR(G8_SA(0, 1), a2, 1);
            G8_WAIT_V(8); G8_WAIT_L(0); G8_BAR; G8_MMA(0, 0, At, At8, B0, B08); G8_MMA(0, 1, At, At8, B1, B18); G8_BAR; G8_SCHED;
            G8_LDA(At, At8, 1, 1); G8_ST2(G8_SB(1, 0), b3, 1); G8_ST2(G8_SB(1, 1), b3 + hstep, 1); G8_STA_CUR(G8_SA(1, 0), a3, 0);
            G8_WAIT_V(8); G8_WAIT_L(0); G8_BAR; G8_MMA(1, 0, At, At8, B0, B08); G8_MMA(1, 1, At, At8, B1, B18); G8_BAR; G8_SCHED;
        }
        if (wr == 0) G8_BAR;
        E(acc, cur, wr, wc, fr, fq, (const LAS unsigned*)(SIDE + (ui & 1) * 768));
        if (!has_next) break;
#pragma unroll
        for (int a = 0; a < 2; ++a)
#pragma unroll
            for (int b = 0; b < 2; ++b)
#pragma unroll
                for (int m = 0; m < 4; ++m)
#pragma unroll
                    for (int n = 0; n < 2; ++n) acc[a][b][m][n] = (f32x4){0.f, 0.f, 0.f, 0.f};
        cur = nxt; cA = nA; cB = nB; ++ui;
        if (wr == 1) G8_BAR;
    }
    G8_WAIT_V(0);
    G8_BAR;
#undef G8_SA
#undef G8_SB
#undef G8_ST2
#undef G8_STA_CUR
#undef G8_LDA
#undef G8_LDB
#undef G8_MMA
#undef G8_WAIT_V
#undef G8_WAIT_L
#undef G8_BAR
#undef G8_SCHED
}
}

struct Params {
    const float *x, *c, *ctx, *c_ctx, *w_mod, *b_mod, *norm1_g, *norm2_g, *w_in, *b_in, *conv_a_w, *conv_a_b, *w_rg_r, *b_rg_r, *w_rg_i, *b_rg_i, *rg_lambda,
        *w_pool, *b_pool, *pool_scale, *w_four, *b_four, *conv_d_w, *conv_d_b, *ln_d_g, *ln_d_b, *w_pw, *b_pw, *w_out, *b_out, *w_router, *b_router,
        *w_gu, *b_gu, *w_down, *b_down, *final_norm_g;
    float* out; unsigned char* ws; int ph_lo, ph_hi;
};
typedef const Params __attribute__((address_space(4)))* CP;
__device__ __forceinline__ CP launder_params() { CP k = (CP)__builtin_amdgcn_kernarg_segment_ptr(); asm volatile("" : "+s"(k)); return k; }
__device__ __forceinline__ int row_mb(int row) { return row < TL ? (row >> 12) : 8; }

template <class RowMap>
__device__ __forceinline__ void tr_block(const float* __restrict__ src, int spitch, int k0, int n0, bf16_t* __restrict__ dst, int dpitch, int kd0, RowMap rm, LAS unsigned char* lds) {
    LAS unsigned* T = (LAS unsigned*)lds;
    const int tid = tid_();
    __syncthreads();
#pragma unroll
    for (int it = 0; it < 4; ++it) { const int task = it * 512 + tid, q = task & 63, kp = task >> 6;
        const f32x4 v0 = *(const f32x4*)(src + (size_t)(k0 + 2 * kp) * spitch + n0 + 4 * q), v1 = *(const f32x4*)(src + (size_t)(k0 + 2 * kp + 1) * spitch + n0 + 4 * q);
        u32x4 w; w.x = cvt_pk_bf16(v0[0], v1[0]); w.y = cvt_pk_bf16(v0[1], v1[1]); w.z = cvt_pk_bf16(v0[2], v1[2]); w.w = cvt_pk_bf16(v0[3], v1[3]);
        *(LAS u32x4*)(T + kp * 260 + 4 * q) = w; }
    __syncthreads();
#pragma unroll
    for (int it = 0; it < 4; ++it) { const int n = tid & 255, c = (tid >> 8) * 4 + it;
        u32x4 w; w.x = T[(4 * c + 0) * 260 + n]; w.y = T[(4 * c + 1) * 260 + n]; w.z = T[(4 * c + 2) * 260 + n]; w.w = T[(4 * c + 3) * 260 + n];
        *(u32x4*)(dst + (size_t)rm(n0 + n) * dpitch + kd0 + 8 * c) = w; }
}
template <class RowMap>
__device__ __forceinline__ void tr_block8(const float* __restrict__ src, int spitch, int k0, int n0, unsigned char* __restrict__ dst, int dpitch, int kd0, RowMap rm, LAS unsigned char* lds) {
    LAS unsigned* T = (LAS unsigned*)lds;
    const int tid = tid_();
    __syncthreads();
#pragma unroll
    for (int it = 0; it < 4; ++it) { const int task = it * 512 + tid, q = task & 63, kq = task >> 6; f32x4 v[4];
#pragma unroll
        for (int r = 0; r < 4; ++r) v[r] = *(const f32x4*)(src + (size_t)(k0 + 4 * kq + r) * spitch + n0 + 4 * q) * 64.0f;
        u32x4 w; w.x = pk4_fp8(v[0][0], v[1][0], v[2][0], v[3][0]); w.y = pk4_fp8(v[0][1], v[1][1], v[2][1], v[3][1]); w.z = pk4_fp8(v[0][2], v[1][2], v[2][2], v[3][2]); w.w = pk4_fp8(v[0][3], v[1][3], v[2][3], v[3][3]);
        *(LAS u32x4*)(T + kq * 260 + 4 * q) = w; }
    __syncthreads();
#pragma unroll
    for (int it = 0; it < 4; ++it) { const int n = tid & 255, c = (tid >> 8) * 4 + it;
        u32x4 w; w.x = T[(4 * c + 0) * 260 + n]; w.y = T[(4 * c + 1) * 260 + n]; w.z = T[(4 * c + 2) * 260 + n]; w.w = T[(4 * c + 3) * 260 + n];
        *(u32x4*)(dst + (size_t)rm(n0 + n) * dpitch + kd0 + 16 * c) = w; }
}
struct RmId { int off; __device__ __forceinline__ int operator()(int n) const { return n + off; } };
struct RmGu { __device__ __forceinline__ int operator()(int n) const { const int rem = n & 1023; return 256 * (rem >> 7) + 128 * (n >> 10) + (rem & 127); } };
struct RmIn { __device__ __forceinline__ int operator()(int n) const { return n < 512 ? n : n - 1024 + 768; } };

__device__ __forceinline__ void job_mod(CP p, int l, int cb, LAS unsigned char* lds) {
    LAS float* SC = (LAS float*)lds;
    LAS float* RED = (LAS float*)(lds + 49152);
    const int tid = tid_();
    __syncthreads();
    for (int i = tid; i < 9 * 1024; i += 512) { const int b = i >> 10, k = i & 1023; const float v = b < 8 ? p->c[b * 1024 + k] : p->c_ctx[k]; SC[k * 12 + b] = v * sigmoidf_(v); }
    __syncthreads();
    const int col = cb * 64 + (tid & 63), kg = tid >> 6;
    float acc[9];
#pragma unroll
    for (int b = 0; b < 9; ++b) acc[b] = 0.f;
    const float* wp = p->w_mod + (size_t)l * 1024 * 6144 + col;
#pragma unroll 8
    for (int kk = 0; kk < 128; ++kk) { const int k = kg * 128 + kk; const float w = wp[(size_t)k * 6144];
        const f32x4 s0 = *(const LAS f32x4*)(SC + k * 12), s1 = *(const LAS f32x4*)(SC + k * 12 + 4); const float s8 = SC[k * 12 + 8];
        acc[0] += s0[0] * w; acc[1] += s0[1] * w; acc[2] += s0[2] * w; acc[3] += s0[3] * w; acc[4] += s1[0] * w; acc[5] += s1[1] * w; acc[6] += s1[2] * w; acc[7] += s1[3] * w; acc[8] += s8 * w; }
#pragma unroll
    for (int b = 0; b < 9; ++b) RED[(kg * 9 + b) * 64 + (tid & 63)] = acc[b];
    __syncthreads();
    for (int i = tid; i < 9 * 64; i += 512) { const int b = i >> 6, cc = i & 63; float s = 0.f;
#pragma unroll
        for (int g = 0; g < 8; ++g) s += RED[(g * 9 + b) * 64 + cc];
        ((float*)(p->ws + WS_MODV))[(size_t)(l * 9 + b) * 6144 + cb * 64 + cc] = s + p->b_mod[l * 6144 + cb * 64 + cc]; }
}
__device__ __forceinline__ void job_fold_out(CP p, int l, int nb, LAS unsigned char* lds) {
    LAS float* WO = (LAS float*)lds;
    LAS float* PW = (LAS float*)(lds + 65536);
    const int tid = tid_(), lane = tid & 63, w = __builtin_amdgcn_readfirstlane(tid >> 6);
    __syncthreads();
#pragma unroll
    for (int it = 0; it < 8; ++it) { const int task = it * 512 + tid, j = task >> 4, q = task & 15;
        *(LAS f32x4*)(WO + j * 64 + 4 * q) = *(const f32x4*)(p->w_out + ((size_t)l * 1024 + 768 + j) * 1024 + nb * 64 + 4 * q); }
    float acc[32];
#pragma unroll
    for (int i = 0; i < 32; ++i) acc[i] = 0.f;
    for (int jc = 0; jc < 4; ++jc) {
        __syncthreads();
#pragma unroll
        for (int it = 0; it < 8; ++it) { const int task = it * 512 + tid, i = task & 255, jq = task >> 8;
            const f32x4 v = *(const f32x4*)(p->w_pw + ((size_t)l * 256 + i) * 256 + jc * 64 + 4 * jq);
            PW[(4 * jq + 0) * 256 + i] = v[0]; PW[(4 * jq + 1) * 256 + i] = v[1]; PW[(4 * jq + 2) * 256 + i] = v[2]; PW[(4 * jq + 3) * 256 + i] = v[3]; }
        __syncthreads();
        for (int jj = 0; jj < 64; ++jj) { const float b = WO[(jc * 64 + jj) * 64 + lane];
#pragma unroll
            for (int i4 = 0; i4 < 8; ++i4) { const f32x4 a = *(const LAS f32x4*)(PW + jj * 256 + 32 * w + 4 * i4);
                acc[4 * i4 + 0] += a[0] * b; acc[4 * i4 + 1] += a[1] * b; acc[4 * i4 + 2] += a[2] * b; acc[4 * i4 + 3] += a[3] * b; } }
    }
    bf16_t* dst = (bf16_t*)(p->ws + WS_WOUTT) + ((size_t)l * 1024 + nb * 64 + lane) * 1024 + 768 + 32 * w;
#pragma unroll
    for (int c = 0; c < 4; ++c) { float f[8];
#pragma unroll
        for (int e = 0; e < 8; ++e) f[e] = acc[8 * c + e];
        *(u32x4*)(dst + 8 * c) = pack8(f); }
    if (w == 0) { float s = p->b_out[l * 1024 + nb * 64 + lane];
        for (int j = 0; j < 256; ++j) s += p->b_pw[l * 256 + j] * WO[j * 64 + lane];
        ((float*)(p->ws + WS_BOUT))[l * 1024 + nb * 64 + lane] = s; }
}
__device__ __forceinline__ void job_fold_in(CP p, int l, int f, int g, int kb, LAS unsigned char* lds) {
    LAS float* M = (LAS float*)lds;
    LAS float* WI = (LAS float*)(lds + 16384);
    const int tid = tid_();
    const int cbase = f == 0 ? 512 : 768;
    LAS float* TRG = (LAS float*)(lds + 16384 + 256 * 65 * 4);
    __syncthreads();
    if (tid < 64) TRG[tid] = f == 2 ? sinpif((float)tid * (1.0f / 32.0f)) : cospif((float)tid * (1.0f / 32.0f));
    __syncthreads();
#pragma unroll
    for (int it = 0; it < 8; ++it) { const int id = it * 512 + tid, i = id >> 6, j = id & 63; float s;
        if (f == 0) s = p->w_pool[(((size_t)l * 4 + g) * 64 + i) * 64 + j];
        else { s = 0.f; for (int m = 0; m < 64; ++m) s += TRG[(i * m) & 63] * p->w_four[(((size_t)l * 4 + g) * 64 + m) * 64 + j]; }
        M[i * 64 + j] = s; }
#pragma unroll
    for (int it = 0; it < 8; ++it) { const int task = it * 512 + tid, kk = task >> 4, i4 = task & 15;
        const f32x4 v = *(const f32x4*)(p->w_in + ((size_t)l * 1024 + kb * 256 + kk) * 1536 + cbase + 64 * g + 4 * i4);
        WI[kk * 65 + 4 * i4 + 0] = v[0]; WI[kk * 65 + 4 * i4 + 1] = v[1]; WI[kk * 65 + 4 * i4 + 2] = v[2]; WI[kk * 65 + 4 * i4 + 3] = v[3]; }
    __syncthreads();
    const int kk = tid & 255, jh = tid >> 8;
    float acc[32];
#pragma unroll
    for (int j = 0; j < 32; ++j) acc[j] = 0.f;
    for (int i = 0; i < 64; ++i) { const float a = WI[kk * 65 + i];
#pragma unroll
        for (int j4 = 0; j4 < 8; ++j4) { const f32x4 m = *(const LAS f32x4*)(M + i * 64 + 32 * jh + 4 * j4);
            acc[4 * j4 + 0] += a * m[0]; acc[4 * j4 + 1] += a * m[1]; acc[4 * j4 + 2] += a * m[2]; acc[4 * j4 + 3] += a * m[3]; } }
    bf16_t* dst = f == 0 ? (bf16_t*)(p->ws + WS_WINT) + ((size_t)l * NPROJ + 512 + 64 * g) * 1024 : (bf16_t*)(p->ws + WS_WFT) + ((size_t)l * 512 + (f - 1) * 256 + 64 * g) * 1024;
#pragma unroll
    for (int j = 0; j < 32; ++j) dst[(size_t)(32 * jh + j) * 1024 + kb * 256 + kk] = f2bf(acc[j]);
    if (kb == 0 && f >= 1 && tid < 64) { float s = 0.f;
        for (int i = 0; i < 64; ++i) s += p->b_in[l * 1536 + 768 + 64 * g + i] * M[i * 64 + tid];
        ((float*)(p->ws + WS_BF))[l * 512 + (f - 1) * 256 + 64 * g + tid] = s; }
    if (kb == 0 && f == 0 && g == 0) for (int i = tid; i < NPROJ; i += 512)
        ((float*)(p->ws + WS_BIN))[l * NPROJ + i] = i < 512 ? p->b_in[l * 1536 + i] : (i < 768 ? 0.f : p->b_in[l * 1536 + i - 768 + 1024]);
}
__device__ __forceinline__ void job_small(CP p, int j) {
    const int tid = tid_();
    if (j < 32) {
        const int l = j >> 4, d = (j >> 3) & 1, gate = (j >> 2) & 1, hd = j & 3;
        const float* src = (gate ? p->w_rg_i : p->w_rg_r) + ((size_t)((l * 2 + d) * 4 + hd)) * 4096;
        bf16_t* dst = (bf16_t*)(p->ws + WS_WGT) + (size_t)j * 4096;
        for (int id = tid; id < 4096; id += 512) { const int n = id >> 6, k = id & 63; dst[id] = f2bf(src[k * 64 + n]); }
        return; }
    j -= 32;
    if (j < 2) {
        const int l = j; bf16_t* hi = (bf16_t*)(p->ws + WS_WRT) + (size_t)l * 2 * NE * 1024; bf16_t* lo = hi + NE * 1024;
        for (int id = tid; id < NE * 1024; id += 512) { const int e = id >> 10, c = id & 1023; const float v = p->w_router[((size_t)l * 1024 + c) * NE + e];
            const bf16_t h = f2bf(v); hi[id] = h; lo[id] = f2bf(v - bf2f(h)); }
        return; }
    j -= 2;
    if (j < 144 + 128) {
        const bool sn = j >= 144; const int r0 = (sn ? j - 144 : j) * 16; unsigned* dst = (unsigned*)(p->ws + (sn ? WS_SMAT : WS_CMAT));
        for (int id = tid; id < 16 * 1024; id += 512) { const int k = r0 + (id >> 10), t4 = (id & 1023) * 4; float v[4];
#pragma unroll
            for (int e = 0; e < 4; ++e) { const float ang = (float)((k * (t4 + e)) & 4095) * (1.0f / 2048.0f); v[e] = 64.0f * (sn ? sinpif(ang) : cospif(ang)); }
            dst[((size_t)k * 4096 + t4) >> 2] = pk4_fp8(v[0], v[1], v[2], v[3]); }
        return; }
    j -= 272;
    if (j == 1) {
        float* dst = (float*)(p->ws + WS_POS);
        for (int id = tid; id < 64 * 512; id += 512) { const int pp = id >> 9, jj = id & 511, i = jj & 255; const float a = (float)pp * exp2f(-(float)i * (13.287712379549449f / 256.0f));
            dst[id] = jj < 256 ? sinf(a) : cosf(a); }
        return; }
    {
        unsigned* dst = (unsigned*)(p->ws + WS_DFTC);
        for (int id = tid; id < 256 * 128; id += 512) { const int k = id >> 7, j4 = (id & 127) * 4; float v[4];
#pragma unroll
            for (int e = 0; e < 4; ++e) { const int jj = j4 + e, t = jj & 255; const float ang = (float)((k * t) & 255) * (1.0f / 128.0f); v[e] = 64.0f * (jj < 256 ? cospif(ang) : -sinpif(ang)); }
            dst[id] = pk4_fp8(v[0], v[1], v[2], v[3]); }
    }
}
#ifndef MOE_W_IN_QUEUE
#define MOE_W_IN_QUEUE 0
#endif
constexpr bool fp8_layer(int l) { return l >= FP8_FROM; }
constexpr int J_TGU_L(int l) { return fp8_layer(l) ? 32 * 8 * 8 : 32 * 16 * 8; }
constexpr int J_TD_L(int l) { return fp8_layer(l) ? 32 * 8 * 4 : 32 * 16 * 4; }
constexpr int J_MOD = 192, J_FOUT = 32, J_FIN = 96, J_SMALL = 32 + 2 + 272 + 2, J_TIN = 128, J_TOUT = 96, J_TGU = J_TGU_L(0) + J_TGU_L(1), J_TD = J_TD_L(0) + J_TD_L(1);
static_assert(!MOE_W_IN_QUEUE || (J_TGU_L(0) + J_TD_L(0) <= 6 * NCHUNK && J_TGU_L(1) + J_TD_L(1) <= 6 * NCHUNK), "the phase-3 queue interleaves at most 2 weight jobs per compute unit: needs fp8 expert weights in both layers");
constexpr int J_TOTAL = J_MOD + J_FOUT + J_FIN + J_SMALL + J_TIN + J_TOUT + (MOE_W_IN_QUEUE ? 0 : J_TGU + J_TD);
template <class RowMap>
__device__ __forceinline__ void tr8_slab(const float* __restrict__ src, int spitch, int k0, int n4, unsigned char* __restrict__ dst, int dpitch, RowMap rm) {
    f32x4 v[16];
#pragma unroll
    for (int r = 0; r < 16; ++r) v[r] = *(const f32x4*)(src + (size_t)(k0 + r) * spitch + n4) * 64.0f;
#pragma unroll
    for (int j = 0; j < 4; ++j) { u32x4 w; w.x = pk4_fp8(v[0][j], v[1][j], v[2][j], v[3][j]); w.y = pk4_fp8(v[4][j], v[5][j], v[6][j], v[7][j]); w.z = pk4_fp8(v[8][j], v[9][j], v[10][j], v[11][j]); w.w = pk4_fp8(v[12][j], v[13][j], v[14][j], v[15][j]);
        *(u32x4*)(dst + (size_t)rm(n4 + j) * dpitch + k0) = w; }
}
struct W8Job { const float* src; unsigned char* dst; int spitch, gu; };
__device__ __forceinline__ bool w8_job(CP p, int jm, W8Job& J, int& n0) {
    constexpr int PER_L = 32 * 64 + 32 * 32; if (jm >= 2 * PER_L) return false;
    const int l = jm / PER_L; int jj = jm - l * PER_L;
    if (jj < 32 * 64) { const int e = jj >> 6, r = jj & 63, kb = r >> 3, q = r & 7; J.spitch = 2048; J.gu = 1; n0 = q * 256;
        J.src = p->w_gu + ((size_t)(l * NE + e) * 1024 + kb * 128) * 2048 + n0; J.dst = p->ws + WS_WGUT + (size_t)l * NE * 2048 * 2048 + (size_t)e * 2048 * 1024 + kb * 128; }
    else { jj -= 32 * 64; const int e = jj >> 5, r = jj & 31, kb = r >> 2, q = r & 3; J.spitch = 1024; J.gu = 0; n0 = q * 256;
        J.src = p->w_down + ((size_t)(l * NE + e) * 1024 + kb * 128) * 1024 + n0; J.dst = p->ws + WS_WDT + (size_t)l * NE * 1024 * 2048 + (size_t)e * 1024 * 1024 + kb * 128; }
    return true;
}
__device__ __forceinline__ void w8_load(const W8Job& J, int tid, f32x4 (&v)[4][4]) {
#pragma unroll
    for (int it = 0; it < 4; ++it) { const int task = it * 512 + tid, q = task & 63, kq = task >> 6;
#pragma unroll
        for (int r = 0; r < 4; ++r) v[it][r] = *(const f32x4*)(J.src + (size_t)(4 * kq + r) * J.spitch + 4 * q); }
}
__device__ __forceinline__ void w8_finish(const W8Job& J, int n0, int tid, const f32x4 (&v)[4][4], LAS unsigned char* lds) {
    LAS unsigned* T = (LAS unsigned*)lds;
    __syncthreads();
#pragma unroll
    for (int it = 0; it < 4; ++it) { const int task = it * 512 + tid, q = task & 63, kq = task >> 6;
        u32x4 w; w.x = pk4_fp8(v[it][0][0] * 64.f, v[it][1][0] * 64.f, v[it][2][0] * 64.f, v[it][3][0] * 64.f); w.y = pk4_fp8(v[it][0][1] * 64.f, v[it][1][1] * 64.f, v[it][2][1] * 64.f, v[it][3][1] * 64.f);
        w.z = pk4_fp8(v[it][0][2] * 64.f, v[it][1][2] * 64.f, v[it][2][2] * 64.f, v[it][3][2] * 64.f); w.w = pk4_fp8(v[it][0][3] * 64.f, v[it][1][3] * 64.f, v[it][2][3] * 64.f, v[it][3][3] * 64.f);
        *(LAS u32x4*)(T + kq * 260 + 4 * q) = w; }
    __syncthreads();
    if (tid < 256) {
        const int n = tid, nn = n0 + n; const int row = J.gu ? RmGu{}(nn) : nn; u32x4 w[8];
#pragma unroll
        for (int c = 0; c < 8; ++c) { w[c].x = T[(4 * c + 0) * 260 + n]; w[c].y = T[(4 * c + 1) * 260 + n]; w[c].z = T[(4 * c + 2) * 260 + n]; w[c].w = T[(4 * c + 3) * 260 + n]; }
#pragma unroll
        for (int c = 0; c < 8; ++c) *(u32x4*)(J.dst + (size_t)row * 1024 + 16 * c) = w[c]; }
}
__device__ __forceinline__ void moe_weight_job(CP p, int l, int jj, LAS unsigned char* lds) {
    const bool f8 = l >= FP8_FROM;
    if (jj < (f8 ? 32 * 8 * 8 : 32 * 16 * 8)) { const float* src = p->w_gu + (size_t)l * NE * 1024 * 2048; unsigned char* dstb = p->ws + WS_WGUT + (size_t)l * NE * 2048 * 2048;
        if (f8) { const int e = jj >> 6, r = jj & 63, kb = r >> 3, q = r & 7; tr_block8(src + (size_t)e * 1024 * 2048, 2048, kb * 128, q * 256, dstb + (size_t)e * 2048 * 1024, 1024, kb * 128, RmGu{}, lds); }
        else { const int e = jj >> 7, r = jj & 127, kb = r >> 3, q = r & 7; tr_block(src + (size_t)e * 1024 * 2048, 2048, kb * 64, q * 256, (bf16_t*)dstb + (size_t)e * 2048 * 1024, 1024, kb * 64, RmGu{}, lds); }
        return; }
    jj -= (f8 ? 32 * 8 * 8 : 32 * 16 * 8);
    { const float* src = p->w_down + (size_t)l * NE * 1024 * 1024; unsigned char* dstb = p->ws + WS_WDT + (size_t)l * NE * 1024 * 2048;
        if (f8) { const int e = jj >> 5, r = jj & 31, kb = r >> 2, q = r & 3; tr_block8(src + (size_t)e * 1024 * 1024, 1024, kb * 128, q * 256, dstb + (size_t)e * 1024 * 1024, 1024, kb * 128, RmId{0}, lds); }
        else { const int e = jj >> 6, r = jj & 63, kb = r >> 2, q = r & 3; tr_block(src + (size_t)e * 1024 * 1024, 1024, kb * 64, q * 256, (bf16_t*)dstb + (size_t)e * 1024 * 1024, 1024, kb * 64, RmId{0}, lds); } }
}
constexpr bool W8_PIPE = (FP8_FROM == 0) && !MOE_W_IN_QUEUE;
#ifndef PRO_PART
#define PRO_PART 0
#endif
__device__ __forceinline__ int q_pull(unsigned* head, LAS int* slot) {
    __syncthreads(); if (tid_() == 0) *slot = (int)__hip_atomic_fetch_add(head, 1u, __ATOMIC_RELAXED, __HIP_MEMORY_SCOPE_AGENT); __syncthreads();
    return __builtin_amdgcn_readfirstlane(*slot);
}
__device__ __forceinline__ void phase_prologue(CP p, LAS unsigned char* lds, int rep) {
    unsigned* qs = (unsigned*)(p->ws + WS_CTL) + CW_QUEUE + (4 + rep) * 64; unsigned* qw = (unsigned*)(p->ws + WS_CTL) + CW_QUEUE + (6 + rep) * 64; LAS int* qslot = (LAS int*)(lds - LDS_BASE + 64);
    const int njobs = (rep && PRO_PART == 1) ? 0 : J_TOTAL - (W8_PIPE ? J_TGU + J_TD : 0);
    if (!W8_PIPE || (blockIdx.x & 1) == 0) for (;;) {
        int j = q_pull(qs, qslot); if (j >= njobs) break;
        if (j < J_FIN) { const int l = j / 48, r = j % 48; job_fold_in(p, l, r / 16, (r >> 2) & 3, r & 3, lds); continue; } j -= J_FIN;
        if (j < J_FOUT) { job_fold_out(p, j >> 4, j & 15, lds); continue; } j -= J_FOUT;
        if (j < J_MOD) { job_mod(p, j / 96, j % 96, lds); continue; } j -= J_MOD;
        if (j < J_SMALL) { job_small(p, j); continue; } j -= J_SMALL;
        if (j < J_TIN) { const int l = j >> 6, r = j & 63, kb = r >> 2, q = r & 3;
            tr_block(p->w_in + (size_t)l * 1024 * 1536, 1536, kb * 64, q < 2 ? q * 256 : 1024 + (q - 2) * 256, (bf16_t*)(p->ws + WS_WINT) + (size_t)l * NPROJ * 1024, 1024, kb * 64, RmIn{}, lds); continue; } j -= J_TIN;
        if (j < J_TOUT) { const int l = j / 48, r = j % 48, kb = r >> 2, q = r & 3;
            tr_block(p->w_out + (size_t)l * 1024 * 1024, 1024, kb * 64, q * 256, (bf16_t*)(p->ws + WS_WOUTT) + (size_t)l * 1024 * 1024, 1024, kb * 64, RmId{0}, lds); continue; } j -= J_TOUT;
        moe_weight_job(p, j < J_TGU_L(0) + J_TD_L(0) ? 0 : 1, j < J_TGU_L(0) + J_TD_L(0) ? j : j - J_TGU_L(0) - J_TD_L(0), lds);
    }
    if (W8_PIPE && !(rep && PRO_PART == 2)) { const int tid = tid_(); W8Job Jc, Jn; int nc = 0, nn_ = 0; f32x4 va[4][4], vb[4][4];
        bool okc = w8_job(p, q_pull(qw, qslot), Jc, nc); if (okc) w8_load(Jc, tid, va);
        while (okc) {
            const bool okn = w8_job(p, q_pull(qw, qslot), Jn, nn_); if (okn) w8_load(Jn, tid, vb);
            w8_finish(Jc, nc, tid, va, lds);
            if (!okn) break;
            okc = w8_job(p, q_pull(qw, qslot), Jc, nc); if (okc) w8_load(Jc, tid, va);
            w8_finish(Jn, nn_, tid, vb, lds); } }
}

__device__ __forceinline__ void phase_norm(CP p, int mode) {
    const int tid = tid_(), lane = tid & 63, wid = tid >> 6;
    float* X = (float*)(p->ws + WS_X); bf16_t* U = (bf16_t*)(p->ws + WS_U); const bf16_t* YS = (const bf16_t*)(p->ws + WS_YS); const float* modv = (const float*)(p->ws + WS_MODV);
    const float* POS = (const float*)(p->ws + WS_POS);
    const int nrows = mode == 2 ? TL : TT;
    const int lprev = mode == 2 ? 1 : 0, lcur = mode == 0 ? 0 : 1;
    const int nw = (int)gridDim.x * 8;
    for (int rowa = blockIdx.x * 8 + wid; rowa < nrows; rowa += 2 * nw) {
        int rows[2]; bool ok[2]; f32x4 v[2][4];
#pragma unroll
        for (int rb = 0; rb < 2; ++rb) { const int r = rowa + rb * nw; ok[rb] = r < nrows; rows[rb] = ok[rb] ? r : rowa; }
        if (mode == 0) {
#pragma unroll
            for (int rb = 0; rb < 2; ++rb) { const int row = rows[rb]; const float* src = row < TL ? p->x + (size_t)row * D : p->ctx + (size_t)(row - TL) * D;
#pragma unroll
                for (int j = 0; j < 4; ++j) v[rb][j] = *(const f32x4*)(src + 256 * j + 4 * lane); }
#pragma unroll
            for (int rb = 0; rb < 2; ++rb) { const int row = rows[rb]; if (row < TL) { const int t = row & 4095;
#pragma unroll
                    for (int j = 0; j < 4; ++j) v[rb][j] += *(const f32x4*)(POS + (size_t)(j < 2 ? (t >> 6) : (t & 63)) * 512 + (j & 1) * 256 + 4 * lane); } }
        } else {
            unsigned ys[2][4][4]; u32x2 y2[2][4]; const bf16_t* Y2 = (const bf16_t*)(p->ws + WS_PROJ);
#pragma unroll
            for (int rb = 0; rb < 2; ++rb) { const int row = rows[rb];
#pragma unroll
                for (int j = 0; j < 4; ++j) { v[rb][j] = *(const f32x4*)(X + (size_t)row * D + 256 * j + 4 * lane); y2[rb][j] = *(const u32x2*)(Y2 + (size_t)row * D + 256 * j + 4 * lane);
#pragma unroll
                    for (int k = 0; k < 4; ++k) ys[rb][j][k] = *(const unsigned*)((const unsigned char*)YS + ((size_t)row * 4 + k) * D + 256 * j + 4 * lane); } }
#pragma unroll
            for (int rb = 0; rb < 2; ++rb) { const float* g2 = modv + (size_t)(lprev * 9 + row_mb(rows[rb])) * 6144 + 5120;
#pragma unroll
                for (int j = 0; j < 4; ++j) { f32x4 s = {0.f, 0.f, 0.f, 0.f};
#pragma unroll
                    for (int k = 0; k < 4; ++k) { const int w = (int)ys[rb][j][k]; const f32x2 lo = __builtin_amdgcn_cvt_pk_f32_fp8(w, false), hi = __builtin_amdgcn_cvt_pk_f32_fp8(w, true); s[0] += lo.x; s[1] += lo.y; s[2] += hi.x; s[3] += hi.y; }
                    v[rb][j] += (f32x4){bflo(y2[rb][j].x), bfhi(y2[rb][j].x), bflo(y2[rb][j].y), bfhi(y2[rb][j].y)} + *(const f32x4*)(g2 + 256 * j + 4 * lane) * (s * (1.0f / 16.0f)); } }
        }
        float ss[2];
#pragma unroll
        for (int rb = 0; rb < 2; ++rb) { ss[rb] = 0.f;
#pragma unroll
            for (int j = 0; j < 4; ++j) ss[rb] += v[rb][j][0] * v[rb][j][0] + v[rb][j][1] * v[rb][j][1] + v[rb][j][2] * v[rb][j][2] + v[rb][j][3] * v[rb][j][3]; }
#pragma unroll
        for (int o = 32; o >= 1; o >>= 1) { const float t0 = bperm(ss[0], lane ^ o), t1 = bperm(ss[1], lane ^ o); ss[0] += t0; ss[1] += t1; }
#pragma unroll
        for (int rb = 0; rb < 2; ++rb) { if (!ok[rb]) continue; const int row = rows[rb]; const float rstd = __builtin_amdgcn_rsqf(ss[rb] * (1.0f / 1024.0f) + 1e-6f);
            if (mode == 2) {
#pragma unroll
                for (int j = 0; j < 4; ++j) *(f32x4*)(p->out + (size_t)row * D + 256 * j + 4 * lane) = v[rb][j] * rstd * *(const f32x4*)(p->final_norm_g + 256 * j + 4 * lane);
            } else { const float* mv = modv + (size_t)(lcur * 9 + row_mb(row)) * 6144;
#pragma unroll
                for (int j = 0; j < 4; ++j) { const int col = 256 * j + 4 * lane;
                    *(f32x4*)(X + (size_t)row * D + col) = v[rb][j];
                    const f32x4 g = *(const f32x4*)(p->norm1_g + lcur * D + col), sc = *(const f32x4*)(mv + 1024 + col), sh = *(const f32x4*)(mv + col);
                    const f32x4 u = v[rb][j] * rstd * g * (sc + 1.0f) + sh;
                    u32x2 w; w.x = cvt_pk_bf16(u[0], u[1]); w.y = cvt_pk_bf16(u[2], u[3]); *(u32x2*)(U + (size_t)row * D + col) = w; } }
        }
    }
}

constexpr int HP = 2064;
__device__ __forceinline__ void phase_router(CP p, int l, LAS unsigned char* lds, int rep) {
    LAS unsigned char* HHI = lds; LAS unsigned char* HLO = lds + 32 * HP;
    LAS float* LG = (LAS float*)(lds + 64 * HP);
    LAS int* hist = (LAS int*)(lds + 64 * HP + 8448); LAS int* basee = hist + 32;
    const int tid = tid_(), lane = tid & 63, wid = __builtin_amdgcn_readfirstlane(tid >> 6), fr = lane & 15, fq = lane >> 4;
    const float* X = (const float*)(p->ws + WS_X); const bf16_t* Y2 = (const bf16_t*)(p->ws + WS_PROJ);
    bf16_t* U = (bf16_t*)(p->ws + (rep ? WS_ACT + (size_t)TT * D * 4 : WS_U)); const float* modv = (const float*)(p->ws + WS_MODV);
    unsigned char* U8 = p->ws + (rep ? WS_ACT + (size_t)TT * D * 4 : WS_U8);
    unsigned* ctl = (unsigned*)(p->ws + WS_CTL) + (rep ? 4096 : 0); int* rasg = (int*)(p->ws + (rep ? WS_YS : WS_RASG)); float* gate = (float*)(p->ws + (rep ? WS_YS + (size_t)NE * TT * 4 : WS_GATE));
    const bf16_t* wrt = (const bf16_t*)(p->ws + WS_WRT) + (size_t)l * 2 * NE * 1024;
    const int ntiles = (l == 0 ? TT : TL) / 32;
    for (int tile = blockIdx.x; tile < ntiles; tile += gridDim.x) {
        const int row0 = tile * 32, mb = row_mb(row0);
        const float* mv = modv + (size_t)(l * 9 + mb) * 6144;
        __syncthreads();
        if (tid < 32) hist[tid] = 0;
        { f32x4 v[4][4]; u32x2 y2[4][4]; float ss[4];
#pragma unroll
          for (int rr = 0; rr < 4; ++rr)
#pragma unroll
              for (int j = 0; j < 4; ++j) { v[rr][j] = *(const f32x4*)(X + (size_t)(row0 + wid * 4 + rr) * D + 256 * j + 4 * lane); y2[rr][j] = *(const u32x2*)(Y2 + (size_t)(row0 + wid * 4 + rr) * D + 256 * j + 4 * lane); }
#pragma unroll
          for (int rr = 0; rr < 4; ++rr)
#pragma unroll
              for (int j = 0; j < 4; ++j) v[rr][j] += (f32x4){bflo(y2[rr][j].x), bfhi(y2[rr][j].x), bflo(y2[rr][j].y), bfhi(y2[rr][j].y)};
#pragma unroll
          for (int rr = 0; rr < 4; ++rr) { ss[rr] = 0.f;
#pragma unroll
              for (int j = 0; j < 4; ++j) ss[rr] += v[rr][j][0] * v[rr][j][0] + v[rr][j][1] * v[rr][j][1] + v[rr][j][2] * v[rr][j][2] + v[rr][j][3] * v[rr][j][3]; }
#pragma unroll
          for (int o = 32; o >= 1; o >>= 1) { float t[4];
#pragma unroll
              for (int rr = 0; rr < 4; ++rr) t[rr] = bperm(ss[rr], lane ^ o);
#pragma unroll
              for (int rr = 0; rr < 4; ++rr) ss[rr] += t[rr]; }
#pragma unroll
          for (int j = 0; j < 4; ++j) { const int col = 256 * j + 4 * lane;
              const f32x4 g = *(const f32x4*)(p->norm2_g + l * D + col), sc = *(const f32x4*)(mv + 4096 + col), sh = *(const f32x4*)(mv + 3072 + col);
#pragma unroll
              for (int rr = 0; rr < 4; ++rr) { const int r = wid * 4 + rr; const float rstd = __builtin_amdgcn_rsqf(ss[rr] * (1.0f / 1024.0f) + 1e-6f);
                  const f32x4 h = v[rr][j] * rstd * g * (sc + 1.0f) + sh;
                  u32x2 w; w.x = cvt_pk_bf16(h[0], h[1]); w.y = cvt_pk_bf16(h[2], h[3]);
                  if (fp8_layer(l)) *(unsigned*)(U8 + (size_t)(row0 + r) * D + col) = pk4_fp8(h[0], h[1], h[2], h[3]); else *(u32x2*)(U + (size_t)(row0 + r) * D + col) = w;
                  u32x2 wl; wl.x = cvt_pk_bf16(h[0] - bflo(w.x), h[1] - bfhi(w.x)); wl.y = cvt_pk_bf16(h[2] - bflo(w.y), h[3] - bfhi(w.y));
                  *(LAS u32x2*)(HHI + r * HP + col * 2) = w; *(LAS u32x2*)(HLO + r * HP + col * 2) = wl; } } }
        __syncthreads();
        { const int mt = wid & 1, ntl = (wid >> 1) & 1, kh = wid >> 2;
          f32x4 acc = {0.f, 0.f, 0.f, 0.f};
          const bf16_t* bh = wrt + (size_t)(16 * ntl + fr) * 1024 + kh * 512 + 8 * fq; const bf16_t* bl = bh + NE * 1024;
          const LAS unsigned char* ah = HHI + (16 * mt + fr) * HP + (kh * 512 + 8 * fq) * 2; const LAS unsigned char* al = HLO + (16 * mt + fr) * HP + (kh * 512 + 8 * fq) * 2;
#pragma unroll 8
          for (int s = 0; s < 16; ++s) { const bf16x8 Ah = *(const LAS bf16x8*)(ah + s * 64), Al = *(const LAS bf16x8*)(al + s * 64); const bf16x8 Bh = *(const bf16x8*)(bh + s * 32), Bl = *(const bf16x8*)(bl + s * 32);
              acc = __builtin_amdgcn_mfma_f32_16x16x32_bf16(Ah, Bh, acc, 0, 0, 0); acc = __builtin_amdgcn_mfma_f32_16x16x32_bf16(Ah, Bl, acc, 0, 0, 0); acc = __builtin_amdgcn_mfma_f32_16x16x32_bf16(Al, Bh, acc, 0, 0, 0); }
#pragma unroll
          for (int j = 0; j < 4; ++j) LG[(kh * 32 + 16 * mt + 4 * fq + j) * 33 + 16 * ntl + fr] = acc[j]; }
        __syncthreads();
        int ek[4] = {0, 0, 0, 0}, rk[4] = {0, 0, 0, 0}; float gk[4] = {0.f, 0.f, 0.f, 0.f};
        if (tid < 32) { float lg[32];
#pragma unroll
            for (int e = 0; e < 32; ++e) lg[e] = LG[tid * 33 + e] + LG[(32 + tid) * 33 + e] + p->b_router[l * NE + e];
            float vk[4];
#pragma unroll
            for (int k = 0; k < 4; ++k) { float best = -3.0e38f; int bi = 0;
#pragma unroll
                for (int e = 0; e < 32; ++e) if (lg[e] > best) { best = lg[e]; bi = e; }
                vk[k] = best; ek[k] = bi;
#pragma unroll
                for (int e = 0; e < 32; ++e) if (e == bi) lg[e] = -3.0e38f; }
            float sum = 0.f;
#pragma unroll
            for (int k = 0; k < 4; ++k) { gk[k] = fexp2(1.4426950408889634f * (vk[k] - vk[0])); sum += gk[k]; }
            const float inv = 1.0f / sum;
#pragma unroll
            for (int k = 0; k < 4; ++k) { gk[k] *= inv; rk[k] = __hip_atomic_fetch_add(hist + ek[k], 1, __ATOMIC_RELAXED, __HIP_MEMORY_SCOPE_WORKGROUP); } }
        __syncthreads();
        if (tid < 32) { const int h = hist[tid]; basee[tid] = h ? (int)__hip_atomic_fetch_add(ctl + CW_COUNT + (l * NE + tid) * 64, (unsigned)h, __ATOMIC_RELAXED, __HIP_MEMORY_SCOPE_AGENT) : 0; }
        __syncthreads();
        if (tid < 32) { const int tok = row0 + tid;
#pragma unroll
            for (int k = 0; k < 4; ++k) { rasg[(size_t)ek[k] * TT + basee[ek[k]] + rk[k]] = tok * 4 + k; gate[tok * 4 + k] = gk[k]; } }
    }
}

constexpr int XCP = 144;
constexpr int XAP = 528;
struct Seq { int b, jc, L, rowbase, t0; bool lat; };
__device__ __forceinline__ Seq seq_of(int q) { Seq s; s.lat = q < 512; s.b = s.lat ? q >> 6 : (q - 512) >> 2; s.jc = s.lat ? q & 63 : (q - 512) & 3; s.L = s.lat ? SEQ : LCX; s.rowbase = s.lat ? s.b * SEQ : TL + s.b * LCX; s.t0 = s.jc * 64; return s; }
template <int PASS>
__device__ __forceinline__ void scan_unit(CP p, int l, int q, LAS unsigned char* lds) {
    const int tid = tid_(), lane = tid & 63, wid = __builtin_amdgcn_readfirstlane(tid >> 6), d = wid >> 2, hd = wid & 3, fr = lane & 15, fq = lane >> 4;
    LAS unsigned char* XC = lds + wid * (64 * XCP);
    LAS float* CAR = (LAS float*)(lds + 8 * 64 * XCP + wid * 256);
    LAS unsigned char* HB = lds + 8 * 64 * XCP + 2048;
    LAS unsigned char* XA = HB;
    const bf16_t* PROJ = (const bf16_t*)(p->ws + WS_PROJ); float* SUMM = (float*)(p->ws + WS_SUMM);
    const Seq sq = seq_of(q); const int b = sq.b, jc = sq.jc, L = sq.L, rowbase = sq.rowbase, t0 = sq.t0; const bool lat = sq.lat;
    __syncthreads();
    { u32x4 w[5];
#pragma unroll
      for (int it = 0; it < 5; ++it) { const int task = it * 512 + tid, r = task >> 5, cg = task & 31, tt = t0 - 3 + r; w[it] = (u32x4){0u, 0u, 0u, 0u};
          if (task < 70 * 32 && tt >= 0 && tt < L) w[it] = *(const u32x4*)(PROJ + (size_t)(rowbase + tt) * NPROJ + 8 * cg); }
#pragma unroll
      for (int it = 0; it < 5; ++it) { const int task = it * 512 + tid, r = task >> 5, cg = task & 31; if (task < 70 * 32) *(LAS u32x4*)(XA + r * XAP + cg * 16) = w[it]; } }
    float car = 0.f;
    if (PASS == 2) { const int c = 64 * hd + lane;
        const int n = d == 0 ? (lat ? 4 + jc : jc) : (lat ? 4 + 63 - jc : 3 - jc);
        for (int s0 = 0; s0 < n; s0 += 16) { float A_[16], H_[16];
#pragma unroll
            for (int e = 0; e < 16; ++e) { const int s = s0 + e; int qq;
                if (d == 0) qq = (lat && s >= 4) ? b * 64 + (s - 4) : 512 + b * 4 + s; else qq = (lat && s >= 4) ? b * 64 + 63 - (s - 4) : 512 + b * 4 + 3 - s;
                A_[e] = 1.f; H_[e] = 0.f; if (s < n) { const float* sp_ = SUMM + ((size_t)qq * 2 + d) * 512; A_[e] = sp_[c]; H_[e] = sp_[256 + c]; } }
#pragma unroll
            for (int e = 0; e < 16; ++e) car = A_[e] * car + H_[e]; } }
    __syncthreads();
    { const int c = 64 * hd + lane; const float* cw = p->conv_a_w + ((size_t)(l * 2 + d) * 4) * 256 + c;
      const float w0 = cw[0], w1 = cw[256], w2 = cw[512], w3 = cw[768], cb = p->conv_a_b[(l * 2 + d) * 256 + c];
      const float k0 = d ? w3 : w0, k1 = d ? w2 : w1, k2 = d ? w1 : w2, k3 = d ? w0 : w3;
      const LAS unsigned char* xp = XA + (d ? 3 : 0) * XAP + c * 2;
      float xa_ = bf2f(*(const LAS bf16_t*)(xp)), xb_ = bf2f(*(const LAS bf16_t*)(xp + XAP)), xc_ = bf2f(*(const LAS bf16_t*)(xp + 2 * XAP));
#pragma unroll 16
      for (int t = 0; t < 64; ++t) { const float xd_ = bf2f(*(const LAS bf16_t*)(xp + (t + 3) * XAP)); const float v = k0 * xa_ + k1 * xb_ + k2 * xc_ + k3 * xd_ + cb;
          *(LAS bf16_t*)(XC + t * XCP + lane * 2) = f2bf(v); xa_ = xb_; xb_ = xc_; xc_ = xd_; } }
    if (PASS == 2) CAR[lane] = car;
    asm volatile("" ::: "memory");
    if (PASS == 2) __syncthreads();
    float cr[4], at[4], sp[4], brr[4], bii[4];
#pragma unroll
    for (int n = 0; n < 4; ++n) { const int ch = 16 * n + fr; cr[n] = PASS == 2 ? CAR[ch] : 0.f; at[n] = 1.f;
        const float lam = p->rg_lambda[(l * 2 + d) * 256 + 64 * hd + ch]; sp[n] = -8.0f * 1.4426950408889634f * log1pf(__expf(-lam));
        brr[n] = p->b_rg_r[((l * 2 + d) * 4 + hd) * 64 + ch]; bii[n] = p->b_rg_i[((l * 2 + d) * 4 + hd) * 64 + ch]; }
    const bf16_t* wg = (const bf16_t*)(p->ws + WS_WGT) + (size_t)((l * 2 + d) * 2) * 4 * 4096;
    u32x4* ABo = (u32x4*)(p->ws + WS_AB) + ((size_t)q * 8 + wid) * 16 * 64 + lane;
    const int src1 = d ? lane + 16 : lane - 16, src2 = d ? lane + 32 : lane - 32, srct = d ? fr : 48 + fr;
    const bool has1 = d ? fq <= 2 : fq >= 1, has2 = d ? fq <= 1 : fq >= 2;
    for (int n = 0; n < 4; ++n) {
        bf16x8 Br[2], Bi[2];
#pragma unroll
        for (int s = 0; s < 2; ++s) { Br[s] = *(const bf16x8*)(wg + ((size_t)(0 * 4 + hd) * 64 + 16 * n + fr) * 64 + 32 * s + 8 * fq); Bi[s] = *(const bf16x8*)(wg + ((size_t)(1 * 4 + hd) * 64 + 16 * n + fr) * 64 + 32 * s + 8 * fq); }
        float Hj[4][4], Aj[4][4];
#pragma unroll
        for (int mt = 0; mt < 4; ++mt) {
            const bf16x8 A0 = *(const LAS bf16x8*)(XC + (16 * mt + fr) * XCP + (8 * fq) * 2), A1 = *(const LAS bf16x8*)(XC + (16 * mt + fr) * XCP + (32 + 8 * fq) * 2);
            f32x4 ar = {0.f, 0.f, 0.f, 0.f}, ai = {0.f, 0.f, 0.f, 0.f};
            ar = __builtin_amdgcn_mfma_f32_16x16x32_bf16(A0, Br[0], ar, 0, 0, 0); ar = __builtin_amdgcn_mfma_f32_16x16x32_bf16(A1, Br[1], ar, 0, 0, 0);
            ai = __builtin_amdgcn_mfma_f32_16x16x32_bf16(A0, Bi[0], ai, 0, 0, 0); ai = __builtin_amdgcn_mfma_f32_16x16x32_bf16(A1, Bi[1], ai, 0, 0, 0);
            float a_[4], b_[4], la_[4];
#pragma unroll
            for (int j = 0; j < 4; ++j) { const float r = sigmoidf_(ar[j] + brr[n]); la_[j] = r * sp[n]; }
            u32x4 w; w.x = cvt_pk_bf16(la_[0], la_[1]); w.y = cvt_pk_bf16(la_[2], la_[3]);
            la_[0] = bflo(w.x); la_[1] = bfhi(w.x); la_[2] = bflo(w.y); la_[3] = bfhi(w.y);
#pragma unroll
            for (int j = 0; j < 4; ++j) { const int tok = 16 * mt + 4 * fq + j; const float xcv = bf2f(*(const LAS bf16_t*)(XC + tok * XCP + (16 * n + fr) * 2));
                const float ig = sigmoidf_(ai[j] + bii[n]); const float a = fexp2(la_[j]);
                a_[j] = a; b_[j] = __builtin_amdgcn_sqrtf(fmaxf(1.0f - a * a, 0.f)) * (ig * xcv); }
            w.z = cvt_pk_bf16(b_[0], b_[1]); w.w = cvt_pk_bf16(b_[2], b_[3]);
            b_[0] = bflo(w.z); b_[1] = bfhi(w.z); b_[2] = bflo(w.w); b_[3] = bfhi(w.w);
            ABo[(size_t)((n * 4 + mt) * 64)] = w;
            if (d == 0) { Hj[mt][0] = b_[0]; Aj[mt][0] = a_[0];
#pragma unroll
                for (int j = 1; j < 4; ++j) { Hj[mt][j] = a_[j] * Hj[mt][j - 1] + b_[j]; Aj[mt][j] = a_[j] * Aj[mt][j - 1]; } }
            else { Hj[mt][3] = b_[3]; Aj[mt][3] = a_[3];
#pragma unroll
                for (int j = 2; j >= 0; --j) { Hj[mt][j] = a_[j] * Hj[mt][j + 1] + b_[j]; Aj[mt][j] = a_[j] * Aj[mt][j + 1]; } }
        }
        float iA[4], iH[4], eA[4], eH[4], tA[4], tH[4];
#pragma unroll
        for (int mt = 0; mt < 4; ++mt) { iA[mt] = d ? Aj[mt][0] : Aj[mt][3]; iH[mt] = d ? Hj[mt][0] : Hj[mt][3]; }
        { float pA[4], pH[4];
#pragma unroll
          for (int mt = 0; mt < 4; ++mt) { pA[mt] = bperm(iA[mt], src1); pH[mt] = bperm(iH[mt], src1); }
#pragma unroll
          for (int mt = 0; mt < 4; ++mt) if (has1) { iH[mt] = iA[mt] * pH[mt] + iH[mt]; iA[mt] = iA[mt] * pA[mt]; }
#pragma unroll
          for (int mt = 0; mt < 4; ++mt) { pA[mt] = bperm(iA[mt], src2); pH[mt] = bperm(iH[mt], src2); }
#pragma unroll
          for (int mt = 0; mt < 4; ++mt) if (has2) { iH[mt] = iA[mt] * pH[mt] + iH[mt]; iA[mt] = iA[mt] * pA[mt]; } }
#pragma unroll
        for (int mt = 0; mt < 4; ++mt) { eA[mt] = bperm(iA[mt], src1); eH[mt] = bperm(iH[mt], src1); tA[mt] = bperm(iA[mt], srct); tH[mt] = bperm(iH[mt], srct); if (!has1) { eA[mt] = 1.f; eH[mt] = 0.f; } }
#pragma unroll
        for (int mi = 0; mi < 4; ++mi) { const int mt = d ? 3 - mi : mi;
            const float hin = eH[mt] + eA[mt] * cr[n];
            if (PASS == 2) {
#pragma unroll
                for (int j = 0; j < 4; ++j) { const int tok = 16 * mt + 4 * fq + j; *(LAS bf16_t*)(HB + ((d * 64 + tok) * 256 + 64 * hd + 16 * n + fr) * 2) = f2bf(Hj[mt][j] + Aj[mt][j] * hin); } }
            cr[n] = tH[mt] + tA[mt] * cr[n]; at[n] *= tA[mt]; }
    }
    if (PASS == 1) { if (fq == 0) {
#pragma unroll
            for (int n = 0; n < 4; ++n) { float* s = SUMM + ((size_t)q * 2 + d) * 512 + 64 * hd + 16 * n + fr; s[0] = at[n]; s[256] = cr[n]; } } }
    else {
        __syncthreads();
        bf16_t* Y = (bf16_t*)(p->ws + WS_YCAT);
        u32x4 gaw[4];
#pragma unroll
        for (int it = 0; it < 4; ++it) { const int task = it * 512 + tid, tok = task >> 5, cg = task & 31; gaw[it] = *(const u32x4*)(PROJ + ((size_t)rowbase + t0 + tok) * NPROJ + 256 + 8 * cg); }
#pragma unroll
        for (int it = 0; it < 4; ++it) { const int task = it * 512 + tid, tok = task >> 5, cg = task & 31; const size_t row = (size_t)rowbase + t0 + tok;
            float hf[8], hb[8], ga[8], y[8];
            unpack8(*(const LAS u32x4*)(HB + ((0 * 64 + tok) * 256 + 8 * cg) * 2), hf); unpack8(*(const LAS u32x4*)(HB + ((1 * 64 + tok) * 256 + 8 * cg) * 2), hb);
            unpack8(gaw[it], ga);
#pragma unroll
            for (int e = 0; e < 8; ++e) { const float g = ga[e]; y[e] = (hf[e] + hb[e]) * (g * sigmoidf_(1.5957691216057308f * (g + 0.044715f * g * g * g))); }
            *(u32x4*)(Y + row * D + 8 * cg) = pack8(y); }
    }
}

__device__ __forceinline__ void scan2_unit(CP p, int l, int q, LAS unsigned char* lds) {
    const int tid = tid_(), lane = tid & 63, wid = __builtin_amdgcn_readfirstlane(tid >> 6), d = wid >> 2, hd = wid & 3, fr = lane & 15, fq = lane >> 4;
    LAS float* CAR = (LAS float*)(lds + wid * 256);
    LAS unsigned char* HB = lds + 2048;
    const bf16_t* PROJ = (const bf16_t*)(p->ws + WS_PROJ); const float* SUMM = (const float*)(p->ws + WS_SUMM);
    const Seq sq = seq_of(q); const int b = sq.b, jc = sq.jc, rowbase = sq.rowbase, t0 = sq.t0; const bool lat = sq.lat;
    __syncthreads();
    u32x4 ab[4][4];
    { const u32x4* ABi = (const u32x4*)(p->ws + WS_AB) + ((size_t)q * 8 + wid) * 16 * 64 + lane;
#pragma unroll
      for (int n = 0; n < 4; ++n)
#pragma unroll
          for (int mt = 0; mt < 4; ++mt) ab[n][mt] = ABi[(size_t)((n * 4 + mt) * 64)]; }
    u32x4 gaw[4];
#pragma unroll
    for (int it = 0; it < 4; ++it) { const int task = it * 512 + tid, tok = task >> 5, cg = task & 31; gaw[it] = *(const u32x4*)(PROJ + ((size_t)rowbase + t0 + tok) * NPROJ + 256 + 8 * cg); }
    { float car = 0.f; const int c = 64 * hd + lane;
      const int n = d == 0 ? (lat ? 4 + jc : jc) : (lat ? 4 + 63 - jc : 3 - jc);
      for (int s0 = 0; s0 < n; s0 += 16) { float A_[16], H_[16];
#pragma unroll
          for (int e = 0; e < 16; ++e) { const int s = s0 + e; int qq;
              if (d == 0) qq = (lat && s >= 4) ? b * 64 + (s - 4) : 512 + b * 4 + s; else qq = (lat && s >= 4) ? b * 64 + 63 - (s - 4) : 512 + b * 4 + 3 - s;
              A_[e] = 1.f; H_[e] = 0.f; if (s < n) { const float* sp_ = SUMM + ((size_t)qq * 2 + d) * 512; A_[e] = sp_[c]; H_[e] = sp_[256 + c]; } }
#pragma unroll
          for (int e = 0; e < 16; ++e) car = A_[e] * car + H_[e]; }
      CAR[lane] = car; }
    asm volatile("" ::: "memory");
    const int src1 = d ? lane + 16 : lane - 16, src2 = d ? lane + 32 : lane - 32, srct = d ? fr : 48 + fr;
    const bool has1 = d ? fq <= 2 : fq >= 1, has2 = d ? fq <= 1 : fq >= 2;
#pragma unroll
    for (int n = 0; n < 4; ++n) { float cr = CAR[16 * n + fr];
        float Hj[4][4], Aj[4][4];
#pragma unroll
        for (int mt = 0; mt < 4; ++mt) { const u32x4 w = ab[n][mt];
            const float a_[4] = {fexp2(bflo(w.x)), fexp2(bfhi(w.x)), fexp2(bflo(w.y)), fexp2(bfhi(w.y))}, b_[4] = {bflo(w.z), bfhi(w.z), bflo(w.w), bfhi(w.w)};
            if (d == 0) { Hj[mt][0] = b_[0]; Aj[mt][0] = a_[0];
#pragma unroll
                for (int j = 1; j < 4; ++j) { Hj[mt][j] = a_[j] * Hj[mt][j - 1] + b_[j]; Aj[mt][j] = a_[j] * Aj[mt][j - 1]; } }
            else { Hj[mt][3] = b_[3]; Aj[mt][3] = a_[3];
#pragma unroll
                for (int j = 2; j >= 0; --j) { Hj[mt][j] = a_[j] * Hj[mt][j + 1] + b_[j]; Aj[mt][j] = a_[j] * Aj[mt][j + 1]; } } }
        float iA[4], iH[4], eA[4], eH[4], tA[4], tH[4];
#pragma unroll
        for (int mt = 0; mt < 4; ++mt) { iA[mt] = d ? Aj[mt][0] : Aj[mt][3]; iH[mt] = d ? Hj[mt][0] : Hj[mt][3]; }
        { float pA[4], pH[4];
#pragma unroll
          for (int mt = 0; mt < 4; ++mt) { pA[mt] = bperm(iA[mt], src1); pH[mt] = bperm(iH[mt], src1); }
#pragma unroll
          for (int mt = 0; mt < 4; ++mt) if (has1) { iH[mt] = iA[mt] * pH[mt] + iH[mt]; iA[mt] = iA[mt] * pA[mt]; }
#pragma unroll
          for (int mt = 0; mt < 4; ++mt) { pA[mt] = bperm(iA[mt], src2); pH[mt] = bperm(iH[mt], src2); }
#pragma unroll
          for (int mt = 0; mt < 4; ++mt) if (has2) { iH[mt] = iA[mt] * pH[mt] + iH[mt]; iA[mt] = iA[mt] * pA[mt]; } }
#pragma unroll
        for (int mt = 0; mt < 4; ++mt) { eA[mt] = bperm(iA[mt], src1); eH[mt] = bperm(iH[mt], src1); tA[mt] = bperm(iA[mt], srct); tH[mt] = bperm(iH[mt], srct); if (!has1) { eA[mt] = 1.f; eH[mt] = 0.f; } }
#pragma unroll
        for (int mi = 0; mi < 4; ++mi) { const int mt = d ? 3 - mi : mi;
            const float hin = eH[mt] + eA[mt] * cr;
#pragma unroll
            for (int j = 0; j < 4; j += 2) { const int tok = 16 * mt + 4 * fq + j; const LAS unsigned char* dummy = HB; (void)dummy;
                *(LAS bf16_t*)(HB + ((d * 64 + tok) * 256 + 64 * hd + 16 * n + fr) * 2) = f2bf(Hj[mt][j] + Aj[mt][j] * hin);
                *(LAS bf16_t*)(HB + ((d * 64 + tok + 1) * 256 + 64 * hd + 16 * n + fr) * 2) = f2bf(Hj[mt][j + 1] + Aj[mt][j + 1] * hin); }
            cr = tH[mt] + tA[mt] * cr; } }
    __syncthreads();
    bf16_t* Y = (bf16_t*)(p->ws + WS_YCAT);
#pragma unroll
    for (int it = 0; it < 4; ++it) { const int task = it * 512 + tid, tok = task >> 5, cg = task & 31; const size_t row = (size_t)rowbase + t0 + tok;
        float hf[8], hb[8], ga[8], y[8];
        unpack8(*(const LAS u32x4*)(HB + ((0 * 64 + tok) * 256 + 8 * cg) * 2), hf); unpack8(*(const LAS u32x4*)(HB + ((1 * 64 + tok) * 256 + 8 * cg) * 2), hb);
        unpack8(gaw[it], ga);
#pragma unroll
        for (int e = 0; e < 8; ++e) { const float g = ga[e]; y[e] = (hf[e] + hb[e]) * (g * sigmoidf_(1.5957691216057308f * (g + 0.044715f * g * g * g))); }
        *(u32x4*)(Y + row * D + 8 * cg) = pack8(y); }
}

__device__ __forceinline__ void pool_unit(CP p, int l, int q, LAS unsigned char* lds) {
    LAS float* PB = (LAS float*)lds;
    const int tid = tid_();
    const bf16_t* PROJ = (const bf16_t*)(p->ws + WS_PROJ); bf16_t* Y = (bf16_t*)(p->ws + WS_YCAT);
    const Seq sq = seq_of(q); const int L = sq.L, rowbase = sq.rowbase, t0 = sq.t0;
    __syncthreads();
    { u32x4 w[5];
#pragma unroll
      for (int it = 0; it < 5; ++it) { const int task = it * 512 + tid, r = task >> 5, cg = task & 31, tt = t0 - 8 + r; w[it] = (u32x4){0u, 0u, 0u, 0u};
          if (tt >= 0 && tt < L) w[it] = *(const u32x4*)(PROJ + (size_t)(rowbase + tt) * NPROJ + 512 + 8 * cg); }
#pragma unroll
      for (int it = 0; it < 5; ++it) { const int task = it * 512 + tid, r = task >> 5, cg = task & 31; float f[8]; unpack8(w[it], f);
          *(LAS f32x4*)(PB + r * 256 + 8 * cg) = (f32x4){f[0], f[1], f[2], f[3]}; *(LAS f32x4*)(PB + r * 256 + 8 * cg + 4) = (f32x4){f[4], f[5], f[6], f[7]}; } }
    __syncthreads();
    { const int c = tid & 255, th = tid >> 8, hw = 1 << (c >> 6); const float bp = p->b_pool[l * 256 + c], ps = p->pool_scale[l * 256 + c];
#pragma unroll 4
      for (int o = 0; o < 32; ++o) { const int tl = 32 * th + o, t = t0 + tl; const int lo = max(t - hw, 0), hi = min(t + hw, L); float s = 0.f;
          for (int tt = lo; tt < hi; ++tt) s += PB[(tt - t0 + 8) * 256 + c];
          const float yv = (s * frcp((float)(hi - lo)) - PB[(tl + 8) * 256 + c] + bp) * ps;
          Y[(size_t)(rowbase + t) * D + 256 + c] = f2bf(yv); } }
}
__device__ __forceinline__ void four_unit(CP p, int l, int q) {
    const int tid = tid_();
    bf16_t* Y = (bf16_t*)(p->ws + WS_YCAT);
    const Seq sq = seq_of(q); const int b = sq.b, rowbase = sq.rowbase, t0 = sq.t0; const bool lat = sq.lat;
    const float* UU = (const float*)(p->ws + WS_UU); const float* VV = (const float*)(p->ws + WS_VV); const float* YCX = (const float*)(p->ws + WS_YCX);
#pragma unroll
    for (int it = 0; it < 4; ++it) { const int task = it * 512 + tid, tl = task >> 5, cg = task & 31, t = t0 + tl; float y[8];
        f32x4 u0, u1, v0 = {0.f, 0.f, 0.f, 0.f}, v1 = {0.f, 0.f, 0.f, 0.f}; float sgn, scale;
        if (lat) { const int k = t <= 2048 ? t : 4096 - t; sgn = t <= 2048 ? -1.0f : 1.0f; scale = 1.0f / (512.0f * 64.0f);
            const float* up = UU + (size_t)k * 2048 + b * 256 + 8 * cg; u0 = *(const f32x4*)up; u1 = *(const f32x4*)(up + 4);
            if (k < 2048) { const float* vp = VV + (size_t)k * 2048 + b * 256 + 8 * cg; v0 = *(const f32x4*)vp; v1 = *(const f32x4*)(vp + 4); } }
        else { sgn = 0.f; scale = 1.0f / (128.0f * 64.0f); const float* up = YCX + (size_t)t * 2048 + b * 256 + 8 * cg; u0 = *(const f32x4*)up; u1 = *(const f32x4*)(up + 4); }
        const f32x4 bf0 = *(const f32x4*)(p->b_four + l * 256 + 8 * cg), bf1 = *(const f32x4*)(p->b_four + l * 256 + 8 * cg + 4);
        const f32x4 r0 = (u0 + v0 * sgn) * scale + bf0, r1 = (u1 + v1 * sgn) * scale + bf1;
        y[0] = r0[0]; y[1] = r0[1]; y[2] = r0[2]; y[3] = r0[3]; y[4] = r1[0]; y[5] = r1[1]; y[6] = r1[2]; y[7] = r1[3];
        *(u32x4*)(Y + (size_t)(rowbase + t) * D + 512 + 8 * cg) = pack8(y); }
}
__device__ __forceinline__ void conformer_unit(CP p, int l, int q, LAS unsigned char* lds) {
    LAS float* V = (LAS float*)lds;
    const int tid = tid_(), lane = tid & 63, wid = __builtin_amdgcn_readfirstlane(tid >> 6);
    const bf16_t* PROJ = (const bf16_t*)(p->ws + WS_PROJ); bf16_t* Y = (bf16_t*)(p->ws + WS_YCAT);
    const Seq sq = seq_of(q); const int L = sq.L, rowbase = sq.rowbase, t0 = sq.t0;
    __syncthreads();
    { u32x4 wa[6], wg_[6];
#pragma unroll
      for (int it = 0; it < 6; ++it) { const int task = it * 512 + tid, r = task >> 5, cg = task & 31, tt = t0 - 15 + r; wa[it] = (u32x4){0u, 0u, 0u, 0u}; wg_[it] = wa[it];
          if (task < 94 * 32 && tt >= 0 && tt < L) { const bf16_t* pr = PROJ + (size_t)(rowbase + tt) * NPROJ + 768 + 8 * cg; wa[it] = *(const u32x4*)pr; wg_[it] = *(const u32x4*)(pr + 256); } }
#pragma unroll
      for (int it = 0; it < 6; ++it) { const int task = it * 512 + tid, r = task >> 5, cg = task & 31; float a[8], g[8], f[8]; unpack8(wa[it], a); unpack8(wg_[it], g);
#pragma unroll
          for (int e = 0; e < 8; ++e) f[e] = a[e] * sigmoidf_(g[e]);
          if (task < 94 * 32) { *(LAS f32x4*)(V + r * 256 + 8 * cg) = (f32x4){f[0], f[1], f[2], f[3]}; *(LAS f32x4*)(V + r * 256 + 8 * cg + 4) = (f32x4){f[4], f[5], f[6], f[7]}; } } }
    __syncthreads();
    const int hp = wid & 1, tq = wid >> 1, c0 = 128 * hp + 2 * lane;
    f32x2 wk[31];
#pragma unroll
    for (int k = 0; k < 31; ++k) wk[k] = *(const f32x2*)(p->conv_d_w + ((size_t)l * 31 + k) * 256 + c0);
    const f32x2 cb = *(const f32x2*)(p->conv_d_b + l * 256 + c0), lg = *(const f32x2*)(p->ln_d_g + l * 256 + c0), lb = *(const f32x2*)(p->ln_d_b + l * 256 + c0);
    for (int blk = 0; blk < 2; ++blk) { const int tl0 = 16 * tq + 8 * blk;
        f32x2 win[38];
#pragma unroll
        for (int i = 0; i < 38; ++i) win[i] = *(const LAS f32x2*)(V + (tl0 + i) * 256 + c0);
        f32x2 sv[8]; float m1[8], m2[8];
#pragma unroll
        for (int o = 0; o < 8; ++o) { f32x2 sacc = cb;
#pragma unroll
            for (int k = 0; k < 31; ++k) sacc += wk[k] * win[o + k];
            sv[o] = sacc; m1[o] = sacc.x + sacc.y; m2[o] = sacc.x * sacc.x + sacc.y * sacc.y; }
#pragma unroll
        for (int st = 16; st >= 1; st >>= 1) { float t1[8], t2[8];
#pragma unroll
            for (int o = 0; o < 8; ++o) { t1[o] = bperm(m1[o], lane ^ st); t2[o] = bperm(m2[o], lane ^ st); }
#pragma unroll
            for (int o = 0; o < 8; ++o) { m1[o] += t1[o]; m2[o] += t2[o]; } }
#pragma unroll
        for (int o = 0; o < 8; ++o) { const float mean = m1[o] * (1.0f / 64.0f); const float var = fmaxf(m2[o] * (1.0f / 64.0f) - mean * mean, 0.f); const float rs = __builtin_amdgcn_rsqf(var + 1e-6f);
            f32x2 yv = (sv[o] - mean) * rs * lg + lb; yv.x = yv.x * sigmoidf_(yv.x); yv.y = yv.y * sigmoidf_(yv.y);
            *(unsigned*)(Y + (size_t)(rowbase + t0 + tl0 + o) * D + 768 + c0) = cvt_pk_bf16(yv.x, yv.y); } }
}

struct SchedIn { const char *U, *W, *WF; char *PROJ, *PQT, *PQC;
    __device__ __forceinline__ bool next(int i, g8::Unit& u) const { const int L = i * (int)gridDim.x + (int)blockIdx.x; if (L >= 952) return false; const int id = g8::xcd_remap(L, 952);
        if (id < 680) { u.kind = 0; u.pm = id / 5; u.pn = id % 5; u.a = U + (size_t)u.pm * 256 * 2048; u.b = W + (size_t)u.pn * 256 * 2048; u.o = PROJ; u.e = 0; }
        else { const int r = id - 680; u.kind = 1; u.pm = r & 1; u.pn = r >> 1; u.a = WF + (size_t)u.pm * 256 * 2048; u.b = U + (size_t)u.pn * 256 * 2048; u.e = 0;
            if (u.pn < 128) u.o = PQT + ((size_t)(u.pm * 2048 + (u.pn >> 4) * 256) * 4096 + (u.pn & 15) * 256); else u.o = PQC + ((size_t)((u.pn - 128) * 256) * 512 + u.pm * 256); }
        return true; } };
struct EpiIn { static constexpr bool PERM = true; const float* bin; const float* bf;
    __device__ __forceinline__ void side0(const g8::Unit& u, int t, unsigned& a, unsigned& b, unsigned& c) const { a = __float_as_uint(u.kind == 0 ? bin[u.pn * 256 + t] : bf[u.pm * 256 + t]); }
    __device__ __forceinline__ void side1(const g8::Unit&, int, unsigned&, unsigned&, unsigned&) const {}
    __device__ __forceinline__ void operator()(const f32x4 (&acc)[2][2][4][2], const g8::Unit& u, int wr, int wc, int fr, int fq, const LAS unsigned* sd) const {
        { const int ln_ = tid_() & 63; fr = ln_ & 15; fq = ln_ >> 4; }
        if (u.kind == 0) { const int row0 = u.pm * 256 + wr * 64 + fr, col0 = u.pn * 256 + wc * 32 + 8 * fq; bf16_t* O = (bf16_t*)u.o;
            f32x4 bv[2][2];
#pragma unroll
            for (int bj = 0; bj < 2; ++bj)
#pragma unroll
                for (int n = 0; n < 2; ++n) bv[bj][n] = *(const LAS f32x4*)(sd + wc * 32 + 8 * fq + bj * 128 + 4 * n);
#pragma unroll
            for (int ai = 0; ai < 2; ++ai)
#pragma unroll
                for (int m = 0; m < 4; ++m) { bf16_t* rowp = O + (size_t)(row0 + ai * 128 + m * 16) * NPROJ + col0;
#pragma unroll
                    for (int bj = 0; bj < 2; ++bj) { const f32x4 v0 = acc[ai][bj][m][0] + bv[bj][0], v1 = acc[ai][bj][m][1] + bv[bj][1];
                        u32x4 w; w.x = cvt_pk_bf16(v0[0], v0[1]); w.y = cvt_pk_bf16(v0[2], v0[3]); w.z = cvt_pk_bf16(v1[0], v1[1]); w.w = cvt_pk_bf16(v1[2], v1[3]); *(u32x4*)(rowp + bj * 128) = w; } }
        } else { const int pitch = u.pn < 128 ? 4096 : 512; unsigned char* O = (unsigned char*)u.o; const int col0 = wc * 32 + 8 * fq;
#pragma unroll
            for (int ai = 0; ai < 2; ++ai)
#pragma unroll
                for (int m = 0; m < 4; ++m) { const int r = ai * 128 + wr * 64 + m * 16 + fr; const float bb = __uint_as_float(sd[r]); unsigned char* rowp = O + (size_t)r * pitch + col0;
#pragma unroll
                    for (int bj = 0; bj < 2; ++bj) { const f32x4 v0 = acc[ai][bj][m][0] + bb, v1 = acc[ai][bj][m][1] + bb;
                        u32x2 w; w.x = pk4_fp8(v0[0], v0[1], v0[2], v0[3]); w.y = pk4_fp8(v1[0], v1[1], v1[2], v1[3]); *(u32x2*)(rowp + bj * 128) = w; } }
        } } };
struct SchedDft { const char *CM, *SM, *PQT; char *UU, *VV;
    __device__ __forceinline__ bool next(int i, g8::Unit& u) const { const int id = (int)blockIdx.x; if (i > 0 || id >= 136) return false; u.kind = 0; u.e = 0;
        if (id < 72) { u.pm = id >> 3; u.pn = id & 7; u.a = CM + (size_t)u.pm * 256 * 8192; u.b = PQT + (size_t)u.pn * 256 * 8192; u.o = UU + ((size_t)u.pm * 256 * 2048 + u.pn * 256) * 4; }
        else { const int r = id - 72; u.pm = r >> 3; u.pn = r & 7; u.a = SM + (size_t)u.pm * 256 * 8192; u.b = PQT + (size_t)(2048 + u.pn * 256) * 8192; u.o = VV + ((size_t)u.pm * 256 * 2048 + u.pn * 256) * 4; }
        return true; } };
struct SchedOne { g8::Unit u; __device__ __forceinline__ bool next(int i, g8::Unit& o) const { if (i > 0) return false; o = u; return true; } };
struct SchedDftC { const char *DC, *PQC; char* YCX;
    __device__ __forceinline__ bool next(int i, g8::Unit& u) const { const int id = (int)blockIdx.x - 136; if (i > 0 || id < 0 || id >= 8) return false; u.kind = 0; u.e = 0; u.pm = 0; u.pn = id;
        u.a = DC; u.b = PQC + (size_t)id * 256 * 1024; u.o = YCX + (size_t)id * 256 * 4; return true; } };
struct EpiF32 { static constexpr bool PERM = false;
    __device__ __forceinline__ void side0(const g8::Unit&, int, unsigned&, unsigned&, unsigned&) const {}
    __device__ __forceinline__ void side1(const g8::Unit&, int, unsigned&, unsigned&, unsigned&) const {}
    __device__ __forceinline__ void operator()(const f32x4 (&acc)[2][2][4][2], const g8::Unit& u, int wr, int wc, int fr, int fq, const LAS unsigned* sd) const {
        { const int ln_ = tid_() & 63; fr = ln_ & 15; fq = ln_ >> 4; }
        float* O = (float*)u.o; const int row0 = wr * 64 + fr, col0 = wc * 32 + 4 * fq;
#pragma unroll
        for (int ai = 0; ai < 2; ++ai)
#pragma unroll
            for (int m = 0; m < 4; ++m) { float* rowp = O + (size_t)(row0 + ai * 128 + m * 16) * 2048 + col0;
#pragma unroll
                for (int bj = 0; bj < 2; ++bj)
#pragma unroll
                    for (int n = 0; n < 2; ++n) *(f32x4*)(rowp + bj * 128 + n * 16) = acc[ai][bj][m][n]; } } };
struct SchedOut { const char *Y, *W; int nm; const float* modv_l;
    __device__ __forceinline__ bool next(int i, g8::Unit& u) const { const int nu = nm * 4, L = i * (int)gridDim.x + (int)blockIdx.x; if (L >= nu) return false; const int id = g8::xcd_remap(L, nu);
        u.kind = 0; u.pm = id >> 2; u.pn = id & 3; u.a = Y + (size_t)u.pm * 256 * 2048; u.b = W + (size_t)u.pn * 256 * 2048; u.o = nullptr; u.e = u.pm < 128 ? u.pm >> 4 : 8; return true; } };
struct EpiOut { static constexpr bool PERM = true; bf16_t* Y2; const float* bout; const float* modv_l;
    __device__ __forceinline__ void side0(const g8::Unit& u, int t, unsigned& a, unsigned& b, unsigned& c) const { a = __float_as_uint(bout[u.pn * 256 + t]); b = __float_as_uint(modv_l[(size_t)u.e * 6144 + 2048 + u.pn * 256 + t]); }
    __device__ __forceinline__ void side1(const g8::Unit&, int, unsigned&, unsigned&, unsigned&) const {}
    __device__ __forceinline__ void operator()(const f32x4 (&acc)[2][2][4][2], const g8::Unit& u, int wr, int wc, int fr, int fq, const LAS unsigned* sd) const {
        { const int ln_ = tid_() & 63; fr = ln_ & 15; fq = ln_ >> 4; }
        const int row0 = u.pm * 256 + wr * 64 + fr, col0 = u.pn * 256 + wc * 32 + 8 * fq;
        f32x4 bv[2][2], gv[2][2];
#pragma unroll
        for (int bj = 0; bj < 2; ++bj)
#pragma unroll
            for (int n = 0; n < 2; ++n) { bv[bj][n] = *(const LAS f32x4*)(sd + wc * 32 + 8 * fq + bj * 128 + 4 * n); gv[bj][n] = *(const LAS f32x4*)(sd + 256 + wc * 32 + 8 * fq + bj * 128 + 4 * n); }
#pragma unroll
        for (int ai = 0; ai < 2; ++ai)
#pragma unroll
            for (int m = 0; m < 4; ++m) { bf16_t* rowp = Y2 + (size_t)(row0 + ai * 128 + m * 16) * D + col0;
#pragma unroll
                for (int bj = 0; bj < 2; ++bj) { const f32x4 v0 = gv[bj][0] * (acc[ai][bj][m][0] + bv[bj][0]), v1 = gv[bj][1] * (acc[ai][bj][m][1] + bv[bj][1]);
                    u32x4 w; w.x = cvt_pk_bf16(v0[0], v0[1]); w.y = cvt_pk_bf16(v0[2], v0[3]); w.z = cvt_pk_bf16(v1[0], v1[1]); w.w = cvt_pk_bf16(v1[2], v1[3]); *(u32x4*)(rowp + bj * 128) = w; } } } };
struct MoeTab { const LAS int* pref; const LAS int* cnt; const LAS unsigned char* t2e; int ntile;
    __device__ __forceinline__ int pref_(int e) const { return __builtin_amdgcn_readfirstlane(pref[e]); }
    __device__ __forceinline__ int cnt_(int e) const { return __builtin_amdgcn_readfirstlane(cnt[e]); }
    __device__ __forceinline__ int expert_of(int pm) const { return __builtin_amdgcn_readfirstlane((int)t2e[pm]); } };
struct SchedGu { MoeTab tb; const char *U, *W; char* ACT; const int* rasg; int rb;
    __device__ __forceinline__ bool next(int i, g8::Unit& u) const { const int nu = tb.ntile * 8, L = i * (int)gridDim.x + (int)blockIdx.x; if (L >= nu) return false; const int id = g8::xcd_remap(L, nu);
        u.kind = 0; u.pm = id >> 3; u.pn = id & 7; u.e = tb.expert_of(u.pm); u.a = U; u.b = W + ((size_t)u.e * 2048 + u.pn * 256) * rb; u.o = ACT + (size_t)u.pm * 256 * rb; return true; }
    __device__ __forceinline__ int row(const g8::Unit& u, int r) const { const int v = rasg[(size_t)u.e * TT + (u.pm - tb.pref_(u.e)) * 256 + r] >> 2; return min(max(v, 0), TT - 1); } };
template <bool F8> struct EpiGu { static constexpr bool PERM = true; const float* bgu;
    __device__ __forceinline__ void side0(const g8::Unit& u, int t, unsigned& a, unsigned& b, unsigned& c) const { a = __float_as_uint(bgu[(size_t)u.e * 2048 + (t < 128 ? 0 : 1024 - 128) + u.pn * 128 + t]); }
    __device__ __forceinline__ void side1(const g8::Unit&, int, unsigned&, unsigned&, unsigned&) const {}
    __device__ __forceinline__ void operator()(const f32x4 (&acc)[2][2][4][2], const g8::Unit& u, int wr, int wc, int fr, int fq, const LAS unsigned* sd) const {
        { const int ln_ = tid_() & 63; fr = ln_ & 15; fq = ln_ >> 4; }
        const int col0 = u.pn * 128 + wc * 32 + 8 * fq; const float sc = F8 ? (1.0f / 64.0f) : 1.0f;
        f32x4 bgt[2], bup[2];
#pragma unroll
        for (int n = 0; n < 2; ++n) { bgt[n] = *(const LAS f32x4*)(sd + wc * 32 + 8 * fq + 4 * n); bup[n] = *(const LAS f32x4*)(sd + 128 + wc * 32 + 8 * fq + 4 * n); }
#pragma unroll
        for (int ai = 0; ai < 2; ++ai)
#pragma unroll
            for (int m = 0; m < 4; ++m) { const int r = ai * 128 + wr * 64 + m * 16 + fr; float y[8];
#pragma unroll
                for (int n = 0; n < 2; ++n)
#pragma unroll
                    for (int h = 0; h < 2; ++h) {
                        f32x2 g2 = (f32x2){acc[ai][0][m][n][2 * h], acc[ai][0][m][n][2 * h + 1]} * sc + (f32x2){bgt[n][2 * h], bgt[n][2 * h + 1]};
                        f32x2 u2 = (f32x2){acc[ai][1][m][n][2 * h], acc[ai][1][m][n][2 * h + 1]} * sc + (f32x2){bup[n][2 * h], bup[n][2 * h + 1]};
                        g2.x = fminf(g2.x, 7.0f); g2.y = fminf(g2.y, 7.0f); u2.x = __builtin_amdgcn_fmed3f(u2.x, -7.0f, 7.0f); u2.y = __builtin_amdgcn_fmed3f(u2.y, -7.0f, 7.0f);
                        const f32x2 t2 = g2 * (-1.702f * 1.4426950408889634f); f32x2 d2; d2.x = fexp2(t2.x); d2.y = fexp2(t2.y); d2 = d2 + 1.0f;
                        f32x2 s2; s2.x = frcp(d2.x); s2.y = frcp(d2.y);
                        const f32x2 y2 = (u2 + 1.0f) * g2 * s2; y[4 * n + 2 * h] = y2.x; y[4 * n + 2 * h + 1] = y2.y; }
                if constexpr (F8) { u32x2 w; w.x = pk4_fp8(y[0], y[1], y[2], y[3]); w.y = pk4_fp8(y[4], y[5], y[6], y[7]); *(u32x2*)((unsigned char*)u.o + (size_t)r * D + col0) = w; }
                else *(u32x4*)((bf16_t*)u.o + (size_t)r * D + col0) = pack8(y); } } };
struct SchedDown { MoeTab tb; const char *ACT, *W; int rb;
    __device__ __forceinline__ bool next(int i, g8::Unit& u) const { const int nu = tb.ntile * 4, L = i * (int)gridDim.x + (int)blockIdx.x; if (L >= nu) return false; const int id = g8::xcd_remap(L, nu);
        u.kind = 0; u.pm = id >> 2; u.pn = id & 3; u.e = tb.expert_of(u.pm); u.a = ACT + (size_t)u.pm * 256 * rb; u.b = W + ((size_t)u.e * 1024 + u.pn * 256) * rb; u.o = nullptr; return true; } };
struct EpiDown { static constexpr bool PERM = true; MoeTab tb; const float* bd; const int* rasg; const float* gate; bf16_t* YS; float sc;
    __device__ __forceinline__ void side0(const g8::Unit& u, int t, unsigned& a, unsigned& b, unsigned& c) const { const int rank = (u.pm - tb.pref_(u.e)) * 256 + t;
        a = rank < tb.cnt_(u.e) ? (unsigned)rasg[(size_t)u.e * TT + rank] : 0xffffffffu; c = __float_as_uint(bd[(size_t)u.e * 1024 + u.pn * 256 + t]); }
    __device__ __forceinline__ void side1(const g8::Unit&, int, unsigned& a, unsigned& b, unsigned&) const { b = (int)a >= 0 ? __float_as_uint(gate[(int)a]) : 0u; }
    __device__ __forceinline__ void operator()(const f32x4 (&acc)[2][2][4][2], const g8::Unit& u, int wr, int wc, int fr, int fq, const LAS unsigned* sd) const {
        { const int ln_ = tid_() & 63; fr = ln_ & 15; fq = ln_ >> 4; }
        const int col0 = u.pn * 256 + wc * 32 + 8 * fq;
        f32x4 bv[2][2];
#pragma unroll
        for (int bj = 0; bj < 2; ++bj)
#pragma unroll
            for (int n = 0; n < 2; ++n) bv[bj][n] = *(const LAS f32x4*)(sd + 512 + wc * 32 + 8 * fq + bj * 128 + 4 * n);
#pragma unroll
        for (int ai = 0; ai < 2; ++ai)
#pragma unroll
            for (int m = 0; m < 4; ++m) { const int r = ai * 128 + wr * 64 + m * 16 + fr; const int asg = (int)sd[r]; const float g = __uint_as_float(sd[256 + r]);
                if (asg >= 0) { unsigned char* rowp = (unsigned char*)YS + (size_t)asg * D + col0; const float g16 = g * 16.0f;
#pragma unroll
                    for (int bj = 0; bj < 2; ++bj) { const f32x4 v0 = (acc[ai][bj][m][0] * sc + bv[bj][0]) * g16, v1 = (acc[ai][bj][m][1] * sc + bv[bj][1]) * g16;
                        u32x2 w; w.x = pk4_fp8(v0[0], v0[1], v0[2], v0[3]); w.y = pk4_fp8(v1[0], v1[1], v1[2], v1[3]); *(u32x2*)(rowp + bj * 128) = w; } } } } };
__device__ __forceinline__ MoeTab moe_tables(CP p, int l, LAS unsigned char* lds) {
    LAS int* pref = (LAS int*)(lds + g8::STAGE_BYTES); LAS int* cnt = pref + 64; LAS unsigned char* t2e = (LAS unsigned char*)(lds + g8::STAGE_BYTES + 384);
    unsigned* ctl = (unsigned*)(p->ws + WS_CTL);
    const int tid = tid_();
    __syncthreads();
    if (tid < 32) cnt[tid] = (int)__hip_atomic_load(ctl + CW_COUNT + (l * NE + tid) * 64, __ATOMIC_RELAXED, __HIP_MEMORY_SCOPE_AGENT);
    __syncthreads();
    if (tid == 0) { int s = 0; for (int e = 0; e < 32; ++e) { pref[e] = s; s += (cnt[e] + 255) >> 8; } pref[32] = s; }
    __syncthreads();
    for (int pm = tid; pm < NTILE_MAX; pm += 512) { int e = 0; for (int k = 1; k < 32; ++k) e += (pm >= pref[k]) ? 1 : 0; t2e[pm] = (unsigned char)e; }
    __syncthreads();
    MoeTab tb; tb.pref = pref; tb.cnt = cnt; tb.t2e = t2e; tb.ntile = __builtin_amdgcn_readfirstlane(pref[32]); return tb;
}

constexpr int N_PHASES = 18;
__global__ void __launch_bounds__(512, 2) mega_fwd(Params p_unused) {
    CP p = launder_params();
    extern __shared__ __attribute__((aligned(16))) unsigned char shm_[];
    LAS unsigned char* lds0 = (LAS unsigned char*)shm_;
    LAS unsigned char* lds = lds0 + LDS_BASE;
    if (tid_() == 0) *(LAS u32x4*)lds0 = (u32x4){0u, 0u, 0u, 0u};
    __syncthreads();
    XcdBarrier bar = xcd_barrier_post((unsigned*)(p->ws + WS_CTL), (volatile LAS unsigned*)lds0);
    int ph = 0;
#ifndef P3A
#define P3A 1
#define P3B 1
#define P3C 1
#endif
#ifndef PHMASK
#define PHMASK 0x3ff
#endif
#ifndef REPMASK
#define REPMASK 0
#endif
#define PHASE_BEGIN_K(k) p = launder_params(); if (((PHMASK >> (k)) & 1) && ph >= p->ph_lo && ph < p->ph_hi) for (int rep_ = 0; rep_ < ((((REPMASK) >> (k)) & 1) ? 2 : 1); ++rep_) {
#define PHASE_END } ++ph; if (ph > p->ph_lo && ph < p->ph_hi) xcd_barrier(bar);
    PHASE_BEGIN_K(0) phase_prologue(p, lds, rep_); PHASE_END
    for (int l = 0; l < 2; ++l) {
        const float* modv_l = (const float*)(p->ws + WS_MODV) + (size_t)l * 9 * 6144;
        PHASE_BEGIN_K(1) phase_norm(p, l); PHASE_END
        PHASE_BEGIN_K(2) { SchedIn S; S.U = (const char*)(p->ws + WS_U); S.W = (const char*)(p->ws + WS_WINT) + (size_t)l * NPROJ * 2048; S.WF = (const char*)(p->ws + WS_WFT) + (size_t)l * 512 * 2048;
                      S.PROJ = (char*)(p->ws + WS_PROJ); S.PQT = (char*)(p->ws + WS_PQT); S.PQC = (char*)(p->ws + WS_PQC);
                      EpiIn E; E.bin = (const float*)(p->ws + WS_BIN) + l * NPROJ; E.bf = (const float*)(p->ws + WS_BF) + l * 512;
                      g8::gemm_phase<EpiIn, SchedIn, false>(lds, 1024, S, E); } PHASE_END
        PHASE_BEGIN_K(3) {
                      unsigned* qhead = (unsigned*)(p->ws + WS_CTL) + CW_QUEUE + (l * 2 + rep_) * 64; LAS int* qslot = (LAS int*)(lds - LDS_BASE + 64);
                      for (;;) { __syncthreads(); if (tid_() == 0) *qslot = (int)__hip_atomic_fetch_add(qhead, 1u, __ATOMIC_RELAXED, __HIP_MEMORY_SCOPE_AGENT); __syncthreads();
                          const int id = __builtin_amdgcn_readfirstlane(*qslot); const int nwj = MOE_W_IN_QUEUE ? (l == 0 ? J_TGU_L(0) + J_TD_L(0) : J_TGU_L(1) + J_TD_L(1)) : 0;
                          if (id >= 144 + 9 * NCHUNK) break;
                          int small = -1;
                          if (id >= 144) { const int r = id - 144, g = r / 3, k = r - 3 * g; if (k == 0) small = g; else { const int wj = 2 * g + (k - 1); if (wj < nwj) moe_weight_job(p, l, wj, lds); continue; } }
                          if (id < 136) { SchedOne S; S.u.kind = 0; S.u.e = 0;
                              if (id < 72) { S.u.pm = id >> 3; S.u.pn = id & 7; S.u.a = (const char*)(p->ws + WS_CMAT) + (size_t)S.u.pm * 256 * 4096; S.u.b = (const char*)(p->ws + WS_PQT) + (size_t)S.u.pn * 256 * 4096; S.u.o = (char*)(p->ws + WS_UU) + ((size_t)S.u.pm * 256 * 2048 + S.u.pn * 256) * 4; }
                              else { const int r = id - 72; S.u.pm = r >> 3; S.u.pn = r & 7; S.u.a = (const char*)(p->ws + WS_SMAT) + (size_t)S.u.pm * 256 * 4096; S.u.b = (const char*)(p->ws + WS_PQT) + (size_t)(2048 + S.u.pn * 256) * 4096; S.u.o = (char*)(p->ws + WS_VV) + ((size_t)S.u.pm * 256 * 2048 + S.u.pn * 256) * 4; }
                              g8::gemm_phase<EpiF32, SchedOne, false, true>(lds, 2048, S, EpiF32{}); }
                          else if (id < 144) { SchedOne S; S.u.kind = 0; S.u.e = 0; S.u.pm = 0; S.u.pn = id - 136; S.u.a = (const char*)(p->ws + WS_DFTC); S.u.b = (const char*)(p->ws + WS_PQC) + (size_t)S.u.pn * 256 * 512; S.u.o = (char*)(p->ws + WS_YCX) + (size_t)S.u.pn * 256 * 4;
                              g8::gemm_phase<EpiF32, SchedOne, false, true>(lds, 256, S, EpiF32{}); }
                          else { const int uu = small, kind = uu / NCHUNK, q = uu % NCHUNK;
                              if (kind == 0) scan_unit<1>(p, l, q, lds); else if (kind == 1) conformer_unit(p, l, q, lds); else pool_unit(p, l, q, lds); } } } PHASE_END
        PHASE_BEGIN_K(4) { for (int q = blockIdx.x; q < NCHUNK; q += gridDim.x) { scan2_unit(p, l, q, lds); four_unit(p, l, q); } } PHASE_END
        PHASE_BEGIN_K(5) { SchedOut S; S.Y = (const char*)(p->ws + WS_YCAT); S.W = (const char*)(p->ws + WS_WOUTT) + (size_t)l * D * 2048; S.nm = l == 0 ? 136 : 128; S.modv_l = modv_l;
                      EpiOut E; E.Y2 = (bf16_t*)(p->ws + WS_PROJ);   E.bout = (const float*)(p->ws + WS_BOUT) + l * D; E.modv_l = modv_l;
                      g8::gemm_phase<EpiOut, SchedOut, false>(lds, 1024, S, E); } PHASE_END
        PHASE_BEGIN_K(6) phase_router(p, l, lds, rep_); PHASE_END
        PHASE_BEGIN_K(7) { MoeTab tb = moe_tables(p, l, lds);
                      SchedGu S; S.tb = tb; S.W = (const char*)(p->ws + WS_WGUT) + (size_t)l * NE * 2048 * 2048; S.ACT = (char*)(p->ws + WS_ACT); S.rasg = (const int*)(p->ws + WS_RASG);
                      if (fp8_layer(l)) { S.U = (const char*)(p->ws + WS_U8); S.rb = 1024; EpiGu<true> E; E.bgu = p->b_gu + (size_t)l * NE * 2048; g8::gemm_phase<EpiGu<true>, SchedGu, true, true>(lds, 512, S, E); }
                      else { S.U = (const char*)(p->ws + WS_U); S.rb = 2048; EpiGu<false> E; E.bgu = p->b_gu + (size_t)l * NE * 2048; g8::gemm_phase<EpiGu<false>, SchedGu, true, false>(lds, 1024, S, E); } } PHASE_END
        PHASE_BEGIN_K(8) { MoeTab tb = moe_tables(p, l, lds);
                      SchedDown S; S.tb = tb; S.ACT = (const char*)(p->ws + WS_ACT); S.W = (const char*)(p->ws + WS_WDT) + (size_t)l * NE * 1024 * 2048;
                      EpiDown E; E.tb = tb; E.bd = p->b_down + (size_t)l * NE * 1024; E.rasg = (const int*)(p->ws + WS_RASG); E.gate = (const float*)(p->ws + WS_GATE); E.YS = (bf16_t*)(p->ws + WS_YS);
                      if (fp8_layer(l)) { S.rb = 1024; E.sc = 1.0f / 64.0f; g8::gemm_phase<EpiDown, SchedDown, false, true>(lds, 512, S, E); }
                      else { S.rb = 2048; E.sc = 1.0f; g8::gemm_phase<EpiDown, SchedDown, false, false>(lds, 1024, S, E); } } PHASE_END
    }
    PHASE_BEGIN_K(9) phase_norm(p, 2); PHASE_END
#undef PHASE_BEGIN_K
#undef PHASE_END
}

extern "C" void kernel_launch(void* const* d_in, const int* in_sizes, int n_in, void* d_out, int out_size, void* d_ws, size_t ws_size, hipStream_t stream) {
    static int grid = 0;
    if (!grid) {
        if (n_in != 37 || ws_size < WS_END) { fprintf(stderr, "kernel_launch: expected 37 inputs and >= %zu bytes of workspace (got %d, %zu)\n", (size_t)WS_END, n_in, ws_size); }
        int dev = 0, cus = 0, per_cu = 0;
        hipGetDevice(&dev); hipDeviceGetAttribute(&cus, hipDeviceAttributeMultiprocessorCount, dev);
        hipFuncSetAttribute((const void*)mega_fwd, hipFuncAttributeMaxDynamicSharedMemorySize, LDS_BYTES);
        hipOccupancyMaxActiveBlocksPerMultiprocessor(&per_cu, (const void*)mega_fwd, 512, LDS_BYTES);
        if (per_cu < 1) fprintf(stderr, "kernel_launch: occupancy query reports %d workgroups per CU\n", per_cu);
        grid = cus > 0 ? cus : 256;
    }
    hipMemsetAsync((char*)d_ws + WS_CTL, 0, CTL_BYTES, stream);
    Params hp{};
    const float** f = (const float**)&hp;
    for (int i = 0; i < 37; ++i) f[i] = (const float*)d_in[i];
    hp.out = (float*)d_out; hp.ws = (unsigned char*)d_ws;
#if MK_N_LAUNCHES == 1
    hp.ph_lo = 0; hp.ph_hi = N_PHASES;
    hipLaunchKernelGGL(mega_fwd, dim3(grid), dim3(512), LDS_BYTES, stream, hp);
#else
    for (int ph = 0; ph < N_PHASES; ++ph) { hp.ph_lo = ph; hp.ph_hi = ph + 1; hipLaunchKernelGGL(mega_fwd, dim3(grid), dim3(512), LDS_BYTES, stream, hp); }
#endif
}
```

```cpp
#include <hip/hip_runtime.h>
#include <cstdio>
#include <cstdint>

#ifndef MK_N_LAUNCHES
#define MK_N_LAUNCHES 1
#endif

#ifndef FP8_FROM
#define FP8_FROM 0
#endif
#define LAS __attribute__((address_space(3)))
typedef unsigned short bf16_t;
typedef short bf16x8 __attribute__((ext_vector_type(8)));
typedef float f32x4 __attribute__((ext_vector_type(4)));
typedef float f32x2 __attribute__((ext_vector_type(2)));
typedef unsigned u32x4 __attribute__((ext_vector_type(4)));
typedef unsigned u32x2 __attribute__((ext_vector_type(2)));
typedef int i32x4 __attribute__((ext_vector_type(4)));
typedef int i32x8 __attribute__((ext_vector_type(8)));

constexpr int D = 1024, NB = 8, SEQ = 4096, LCX = 256, TL = NB * SEQ, TC = NB * LCX, TT = TL + TC;
constexpr int NPROJ = 1280;
constexpr int NE = 32, NCHUNK = 544;
constexpr int NTILE_MAX = 576;

constexpr size_t AL(size_t x) { return (x + 255) & ~(size_t)255; }
constexpr size_t CTL_BYTES = 65536;
constexpr size_t WS_CTL = 0;
constexpr size_t WS_MODV = WS_CTL + CTL_BYTES;
constexpr size_t WS_X = AL(WS_MODV + (size_t)2 * 9 * 6144 * 4);
constexpr size_t WS_U = AL(WS_X + (size_t)TT * D * 4);
constexpr size_t WS_PROJ = AL(WS_U + (size_t)TT * D * 2);
constexpr size_t WS_PQT = AL(WS_PROJ + (size_t)TT * NPROJ * 2);
constexpr size_t WS_PQC = AL(WS_PQT + (size_t)4096 * 4096 * 2);
constexpr size_t WS_UU = AL(WS_PQC + (size_t)2048 * 512 * 2);
constexpr size_t WS_VV = AL(WS_UU + (size_t)2304 * 2048 * 4);
constexpr size_t WS_YCX = AL(WS_VV + (size_t)2048 * 2048 * 4);
constexpr size_t WS_YCAT = AL(WS_YCX + (size_t)256 * 2048 * 4);
constexpr size_t WS_SUMM = AL(WS_YCAT + (size_t)TT * D * 2);
constexpr size_t WS_WINT = AL(WS_SUMM + (size_t)NCHUNK * 1024 * 4);
constexpr size_t WS_WFT = AL(WS_WINT + (size_t)2 * NPROJ * D * 2);
constexpr size_t WS_BIN = AL(WS_WFT + (size_t)2 * 512 * D * 2);
constexpr size_t WS_BF = AL(WS_BIN + (size_t)2 * NPROJ * 4);
constexpr size_t WS_WOUTT = AL(WS_BF + (size_t)2 * 512 * 4);
constexpr size_t WS_BOUT = AL(WS_WOUTT + (size_t)2 * D * D * 2);
constexpr size_t WS_WGUT = AL(WS_BOUT + (size_t)2 * D * 4);
constexpr size_t WS_WDT = AL(WS_WGUT + (size_t)2 * NE * 2048 * D * 2);
constexpr size_t WS_WRT = AL(WS_WDT + (size_t)2 * NE * D * D * 2);
constexpr size_t WS_WGT = AL(WS_WRT + (size_t)2 * 2 * NE * D * 2);
constexpr size_t WS_CMAT = AL(WS_WGT + (size_t)2 * 2 * 2 * 4 * 64 * 64 * 2);
constexpr size_t WS_SMAT = AL(WS_CMAT + (size_t)2304 * 4096 * 2);
constexpr size_t WS_DFTC = AL(WS_SMAT + (size_t)2048 * 4096 * 2);
constexpr size_t WS_RASG = AL(WS_DFTC + (size_t)256 * 512 * 2);
constexpr size_t WS_GATE = AL(WS_RASG + (size_t)NE * TT * 4);
constexpr size_t WS_ACT = AL(WS_GATE + (size_t)TT * 4 * 4);
constexpr size_t WS_YS = AL(WS_ACT + (size_t)NTILE_MAX * 256 * D * 2);
constexpr size_t WS_POS = AL(WS_YS + (size_t)TT * 4 * D * 2);
constexpr size_t WS_AB = AL(WS_POS + (size_t)64 * 512 * 4);
constexpr size_t WS_U8 = AL(WS_AB + (size_t)NCHUNK * 8 * 16 * 64 * 16);
constexpr size_t WS_RGATE = AL(WS_U8 + (size_t)TT * D);
constexpr size_t WS_RROFF = AL(WS_RGATE + (size_t)NE * TT * 4 + 4096);
constexpr size_t WS_END = AL(WS_RROFF + (size_t)NE * TT * 4 + 4096);
constexpr int CW_QUEUE = 12288;
constexpr int CW_COUNT = 4096;

constexpr int LDS_BYTES = 159744;
constexpr int LDS_BASE = 1024;

__device__ __forceinline__ unsigned cvt_pk_bf16(float lo, float hi) { unsigned r; asm("v_cvt_pk_bf16_f32 %0, %1, %2" : "=v"(r) : "v"(lo), "v"(hi)); return r; }
__device__ __forceinline__ bf16_t f2bf(float f) { return (bf16_t)(cvt_pk_bf16(f, 0.f) & 0xffffu); }
__device__ __forceinline__ unsigned pk4_fp8(float a, float b, float c, float d) { int w = 0; w = __builtin_amdgcn_cvt_pk_fp8_f32(a, b, w, false); w = __builtin_amdgcn_cvt_pk_fp8_f32(c, d, w, true); return (unsigned)w; }
__device__ __forceinline__ float bf2f(bf16_t b) { return __uint_as_float(((unsigned)b) << 16); }
__device__ __forceinline__ float bflo(unsigned w) { return __uint_as_float(w << 16); }
__device__ __forceinline__ float bfhi(unsigned w) { return __uint_as_float(w & 0xffff0000u); }
__device__ __forceinline__ float fexp2(float x) { return __builtin_amdgcn_exp2f(x); }
__device__ __forceinline__ float frcp(float x) { return __builtin_amdgcn_rcpf(x); }
__device__ __forceinline__ float sigmoidf_(float x) { return frcp(1.0f + fexp2(-1.4426950408889634f * x)); }
__device__ __forceinline__ int tid_() { int t = (int)threadIdx.x; asm volatile("" : "+v"(t)); return t; }
__device__ __forceinline__ float bperm(float v, int src) { return __int_as_float(__builtin_amdgcn_ds_bpermute(src << 2, __float_as_int(v))); }
__device__ __forceinline__ float wave_sum(float v, int lane) {
#pragma unroll
    for (int o = 32; o >= 1; o >>= 1) v += bperm(v, lane ^ o);
    return v;
}
__device__ __forceinline__ void unpack8(const u32x4 w, float (&f)[8]) { f[0] = bflo(w.x); f[1] = bfhi(w.x); f[2] = bflo(w.y); f[3] = bfhi(w.y); f[4] = bflo(w.z); f[5] = bfhi(w.z); f[6] = bflo(w.w); f[7] = bfhi(w.w); }
__device__ __forceinline__ u32x4 pack8(const float (&f)[8]) { u32x4 w; w.x = cvt_pk_bf16(f[0], f[1]); w.y = cvt_pk_bf16(f[2], f[3]); w.z = cvt_pk_bf16(f[4], f[5]); w.w = cvt_pk_bf16(f[6], f[7]); return w; }

#define XB_TMO      128
#define XB_XCNT(j)  (256  + 64 * (j))
#define XB_XSUB(j)  (1280 + 64 * (j))
#define XB_XGEN(j)  (2304 + 64 * (j))
#define XB_TOP      3328
#define XB_TOPGEN   3392
#define XCD_BAR_WORDS 3456
#define XB_SPIN_CAP (1u << 18)
__device__ __forceinline__ unsigned xb_ld(unsigned* p)              { return __hip_atomic_load(p, __ATOMIC_RELAXED, __HIP_MEMORY_SCOPE_AGENT); }
__device__ __forceinline__ unsigned xb_add(unsigned* p, unsigned v) { return __hip_atomic_fetch_add(p, v, __ATOMIC_RELAXED, __HIP_MEMORY_SCOPE_AGENT); }
__device__ __forceinline__ unsigned xb_xcc_id() { return (unsigned)__builtin_amdgcn_s_getreg((3 << 11) | 20) & 0xFu; }
#define XB_SPIN(cond, bar) do { unsigned _sp = 0; while (cond) { __builtin_amdgcn_s_sleep(1); \
    if ((++_sp & 255u) == 0u) { if (xb_ld(&(bar)[XB_TMO])) break; if (_sp > XB_SPIN_CAP) { atomicAdd(&(bar)[XB_TMO], 1u); break; } } } } while (0)
struct XcdBarrier { unsigned* bar; unsigned x; volatile LAS unsigned* st; };
__device__ __forceinline__ XcdBarrier xcd_barrier_post(unsigned* bar, volatile LAS unsigned* st) {
    XcdBarrier b; b.bar = bar; b.x = xb_xcc_id(); b.st = st;
    if (threadIdx.x == 0) (void)xb_add(&bar[XB_XCNT(b.x)], 1u);
    return b;
}
__device__ __forceinline__ void xcd_barrier_complete(unsigned* bar, unsigned x, unsigned& nloc, unsigned& nx) {
    const unsigned G = gridDim.x * gridDim.y * gridDim.z;
    unsigned sum, cnt, mine, sp = 0u;
    for (;;) {
        sum = 0u; cnt = 0u; mine = 0u;
#pragma unroll
        for (unsigned j = 0; j < 16; ++j) { const unsigned c = xb_ld(&bar[XB_XCNT(j)]); sum += c; cnt += (c > 0u) ? 1u : 0u; mine = (j == x) ? c : mine; }
        if (sum == G) break;
        __builtin_amdgcn_s_sleep(1);
        if ((++sp & 255u) == 0u) { if (xb_ld(&bar[XB_TMO])) break; if (sp > XB_SPIN_CAP) { atomicAdd(&bar[XB_TMO], 1u); break; } }
    }
    nloc = mine > 0u ? mine : 1u; nx = cnt > 0u ? cnt : 1u;
}
__device__ __forceinline__ void xcd_barrier(const XcdBarrier& b) {
    asm volatile("s_waitcnt vmcnt(0)" ::: "memory");
    __syncthreads();
    if (threadIdx.x == 0) {
        unsigned* bar = b.bar;
        __builtin_amdgcn_s_waitcnt(0);
        unsigned nloc = b.st[0], nx = b.st[1];
        if (nloc == 0u) { unsigned xo = b.x; asm volatile("" : "+s"(xo)); xcd_barrier_complete(bar, xo, nloc, nx); b.st[0] = nloc; b.st[1] = nx; }
        const unsigned old = xb_add(&bar[XB_XSUB(b.x)], 1u);
        const unsigned gen = old / nloc;
        if (old + 1u == (gen + 1u) * nloc) {
            __builtin_amdgcn_fence(__ATOMIC_RELEASE, "agent");
            asm volatile("s_waitcnt vmcnt(0)" ::: "memory");
            const unsigned og = xb_add(&bar[XB_TOP], 1u);
            const unsigned tg = og / nx;
            if (og + 1u == (tg + 1u) * nx) xb_add(&bar[XB_TOPGEN], 1u);
            else XB_SPIN(xb_ld(&bar[XB_TOPGEN]) == tg, bar);
            __builtin_amdgcn_fence(__ATOMIC_ACQUIRE, "agent");
            xb_add(&bar[XB_XGEN(b.x)], 1u);
            asm volatile("s_waitcnt vmcnt(0)" ::: "memory");
        } else {
            XB_SPIN(xb_ld(&bar[XB_XGEN(b.x)]) == gen, bar);
            __builtin_amdgcn_fence(__ATOMIC_ACQUIRE, "agent");
            asm volatile("s_waitcnt vmcnt(0)" ::: "memory");
        }
    }
    __syncthreads();
}

namespace g8 {
constexpr int BM = 256, BK = 64, HALF = 128, HTB = HALF * BK * 2, STAGE_BYTES = 8 * HTB;
__device__ __forceinline__ int lds_byte(int r, int c) { const int st = (r >> 4) * 2 + (c >> 5), rr = r & 15, cc = c & 31, ob = rr * 64 + cc * 2; return st * 1024 + (ob ^ (((ob >> 9) & 1) << 5)); }
__device__ __forceinline__ void stage_rc(int b, int& R, int& C) { const int st = b / 1024, sb = b % 1024, swz = sb ^ (((sb >> 9) & 1) << 5); R = (st >> 1) * 16 + swz / 64; C = (st & 1) * 32 + (swz % 64) / 2; }
__device__ __forceinline__ int perm32(int rho) { const int n = rho >> 4, i = rho & 15; return 8 * (i >> 2) + 4 * n + (i & 3); }

struct Unit { const char* a; const char* b; char* o; int kind, pm, pn, e; };
__device__ __forceinline__ void dma4(const void* g, LAS unsigned char* l) { __builtin_amdgcn_global_load_lds((const unsigned*)g, (LAS unsigned*)l, 4, 0, 0); }

__device__ __forceinline__ int xcd_remap(int L, int nu) { const int q = nu / 8, r = nu % 8, xcd = L % 8, off = L / 8; return (xcd < r ? xcd * (q + 1) : r * (q + 1) + (xcd - r) * q) + off; }

template <class Epi, class Sched, bool GATHER, bool FP8 = false>
__device__ __forceinline__ void gemm_phase(LAS unsigned char* lds, const int K, const Sched& S, const Epi& E) {
    const int tid = tid_(), wid = __builtin_amdgcn_readfirstlane(tid >> 6), lane = tid & 63, wr = wid >> 2, wc = wid & 3, fr = lane & 15, fq = lane >> 4;
    const int nt = K / BK;
    { u32x4 vo4;
      { int R, C; stage_rc(tid * 16, R, C); const int Rb = Epi::PERM ? ((R & ~31) + perm32(R & 31)) : R; vo4.x = (unsigned)(R * K + C) * 2u; vo4.z = (unsigned)(Rb * K + C) * 2u; }
      { int R, C; stage_rc(tid * 16 + 8192, R, C); const int Rb = Epi::PERM ? ((R & ~31) + perm32(R & 31)) : R; vo4.y = (unsigned)(R * K + C) * 2u; vo4.w = (unsigned)(Rb * K + C) * 2u; }
      *(LAS u32x4*)(lds + STAGE_BYTES + 4096 + tid * 16) = vo4; asm volatile("s_waitcnt lgkmcnt(0)" ::: "memory"); }
    const size_t kstep = (size_t)(BK * 2);
    const size_t hstep = (size_t)HALF * K * 2;
    const unsigned ldsw = (unsigned)wid * 1024u;
    const int aoff = lds_byte(wr * 64 + fr, fq * 8), boff = lds_byte(wc * 32 + fr, fq * 8);
#define G8_SA(b, h) (((b) * 2 + (h)) * HTB)
#define G8_SB(b, h) ((4 + (b) * 2 + (h)) * HTB)
#define G8_ST2(bufoff, gbase, isb) do { const u32x2 _v2 = *(const LAS u32x2*)(lds + STAGE_BYTES + 4096 + tid_() * 16 + (isb) * 8); _Pragma("unroll") for (int _i = 0; _i < 2; ++_i) { unsigned _vo = _i ? _v2.y : _v2.x; asm volatile("" : "+v"(_vo)); \
        __builtin_amdgcn_global_load_lds((const unsigned*)((const char*)(gbase) + _vo), (LAS unsigned*)(lds + (bufoff) + ldsw + _i * 8192), 16, 0, 0); } } while (0)
#define G8_STA_CUR(bufoff, gbase, h) do { if constexpr (GATHER) { const int _t = tid_(); _Pragma("unroll") for (int _i = 0; _i < 2; ++_i) { int _R, _C; stage_rc(_t * 16 + _i * 8192, _R, _C); unsigned _o = min(ROFF[parA * 256 + (h) * 128 + _R], S.maxoff) + (unsigned)(_C * 2); asm volatile("" : "+v"(_o));     \
        __builtin_amdgcn_global_load_lds((const unsigned*)((const char*)(gbase) + _o), (LAS unsigned*)(lds + (bufoff) + ldsw + _i * 8192), 16, 0, 0); } } else { G8_ST2(bufoff, (gbase) + (h) * hstep, 0); } } while (0)
#define G8_LDA(dst, dst8, b, h) do { _Pragma("unroll") for (int m = 0; m < 4; ++m) { if constexpr (FP8) { const i32x4 lo_ = *(const LAS i32x4*)(lds + G8_SA(b, h) + aoff + m * 2048), hi_ = *(const LAS i32x4*)(lds + G8_SA(b, h) + aoff + m * 2048 + 1024); dst8[m] = __builtin_shufflevector(lo_, hi_, 0, 1, 2, 3, 4, 5, 6, 7); } \
        else { _Pragma("unroll") for (int k = 0; k < 2; ++k) dst[m][k] = *(const LAS bf16x8*)(lds + G8_SA(b, h) + aoff + m * 2048 + k * 1024); } } } while (0)
#define G8_LDB(dst, dst8, b, h) do { _Pragma("unroll") for (int n = 0; n < 2; ++n) { if constexpr (FP8) { const i32x4 lo_ = *(const LAS i32x4*)(lds + G8_SB(b, h) + boff + n * 2048), hi_ = *(const LAS i32x4*)(lds + G8_SB(b, h) + boff + n * 2048 + 1024); dst8[n] = __builtin_shufflevector(lo_, hi_, 0, 1, 2, 3, 4, 5, 6, 7); } \
        else { _Pragma("unroll") for (int k = 0; k < 2; ++k) dst[n][k] = *(const LAS bf16x8*)(lds + G8_SB(b, h) + boff + n * 2048 + k * 1024); } } } while (0)
#define G8_MMA(ai, bj, At, At8, Bt, Bt8) do { __builtin_amdgcn_s_setprio(1); _Pragma("unroll") for (int m = 0; m < 4; ++m) _Pragma("unroll") for (int n = 0; n < 2; ++n) { \
        if constexpr (FP8) acc[ai][bj][m][n] = __builtin_amdgcn_mfma_scale_f32_16x16x128_f8f6f4(Bt8[n], At8[m], acc[ai][bj][m][n], 0, 0, 0, 0, 0, 0);     \
        else { _Pragma("unroll") for (int k = 0; k < 2; ++k) acc[ai][bj][m][n] = __builtin_amdgcn_mfma_f32_16x16x32_bf16(Bt[n][k], At[m][k], acc[ai][bj][m][n], 0, 0, 0); } } __builtin_amdgcn_s_setprio(0); } while (0)
#define G8_WAIT_V(n) asm volatile("s_waitcnt vmcnt(" #n ")" ::: "memory")
#define G8_WAIT_L(n) asm volatile("s_waitcnt lgkmcnt(" #n ")" ::: "memory")
#define G8_BAR __builtin_amdgcn_s_barrier()
#define G8_SCHED __builtin_amdgcn_sched_barrier(0)
    Unit cur, nxt; int ui = 0;
    if (!S.next(0, cur)) return;
    f32x4 acc[2][2][4][2];
#pragma unroll
    for (int a = 0; a < 2; ++a)
#pragma unroll
        for (int b = 0; b < 2; ++b)
#pragma unroll
            for (int m = 0; m < 4; ++m)
#pragma unroll
                for (int n = 0; n < 2; ++n) acc[a][b][m][n] = (f32x4){0.f, 0.f, 0.f, 0.f};
    bf16x8 At[4][2], B0[2][2], B1[2][2]; i32x8 At8[4], B08[2], B18[2];
    LAS unsigned* ROFF = (LAS unsigned*)(lds + STAGE_BYTES + 1024);
    LAS unsigned* SIDE = (LAS unsigned*)(lds + STAGE_BYTES + 12288);
    int parA = 0;
    if constexpr (GATHER) {
        if (wr == 0) S.roff_dma(cur, tid, (LAS unsigned char*)ROFF + wid * 256);
        asm volatile("s_waitcnt vmcnt(0)" ::: "memory"); __builtin_amdgcn_s_barrier(); asm volatile("" ::: "memory");
    }
    const char* cA = cur.a; const char* cB = cur.b;
    G8_ST2(G8_SB(0, 0), cB, 1); G8_ST2(G8_SB(0, 1), cB + hstep, 1); G8_STA_CUR(G8_SA(0, 0), cA, 0); G8_STA_CUR(G8_SA(0, 1), cA, 1);
    if (wr == 1) G8_BAR;
    G8_WAIT_V(2); G8_BAR;
    G8_ST2(G8_SB(1, 0), cB + kstep, 1); G8_STA_CUR(G8_SA(1, 0), cA + kstep, 0); G8_ST2(G8_SB(1, 1), cB + hstep + kstep, 1);
    G8_WAIT_V(6); G8_BAR;
    for (;;) {
        const bool has_next = S.next(ui + 1, nxt);
        const char* nA = has_next ? nxt.a : cA; const char* nB = has_next ? nxt.b : cB;
#pragma clang loop unroll(disable)
        for (int t = 0; t < nt; t += 2) {
            const bool last = (t == nt - 2);
            int to = t; asm volatile("" : "+s"(to));
            const char* a1 = cA + (size_t)(to + 1) * kstep;
            const char* a2 = last ? nA : cA + (size_t)(to + 2) * kstep; const char* b2 = last ? nB : cB + (size_t)(to + 2) * kstep;
            const char* a3 = a2 + kstep; const char* b3 = b2 + kstep;
            if (t == 0 && wr == 0) E.side_dma(cur, tid_(), (LAS unsigned char*)(SIDE + (ui & 1) * 768) + wid * 256);
            if constexpr (GATHER) { if (has_next && t == nt - 4 && wr == 0) S.roff_dma(nxt, tid_(), (LAS unsigned char*)(ROFF + (parA ^ 1) * 256) + wid * 256); }
            G8_LDB(B0, B08, 0, 0); G8_LDB(B1, B18, 0, 1); G8_SCHED; G8_LDA(At, At8, 0, 0); G8_STA_CUR(G8_SA(1, 1), a1, 1);
            if constexpr (GATHER) { if (has_next && last) parA ^= 1; }
            G8_WAIT_V(8); G8_WAIT_L(0); G8_BAR; G8_MMA(0, 0, At, At8, B0, B08); G8_MMA(0, 1, At, At8, B1, B18); G8_BAR; G8_SCHED;
            G8_LDA(At, At8, 0, 1); G8_ST2(G8_SB(0, 0), b2, 1); G8_ST2(G8_SB(0, 1), b2 + hstep, 1); G8_STA_CUR(G8_SA(0, 0), a2, 0);
            G8_WAIT_V(8); G8_WAIT_L(0); G8_BAR; G8_MMA(1, 0, At, At8, B0, B08); G8_MMA(1, 1, At, At8, B1, B18); G8_BAR; G8_SCHED;
            G8_LDB(B0, B08, 1, 0); G8_LDB(B1, B18, 1, 1); G8_SCHED; G8_LDA(At, At8, 1, 0); G8_STA_CUR(G8_SA(0, 1), a2, 1);
            G8_WAIT_V(8); G8_WAIT_L(0); G8_BAR; G8_MMA(0, 0, At, At8, B0, B08); G8_MMA(0, 1, At, At8, B1, B18); G8_BAR; G8_SCHED;
            G8_LDA(At, At8, 1, 1); G8_ST2(G8_SB(1, 0), b3, 1); G8_ST2(G8_SB(1, 1), b3 + hstep, 1); G8_STA_CUR(G8_SA(1, 0), a3, 0);
            G8_WAIT_V(8); G8_WAIT_L(0); G8_BAR; G8_MMA(1, 0, At, At8, B0, B08); G8_MMA(1, 1, At, At8, B1, B18); G8_BAR; G8_SCHED;
        }
        if (wr == 0) G8_BAR;
        E(acc, cur, wr, wc, fr, fq, (const LAS unsigned*)(SIDE + (ui & 1) * 768));
        if (!has_next) break;
#pragma unroll
        for (int a = 0; a < 2; ++a)
#pragma unroll
            for (int b = 0; b < 2; ++b)
#pragma unroll
                for (int m = 0; m < 4; ++m)
#pragma unroll
                    for (int n = 0; n < 2; ++n) acc[a][b][m][n] = (f32x4){0.f, 0.f, 0.f, 0.f};
        cur = nxt; cA = nA; cB = nB; ++ui;
        if (wr == 1) G8_BAR;
    }
    G8_WAIT_V(0);
    G8_BAR;
#undef G8_SA
#undef G8_SB
#undef G8_ST2
#undef G8_STA_CUR
#undef G8_LDA
#undef G8_LDB
#undef G8_MMA
#undef G8_WAIT_V
#undef G8_WAIT_L
#undef G8_BAR
#undef G8_SCHED
}
}

struct Params {
    const float *x, *c, *ctx, *c_ctx, *w_mod, *b_mod, *norm1_g, *norm2_g, *w_in, *b_in, *conv_a_w, *conv_a_b, *w_rg_r, *b_rg_r, *w_rg_i, *b_rg_i, *rg_lambda,
        *w_pool, *b_pool, *pool_scale, *w_four, *b_four, *conv_d_w, *conv_d_b, *ln_d_g, *ln_d_b, *w_pw, *b_pw, *w_out, *b_out, *w_router, *b_router,
        *w_gu, *b_gu, *w_down, *b_down, *final_norm_g;
    float* out; unsigned char* ws; int ph_lo, ph_hi;
};
typedef const Params __attribute__((address_space(4)))* CP;
__device__ __forceinline__ CP launder_params() { CP k = (CP)__builtin_amdgcn_kernarg_segment_ptr(); asm volatile("" : "+s"(k)); return k; }
__device__ __forceinline__ int row_mb(int row) { return row < TL ? (row >> 12) : 8; }

template <class RowMap>
__device__ __forceinline__ void tr_block(const float* __restrict__ src, int spitch, int k0, int n0, bf16_t* __restrict__ dst, int dpitch, int kd0, RowMap rm, LAS unsigned char* lds) {
    LAS unsigned* T = (LAS unsigned*)lds;
    const int tid = tid_();
    __syncthreads();
#pragma unroll
    for (int it = 0; it < 4; ++it) { const int task = it * 512 + tid, q = task & 63, kp = task >> 6;
        const f32x4 v0 = *(const f32x4*)(src + (size_t)(k0 + 2 * kp) * spitch + n0 + 4 * q), v1 = *(const f32x4*)(src + (size_t)(k0 + 2 * kp + 1) * spitch + n0 + 4 * q);
        u32x4 w; w.x = cvt_pk_bf16(v0[0], v1[0]); w.y = cvt_pk_bf16(v0[1], v1[1]); w.z = cvt_pk_bf16(v0[2], v1[2]); w.w = cvt_pk_bf16(v0[3], v1[3]);
        *(LAS u32x4*)(T + kp * 260 + 4 * q) = w; }
    __syncthreads();
#pragma unroll
    for (int it = 0; it < 4; ++it) { const int n = tid & 255, c = (tid >> 8) * 4 + it;
        u32x4 w; w.x = T[(4 * c + 0) * 260 + n]; w.y = T[(4 * c + 1) * 260 + n]; w.z = T[(4 * c + 2) * 260 + n]; w.w = T[(4 * c + 3) * 260 + n];
        *(u32x4*)(dst + (size_t)rm(n0 + n) * dpitch + kd0 + 8 * c) = w; }
}
template <class RowMap>
__device__ __forceinline__ void tr_block8(const float* __restrict__ src, int spitch, int k0, int n0, unsigned char* __restrict__ dst, int dpitch, int kd0, RowMap rm, LAS unsigned char* lds) {
    LAS unsigned* T = (LAS unsigned*)lds;
    const int tid = tid_();
    __syncthreads();
#pragma unroll
    for (int it = 0; it < 4; ++it) { const int task = it * 512 + tid, q = task & 63, kq = task >> 6; f32x4 v[4];
#pragma unroll
        for (int r = 0; r < 4; ++r) v[r] = *(const f32x4*)(src + (size_t)(k0 + 4 * kq + r) * spitch + n0 + 4 * q) * 64.0f;
        u32x4 w; w.x = pk4_fp8(v[0][0], v[1][0], v[2][0], v[3][0]); w.y = pk4_fp8(v[0][1], v[1][1], v[2][1], v[3][1]); w.z = pk4_fp8(v[0][2], v[1][2], v[2][2], v[3][2]); w.w = pk4_fp8(v[0][3], v[1][3], v[2][3], v[3][3]);
        *(LAS u32x4*)(T + kq * 260 + 4 * q) = w; }
    __syncthreads();
#pragma unroll
    for (int it = 0; it < 4; ++it) { const int n = tid & 255, c = (tid >> 8) * 4 + it;
        u32x4 w; w.x = T[(4 * c + 0) * 260 + n]; w.y = T[(4 * c + 1) * 260 + n]; w.z = T[(4 * c + 2) * 260 + n]; w.w = T[(4 * c + 3) * 260 + n];
        *(u32x4*)(dst + (size_t)rm(n0 + n) * dpitch + kd0 + 16 * c) = w; }
}
struct RmId { int off; __device__ __forceinline__ int operator()(int n) const { return n + off; } };
struct RmGu { __device__ __forceinline__ int operator()(int n) const { const int rem = n & 1023; return 256 * (rem >> 7) + 128 * (n >> 10) + (rem & 127); } };
struct RmIn { __device__ __forceinline__ int operator()(int n) const { return n < 512 ? n : n - 1024 + 768; } };

__device__ __forceinline__ void job_mod(CP p, int l, int cb, LAS unsigned char* lds) {
    LAS float* SC = (LAS float*)lds;
    LAS float* RED = (LAS float*)(lds + 49152);
    const int tid = tid_();
    __syncthreads();
    for (int i = tid; i < 9 * 1024; i += 512) { const int b = i >> 10, k = i & 1023; const float v = b < 8 ? p->c[b * 1024 + k] : p->c_ctx[k]; SC[k * 12 + b] = v * sigmoidf_(v); }
    __syncthreads();
    const int col = cb * 64 + (tid & 63), kg = tid >> 6;
    float acc[9];
#pragma unroll
    for (int b = 0; b < 9; ++b) acc[b] = 0.f;
    const float* wp = p->w_mod + (size_t)l * 1024 * 6144 + col;
#pragma unroll 8
    for (int kk = 0; kk < 128; ++kk) { const int k = kg * 128 + kk; const float w = wp[(size_t)k * 6144];
        const f32x4 s0 = *(const LAS f32x4*)(SC + k * 12), s1 = *(const LAS f32x4*)(SC + k * 12 + 4); const float s8 = SC[k * 12 + 8];
        acc[0] += s0[0] * w; acc[1] += s0[1] * w; acc[2] += s0[2] * w; acc[3] += s0[3] * w; acc[4] += s1[0] * w; acc[5] += s1[1] * w; acc[6] += s1[2] * w; acc[7] += s1[3] * w; acc[8] += s8 * w; }
#pragma unroll
    for (int b = 0; b < 9; ++b) RED[(kg * 9 + b) * 64 + (tid & 63)] = acc[b];
    __syncthreads();
    for (int i = tid; i < 9 * 64; i += 512) { const int b = i >> 6, cc = i & 63; float s = 0.f;
#pragma unroll
        for (int g = 0; g < 8; ++g) s += RED[(g * 9 + b) * 64 + cc];
        ((float*)(p->ws + WS_MODV))[(size_t)(l * 9 + b) * 6144 + cb * 64 + cc] = s + p->b_mod[l * 6144 + cb * 64 + cc]; }
}
__device__ __forceinline__ void job_fold_out(CP p, int l, int nb, LAS unsigned char* lds) {
    LAS float* WO = (LAS float*)lds;
    LAS float* PW = (LAS float*)(lds + 65536);
    const int tid = tid_(), lane = tid & 63, w = __builtin_amdgcn_readfirstlane(tid >> 6);
    __syncthreads();
#pragma unroll
    for (int it = 0; it < 8; ++it) { const int task = it * 512 + tid, j = task >> 4, q = task & 15;
        *(LAS f32x4*)(WO + j * 64 + 4 * q) = *(const f32x4*)(p->w_out + ((size_t)l * 1024 + 768 + j) * 1024 + nb * 64 + 4 * q); }
    float acc[32];
#pragma unroll
    for (int i = 0; i < 32; ++i) acc[i] = 0.f;
    for (int jc = 0; jc < 4; ++jc) {
        __syncthreads();
#pragma unroll
        for (int it = 0; it < 8; ++it) { const int task = it * 512 + tid, i = task & 255, jq = task >> 8;
            const f32x4 v = *(const f32x4*)(p->w_pw + ((size_t)l * 256 + i) * 256 + jc * 64 + 4 * jq);
            PW[(4 * jq + 0) * 256 + i] = v[0]; PW[(4 * jq + 1) * 256 + i] = v[1]; PW[(4 * jq + 2) * 256 + i] = v[2]; PW[(4 * jq + 3) * 256 + i] = v[3]; }
        __syncthreads();
        for (int jj = 0; jj < 64; ++jj) { const float b = WO[(jc * 64 + jj) * 64 + lane];
#pragma unroll
            for (int i4 = 0; i4 < 8; ++i4) { const f32x4 a = *(const LAS f32x4*)(PW + jj * 256 + 32 * w + 4 * i4);
                acc[4 * i4 + 0] += a[0] * b; acc[4 * i4 + 1] += a[1] * b; acc[4 * i4 + 2] += a[2] * b; acc[4 * i4 + 3] += a[3] * b; } }
    }
    bf16_t* dst = (bf16_t*)(p->ws + WS_WOUTT) + ((size_t)l * 1024 + nb * 64 + lane) * 1024 + 768 + 32 * w;
#pragma unroll
    for (int c = 0; c < 4; ++c) { float f[8];
#pragma unroll
        for (int e = 0; e < 8; ++e) f[e] = acc[8 * c + e];
        *(u32x4*)(dst + 8 * c) = pack8(f); }
    if (w == 0) { float s = p->b_out[l * 1024 + nb * 64 + lane];
        for (int j = 0; j < 256; ++j) s += p->b_pw[l * 256 + j] * WO[j * 64 + lane];
        ((float*)(p->ws + WS_BOUT))[l * 1024 + nb * 64 + lane] = s; }
}
__device__ __forceinline__ void job_fold_in(CP p, int l, int f, int g, int kb, LAS unsigned char* lds) {
    LAS float* M = (LAS float*)lds;
    LAS float* WI = (LAS float*)(lds + 16384);
    const int tid = tid_();
    const int cbase = f == 0 ? 512 : 768;
    LAS float* TRG = (LAS float*)(lds + 16384 + 256 * 65 * 4);
    __syncthreads();
    if (tid < 64) TRG[tid] = f == 2 ? sinpif((float)tid * (1.0f / 32.0f)) : cospif((float)tid * (1.0f / 32.0f));
    __syncthreads();
#pragma unroll
    for (int it = 0; it < 8; ++it) { const int id = it * 512 + tid, i = id >> 6, j = id & 63; float s;
        if (f == 0) s = p->w_pool[(((size_t)l * 4 + g) * 64 + i) * 64 + j];
        else { s = 0.f; for (int m = 0; m < 64; ++m) s += TRG[(i * m) & 63] * p->w_four[(((size_t)l * 4 + g) * 64 + m) * 64 + j]; }
        M[i * 64 + j] = s; }
#pragma unroll
    for (int it = 0; it < 8; ++it) { const int task = it * 512 + tid, kk = task >> 4, i4 = task & 15;
        const f32x4 v = *(const f32x4*)(p->w_in + ((size_t)l * 1024 + kb * 256 + kk) * 1536 + cbase + 64 * g + 4 * i4);
        WI[kk * 65 + 4 * i4 + 0] = v[0]; WI[kk * 65 + 4 * i4 + 1] = v[1]; WI[kk * 65 + 4 * i4 + 2] = v[2]; WI[kk * 65 + 4 * i4 + 3] = v[3]; }
    __syncthreads();
    const int kk = tid & 255, jh = tid >> 8;
    float acc[32];
#pragma unroll
    for (int j = 0; j < 32; ++j) acc[j] = 0.f;
    for (int i = 0; i < 64; ++i) { const float a = WI[kk * 65 + i];
#pragma unroll
        for (int j4 = 0; j4 < 8; ++j4) { const f32x4 m = *(const LAS f32x4*)(M + i * 64 + 32 * jh + 4 * j4);
            acc[4 * j4 + 0] += a * m[0]; acc[4 * j4 + 1] += a * m[1]; acc[4 * j4 + 2] += a * m[2]; acc[4 * j4 + 3] += a * m[3]; } }
    bf16_t* dst = f == 0 ? (bf16_t*)(p->ws + WS_WINT) + ((size_t)l * NPROJ + 512 + 64 * g) * 1024 : (bf16_t*)(p->ws + WS_WFT) + ((size_t)l * 512 + (f - 1) * 256 + 64 * g) * 1024;
#pragma unroll
    for (int j = 0; j < 32; ++j) dst[(size_t)(32 * jh + j) * 1024 + kb * 256 + kk] = f2bf(acc[j]);
    if (kb == 0 && f >= 1 && tid < 64) { float s = 0.f;
        for (int i = 0; i < 64; ++i) s += p->b_in[l * 1536 + 768 + 64 * g + i] * M[i * 64 + tid];
        ((float*)(p->ws + WS_BF))[l * 512 + (f - 1) * 256 + 64 * g + tid] = s; }
    if (kb == 0 && f == 0 && g == 0) for (int i = tid; i < NPROJ; i += 512)
        ((float*)(p->ws + WS_BIN))[l * NPROJ + i] = i < 512 ? p->b_in[l * 1536 + i] : (i < 768 ? 0.f : p->b_in[l * 1536 + i - 768 + 1024]);
}
__device__ __forceinline__ void job_small(CP p, int j) {
    const int tid = tid_();
    if (j < 32) {
        const int l = j >> 4, d = (j >> 3) & 1, gate = (j >> 2) & 1, hd = j & 3;
        const float* src = (gate ? p->w_rg_i : p->w_rg_r) + ((size_t)((l * 2 + d) * 4 + hd)) * 4096;
        bf16_t* dst = (bf16_t*)(p->ws + WS_WGT) + (size_t)j * 4096;
        for (int id = tid; id < 4096; id += 512) { const int n = id >> 6, k = id & 63; dst[id] = f2bf(src[k * 64 + n]); }
        return; }
    j -= 32;
    if (j < 2) {
        const int l = j; bf16_t* hi = (bf16_t*)(p->ws + WS_WRT) + (size_t)l * 2 * NE * 1024; bf16_t* lo = hi + NE * 1024;
        for (int id = tid; id < NE * 1024; id += 512) { const int e = id >> 10, c = id & 1023; const float v = p->w_router[((size_t)l * 1024 + c) * NE + e];
            const bf16_t h = f2bf(v); hi[id] = h; lo[id] = f2bf(v - bf2f(h)); }
        return; }
    j -= 2;
    if (j < 144 + 128) {
        const bool sn = j >= 144; const int r0 = (sn ? j - 144 : j) * 16; unsigned* dst = (unsigned*)(p->ws + (sn ? WS_SMAT : WS_CMAT));
        for (int id = tid; id < 16 * 1024; id += 512) { const int k = r0 + (id >> 10), t4 = (id & 1023) * 4; float v[4];
#pragma unroll
            for (int e = 0; e < 4; ++e) { const float ang = (float)((k * (t4 + e)) & 4095) * (1.0f / 2048.0f); v[e] = 64.0f * (sn ? sinpif(ang) : cospif(ang)); }
            dst[((size_t)k * 4096 + t4) >> 2] = pk4_fp8(v[0], v[1], v[2], v[3]); }
        return; }
    j -= 272;
    if (j == 1) {
        float* dst = (float*)(p->ws + WS_POS);
        for (int id = tid; id < 64 * 512; id += 512) { const int pp = id >> 9, jj = id & 511, i = jj & 255; const float a = (float)pp * exp2f(-(float)i * (13.287712379549449f / 256.0f));
            dst[id] = jj < 256 ? sinf(a) : cosf(a); }
        return; }
    {
        unsigned* dst = (unsigned*)(p->ws + WS_DFTC);
        for (int id = tid; id < 256 * 128; id += 512) { const int k = id >> 7, j4 = (id & 127) * 4; float v[4];
#pragma unroll
            for (int e = 0; e < 4; ++e) { const int jj = j4 + e, t = jj & 255; const float ang = (float)((k * t) & 255) * (1.0f / 128.0f); v[e] = 64.0f * (jj < 256 ? cospif(ang) : -sinpif(ang)); }
            dst[id] = pk4_fp8(v[0], v[1], v[2], v[3]); }
    }
}
#ifndef MOE_W_IN_QUEUE
#define MOE_W_IN_QUEUE 0
#endif
constexpr bool fp8_layer(int l) { return l >= FP8_FROM; }
constexpr int J_TGU_L(int l) { return fp8_layer(l) ? 32 * 8 * 8 : 32 * 16 * 8; }
constexpr int J_TD_L(int l) { return fp8_layer(l) ? 32 * 8 * 4 : 32 * 16 * 4; }
constexpr int J_MOD = 192, J_FOUT = 32, J_FIN = 96, J_SMALL = 32 + 2 + 272 + 2, J_TIN = 128, J_TOUT = 96, J_TGU = J_TGU_L(0) + J_TGU_L(1), J_TD = J_TD_L(0) + J_TD_L(1);
static_assert(!MOE_W_IN_QUEUE || (J_TGU_L(0) + J_TD_L(0) <= 6 * NCHUNK && J_TGU_L(1) + J_TD_L(1) <= 6 * NCHUNK), "the phase-3 queue interleaves at most 2 weight jobs per compute unit: needs fp8 expert weights in both layers");
constexpr int J_TOTAL = J_MOD + J_FOUT + J_FIN + J_SMALL + J_TIN + J_TOUT + (MOE_W_IN_QUEUE ? 0 : J_TGU + J_TD);
template <class RowMap>
__device__ __forceinline__ void tr8_slab(const float* __restrict__ src, int spitch, int k0, int n4, unsigned char* __restrict__ dst, int dpitch, RowMap rm) {
    f32x4 v[16];
#pragma unroll
    for (int r = 0; r < 16; ++r) v[r] = *(const f32x4*)(src + (size_t)(k0 + r) * spitch + n4) * 64.0f;
#pragma unroll
    for (int j = 0; j < 4; ++j) { u32x4 w; w.x = pk4_fp8(v[0][j], v[1][j], v[2][j], v[3][j]); w.y = pk4_fp8(v[4][j], v[5][j], v[6][j], v[7][j]); w.z = pk4_fp8(v[8][j], v[9][j], v[10][j], v[11][j]); w.w = pk4_fp8(v[12][j], v[13][j], v[14][j], v[15][j]);
        *(u32x4*)(dst + (size_t)rm(n4 + j) * dpitch + k0) = w; }
}
struct W8Job { const float* src; unsigned char* dst; int spitch, gu; };
__device__ __forceinline__ bool w8_job(CP p, int jm, W8Job& J, int& n0) {
    constexpr int PER_L = 32 * 64 + 32 * 32; if (jm >= 2 * PER_L) return false;
    const int l = jm / PER_L; int jj = jm - l * PER_L;
    if (jj < 32 * 64) { const int e = jj >> 6, r = jj & 63, kb = r >> 3, q = r & 7; J.spitch = 2048; J.gu = 1; n0 = q * 256;
        J.src = p->w_gu + ((size_t)(l * NE + e) * 1024 + kb * 128) * 2048 + n0; J.dst = p->ws + WS_WGUT + (size_t)l * NE * 2048 * 2048 + (size_t)e * 2048 * 1024 + kb * 128; }
    else { jj -= 32 * 64; const int e = jj >> 5, r = jj & 31, kb = r >> 2, q = r & 3; J.spitch = 1024; J.gu = 0; n0 = q * 256;
        J.src = p->w_down + ((size_t)(l * NE + e) * 1024 + kb * 128) * 1024 + n0; J.dst = p->ws + WS_WDT + (size_t)l * NE * 1024 * 2048 + (size_t)e * 1024 * 1024 + kb * 128; }
    return true;
}
__device__ __forceinline__ void w8_load(const W8Job& J, int tid, f32x4 (&v)[4][4]) {
#pragma unroll
    for (int it = 0; it < 4; ++it) { const int task = it * 512 + tid, q = task & 63, kq = task >> 6;
#pragma unroll
        for (int r = 0; r < 4; ++r) v[it][r] = *(const f32x4*)(J.src + (size_t)(4 * kq + r) * J.spitch + 4 * q); }
}
__device__ __forceinline__ void w8_finish(const W8Job& J, int n0, int tid, const f32x4 (&v)[4][4], LAS unsigned char* lds) {
    LAS unsigned* T = (LAS unsigned*)lds;
    __syncthreads();
#pragma unroll
    for (int it = 0; it < 4; ++it) { const int task = it * 512 + tid, q = task & 63, kq = task >> 6;
        u32x4 w; w.x = pk4_fp8(v[it][0][0] * 64.f, v[it][1][0] * 64.f, v[it][2][0] * 64.f, v[it][3][0] * 64.f); w.y = pk4_fp8(v[it][0][1] * 64.f, v[it][1][1] * 64.f, v[it][2][1] * 64.f, v[it][3][1] * 64.f);
        w.z = pk4_fp8(v[it][0][2] * 64.f, v[it][1][2] * 64.f, v[it][2][2] * 64.f, v[it][3][2] * 64.f); w.w = pk4_fp8(v[it][0][3] * 64.f, v[it][1][3] * 64.f, v[it][2][3] * 64.f, v[it][3][3] * 64.f);
        *(LAS u32x4*)(T + kq * 260 + 4 * q) = w; }
    __syncthreads();
    if (tid < 256) {
        const int n = tid, nn = n0 + n; const int row = J.gu ? RmGu{}(nn) : nn; u32x4 w[8];
#pragma unroll
        for (int c = 0; c < 8; ++c) { w[c].x = T[(4 * c + 0) * 260 + n]; w[c].y = T[(4 * c + 1) * 260 + n]; w[c].z = T[(4 * c + 2) * 260 + n]; w[c].w = T[(4 * c + 3) * 260 + n]; }
#pragma unroll
        for (int c = 0; c < 8; ++c) *(u32x4*)(J.dst + (size_t)row * 1024 + 16 * c) = w[c]; }
}
__device__ __forceinline__ void moe_weight_job(CP p, int l, int jj, LAS unsigned char* lds) {
    const bool f8 = l >= FP8_FROM;
    if (jj < (f8 ? 32 * 8 * 8 : 32 * 16 * 8)) { const float* src = p->w_gu + (size_t)l * NE * 1024 * 2048; unsigned char* dstb = p->ws + WS_WGUT + (size_t)l * NE * 2048 * 2048;
        if (f8) { const int e = jj >> 6, r = jj & 63, kb = r >> 3, q = r & 7; tr_block8(src + (size_t)e * 1024 * 2048, 2048, kb * 128, q * 256, dstb + (size_t)e * 2048 * 1024, 1024, kb * 128, RmGu{}, lds); }
        else { const int e = jj >> 7, r = jj & 127, kb = r >> 3, q = r & 7; tr_block(src + (size_t)e * 1024 * 2048, 2048, kb * 64, q * 256, (bf16_t*)dstb + (size_t)e * 2048 * 1024, 1024, kb * 64, RmGu{}, lds); }
        return; }
    jj -= (f8 ? 32 * 8 * 8 : 32 * 16 * 8);
    { const float* src = p->w_down + (size_t)l * NE * 1024 * 1024; unsigned char* dstb = p->ws + WS_WDT + (size_t)l * NE * 1024 * 2048;
        if (f8) { const int e = jj >> 5, r = jj & 31, kb = r >> 2, q = r & 3; tr_block8(src + (size_t)e * 1024 * 1024, 1024, kb * 128, q * 256, dstb + (size_t)e * 1024 * 1024, 1024, kb * 128, RmId{0}, lds); }
        else { const int e = jj >> 6, r = jj & 63, kb = r >> 2, q = r & 3; tr_block(src + (size_t)e * 1024 * 1024, 1024, kb * 64, q * 256, (bf16_t*)dstb + (size_t)e * 1024 * 1024, 1024, kb * 64, RmId{0}, lds); } }
}
constexpr bool W8_PIPE = (FP8_FROM == 0) && !MOE_W_IN_QUEUE;
#ifndef PRO_PART
#define PRO_PART 0
#endif
__device__ __forceinline__ int q_pull(unsigned* head, LAS int* slot) {
    __syncthreads(); if (tid_() == 0) *slot = (int)__hip_atomic_fetch_add(head, 1u, __ATOMIC_RELAXED, __HIP_MEMORY_SCOPE_AGENT); __syncthreads();
    return __builtin_amdgcn_readfirstlane(*slot);
}
__device__ __forceinline__ void phase_prologue(CP p, LAS unsigned char* lds, int rep) {
    unsigned* qs = (unsigned*)(p->ws + WS_CTL) + CW_QUEUE + (4 + rep) * 64; unsigned* qw = (unsigned*)(p->ws + WS_CTL) + CW_QUEUE + (6 + rep) * 64; LAS int* qslot = (LAS int*)(lds - LDS_BASE + 64);
    const int njobs = (rep && PRO_PART == 1) ? 0 : J_TOTAL - (W8_PIPE ? J_TGU + J_TD : 0);
    if (!W8_PIPE || (blockIdx.x & 1) == 0) for (;;) {
        int j = q_pull(qs, qslot); if (j >= njobs) break;
        if (j < J_FIN) { const int l = j / 48, r = j % 48; job_fold_in(p, l, r / 16, (r >> 2) & 3, r & 3, lds); continue; } j -= J_FIN;
        if (j < J_FOUT) { job_fold_out(p, j >> 4, j & 15, lds); continue; } j -= J_FOUT;
        if (j < J_MOD) { job_mod(p, j / 96, j % 96, lds); continue; } j -= J_MOD;
        if (j < J_SMALL) { job_small(p, j); continue; } j -= J_SMALL;
        if (j < J_TIN) { const int l = j >> 6, r = j & 63, kb = r >> 2, q = r & 3;
            tr_block(p->w_in + (size_t)l * 1024 * 1536, 1536, kb * 64, q < 2 ? q * 256 : 1024 + (q - 2) * 256, (bf16_t*)(p->ws + WS_WINT) + (size_t)l * NPROJ * 1024, 1024, kb * 64, RmIn{}, lds); continue; } j -= J_TIN;
        if (j < J_TOUT) { const int l = j / 48, r = j % 48, kb = r >> 2, q = r & 3;
            tr_block(p->w_out + (size_t)l * 1024 * 1024, 1024, kb * 64, q * 256, (bf16_t*)(p->ws + WS_WOUTT) + (size_t)l * 1024 * 1024, 1024, kb * 64, RmId{0}, lds); continue; } j -= J_TOUT;
        moe_weight_job(p, j < J_TGU_L(0) + J_TD_L(0) ? 0 : 1, j < J_TGU_L(0) + J_TD_L(0) ? j : j - J_TGU_L(0) - J_TD_L(0), lds);
    }
    if (W8_PIPE && !(rep && PRO_PART == 2)) { const int tid = tid_(); W8Job Jc, Jn; int nc = 0, nn_ = 0; f32x4 va[4][4], vb[4][4];
        bool okc = w8_job(p, q_pull(qw, qslot), Jc, nc); if (okc) w8_load(Jc, tid, va);
        while (okc) {
            const bool okn = w8_job(p, q_pull(qw, qslot), Jn, nn_); if (okn) w8_load(Jn, tid, vb);
            w8_finish(Jc, nc, tid, va, lds);
            if (!okn) break;
            okc = w8_job(p, q_pull(qw, qslot), Jc, nc); if (okc) w8_load(Jc, tid, va);
            w8_finish(Jn, nn_, tid, vb, lds); } }
}

__device__ __forceinline__ void phase_norm(CP p, int mode) {
    const int tid = tid_(), lane = tid & 63, wid = tid >> 6;
    float* X = (float*)(p->ws + WS_X); bf16_t* U = (bf16_t*)(p->ws + WS_U); const bf16_t* YS = (const bf16_t*)(p->ws + WS_YS); const float* modv = (const float*)(p->ws + WS_MODV);
    const float* POS = (const float*)(p->ws + WS_POS);
    const int nrows = mode == 2 ? TL : TT;
    const int lprev = mode == 2 ? 1 : 0, lcur = mode == 0 ? 0 : 1;
    const int nw = (int)gridDim.x * 8;
    for (int rowa = blockIdx.x * 8 + wid; rowa < nrows; rowa += 2 * nw) {
        int rows[2]; bool ok[2]; f32x4 v[2][4];
#pragma unroll
        for (int rb = 0; rb < 2; ++rb) { const int r = rowa + rb * nw; ok[rb] = r < nrows; rows[rb] = ok[rb] ? r : rowa; }
        if (mode == 0) {
#pragma unroll
            for (int rb = 0; rb < 2; ++rb) { const int row = rows[rb]; const float* src = row < TL ? p->x + (size_t)row * D : p->ctx + (size_t)(row - TL) * D;
#pragma unroll
                for (int j = 0; j < 4; ++j) v[rb][j] = *(const f32x4*)(src + 256 * j + 4 * lane); }
#pragma unroll
            for (int rb = 0; rb < 2; ++rb) { const int row = rows[rb]; if (row < TL) { const int t = row & 4095;
#pragma unroll
                    for (int j = 0; j < 4; ++j) v[rb][j] += *(const f32x4*)(POS + (size_t)(j < 2 ? (t >> 6) : (t & 63)) * 512 + (j & 1) * 256 + 4 * lane); } }
        } else {
            unsigned ys[2][4][4]; u32x2 y2[2][4]; const bf16_t* Y2 = (const bf16_t*)(p->ws + WS_PROJ);
#pragma unroll
            for (int rb = 0; rb < 2; ++rb) { const int row = rows[rb];
#pragma unroll
                for (int j = 0; j < 4; ++j) { v[rb][j] = *(const f32x4*)(X + (size_t)row * D + 256 * j + 4 * lane); y2[rb][j] = *(const u32x2*)(Y2 + (size_t)row * D + 256 * j + 4 * lane);
#pragma unroll
                    for (int k = 0; k < 4; ++k) ys[rb][j][k] = *(const unsigned*)((const unsigned char*)YS + ((size_t)row * 4 + k) * D + 256 * j + 4 * lane); } }
#pragma unroll
            for (int rb = 0; rb < 2; ++rb) { const float* g2 = modv + (size_t)(lprev * 9 + row_mb(rows[rb])) * 6144 + 5120;
#pragma unroll
                for (int j = 0; j < 4; ++j) { f32x4 s = {0.f, 0.f, 0.f, 0.f};
#pragma unroll
                    for (int k = 0; k < 4; ++k) { const int w = (int)ys[rb][j][k]; const f32x2 lo = __builtin_amdgcn_cvt_pk_f32_fp8(w, false), hi = __builtin_amdgcn_cvt_pk_f32_fp8(w, true); s[0] += lo.x; s[1] += lo.y; s[2] += hi.x; s[3] += hi.y; }
                    v[rb][j] += (f32x4){bflo(y2[rb][j].x), bfhi(y2[rb][j].x), bflo(y2[rb][j].y), bfhi(y2[rb][j].y)} + *(const f32x4*)(g2 + 256 * j + 4 * lane) * (s * (1.0f / 16.0f)); } }
        }
        float ss[2];
#pragma unroll
        for (int rb = 0; rb < 2; ++rb) { ss[rb] = 0.f;
#pragma unroll
            for (int j = 0; j < 4; ++j) ss[rb] += v[rb][j][0] * v[rb][j][0] + v[rb][j][1] * v[rb][j][1] + v[rb][j][2] * v[rb][j][2] + v[rb][j][3] * v[rb][j][3]; }
#pragma unroll
        for (int o = 32; o >= 1; o >>= 1) { const float t0 = bperm(ss[0], lane ^ o), t1 = bperm(ss[1], lane ^ o); ss[0] += t0; ss[1] += t1; }
#pragma unroll
        for (int rb = 0; rb < 2; ++rb) { if (!ok[rb]) continue; const int row = rows[rb]; const float rstd = __builtin_amdgcn_rsqf(ss[rb] * (1.0f / 1024.0f) + 1e-6f);
            if (mode == 2) {
#pragma unroll
                for (int j = 0; j < 4; ++j) *(f32x4*)(p->out + (size_t)row * D + 256 * j + 4 * lane) = v[rb][j] * rstd * *(const f32x4*)(p->final_norm_g + 256 * j + 4 * lane);
            } else { const float* mv = modv + (size_t)(lcur * 9 + row_mb(row)) * 6144;
#pragma unroll
                for (int j = 0; j < 4; ++j) { const int col = 256 * j + 4 * lane;
                    *(f32x4*)(X + (size_t)row * D + col) = v[rb][j];
                    const f32x4 g = *(const f32x4*)(p->norm1_g + lcur * D + col), sc = *(const f32x4*)(mv + 1024 + col), sh = *(const f32x4*)(mv + col);
                    const f32x4 u = v[rb][j] * rstd * g * (sc + 1.0f) + sh;
                    u32x2 w; w.x = cvt_pk_bf16(u[0], u[1]); w.y = cvt_pk_bf16(u[2], u[3]); *(u32x2*)(U + (size_t)row * D + col) = w; } }
        }
    }
}

constexpr int HP = 2064;
__device__ __forceinline__ void phase_router(CP p, int l, LAS unsigned char* lds, int rep) {
    LAS unsigned char* HHI = lds; LAS unsigned char* HLO = lds + 32 * HP;
    LAS float* LG = (LAS float*)(lds + 64 * HP);
    LAS int* hist = (LAS int*)(lds + 64 * HP + 8448); LAS int* basee = hist + 32;
    const int tid = tid_(), lane = tid & 63, wid = __builtin_amdgcn_readfirstlane(tid >> 6), fr = lane & 15, fq = lane >> 4;
    const float* X = (const float*)(p->ws + WS_X); const bf16_t* Y2 = (const bf16_t*)(p->ws + WS_PROJ);
    bf16_t* U = (bf16_t*)(p->ws + (rep ? WS_ACT + (size_t)TT * D * 4 : WS_U)); const float* modv = (const float*)(p->ws + WS_MODV);
    unsigned char* U8 = p->ws + (rep ? WS_ACT + (size_t)TT * D * 4 : WS_U8);
    unsigned* ctl = (unsigned*)(p->ws + WS_CTL) + (rep ? 4096 : 0); int* rasg = (int*)(p->ws + (rep ? WS_YS : WS_RASG)); float* rgate = (float*)(p->ws + (rep ? WS_YS + (size_t)NE * TT * 4 : WS_RGATE)); unsigned* rroff = (unsigned*)(p->ws + (rep ? WS_YS + (size_t)2 * NE * TT * 4 : WS_RROFF));
    const bf16_t* wrt = (const bf16_t*)(p->ws + WS_WRT) + (size_t)l * 2 * NE * 1024;
    const int ntiles = (l == 0 ? TT : TL) / 32;
    for (int tile = blockIdx.x; tile < ntiles; tile += gridDim.x) {
        const int row0 = tile * 32, mb = row_mb(row0);
        const float* mv = modv + (size_t)(l * 9 + mb) * 6144;
        __syncthreads();
        if (tid < 32) hist[tid] = 0;
        { f32x4 v[4][4]; u32x2 y2[4][4]; float ss[4];
#pragma unroll
          for (int rr = 0; rr < 4; ++rr)
#pragma unroll
              for (int j = 0; j < 4; ++j) { v[rr][j] = *(const f32x4*)(X + (size_t)(row0 + wid * 4 + rr) * D + 256 * j + 4 * lane); y2[rr][j] = *(const u32x2*)(Y2 + (size_t)(row0 + wid * 4 + rr) * D + 256 * j + 4 * lane); }
#pragma unroll
          for (int rr = 0; rr < 4; ++rr)
#pragma unroll
              for (int j = 0; j < 4; ++j) v[rr][j] += (f32x4){bflo(y2[rr][j].x), bfhi(y2[rr][j].x), bflo(y2[rr][j].y), bfhi(y2[rr][j].y)};
#pragma unroll
          for (int rr = 0; rr < 4; ++rr) { ss[rr] = 0.f;
#pragma unroll
              for (int j = 0; j < 4; ++j) ss[rr] += v[rr][j][0] * v[rr][j][0] + v[rr][j][1] * v[rr][j][1] + v[rr][j][2] * v[rr][j][2] + v[rr][j][3] * v[rr][j][3]; }
#pragma unroll
          for (int o = 32; o >= 1; o >>= 1) { float t[4];
#pragma unroll
              for (int rr = 0; rr < 4; ++rr) t[rr] = bperm(ss[rr], lane ^ o);
#pragma unroll
              for (int rr = 0; rr < 4; ++rr) ss[rr] += t[rr]; }
#pragma unroll
          for (int j = 0; j < 4; ++j) { const int col = 256 * j + 4 * lane;
              const f32x4 g = *(const f32x4*)(p->norm2_g + l * D + col), sc = *(const f32x4*)(mv + 4096 + col), sh = *(const f32x4*)(mv + 3072 + col);
#pragma unroll
              for (int rr = 0; rr < 4; ++rr) { const int r = wid * 4 + rr; const float rstd = __builtin_amdgcn_rsqf(ss[rr] * (1.0f / 1024.0f) + 1e-6f);
                  const f32x4 h = v[rr][j] * rstd * g * (sc + 1.0f) + sh;
                  u32x2 w; w.x = cvt_pk_bf16(h[0], h[1]); w.y = cvt_pk_bf16(h[2], h[3]);
                  if (fp8_layer(l)) *(unsigned*)(U8 + (size_t)(row0 + r) * D + col) = pk4_fp8(h[0], h[1], h[2], h[3]); else *(u32x2*)(U + (size_t)(row0 + r) * D + col) = w;
                  u32x2 wl; wl.x = cvt_pk_bf16(h[0] - bflo(w.x), h[1] - bfhi(w.x)); wl.y = cvt_pk_bf16(h[2] - bflo(w.y), h[3] - bfhi(w.y));
                  *(LAS u32x2*)(HHI + r * HP + col * 2) = w; *(LAS u32x2*)(HLO + r * HP + col * 2) = wl; } } }
        __syncthreads();
        { const int mt = wid & 1, ntl = (wid >> 1) & 1, kh = wid >> 2;
          f32x4 acc = {0.f, 0.f, 0.f, 0.f};
          const bf16_t* bh = wrt + (size_t)(16 * ntl + fr) * 1024 + kh * 512 + 8 * fq; const bf16_t* bl = bh + NE * 1024;
          const LAS unsigned char* ah = HHI + (16 * mt + fr) * HP + (kh * 512 + 8 * fq) * 2; const LAS unsigned char* al = HLO + (16 * mt + fr) * HP + (kh * 512 + 8 * fq) * 2;
#pragma unroll 8
          for (int s = 0; s < 16; ++s) { const bf16x8 Ah = *(const LAS bf16x8*)(ah + s * 64), Al = *(const LAS bf16x8*)(al + s * 64); const bf16x8 Bh = *(const bf16x8*)(bh + s * 32), Bl = *(const bf16x8*)(bl + s * 32);
              acc = __builtin_amdgcn_mfma_f32_16x16x32_bf16(Ah, Bh, acc, 0, 0, 0); acc = __builtin_amdgcn_mfma_f32_16x16x32_bf16(Ah, Bl, acc, 0, 0, 0); acc = __builtin_amdgcn_mfma_f32_16x16x32_bf16(Al, Bh, acc, 0, 0, 0); }
#pragma unroll
          for (int j = 0; j < 4; ++j) LG[(kh * 32 + 16 * mt + 4 * fq + j) * 33 + 16 * ntl + fr] = acc[j]; }
        __syncthreads();
        int ek[4] = {0, 0, 0, 0}, rk[4] = {0, 0, 0, 0}; float gk[4] = {0.f, 0.f, 0.f, 0.f};
        if (tid < 32) { float lg[32];
#pragma unroll
            for (int e = 0; e < 32; ++e) lg[e] = LG[tid * 33 + e] + LG[(32 + tid) * 33 + e] + p->b_router[l * NE + e];
            float vk[4];
#pragma unroll
            for (int k = 0; k < 4; ++k) { float best = -3.0e38f; int bi = 0;
#pragma unroll
                for (int e = 0; e < 32; ++e) if (lg[e] > best) { best = lg[e]; bi = e; }
                vk[k] = best; ek[k] = bi;
#pragma unroll
                for (int e = 0; e < 32; ++e) if (e == bi) lg[e] = -3.0e38f; }
            float sum = 0.f;
#pragma unroll
            for (int k = 0; k < 4; ++k) { gk[k] = fexp2(1.4426950408889634f * (vk[k] - vk[0])); sum += gk[k]; }
            const float inv = 1.0f / sum;
#pragma unroll
            for (int k = 0; k < 4; ++k) { gk[k] *= inv; rk[k] = __hip_atomic_fetch_add(hist + ek[k], 1, __ATOMIC_RELAXED, __HIP_MEMORY_SCOPE_WORKGROUP); } }
        __syncthreads();
        if (tid < 32) { const int h = hist[tid]; basee[tid] = h ? (int)__hip_atomic_fetch_add(ctl + CW_COUNT + (l * NE + tid) * 64, (unsigned)h, __ATOMIC_RELAXED, __HIP_MEMORY_SCOPE_AGENT) : 0; }
        __syncthreads();
        if (tid < 32) { const int tok = row0 + tid;
#pragma unroll
            for (int k = 0; k < 4; ++k) { const size_t pos = (size_t)ek[k] * TT + basee[ek[k]] + rk[k]; rasg[pos] = tok * 4 + k; rgate[pos] = gk[k]; rroff[pos] = (unsigned)tok * (fp8_layer(l) ? 1024u : 2048u); } }
    }
}

constexpr int XCP = 144;
constexpr int XAP = 528;
struct Seq { int b, jc, L, rowbase, t0; bool lat; };
__device__ __forceinline__ Seq seq_of(int q) { Seq s; s.lat = q < 512; s.b = s.lat ? q >> 6 : (q - 512) >> 2; s.jc = s.lat ? q & 63 : (q - 512) & 3; s.L = s.lat ? SEQ : LCX; s.rowbase = s.lat ? s.b * SEQ : TL + s.b * LCX; s.t0 = s.jc * 64; return s; }
template <int PASS>
__device__ __forceinline__ void scan_unit(CP p, int l, int q, LAS unsigned char* lds) {
    const int tid = tid_(), lane = tid & 63, wid = __builtin_amdgcn_readfirstlane(tid >> 6), d = wid >> 2, hd = wid & 3, fr = lane & 15, fq = lane >> 4;
    LAS unsigned char* XC = lds + wid * (64 * XCP);
    LAS float* CAR = (LAS float*)(lds + 8 * 64 * XCP + wid * 256);
    LAS unsigned char* HB = lds + 8 * 64 * XCP + 2048;
    LAS unsigned char* XA = HB;
    const bf16_t* PROJ = (const bf16_t*)(p->ws + WS_PROJ); float* SUMM = (float*)(p->ws + WS_SUMM);
    const Seq sq = seq_of(q); const int b = sq.b, jc = sq.jc, L = sq.L, rowbase = sq.rowbase, t0 = sq.t0; const bool lat = sq.lat;
    __syncthreads();
    { u32x4 w[5];
#pragma unroll
      for (int it = 0; it < 5; ++it) { const int task = it * 512 + tid, r = task >> 5, cg = task & 31, tt = t0 - 3 + r; w[it] = (u32x4){0u, 0u, 0u, 0u};
          if (task < 70 * 32 && tt >= 0 && tt < L) w[it] = *(const u32x4*)(PROJ + (size_t)(rowbase + tt) * NPROJ + 8 * cg); }
#pragma unroll
      for (int it = 0; it < 5; ++it) { const int task = it * 512 + tid, r = task >> 5, cg = task & 31; if (task < 70 * 32) *(LAS u32x4*)(XA + r * XAP + cg * 16) = w[it]; } }
    float car = 0.f;
    if (PASS == 2) { const int c = 64 * hd + lane;
        const int n = d == 0 ? (lat ? 4 + jc : jc) : (lat ? 4 + 63 - jc : 3 - jc);
        for (int s0 = 0; s0 < n; s0 += 16) { float A_[16], H_[16];
#pragma unroll
            for (int e = 0; e < 16; ++e) { const int s = s0 + e; int qq;
                if (d == 0) qq = (lat && s >= 4) ? b * 64 + (s - 4) : 512 + b * 4 + s; else qq = (lat && s >= 4) ? b * 64 + 63 - (s - 4) : 512 + b * 4 + 3 - s;
                A_[e] = 1.f; H_[e] = 0.f; if (s < n) { const float* sp_ = SUMM + ((size_t)qq * 2 + d) * 512; A_[e] = sp_[c]; H_[e] = sp_[256 + c]; } }
#pragma unroll
            for (int e = 0; e < 16; ++e) car = A_[e] * car + H_[e]; } }
    __syncthreads();
    { const int c = 64 * hd + lane; const float* cw = p->conv_a_w + ((size_t)(l * 2 + d) * 4) * 256 + c;
      const float w0 = cw[0], w1 = cw[256], w2 = cw[512], w3 = cw[768], cb = p->conv_a_b[(l * 2 + d) * 256 + c];
      const float k0 = d ? w3 : w0, k1 = d ? w2 : w1, k2 = d ? w1 : w2, k3 = d ? w0 : w3;
      const LAS unsigned char* xp = XA + (d ? 3 : 0) * XAP + c * 2;
      float xa_ = bf2f(*(const LAS bf16_t*)(xp)), xb_ = bf2f(*(const LAS bf16_t*)(xp + XAP)), xc_ = bf2f(*(const LAS bf16_t*)(xp + 2 * XAP));
#pragma unroll 16
      for (int t = 0; t < 64; ++t) { const float xd_ = bf2f(*(const LAS bf16_t*)(xp + (t + 3) * XAP)); const float v = k0 * xa_ + k1 * xb_ + k2 * xc_ + k3 * xd_ + cb;
          *(LAS bf16_t*)(XC + t * XCP + lane * 2) = f2bf(v); xa_ = xb_; xb_ = xc_; xc_ = xd_; } }
    if (PASS == 2) CAR[lane] = car;
    asm volatile("" ::: "memory");
    if (PASS == 2) __syncthreads();
    float cr[4], at[4], sp[4], brr[4], bii[4];
#pragma unroll
    for (int n = 0; n < 4; ++n) { const int ch = 16 * n + fr; cr[n] = PASS == 2 ? CAR[ch] : 0.f; at[n] = 1.f;
        const float lam = p->rg_lambda[(l * 2 + d) * 256 + 64 * hd + ch]; sp[n] = -8.0f * 1.4426950408889634f * log1pf(__expf(-lam));
        brr[n] = p->b_rg_r[((l * 2 + d) * 4 + hd) * 64 + ch]; bii[n] = p->b_rg_i[((l * 2 + d) * 4 + hd) * 64 + ch]; }
    const bf16_t* wg = (const bf16_t*)(p->ws + WS_WGT) + (size_t)((l * 2 + d) * 2) * 4 * 4096;
    u32x4* ABo = (u32x4*)(p->ws + WS_AB) + ((size_t)q * 8 + wid) * 16 * 64 + lane;
    const int src1 = d ? lane + 16 : lane - 16, src2 = d ? lane + 32 : lane - 32, srct = d ? fr : 48 + fr;
    const bool has1 = d ? fq <= 2 : fq >= 1, has2 = d ? fq <= 1 : fq >= 2;
    for (int n = 0; n < 4; ++n) {
        bf16x8 Br[2], Bi[2];
#pragma unroll
        for (int s = 0; s < 2; ++s) { Br[s] = *(const bf16x8*)(wg + ((size_t)(0 * 4 + hd) * 64 + 16 * n + fr) * 64 + 32 * s + 8 * fq); Bi[s] = *(const bf16x8*)(wg + ((size_t)(1 * 4 + hd) * 64 + 16 * n + fr) * 64 + 32 * s + 8 * fq); }
        float Hj[4][4], Aj[4][4];
#pragma unroll
        for (int mt = 0; mt < 4; ++mt) {
            const bf16x8 A0 = *(const LAS bf16x8*)(XC + (16 * mt + fr) * XCP + (8 * fq) * 2), A1 = *(const LAS bf16x8*)(XC + (16 * mt + fr) * XCP + (32 + 8 * fq) * 2);
            f32x4 ar = {0.f, 0.f, 0.f, 0.f}, ai = {0.f, 0.f, 0.f, 0.f};
            ar = __builtin_amdgcn_mfma_f32_16x16x32_bf16(A0, Br[0], ar, 0, 0, 0); ar = __builtin_amdgcn_mfma_f32_16x16x32_bf16(A1, Br[1], ar, 0, 0, 0);
            ai = __builtin_amdgcn_mfma_f32_16x16x32_bf16(A0, Bi[0], ai, 0, 0, 0); ai = __builtin_amdgcn_mfma_f32_16x16x32_bf16(A1, Bi[1], ai, 0, 0, 0);
            float a_[4], b_[4], la_[4];
#pragma unroll
            for (int j = 0; j < 4; ++j) { const float r = sigmoidf_(ar[j] + brr[n]); la_[j] = r * sp[n]; }
            u32x4 w; w.x = cvt_pk_bf16(la_[0], la_[1]); w.y = cvt_pk_bf16(la_[2], la_[3]);
            la_[0] = bflo(w.x); la_[1] = bfhi(w.x); la_[2] = bflo(w.y); la_[3] = bfhi(w.y);
#pragma unroll
            for (int j = 0; j < 4; ++j) { const int tok = 16 * mt + 4 * fq + j; const float xcv = bf2f(*(const LAS bf16_t*)(XC + tok * XCP + (16 * n + fr) * 2));
                const float ig = sigmoidf_(ai[j] + bii[n]); const float a = fexp2(la_[j]);
                a_[j] = a; b_[j] = __builtin_amdgcn_sqrtf(fmaxf(1.0f - a * a, 0.f)) * (ig * xcv); }
            w.z = cvt_pk_bf16(b_[0], b_[1]); w.w = cvt_pk_bf16(b_[2], b_[3]);
            b_[0] = bflo(w.z); b_[1] = bfhi(w.z); b_[2] = bflo(w.w); b_[3] = bfhi(w.w);
            ABo[(size_t)((n * 4 + mt) * 64)] = w;
            if (d == 0) { Hj[mt][0] = b_[0]; Aj[mt][0] = a_[0];
#pragma unroll
                for (int j = 1; j < 4; ++j) { Hj[mt][j] = a_[j] * Hj[mt][j - 1] + b_[j]; Aj[mt][j] = a_[j] * Aj[mt][j - 1]; } }
            else { Hj[mt][3] = b_[3]; Aj[mt][3] = a_[3];
#pragma unroll
                for (int j = 2; j >= 0; --j) { Hj[mt][j] = a_[j] * Hj[mt][j + 1] + b_[j]; Aj[mt][j] = a_[j] * Aj[mt][j + 1]; } }
        }
        float iA[4], iH[4], eA[4], eH[4], tA[4], tH[4];
#pragma unroll
        for (int mt = 0; mt < 4; ++mt) { iA[mt] = d ? Aj[mt][0] : Aj[mt][3]; iH[mt] = d ? Hj[mt][0] : Hj[mt][3]; }
        { float pA[4], pH[4];
#pragma unroll
          for (int mt = 0; mt < 4; ++mt) { pA[mt] = bperm(iA[mt], src1); pH[mt] = bperm(iH[mt], src1); }
#pragma unroll
          for (int mt = 0; mt < 4; ++mt) if (has1) { iH[mt] = iA[mt] * pH[mt] + iH[mt]; iA[mt] = iA[mt] * pA[mt]; }
#pragma unroll
          for (int mt = 0; mt < 4; ++mt) { pA[mt] = bperm(iA[mt], src2); pH[mt] = bperm(iH[mt], src2); }
#pragma unroll
          for (int mt = 0; mt < 4; ++mt) if (has2) { iH[mt] = iA[mt] * pH[mt] + iH[mt]; iA[mt] = iA[mt] * pA[mt]; } }
#pragma unroll
        for (int mt = 0; mt < 4; ++mt) { eA[mt] = bperm(iA[mt], src1); eH[mt] = bperm(iH[mt], src1); tA[mt] = bperm(iA[mt], srct); tH[mt] = bperm(iH[mt], srct); if (!has1) { eA[mt] = 1.f; eH[mt] = 0.f; } }
#pragma unroll
        for (int mi = 0; mi < 4; ++mi) { const int mt = d ? 3 - mi : mi;
            const float hin = eH[mt] + eA[mt] * cr[n];
            if (PASS == 2) {
#pragma unroll
                for (int j = 0; j < 4; ++j) { const int tok = 16 * mt + 4 * fq + j; *(LAS bf16_t*)(HB + ((d * 64 + tok) * 256 + 64 * hd + 16 * n + fr) * 2) = f2bf(Hj[mt][j] + Aj[mt][j] * hin); } }
            cr[n] = tH[mt] + tA[mt] * cr[n]; at[n] *= tA[mt]; }
    }
    if (PASS == 1) { if (fq == 0) {
#pragma unroll
            for (int n = 0; n < 4; ++n) { float* s = SUMM + ((size_t)q * 2 + d) * 512 + 64 * hd + 16 * n + fr; s[0] = at[n]; s[256] = cr[n]; } } }
    else {
        __syncthreads();
        bf16_t* Y = (bf16_t*)(p->ws + WS_YCAT);
        u32x4 gaw[4];
#pragma unroll
        for (int it = 0; it < 4; ++it) { const int task = it * 512 + tid, tok = task >> 5, cg = task & 31; gaw[it] = *(const u32x4*)(PROJ + ((size_t)rowbase + t0 + tok) * NPROJ + 256 + 8 * cg); }
#pragma unroll
        for (int it = 0; it < 4; ++it) { const int task = it * 512 + tid, tok = task >> 5, cg = task & 31; const size_t row = (size_t)rowbase + t0 + tok;
            float hf[8], hb[8], ga[8], y[8];
            unpack8(*(const LAS u32x4*)(HB + ((0 * 64 + tok) * 256 + 8 * cg) * 2), hf); unpack8(*(const LAS u32x4*)(HB + ((1 * 64 + tok) * 256 + 8 * cg) * 2), hb);
            unpack8(gaw[it], ga);
#pragma unroll
            for (int e = 0; e < 8; ++e) { const float g = ga[e]; y[e] = (hf[e] + hb[e]) * (g * sigmoidf_(1.5957691216057308f * (g + 0.044715f * g * g * g))); }
            *(u32x4*)(Y + row * D + 8 * cg) = pack8(y); }
    }
}

__device__ __forceinline__ void scan2_unit(CP p, int l, int q, LAS unsigned char* lds) {
    const int tid = tid_(), lane = tid & 63, wid = __builtin_amdgcn_readfirstlane(tid >> 6), d = wid >> 2, hd = wid & 3, fr = lane & 15, fq = lane >> 4;
    LAS float* CAR = (LAS float*)(lds + wid * 256);
    LAS unsigned char* HB = lds + 2048;
    const bf16_t* PROJ = (const bf16_t*)(p->ws + WS_PROJ); const float* SUMM = (const float*)(p->ws + WS_SUMM);
    const Seq sq = seq_of(q); const int b = sq.b, jc = sq.jc, rowbase = sq.rowbase, t0 = sq.t0; const bool lat = sq.lat;
    __syncthreads();
    u32x4 ab[4][4];
    { const u32x4* ABi = (const u32x4*)(p->ws + WS_AB) + ((size_t)q * 8 + wid) * 16 * 64 + lane;
#pragma unroll
      for (int n = 0; n < 4; ++n)
#pragma unroll
          for (int mt = 0; mt < 4; ++mt) ab[n][mt] = ABi[(size_t)((n * 4 + mt) * 64)]; }
    u32x4 gaw[4];
#pragma unroll
    for (int it = 0; it < 4; ++it) { const int task = it * 512 + tid, tok = task >> 5, cg = task & 31; gaw[it] = *(const u32x4*)(PROJ + ((size_t)rowbase + t0 + tok) * NPROJ + 256 + 8 * cg); }
    { float car = 0.f; const int c = 64 * hd + lane;
      const int n = d == 0 ? (lat ? 4 + jc : jc) : (lat ? 4 + 63 - jc : 3 - jc);
      for (int s0 = 0; s0 < n; s0 += 16) { float A_[16], H_[16];
#pragma unroll
          for (int e = 0; e < 16; ++e) { const int s = s0 + e; int qq;
              if (d == 0) qq = (lat && s >= 4) ? b * 64 + (s - 4) : 512 + b * 4 + s; else qq = (lat && s >= 4) ? b * 64 + 63 - (s - 4) : 512 + b * 4 + 3 - s;
              A_[e] = 1.f; H_[e] = 0.f; if (s < n) { const float* sp_ = SUMM + ((size_t)qq * 2 + d) * 512; A_[e] = sp_[c]; H_[e] = sp_[256 + c]; } }
#pragma unroll
          for (int e = 0; e < 16; ++e) car = A_[e] * car + H_[e]; }
      CAR[lane] = car; }
    asm volatile("" ::: "memory");
    const int src1 = d ? lane + 16 : lane - 16, src2 = d ? lane + 32 : lane - 32, srct = d ? fr : 48 + fr;
    const bool has1 = d ? fq <= 2 : fq >= 1, has2 = d ? fq <= 1 : fq >= 2;
#pragma unroll
    for (int n = 0; n < 4; ++n) { float cr = CAR[16 * n + fr];
        float Hj[4][4], Aj[4][4];
#pragma unroll
        for (int mt = 0; mt < 4; ++mt) { const u32x4 w = ab[n][mt];
            const float a_[4] = {fexp2(bflo(w.x)), fexp2(bfhi(w.x)), fexp2(bflo(w.y)), fexp2(bfhi(w.y))}, b_[4] = {bflo(w.z), bfhi(w.z), bflo(w.w), bfhi(w.w)};
            if (d == 0) { Hj[mt][0] = b_[0]; Aj[mt][0] = a_[0];
#pragma unroll
                for (int j = 1; j < 4; ++j) { Hj[mt][j] = a_[j] * Hj[mt][j - 1] + b_[j]; Aj[mt][j] = a_[j] * Aj[mt][j - 1]; } }
            else { Hj[mt][3] = b_[3]; Aj[mt][3] = a_[3];
#pragma unroll
                for (int j = 2; j >= 0; --j) { Hj[mt][j] = a_[j] * Hj[mt][j + 1] + b_[j]; Aj[mt][j] = a_[j] * Aj[mt][j + 1]; } } }
        float iA[4], iH[4], eA[4], eH[4], tA[4], tH[4];
#pragma unroll
        for (int mt = 0; mt < 4; ++mt) { iA[mt] = d ? Aj[mt][0] : Aj[mt][3]; iH[mt] = d ? Hj[mt][0] : Hj[mt][3]; }
        { float pA[4], pH[4];
#pragma unroll
          for (int mt = 0; mt < 4; ++mt) { pA[mt] = bperm(iA[mt], src1); pH[mt] = bperm(iH[mt], src1); }
#pragma unroll
          for (int mt = 0; mt < 4; ++mt) if (has1) { iH[mt] = iA[mt] * pH[mt] + iH[mt]; iA[mt] = iA[mt] * pA[mt]; }
#pragma unroll
          for (int mt = 0; mt < 4; ++mt) { pA[mt] = bperm(iA[mt], src2); pH[mt] = bperm(iH[mt], src2); }
#pragma unroll
          for (int mt = 0; mt < 4; ++mt) if (has2) { iH[mt] = iA[mt] * pH[mt] + iH[mt]; iA[mt] = iA[mt] * pA[mt]; } }
#pragma unroll
        for (int mt = 0; mt < 4; ++mt) { eA[mt] = bperm(iA[mt], src1); eH[mt] = bperm(iH[mt], src1); tA[mt] = bperm(iA[mt], srct); tH[mt] = bperm(iH[mt], srct); if (!has1) { eA[mt] = 1.f; eH[mt] = 0.f; } }
#pragma unroll
        for (int mi = 0; mi < 4; ++mi) { const int mt = d ? 3 - mi : mi;
            const float hin = eH[mt] + eA[mt] * cr;
#pragma unroll
            for (int j = 0; j < 4; j += 2) { const int tok = 16 * mt + 4 * fq + j; const LAS unsigned char* dummy = HB; (void)dummy;
                *(LAS bf16_t*)(HB + ((d * 64 + tok) * 256 + 64 * hd + 16 * n + fr) * 2) = f2bf(Hj[mt][j] + Aj[mt][j] * hin);
                *(LAS bf16_t*)(HB + ((d * 64 + tok + 1) * 256 + 64 * hd + 16 * n + fr) * 2) = f2bf(Hj[mt][j + 1] + Aj[mt][j + 1] * hin); }
            cr = tH[mt] + tA[mt] * cr; } }
    __syncthreads();
    bf16_t* Y = (bf16_t*)(p->ws + WS_YCAT);
#pragma unroll
    for (int it = 0; it < 4; ++it) { const int task = it * 512 + tid, tok = task >> 5, cg = task & 31; const size_t row = (size_t)rowbase + t0 + tok;
        float hf[8], hb[8], ga[8], y[8];
        unpack8(*(const LAS u32x4*)(HB + ((0 * 64 + tok) * 256 + 8 * cg) * 2), hf); unpack8(*(const LAS u32x4*)(HB + ((1 * 64 + tok) * 256 + 8 * cg) * 2), hb);
        unpack8(gaw[it], ga);
#pragma unroll
        for (int e = 0; e < 8; ++e) { const float g = ga[e]; y[e] = (hf[e] + hb[e]) * (g * sigmoidf_(1.5957691216057308f * (g + 0.044715f * g * g * g))); }
        *(u32x4*)(Y + row * D + 8 * cg) = pack8(y); }
}

template <int HW>
__device__ __forceinline__ void pool_core(const float (&vals)[48], int tb, int L, float bp, float ps, bf16_t* yp) {
    float sacc = 0.f;
#pragma unroll
    for (int i = 8 - HW; i < 8 + HW; ++i) sacc += vals[i];
#pragma unroll
    for (int o = 0; o < 32; ++o) { const int t = tb + o; const int cnt = min(t + HW, L) - max(t - HW, 0);
        const float yv = (sacc * frcp((float)cnt) - vals[8 + o] + bp) * ps;
        yp[(size_t)o * D] = f2bf(yv);
        if (o < 31) sacc += vals[8 + o + HW] - vals[8 + o - HW]; }
}
__device__ __forceinline__ void pool_unit(CP p, int l, int q, LAS unsigned char* lds) {
    LAS float* PB = (LAS float*)lds;
    const int tid = tid_();
    const bf16_t* PROJ = (const bf16_t*)(p->ws + WS_PROJ); bf16_t* Y = (bf16_t*)(p->ws + WS_YCAT);
    const Seq sq = seq_of(q); const int L = sq.L, rowbase = sq.rowbase, t0 = sq.t0;
    __syncthreads();
    { u32x4 w[5];
#pragma unroll
      for (int it = 0; it < 5; ++it) { const int task = it * 512 + tid, r = task >> 5, cg = task & 31, tt = t0 - 8 + r; w[it] = (u32x4){0u, 0u, 0u, 0u};
          if (tt >= 0 && tt < L) w[it] = *(const u32x4*)(PROJ + (size_t)(rowbase + tt) * NPROJ + 512 + 8 * cg); }
#pragma unroll
      for (int it = 0; it < 5; ++it) { const int task = it * 512 + tid, r = task >> 5, cg = task & 31; float f[8]; unpack8(w[it], f);
          *(LAS f32x4*)(PB + r * 256 + 8 * cg) = (f32x4){f[0], f[1], f[2], f[3]}; *(LAS f32x4*)(PB + r * 256 + 8 * cg + 4) = (f32x4){f[4], f[5], f[6], f[7]}; } }
    __syncthreads();
    { const int c = tid & 255, th = tid >> 8, g = __builtin_amdgcn_readfirstlane(c >> 6); const float bp = p->b_pool[l * 256 + c], ps = p->pool_scale[l * 256 + c];
      float vals[48];
#pragma unroll
      for (int i = 0; i < 48; ++i) vals[i] = PB[(32 * th + i) * 256 + c];
      bf16_t* yp = Y + (size_t)(rowbase + t0 + 32 * th) * D + 256 + c; const int tb = t0 + 32 * th;
      if (g == 0) pool_core<1>(vals, tb, L, bp, ps, yp); else if (g == 1) pool_core<2>(vals, tb, L, bp, ps, yp); else if (g == 2) pool_core<4>(vals, tb, L, bp, ps, yp); else pool_core<8>(vals, tb, L, bp, ps, yp); }
}
__device__ __forceinline__ void four_unit(CP p, int l, int q) {
    const int tid = tid_();
    bf16_t* Y = (bf16_t*)(p->ws + WS_YCAT);
    const Seq sq = seq_of(q); const int b = sq.b, rowbase = sq.rowbase, t0 = sq.t0; const bool lat = sq.lat;
    const float* UU = (const float*)(p->ws + WS_UU); const float* VV = (const float*)(p->ws + WS_VV); const float* YCX = (const float*)(p->ws + WS_YCX);
#pragma unroll
    for (int it = 0; it < 4; ++it) { const int task = it * 512 + tid, tl = task >> 5, cg = task & 31, t = t0 + tl; float y[8];
        f32x4 u0, u1, v0 = {0.f, 0.f, 0.f, 0.f}, v1 = {0.f, 0.f, 0.f, 0.f}; float sgn, scale;
        if (lat) { const int k = t <= 2048 ? t : 4096 - t; sgn = t <= 2048 ? -1.0f : 1.0f; scale = 1.0f / (512.0f * 64.0f);
            const float* up = UU + (size_t)k * 2048 + b * 256 + 8 * cg; u0 = *(const f32x4*)up; u1 = *(const f32x4*)(up + 4);
            if (k < 2048) { const float* vp = VV + (size_t)k * 2048 + b * 256 + 8 * cg; v0 = *(const f32x4*)vp; v1 = *(const f32x4*)(vp + 4); } }
        else { sgn = 0.f; scale = 1.0f / (128.0f * 64.0f); const float* up = YCX + (size_t)t * 2048 + b * 256 + 8 * cg; u0 = *(const f32x4*)up; u1 = *(const f32x4*)(up + 4); }
        const f32x4 bf0 = *(const f32x4*)(p->b_four + l * 256 + 8 * cg), bf1 = *(const f32x4*)(p->b_four + l * 256 + 8 * cg + 4);
        const f32x4 r0 = (u0 + v0 * sgn) * scale + bf0, r1 = (u1 + v1 * sgn) * scale + bf1;
        y[0] = r0[0]; y[1] = r0[1]; y[2] = r0[2]; y[3] = r0[3]; y[4] = r1[0]; y[5] = r1[1]; y[6] = r1[2]; y[7] = r1[3];
        *(u32x4*)(Y + (size_t)(rowbase + t) * D + 512 + 8 * cg) = pack8(y); }
}
__device__ __forceinline__ void conformer_unit(CP p, int l, int q, LAS unsigned char* lds) {
    LAS float* V = (LAS float*)lds;
    const int tid = tid_(), lane = tid & 63, wid = __builtin_amdgcn_readfirstlane(tid >> 6);
    const bf16_t* PROJ = (const bf16_t*)(p->ws + WS_PROJ); bf16_t* Y = (bf16_t*)(p->ws + WS_YCAT);
    const Seq sq = seq_of(q); const int L = sq.L, rowbase = sq.rowbase, t0 = sq.t0;
    __syncthreads();
    { u32x4 wa[6], wg_[6];
#pragma unroll
      for (int it = 0; it < 6; ++it) { const int task = it * 512 + tid, r = task >> 5, cg = task & 31, tt = t0 - 15 + r; wa[it] = (u32x4){0u, 0u, 0u, 0u}; wg_[it] = wa[it];
          if (task < 94 * 32 && tt >= 0 && tt < L) { const bf16_t* pr = PROJ + (size_t)(rowbase + tt) * NPROJ + 768 + 8 * cg; wa[it] = *(const u32x4*)pr; wg_[it] = *(const u32x4*)(pr + 256); } }
#pragma unroll
      for (int it = 0; it < 6; ++it) { const int task = it * 512 + tid, r = task >> 5, cg = task & 31; float a[8], g[8], f[8]; unpack8(wa[it], a); unpack8(wg_[it], g);
#pragma unroll
          for (int e = 0; e < 8; ++e) f[e] = a[e] * sigmoidf_(g[e]);
          if (task < 94 * 32) { *(LAS f32x4*)(V + r * 256 + 8 * cg) = (f32x4){f[0], f[1], f[2], f[3]}; *(LAS f32x4*)(V + r * 256 + 8 * cg + 4) = (f32x4){f[4], f[5], f[6], f[7]}; } } }
    __syncthreads();
    const int hp = wid & 1, tq = wid >> 1, c0 = 128 * hp + 2 * lane;
    f32x2 wk[31];
#pragma unroll
    for (int k = 0; k < 31; ++k) wk[k] = *(const f32x2*)(p->conv_d_w + ((size_t)l * 31 + k) * 256 + c0);
    const f32x2 cb = *(const f32x2*)(p->conv_d_b + l * 256 + c0), lg = *(const f32x2*)(p->ln_d_g + l * 256 + c0), lb = *(const f32x2*)(p->ln_d_b + l * 256 + c0);
    for (int blk = 0; blk < 2; ++blk) { const int tl0 = 16 * tq + 8 * blk;
        f32x2 win[38];
#pragma unroll
        for (int i = 0; i < 38; ++i) win[i] = *(const LAS f32x2*)(V + (tl0 + i) * 256 + c0);
        f32x2 sv[8]; float m1[8], m2[8];
#pragma unroll
        for (int o = 0; o < 8; ++o) { f32x2 sacc = cb;
#pragma unroll
            for (int k = 0; k < 31; ++k) sacc += wk[k] * win[o + k];
            sv[o] = sacc; m1[o] = sacc.x + sacc.y; m2[o] = sacc.x * sacc.x + sacc.y * sacc.y; }
#pragma unroll
        for (int st = 16; st >= 1; st >>= 1) { float t1[8], t2[8];
#pragma unroll
            for (int o = 0; o < 8; ++o) { t1[o] = bperm(m1[o], lane ^ st); t2[o] = bperm(m2[o], lane ^ st); }
#pragma unroll
            for (int o = 0; o < 8; ++o) { m1[o] += t1[o]; m2[o] += t2[o]; } }
#pragma unroll
        for (int o = 0; o < 8; ++o) { const float mean = m1[o] * (1.0f / 64.0f); const float var = fmaxf(m2[o] * (1.0f / 64.0f) - mean * mean, 0.f); const float rs = __builtin_amdgcn_rsqf(var + 1e-6f);
            f32x2 yv = (sv[o] - mean) * rs * lg + lb; yv.x = yv.x * sigmoidf_(yv.x); yv.y = yv.y * sigmoidf_(yv.y);
            *(unsigned*)(Y + (size_t)(rowbase + t0 + tl0 + o) * D + 768 + c0) = cvt_pk_bf16(yv.x, yv.y); } }
}

struct SchedIn { const char *U, *W, *WF; char *PROJ, *PQT, *PQC;
    __device__ __forceinline__ bool next(int i, g8::Unit& u) const { const int L = i * (int)gridDim.x + (int)blockIdx.x; if (L >= 952) return false; const int id = g8::xcd_remap(L, 952);
        if (id < 680) { u.kind = 0; u.pm = id / 5; u.pn = id % 5; u.a = U + (size_t)u.pm * 256 * 2048; u.b = W + (size_t)u.pn * 256 * 2048; u.o = PROJ; u.e = 0; }
        else { const int r = id - 680; u.kind = 1; u.pm = r & 1; u.pn = r >> 1; u.a = WF + (size_t)u.pm * 256 * 2048; u.b = U + (size_t)u.pn * 256 * 2048; u.e = 0;
            if (u.pn < 128) u.o = PQT + ((size_t)(u.pm * 2048 + (u.pn >> 4) * 256) * 4096 + (u.pn & 15) * 256); else u.o = PQC + ((size_t)((u.pn - 128) * 256) * 512 + u.pm * 256); }
        return true; } };
struct EpiIn { static constexpr bool PERM = true; const float* bin; const float* bf;
    __device__ __forceinline__ void side_dma(const g8::Unit& u, int t, LAS unsigned char* d) const { g8::dma4((u.kind == 0 ? bin + u.pn * 256 : bf + u.pm * 256) + t, d); }
    __device__ __forceinline__ void operator()(const f32x4 (&acc)[2][2][4][2], const g8::Unit& u, int wr, int wc, int fr, int fq, const LAS unsigned* sd) const {
        { const int ln_ = tid_() & 63; fr = ln_ & 15; fq = ln_ >> 4; }
        if (u.kind == 0) { const int row0 = u.pm * 256 + wr * 64 + fr, col0 = u.pn * 256 + wc * 32 + 8 * fq; bf16_t* O = (bf16_t*)u.o;
            f32x4 bv[2][2];
#pragma unroll
            for (int bj = 0; bj < 2; ++bj)
#pragma unroll
                for (int n = 0; n < 2; ++n) bv[bj][n] = *(const LAS f32x4*)(sd + wc * 32 + 8 * fq + bj * 128 + 4 * n);
#pragma unroll
            for (int ai = 0; ai < 2; ++ai)
#pragma unroll
                for (int m = 0; m < 4; ++m) { bf16_t* rowp = O + (size_t)(row0 + ai * 128 + m * 16) * NPROJ + col0;
#pragma unroll
                    for (int bj = 0; bj < 2; ++bj) { const f32x4 v0 = acc[ai][bj][m][0] + bv[bj][0], v1 = acc[ai][bj][m][1] + bv[bj][1];
                        u32x4 w; w.x = cvt_pk_bf16(v0[0], v0[1]); w.y = cvt_pk_bf16(v0[2], v0[3]); w.z = cvt_pk_bf16(v1[0], v1[1]); w.w = cvt_pk_bf16(v1[2], v1[3]); *(u32x4*)(rowp + bj * 128) = w; } }
        } else { const int pitch = u.pn < 128 ? 4096 : 512; unsigned char* O = (unsigned char*)u.o; const int col0 = wc * 32 + 8 * fq;
#pragma unroll
            for (int ai = 0; ai < 2; ++ai)
#pragma unroll
                for (int m = 0; m < 4; ++m) { const int r = ai * 128 + wr * 64 + m * 16 + fr; const float bb = __uint_as_float(sd[r]); unsigned char* rowp = O + (size_t)r * pitch + col0;
#pragma unroll
                    for (int bj = 0; bj < 2; ++bj) { const f32x4 v0 = acc[ai][bj][m][0] + bb, v1 = acc[ai][bj][m][1] + bb;
                        u32x2 w; w.x = pk4_fp8(v0[0], v0[1], v0[2], v0[3]); w.y = pk4_fp8(v1[0], v1[1], v1[2], v1[3]); *(u32x2*)(rowp + bj * 128) = w; } }
        } } };
struct SchedDft { const char *CM, *SM, *PQT; char *UU, *VV;
    __device__ __forceinline__ bool next(int i, g8::Unit& u) const { const int id = (int)blockIdx.x; if (i > 0 || id >= 136) return false; u.kind = 0; u.e = 0;
        if (id < 72) { u.pm = id >> 3; u.pn = id & 7; u.a = CM + (size_t)u.pm * 256 * 8192; u.b = PQT + (size_t)u.pn * 256 * 8192; u.o = UU + ((size_t)u.pm * 256 * 2048 + u.pn * 256) * 4; }
        else { const int r = id - 72; u.pm = r >> 3; u.pn = r & 7; u.a = SM + (size_t)u.pm * 256 * 8192; u.b = PQT + (size_t)(2048 + u.pn * 256) * 8192; u.o = VV + ((size_t)u.pm * 256 * 2048 + u.pn * 256) * 4; }
        return true; } };
struct SchedOne { g8::Unit u; __device__ __forceinline__ bool next(int i, g8::Unit& o) const { if (i > 0) return false; o = u; return true; } };
struct SchedDftC { const char *DC, *PQC; char* YCX;
    __device__ __forceinline__ bool next(int i, g8::Unit& u) const { const int id = (int)blockIdx.x - 136; if (i > 0 || id < 0 || id >= 8) return false; u.kind = 0; u.e = 0; u.pm = 0; u.pn = id;
        u.a = DC; u.b = PQC + (size_t)id * 256 * 1024; u.o = YCX + (size_t)id * 256 * 4; return true; } };
struct EpiF32 { static constexpr bool PERM = false;
    __device__ __forceinline__ void side_dma(const g8::Unit&, int, LAS unsigned char*) const {}
    __device__ __forceinline__ void operator()(const f32x4 (&acc)[2][2][4][2], const g8::Unit& u, int wr, int wc, int fr, int fq, const LAS unsigned* sd) const {
        { const int ln_ = tid_() & 63; fr = ln_ & 15; fq = ln_ >> 4; }
        float* O = (float*)u.o; const int row0 = wr * 64 + fr, col0 = wc * 32 + 4 * fq;
#pragma unroll
        for (int ai = 0; ai < 2; ++ai)
#pragma unroll
            for (int m = 0; m < 4; ++m) { float* rowp = O + (size_t)(row0 + ai * 128 + m * 16) * 2048 + col0;
#pragma unroll
                for (int bj = 0; bj < 2; ++bj)
#pragma unroll
                    for (int n = 0; n < 2; ++n) *(f32x4*)(rowp + bj * 128 + n * 16) = acc[ai][bj][m][n]; } } };
struct SchedOut { const char *Y, *W; int nm; const float* modv_l;
    __device__ __forceinline__ bool next(int i, g8::Unit& u) const { const int nu = nm * 4, L = i * (int)gridDim.x + (int)blockIdx.x; if (L >= nu) return false; const int id = g8::xcd_remap(L, nu);
        u.kind = 0; u.pm = id >> 2; u.pn = id & 3; u.a = Y + (size_t)u.pm * 256 * 2048; u.b = W + (size_t)u.pn * 256 * 2048; u.o = nullptr; u.e = u.pm < 128 ? u.pm >> 4 : 8; return true; } };
struct EpiOut { static constexpr bool PERM = true; bf16_t* Y2; const float* bout; const float* modv_l;
    __device__ __forceinline__ void side_dma(const g8::Unit& u, int t, LAS unsigned char* d) const { g8::dma4(bout + u.pn * 256 + t, d); g8::dma4(modv_l + (size_t)u.e * 6144 + 2048 + u.pn * 256 + t, d + 1024); }
    __device__ __forceinline__ void operator()(const f32x4 (&acc)[2][2][4][2], const g8::Unit& u, int wr, int wc, int fr, int fq, const LAS unsigned* sd) const {
        { const int ln_ = tid_() & 63; fr = ln_ & 15; fq = ln_ >> 4; }
        const int row0 = u.pm * 256 + wr * 64 + fr, col0 = u.pn * 256 + wc * 32 + 8 * fq;
        f32x4 bv[2][2], gv[2][2];
#pragma unroll
        for (int bj = 0; bj < 2; ++bj)
#pragma unroll
            for (int n = 0; n < 2; ++n) { bv[bj][n] = *(const LAS f32x4*)(sd + wc * 32 + 8 * fq + bj * 128 + 4 * n); gv[bj][n] = *(const LAS f32x4*)(sd + 256 + wc * 32 + 8 * fq + bj * 128 + 4 * n); }
#pragma unroll
        for (int ai = 0; ai < 2; ++ai)
#pragma unroll
            for (int m = 0; m < 4; ++m) { bf16_t* rowp = Y2 + (size_t)(row0 + ai * 128 + m * 16) * D + col0;
#pragma unroll
                for (int bj = 0; bj < 2; ++bj) { const f32x4 v0 = gv[bj][0] * (acc[ai][bj][m][0] + bv[bj][0]), v1 = gv[bj][1] * (acc[ai][bj][m][1] + bv[bj][1]);
                    u32x4 w; w.x = cvt_pk_bf16(v0[0], v0[1]); w.y = cvt_pk_bf16(v0[2], v0[3]); w.z = cvt_pk_bf16(v1[0], v1[1]); w.w = cvt_pk_bf16(v1[2], v1[3]); *(u32x4*)(rowp + bj * 128) = w; } } } };
struct MoeTab { const LAS int* pref; const LAS int* cnt; const LAS unsigned char* t2e; int ntile;
    __device__ __forceinline__ int pref_(int e) const { return __builtin_amdgcn_readfirstlane(pref[e]); }
    __device__ __forceinline__ int cnt_(int e) const { return __builtin_amdgcn_readfirstlane(cnt[e]); }
    __device__ __forceinline__ int expert_of(int pm) const { return __builtin_amdgcn_readfirstlane((int)t2e[pm]); } };
struct SchedGu { MoeTab tb; const char *U, *W; char* ACT; const unsigned* rroff; unsigned maxoff; int rb;
    __device__ __forceinline__ bool next(int i, g8::Unit& u) const { const int nu = tb.ntile * 8, L = i * (int)gridDim.x + (int)blockIdx.x; if (L >= nu) return false; const int id = g8::xcd_remap(L, nu);
        u.kind = 0; u.pm = id >> 3; u.pn = id & 7; u.e = tb.expert_of(u.pm); u.a = U; u.b = W + ((size_t)u.e * 2048 + u.pn * 256) * rb; u.o = ACT + (size_t)u.pm * 256 * rb; return true; }
    __device__ __forceinline__ void roff_dma(const g8::Unit& u, int t, LAS unsigned char* d) const { g8::dma4(rroff + (size_t)u.e * TT + (u.pm - tb.pref_(u.e)) * 256 + t, d); } };
template <bool F8> struct EpiGu { static constexpr bool PERM = true; const float* bgu;
    __device__ __forceinline__ void side_dma(const g8::Unit& u, int t, LAS unsigned char* d) const { g8::dma4(bgu + (size_t)u.e * 2048 + (t < 128 ? 0 : 1024 - 128) + u.pn * 128 + t, d); }
    __device__ __forceinline__ void operator()(const f32x4 (&acc)[2][2][4][2], const g8::Unit& u, int wr, int wc, int fr, int fq, const LAS unsigned* sd) const {
        { const int ln_ = tid_() & 63; fr = ln_ & 15; fq = ln_ >> 4; }
        const int col0 = u.pn * 128 + wc * 32 + 8 * fq; const float sc = F8 ? (1.0f / 64.0f) : 1.0f;
        f32x4 bgt[2], bup[2];
#pragma unroll
        for (int n = 0; n < 2; ++n) { bgt[n] = *(const LAS f32x4*)(sd + wc * 32 + 8 * fq + 4 * n); bup[n] = *(const LAS f32x4*)(sd + 128 + wc * 32 + 8 * fq + 4 * n); }
#pragma unroll
        for (int ai = 0; ai < 2; ++ai)
#pragma unroll
            for (int m = 0; m < 4; ++m) { const int r = ai * 128 + wr * 64 + m * 16 + fr; float y[8];
#pragma unroll
                for (int n = 0; n < 2; ++n)
#pragma unroll
                    for (int h = 0; h < 2; ++h) {
                        f32x2 g2 = (f32x2){acc[ai][0][m][n][2 * h], acc[ai][0][m][n][2 * h + 1]} * sc + (f32x2){bgt[n][2 * h], bgt[n][2 * h + 1]};
                        f32x2 u2 = (f32x2){acc[ai][1][m][n][2 * h], acc[ai][1][m][n][2 * h + 1]} * sc + (f32x2){bup[n][2 * h], bup[n][2 * h + 1]};
                        g2.x = fminf(g2.x, 7.0f); g2.y = fminf(g2.y, 7.0f); u2.x = __builtin_amdgcn_fmed3f(u2.x, -7.0f, 7.0f); u2.y = __builtin_amdgcn_fmed3f(u2.y, -7.0f, 7.0f);
                        const f32x2 t2 = g2 * (-1.702f * 1.4426950408889634f); f32x2 d2; d2.x = fexp2(t2.x); d2.y = fexp2(t2.y); d2 = d2 + 1.0f;
                        f32x2 s2; s2.x = frcp(d2.x); s2.y = frcp(d2.y);
                        const f32x2 y2 = (u2 + 1.0f) * g2 * s2; y[4 * n + 2 * h] = y2.x; y[4 * n + 2 * h + 1] = y2.y; }
                if constexpr (F8) { u32x2 w; w.x = pk4_fp8(y[0], y[1], y[2], y[3]); w.y = pk4_fp8(y[4], y[5], y[6], y[7]); *(u32x2*)((unsigned char*)u.o + (size_t)r * D + col0) = w; }
                else *(u32x4*)((bf16_t*)u.o + (size_t)r * D + col0) = pack8(y); } } };
struct SchedDown { MoeTab tb; const char *ACT, *W; int rb;
    __device__ __forceinline__ bool next(int i, g8::Unit& u) const { const int nu = tb.ntile * 4, L = i * (int)gridDim.x + (int)blockIdx.x; if (L >= nu) return false; const int id = g8::xcd_remap(L, nu);
        u.kind = 0; u.pm = id >> 2; u.pn = id & 3; u.e = tb.expert_of(u.pm); u.a = ACT + (size_t)u.pm * 256 * rb; u.b = W + ((size_t)u.e * 1024 + u.pn * 256) * rb; u.o = nullptr; return true; } };
struct EpiDown { static constexpr bool PERM = true; MoeTab tb; const float* bd; const int* rasg; const float* gate; bf16_t* YS; float sc;
    __device__ __forceinline__ void side_dma(const g8::Unit& u, int t, LAS unsigned char* d) const { const size_t pos = (size_t)u.e * TT + (u.pm - tb.pref_(u.e)) * 256 + t;
        g8::dma4(rasg + pos, d); g8::dma4(gate + pos, d + 1024); g8::dma4(bd + (size_t)u.e * 1024 + u.pn * 256 + t, d + 2048); }
    __device__ __forceinline__ void operator()(const f32x4 (&acc)[2][2][4][2], const g8::Unit& u, int wr, int wc, int fr, int fq, const LAS unsigned* sd) const {
        { const int ln_ = tid_() & 63; fr = ln_ & 15; fq = ln_ >> 4; }
        const int col0 = u.pn * 256 + wc * 32 + 8 * fq; const int rank0 = (u.pm - tb.pref_(u.e)) * 256, cnt = tb.cnt_(u.e);
        f32x4 bv[2][2];
#pragma unroll
        for (int bj = 0; bj < 2; ++bj)
#pragma unroll
            for (int n = 0; n < 2; ++n) bv[bj][n] = *(const LAS f32x4*)(sd + 512 + wc * 32 + 8 * fq + bj * 128 + 4 * n);
#pragma unroll
        for (int ai = 0; ai < 2; ++ai)
#pragma unroll
            for (int m = 0; m < 4; ++m) { const int r = ai * 128 + wr * 64 + m * 16 + fr; const int asg = (int)sd[r]; const float g = __uint_as_float(sd[256 + r]);
                if (rank0 + r < cnt) { unsigned char* rowp = (unsigned char*)YS + (size_t)asg * D + col0; const float g16 = g * 16.0f;
#pragma unroll
                    for (int bj = 0; bj < 2; ++bj) { const f32x4 v0 = (acc[ai][bj][m][0] * sc + bv[bj][0]) * g16, v1 = (acc[ai][bj][m][1] * sc + bv[bj][1]) * g16;
                        u32x2 w; w.x = pk4_fp8(v0[0], v0[1], v0[2], v0[3]); w.y = pk4_fp8(v1[0], v1[1], v1[2], v1[3]); *(u32x2*)(rowp + bj * 128) = w; } } } } };
__device__ __forceinline__ MoeTab moe_tables(CP p, int l, LAS unsigned char* lds) {
    LAS int* pref = (LAS int*)(lds + g8::STAGE_BYTES); LAS int* cnt = pref + 64; LAS unsigned char* t2e = (LAS unsigned char*)(lds + g8::STAGE_BYTES + 384);
    unsigned* ctl = (unsigned*)(p->ws + WS_CTL);
    const int tid = tid_();
    __syncthreads();
    if (tid < 32) cnt[tid] = (int)__hip_atomic_load(ctl + CW_COUNT + (l * NE + tid) * 64, __ATOMIC_RELAXED, __HIP_MEMORY_SCOPE_AGENT);
    __syncthreads();
    if (tid == 0) { int s = 0; for (int e = 0; e < 32; ++e) { pref[e] = s; s += (cnt[e] + 255) >> 8; } pref[32] = s; }
    __syncthreads();
    for (int pm = tid; pm < NTILE_MAX; pm += 512) { int e = 0; for (int k = 1; k < 32; ++k) e += (pm >= pref[k]) ? 1 : 0; t2e[pm] = (unsigned char)e; }
    __syncthreads();
    MoeTab tb; tb.pref = pref; tb.cnt = cnt; tb.t2e = t2e; tb.ntile = __builtin_amdgcn_readfirstlane(pref[32]); return tb;
}

constexpr int N_PHASES = 18;
__global__ void __launch_bounds__(512, 2) mega_fwd(Params p_unused) {
    CP p = launder_params();
    extern __shared__ __attribute__((aligned(16))) unsigned char shm_[];
    LAS unsigned char* lds0 = (LAS unsigned char*)shm_;
    LAS unsigned char* lds = lds0 + LDS_BASE;
    if (tid_() == 0) *(LAS u32x4*)lds0 = (u32x4){0u, 0u, 0u, 0u};
    __syncthreads();
    XcdBarrier bar = xcd_barrier_post((unsigned*)(p->ws + WS_CTL), (volatile LAS unsigned*)lds0);
    int ph = 0;
#ifndef P3A
#define P3A 1
#define P3B 1
#define P3C 1
#endif
#ifndef PHMASK
#define PHMASK 0x3ff
#endif
#ifndef REPMASK
#define REPMASK 0
#endif
#define PHASE_BEGIN_K(k) p = launder_params(); if (((PHMASK >> (k)) & 1) && ph >= p->ph_lo && ph < p->ph_hi) for (int rep_ = 0; rep_ < ((((REPMASK) >> (k)) & 1) ? 2 : 1); ++rep_) {
#define PHASE_END } ++ph; if (ph > p->ph_lo && ph < p->ph_hi) xcd_barrier(bar);
    PHASE_BEGIN_K(0) phase_prologue(p, lds, rep_); PHASE_END
    for (int l = 0; l < 2; ++l) {
        const float* modv_l = (const float*)(p->ws + WS_MODV) + (size_t)l * 9 * 6144;
        PHASE_BEGIN_K(1) phase_norm(p, l); PHASE_END
        PHASE_BEGIN_K(2) { SchedIn S; S.U = (const char*)(p->ws + WS_U); S.W = (const char*)(p->ws + WS_WINT) + (size_t)l * NPROJ * 2048; S.WF = (const char*)(p->ws + WS_WFT) + (size_t)l * 512 * 2048;
                      S.PROJ = (char*)(p->ws + WS_PROJ); S.PQT = (char*)(p->ws + WS_PQT); S.PQC = (char*)(p->ws + WS_PQC);
                      EpiIn E; E.bin = (const float*)(p->ws + WS_BIN) + l * NPROJ; E.bf = (const float*)(p->ws + WS_BF) + l * 512;
                      g8::gemm_phase<EpiIn, SchedIn, false>(lds, 1024, S, E); } PHASE_END
        PHASE_BEGIN_K(3) {
                      unsigned* qhead = (unsigned*)(p->ws + WS_CTL) + CW_QUEUE + (l * 2 + rep_) * 64; LAS int* qslot = (LAS int*)(lds - LDS_BASE + 64);
                      int tkt = 0; if (tid_() == 0) tkt = (int)__hip_atomic_fetch_add(qhead, 1u, __ATOMIC_RELAXED, __HIP_MEMORY_SCOPE_AGENT);
                      for (;;) { __syncthreads(); if (tid_() == 0) { *qslot = tkt; tkt = (int)__hip_atomic_fetch_add(qhead, 1u, __ATOMIC_RELAXED, __HIP_MEMORY_SCOPE_AGENT); } __syncthreads();
                          const int id = __builtin_amdgcn_readfirstlane(*qslot); const int nwj = MOE_W_IN_QUEUE ? (l == 0 ? J_TGU_L(0) + J_TD_L(0) : J_TGU_L(1) + J_TD_L(1)) : 0;
                          if (id >= 144 + (MOE_W_IN_QUEUE ? 9 : 3) * NCHUNK) break;
#if defined(P3KIND)
                          if (rep_) { const int kc = id < 144 ? 0 : (MOE_W_IN_QUEUE ? ((id - 144) % 3 != 0 ? 4 : 1 + ((id - 144) / 3) / NCHUNK) : 1 + (id - 144) / NCHUNK); if (kc != P3KIND) continue; }
#endif
                          int small = -1;
                          if (id >= 144) { if (!MOE_W_IN_QUEUE) small = id - 144; else { const int r = id - 144, g = r / 3, k = r - 3 * g; if (k == 0) small = g; else { const int wj = 2 * g + (k - 1); if (wj < nwj) moe_weight_job(p, l, wj, lds); continue; } } }
                          if (id < 136) { SchedOne S; S.u.kind = 0; S.u.e = 0;
                              if (id < 72) { S.u.pm = id >> 3; S.u.pn = id & 7; S.u.a = (const char*)(p->ws + WS_CMAT) + (size_t)S.u.pm * 256 * 4096; S.u.b = (const char*)(p->ws + WS_PQT) + (size_t)S.u.pn * 256 * 4096; S.u.o = (char*)(p->ws + WS_UU) + ((size_t)S.u.pm * 256 * 2048 + S.u.pn * 256) * 4; }
                              else { const int r = id - 72; S.u.pm = r >> 3; S.u.pn = r & 7; S.u.a = (const char*)(p->ws + WS_SMAT) + (size_t)S.u.pm * 256 * 4096; S.u.b = (const char*)(p->ws + WS_PQT) + (size_t)(2048 + S.u.pn * 256) * 4096; S.u.o = (char*)(p->ws + WS_VV) + ((size_t)S.u.pm * 256 * 2048 + S.u.pn * 256) * 4; }
                              g8::gemm_phase<EpiF32, SchedOne, false, true>(lds, 2048, S, EpiF32{}); }
                          else if (id < 144) { SchedOne S; S.u.kind = 0; S.u.e = 0; S.u.pm = 0; S.u.pn = id - 136; S.u.a = (const char*)(p->ws + WS_DFTC); S.u.b = (const char*)(p->ws + WS_PQC) + (size_t)S.u.pn * 256 * 512; S.u.o = (char*)(p->ws + WS_YCX) + (size_t)S.u.pn * 256 * 4;
                              g8::gemm_phase<EpiF32, SchedOne, false, true>(lds, 256, S, EpiF32{}); }
                          else { const int uu = small, kind = uu / NCHUNK, q = uu % NCHUNK;
                              if (kind == 0) scan_unit<1>(p, l, q, lds); else if (kind == 1) conformer_unit(p, l, q, lds); else pool_unit(p, l, q, lds); } } } PHASE_END
        PHASE_BEGIN_K(4) { for (int q = blockIdx.x; q < NCHUNK; q += gridDim.x) { scan2_unit(p, l, q, lds); four_unit(p, l, q); } } PHASE_END
        PHASE_BEGIN_K(5) { SchedOut S; S.Y = (const char*)(p->ws + WS_YCAT); S.W = (const char*)(p->ws + WS_WOUTT) + (size_t)l * D * 2048; S.nm = l == 0 ? 136 : 128; S.modv_l = modv_l;
                      EpiOut E; E.Y2 = (bf16_t*)(p->ws + WS_PROJ);   E.bout = (const float*)(p->ws + WS_BOUT) + l * D; E.modv_l = modv_l;
                      g8::gemm_phase<EpiOut, SchedOut, false>(lds, 1024, S, E); } PHASE_END
        PHASE_BEGIN_K(6) phase_router(p, l, lds, rep_); PHASE_END
        PHASE_BEGIN_K(7) { MoeTab tb = moe_tables(p, l, lds);
                      SchedGu S; S.tb = tb; S.W = (const char*)(p->ws + WS_WGUT) + (size_t)l * NE * 2048 * 2048; S.ACT = (char*)(p->ws + WS_ACT); S.rroff = (const unsigned*)(p->ws + WS_RROFF); S.maxoff = (unsigned)(TT - 1) * (fp8_layer(l) ? 1024u : 2048u);
                      if (fp8_layer(l)) { S.U = (const char*)(p->ws + WS_U8); S.rb = 1024; EpiGu<true> E; E.bgu = p->b_gu + (size_t)l * NE * 2048; g8::gemm_phase<EpiGu<true>, SchedGu, true, true>(lds, 512, S, E); }
                      else { S.U = (const char*)(p->ws + WS_U); S.rb = 2048; EpiGu<false> E; E.bgu = p->b_gu + (size_t)l * NE * 2048; g8::gemm_phase<EpiGu<false>, SchedGu, true, false>(lds, 1024, S, E); } } PHASE_END
        PHASE_BEGIN_K(8) { MoeTab tb = moe_tables(p, l, lds);
                      SchedDown S; S.tb = tb; S.ACT = (const char*)(p->ws + WS_ACT); S.W = (const char*)(p->ws + WS_WDT) + (size_t)l * NE * 1024 * 2048;
                      EpiDown E; E.tb = tb; E.bd = p->b_down + (size_t)l * NE * 1024; E.rasg = (const int*)(p->ws + WS_RASG); E.gate = (const float*)(p->ws + WS_RGATE); E.YS = (bf16_t*)(p->ws + WS_YS);
                      if (fp8_layer(l)) { S.rb = 1024; E.sc = 1.0f / 64.0f; g8::gemm_phase<EpiDown, SchedDown, false, true>(lds, 512, S, E); }
                      else { S.rb = 2048; E.sc = 1.0f; g8::gemm_phase<EpiDown, SchedDown, false, false>(lds, 1024, S, E); } } PHASE_END
    }
    PHASE_BEGIN_K(9) phase_norm(p, 2); PHASE_END
#undef PHASE_BEGIN_K
#undef PHASE_END
}

extern "C" void kernel_launch(void* const* d_in, const int* in_sizes, int n_in, void* d_out, int out_size, void* d_ws, size_t ws_size, hipStream_t stream) {
    static int grid = 0;
    if (!grid) {
        if (n_in != 37 || ws_size < WS_END) { fprintf(stderr, "kernel_launch: expected 37 inputs and >= %zu bytes of workspace (got %d, %zu)\n", (size_t)WS_END, n_in, ws_size); }
        int dev = 0, cus = 0, per_cu = 0;
        hipGetDevice(&dev); hipDeviceGetAttribute(&cus, hipDeviceAttributeMultiprocessorCount, dev);
        hipFuncSetAttribute((const void*)mega_fwd, hipFuncAttributeMaxDynamicSharedMemorySize, LDS_BYTES);
        hipOccupancyMaxActiveBlocksPerMultiprocessor(&per_cu, (const void*)mega_fwd, 512, LDS_BYTES);
        if (per_cu < 1) fprintf(stderr, "kernel_launch: occupancy query reports %d workgroups per CU\n", per_cu);
        grid = cus > 0 ? cus : 256;
    }
    hipMemsetAsync((char*)d_ws + WS_CTL, 0, CTL_BYTES, stream);
    Params hp{};
    const float** f = (const float**)&hp;
    for (int i = 0; i < 37; ++i) f[i] = (const float*)d_in[i];
    hp.out = (float*)d_out; hp.ws = (unsigned char*)d_ws;
#if MK_N_LAUNCHES == 1
    hp.ph_lo = 0; hp.ph_hi = N_PHASES;
    hipLaunchKernelGGL(mega_fwd, dim3(grid), dim3(512), LDS_BYTES, stream, hp);
#else
    for (int ph = 0; ph < N_PHASES; ++ph) { hp.ph_lo = ph; hp.ph_hi = ph + 1; hipLaunchKernelGGL(mega_fwd, dim3(grid), dim3(512), LDS_BYTES, stream, hp); }
#endif
}
```

```cpp
#include <hip/hip_runtime.h>
#include <cstdio>
#include <cstdint>

#ifndef MK_N_LAUNCHES
#define MK_N_LAUNCHES 1
#endif

#ifndef FP8_FROM
#define FP8_FROM 0
#endif
#define LAS __attribute__((address_space(3)))
typedef unsigned short bf16_t;
typedef short bf16x8 __attribute__((ext_vector_type(8)));
typedef float f32x4 __attribute__((ext_vector_type(4)));
typedef float f32x2 __attribute__((ext_vector_type(2)));
typedef unsigned u32x4 __attribute__((ext_vector_type(4)));
typedef unsigned u32x2 __attribute__((ext_vector_type(2)));
typedef int i32x4 __attribute__((ext_vector_type(4)));
typedef int i32x8 __attribute__((ext_vector_type(8)));

constexpr int D = 1024, NB = 8, SEQ = 4096, LCX = 256, TL = NB * SEQ, TC = NB * LCX, TT = TL + TC;
constexpr int NPROJ = 1280;
constexpr int NE = 32, NCHUNK = 544;
constexpr int NTILE_MAX = 576;

constexpr size_t AL(size_t x) { return (x + 255) & ~(size_t)255; }
constexpr size_t CTL_BYTES = 65536;
constexpr size_t WS_CTL = 0;
constexpr size_t WS_MODV = WS_CTL + CTL_BYTES;
constexpr size_t WS_X = AL(WS_MODV + (size_t)2 * 9 * 6144 * 4);
constexpr size_t WS_U = AL(WS_X + (size_t)TT * D * 4);
constexpr size_t WS_PROJ = AL(WS_U + (size_t)TT * D * 2);
constexpr size_t WS_PQT = AL(WS_PROJ + (size_t)TT * NPROJ * 2);
constexpr size_t WS_PQC = AL(WS_PQT + (size_t)4096 * 4096 * 2);
constexpr size_t WS_UU = AL(WS_PQC + (size_t)2048 * 512 * 2);
constexpr size_t WS_VV = AL(WS_UU + (size_t)2304 * 2048 * 4);
constexpr size_t WS_YCX = AL(WS_VV + (size_t)2048 * 2048 * 4);
constexpr size_t WS_YCAT = AL(WS_YCX + (size_t)256 * 2048 * 4);
constexpr size_t WS_SUMM = AL(WS_YCAT + (size_t)TT * D * 2);
constexpr size_t WS_WINT = AL(WS_SUMM + (size_t)NCHUNK * 1024 * 4);
constexpr size_t WS_WFT = AL(WS_WINT + (size_t)2 * NPROJ * D * 2);
constexpr size_t WS_BIN = AL(WS_WFT + (size_t)2 * 512 * D * 2);
constexpr size_t WS_BF = AL(WS_BIN + (size_t)2 * NPROJ * 4);
constexpr size_t WS_WOUTT = AL(WS_BF + (size_t)2 * 512 * 4);
constexpr size_t WS_BOUT = AL(WS_WOUTT + (size_t)2 * D * D * 2);
constexpr size_t WS_WGUT = AL(WS_BOUT + (size_t)2 * D * 4);
constexpr size_t WS_WDT = AL(WS_WGUT + (size_t)2 * NE * 2048 * D * 2);
constexpr size_t WS_WRT = AL(WS_WDT + (size_t)2 * NE * D * D * 2);
constexpr size_t WS_WGT = AL(WS_WRT + (size_t)2 * 2 * NE * D * 2);
constexpr size_t WS_CMAT = AL(WS_WGT + (size_t)2 * 2 * 2 * 4 * 64 * 64 * 2);
constexpr size_t WS_SMAT = AL(WS_CMAT + (size_t)2304 * 4096 * 2);
constexpr size_t WS_DFTC = AL(WS_SMAT + (size_t)2048 * 4096 * 2);
constexpr size_t WS_RASG = AL(WS_DFTC + (size_t)256 * 512 * 2);
constexpr size_t WS_GATE = AL(WS_RASG + (size_t)NE * TT * 4);
constexpr size_t WS_ACT = AL(WS_GATE + (size_t)TT * 4 * 4);
constexpr size_t WS_YS = AL(WS_ACT + (size_t)NTILE_MAX * 256 * D * 2);
constexpr size_t WS_POS = AL(WS_YS + (size_t)TT * 4 * D * 2);
constexpr size_t WS_AB = AL(WS_POS + (size_t)64 * 512 * 4);
constexpr size_t WS_U8 = AL(WS_AB + (size_t)NCHUNK * 8 * 16 * 64 * 16);
constexpr size_t WS_RGATE = AL(WS_U8 + (size_t)TT * D);
constexpr size_t WS_RROFF = AL(WS_RGATE + (size_t)NE * TT * 4 + 4096);
constexpr size_t WS_END = AL(WS_RROFF + (size_t)NE * TT * 4 + 4096);
constexpr int CW_QUEUE = 12288;
constexpr int CW_COUNT = 4096;

constexpr int LDS_BYTES = 159744;
constexpr int LDS_BASE = 1024;

__device__ __forceinline__ unsigned cvt_pk_bf16(float lo, float hi) { unsigned r; asm("v_cvt_pk_bf16_f32 %0, %1, %2" : "=v"(r) : "v"(lo), "v"(hi)); return r; }
__device__ __forceinline__ bf16_t f2bf(float f) { return (bf16_t)(cvt_pk_bf16(f, 0.f) & 0xffffu); }
__device__ __forceinline__ unsigned pk4_fp8(float a, float b, float c, float d) { int w = 0; w = __builtin_amdgcn_cvt_pk_fp8_f32(a, b, w, false); w = __builtin_amdgcn_cvt_pk_fp8_f32(c, d, w, true); return (unsigned)w; }
__device__ __forceinline__ float bf2f(bf16_t b) { return __uint_as_float(((unsigned)b) << 16); }
__device__ __forceinline__ float bflo(unsigned w) { return __uint_as_float(w << 16); }
__device__ __forceinline__ float bfhi(unsigned w) { return __uint_as_float(w & 0xffff0000u); }
__device__ __forceinline__ float fexp2(float x) { return __builtin_amdgcn_exp2f(x); }
__device__ __forceinline__ float frcp(float x) { return __builtin_amdgcn_rcpf(x); }
__device__ __forceinline__ f32x4 ld4bf(const bf16_t* p_) { const u32x2 w = __builtin_nontemporal_load((const u32x2*)p_); return (f32x4){bflo(w.x), bfhi(w.x), bflo(w.y), bfhi(w.y)}; }
__device__ __forceinline__ void st4bf(bf16_t* p_, const f32x4 v_) { u32x2 w; w.x = cvt_pk_bf16(v_[0], v_[1]); w.y = cvt_pk_bf16(v_[2], v_[3]); __builtin_nontemporal_store(w, (u32x2*)p_); }
__device__ __forceinline__ float sigmoidf_(float x) { return frcp(1.0f + fexp2(-1.4426950408889634f * x)); }
__device__ __forceinline__ int tid_() { int t = (int)threadIdx.x; asm volatile("" : "+v"(t)); return t; }
__device__ __forceinline__ float bperm(float v, int src) { return __int_as_float(__builtin_amdgcn_ds_bpermute(src << 2, __float_as_int(v))); }
__device__ __forceinline__ float wave_sum(float v, int lane) {
#pragma unroll
    for (int o = 32; o >= 1; o >>= 1) v += bperm(v, lane ^ o);
    return v;
}
__device__ __forceinline__ void unpack8(const u32x4 w, float (&f)[8]) { f[0] = bflo(w.x); f[1] = bfhi(w.x); f[2] = bflo(w.y); f[3] = bfhi(w.y); f[4] = bflo(w.z); f[5] = bfhi(w.z); f[6] = bflo(w.w); f[7] = bfhi(w.w); }
__device__ __forceinline__ u32x4 pack8(const float (&f)[8]) { u32x4 w; w.x = cvt_pk_bf16(f[0], f[1]); w.y = cvt_pk_bf16(f[2], f[3]); w.z = cvt_pk_bf16(f[4], f[5]); w.w = cvt_pk_bf16(f[6], f[7]); return w; }

#define XB_TMO      128
#define XB_XCNT(j)  (256  + 64 * (j))
#define XB_XSUB(j)  (1280 + 64 * (j))
#define XB_XGEN(j)  (2304 + 64 * (j))
#define XB_TOP      3328
#define XB_TOPGEN   3392
#define XCD_BAR_WORDS 3456
#define XB_SPIN_CAP (1u << 18)
__device__ __forceinline__ unsigned xb_ld(unsigned* p)              { return __hip_atomic_load(p, __ATOMIC_RELAXED, __HIP_MEMORY_SCOPE_AGENT); }
__device__ __forceinline__ unsigned xb_add(unsigned* p, unsigned v) { return __hip_atomic_fetch_add(p, v, __ATOMIC_RELAXED, __HIP_MEMORY_SCOPE_AGENT); }
__device__ __forceinline__ unsigned xb_xcc_id() { return (unsigned)__builtin_amdgcn_s_getreg((3 << 11) | 20) & 0xFu; }
#define XB_SPIN(cond, bar) do { unsigned _sp = 0; while (cond) { __builtin_amdgcn_s_sleep(1); \
    if ((++_sp & 255u) == 0u) { if (xb_ld(&(bar)[XB_TMO])) break; if (_sp > XB_SPIN_CAP) { atomicAdd(&(bar)[XB_TMO], 1u); break; } } } } while (0)
struct XcdBarrier { unsigned* bar; unsigned x; volatile LAS unsigned* st; };
__device__ __forceinline__ XcdBarrier xcd_barrier_post(unsigned* bar, volatile LAS unsigned* st) {
    XcdBarrier b; b.bar = bar; b.x = xb_xcc_id(); b.st = st;
    if (threadIdx.x == 0) (void)xb_add(&bar[XB_XCNT(b.x)], 1u);
    return b;
}
__device__ __forceinline__ void xcd_barrier_complete(unsigned* bar, unsigned x, unsigned& nloc, unsigned& nx) {
    const unsigned G = gridDim.x * gridDim.y * gridDim.z;
    unsigned sum, cnt, mine, sp = 0u;
    for (;;) {
        sum = 0u; cnt = 0u; mine = 0u;
#pragma unroll
        for (unsigned j = 0; j < 16; ++j) { const unsigned c = xb_ld(&bar[XB_XCNT(j)]); sum += c; cnt += (c > 0u) ? 1u : 0u; mine = (j == x) ? c : mine; }
        if (sum == G) break;
        __builtin_amdgcn_s_sleep(1);
        if ((++sp & 255u) == 0u) { if (xb_ld(&bar[XB_TMO])) break; if (sp > XB_SPIN_CAP) { atomicAdd(&bar[XB_TMO], 1u); break; } }
    }
    nloc = mine > 0u ? mine : 1u; nx = cnt > 0u ? cnt : 1u;
}
__device__ __forceinline__ void xcd_barrier(const XcdBarrier& b) {
    asm volatile("s_waitcnt vmcnt(0)" ::: "memory");
    __syncthreads();
    if (threadIdx.x == 0) {
        unsigned* bar = b.bar;
        __builtin_amdgcn_s_waitcnt(0);
        unsigned nloc = b.st[0], nx = b.st[1];
        if (nloc == 0u) { unsigned xo = b.x; asm volatile("" : "+s"(xo)); xcd_barrier_complete(bar, xo, nloc, nx); b.st[0] = nloc; b.st[1] = nx; }
        const unsigned old = xb_add(&bar[XB_XSUB(b.x)], 1u);
        const unsigned gen = old / nloc;
        if (old + 1u == (gen + 1u) * nloc) {
            __builtin_amdgcn_fence(__ATOMIC_RELEASE, "agent");
            asm volatile("s_waitcnt vmcnt(0)" ::: "memory");
            const unsigned og = xb_add(&bar[XB_TOP], 1u);
            const unsigned tg = og / nx;
            if (og + 1u == (tg + 1u) * nx) xb_add(&bar[XB_TOPGEN], 1u);
            else XB_SPIN(xb_ld(&bar[XB_TOPGEN]) == tg, bar);
            __builtin_amdgcn_fence(__ATOMIC_ACQUIRE, "agent");
            xb_add(&bar[XB_XGEN(b.x)], 1u);
            asm volatile("s_waitcnt vmcnt(0)" ::: "memory");
        } else {
            XB_SPIN(xb_ld(&bar[XB_XGEN(b.x)]) == gen, bar);
            __builtin_amdgcn_fence(__ATOMIC_ACQUIRE, "agent");
            asm volatile("s_waitcnt vmcnt(0)" ::: "memory");
        }
    }
    __syncthreads();
}

namespace g8 {
constexpr int BM = 256, BK = 64, HALF = 128, HTB = HALF * BK * 2, STAGE_BYTES = 8 * HTB;
__device__ __forceinline__ int lds_byte(int r, int c) { const int st = (r >> 4) * 2 + (c >> 5), rr = r & 15, cc = c & 31, ob = rr * 64 + cc * 2; return st * 1024 + (ob ^ (((ob >> 9) & 1) << 5)); }
__device__ __forceinline__ void stage_rc(int b, int& R, int& C) { const int st = b / 1024, sb = b % 1024, swz = sb ^ (((sb >> 9) & 1) << 5); R = (st >> 1) * 16 + swz / 64; C = (st & 1) * 32 + (swz % 64) / 2; }
__device__ __forceinline__ int perm32(int rho) { const int n = rho >> 4, i = rho & 15; return 8 * (i >> 2) + 4 * n + (i & 3); }

struct Unit { const char* a; const char* b; char* o; int kind, pm, pn, e; };
__device__ __forceinline__ void dma4(const void* g, LAS unsigned char* l) { __builtin_amdgcn_global_load_lds((const unsigned*)g, (LAS unsigned*)l, 4, 0, 0); }

__device__ __forceinline__ int xcd_remap(int L, int nu) { const int q = nu / 8, r = nu % 8, xcd = L % 8, off = L / 8; return (xcd < r ? xcd * (q + 1) : r * (q + 1) + (xcd - r) * q) + off; }

template <class Epi, class Sched, bool GATHER, bool FP8 = false>
__device__ __forceinline__ void gemm_phase(LAS unsigned char* lds, const int K, const Sched& S, const Epi& E) {
    const int tid = tid_(), wid = __builtin_amdgcn_readfirstlane(tid >> 6), lane = tid & 63, wr = wid >> 2, wc = wid & 3, fr = lane & 15, fq = lane >> 4;
    const int nt = K / BK;
    size_t kstep = (size_t)(BK * 2);
    if constexpr (GATHER) { if (S.kz) kstep = 0; }
    const size_t hstep = (size_t)HALF * K * 2;
    const unsigned ldsw = (unsigned)wid * 1024u;
    const int aoff = lds_byte(wr * 64 + fr, fq * 8), boff = lds_byte(wc * 32 + fr, fq * 8);
#define G8_SA(b, h) (((b) * 2 + (h)) * HTB)
#define G8_SB(b, h) ((4 + (b) * 2 + (h)) * HTB)
    const unsigned K2 = (unsigned)K * 2u, urow = (unsigned)(wid >> 1) * 16u, ucol = (unsigned)(wid & 1) * 64u;
    const unsigned uA0 = urow * K2 + ucol, uA1 = (urow + 64u) * K2 + ucol;
    const unsigned uB0 = Epi::PERM ? ((urow & ~31u) + 4u * ((unsigned)(wid >> 1) & 1u)) * K2 + ucol : uA0, uB1 = Epi::PERM ? (((urow + 64u) & ~31u) + 4u * ((unsigned)(wid >> 1) & 1u)) * K2 + ucol : uA1;
#define G8_OFFS(h) const unsigned ln_ = (unsigned)tid_() & 63u; const unsigned cl_ = (((ln_ & 3u) << 3) ^ ((ln_ >> 5) << 4)) * 2u; \
        const unsigned la_ = (ln_ >> 2) * K2 + cl_; const unsigned lb_ = Epi::PERM ? (8u * (ln_ >> 4) + ((ln_ >> 2) & 3u)) * K2 + cl_ : la_; (void)la_; (void)lb_; \
        unsigned ro_[2] = {0u, 0u}; if constexpr (GATHER) { _Pragma("unroll") for (int _i = 0; _i < 2; ++_i) ro_[_i] = ROFF[parA * 256 + (h) * 128 + (int)urow + 64 * _i + (int)(ln_ >> 2)]; }
#define G8_LD2(bufoff, g0, g1, o0, o1) do { _Pragma("unroll") for (int _i = 0; _i < 2; ++_i) { unsigned _vo = _i ? (o1) : (o0); asm volatile("" : "+v"(_vo)); \
        __builtin_amdgcn_global_load_lds((const unsigned*)((const char*)(_i ? (g1) : (g0)) + _vo), (LAS unsigned*)(lds + (bufoff) + ldsw + _i * 8192), 16, 0, 0); } } while (0)
#define G8_STB(bufoff, gbase) G8_LD2(bufoff, (gbase) + uB0, (gbase) + uB1, lb_, lb_)
#define G8_STA(bufoff, gbase, h) do { if constexpr (GATHER) { G8_LD2(bufoff, (gbase) + ucol, (gbase) + ucol, min(ro_[0], S.maxoff) + cl_, min(ro_[1], S.maxoff) + cl_); } \
        else { G8_LD2(bufoff, (gbase) + (h) * hstep + uA0, (gbase) + (h) * hstep + uA1, la_, la_); } } while (0)
#define G8_LDA(dst, dst8, b, h) do { _Pragma("unroll") for (int m = 0; m < 4; ++m) { if constexpr (FP8) { const i32x4 lo_ = *(const LAS i32x4*)(lds + G8_SA(b, h) + aoff + m * 2048), hi_ = *(const LAS i32x4*)(lds + G8_SA(b, h) + aoff + m * 2048 + 1024); dst8[m] = __builtin_shufflevector(lo_, hi_, 0, 1, 2, 3, 4, 5, 6, 7); } \
        else { _Pragma("unroll") for (int k = 0; k < 2; ++k) dst[m][k] = *(const LAS bf16x8*)(lds + G8_SA(b, h) + aoff + m * 2048 + k * 1024); } } } while (0)
#define G8_LDB(dst, dst8, b, h) do { _Pragma("unroll") for (int n = 0; n < 2; ++n) { if constexpr (FP8) { const i32x4 lo_ = *(const LAS i32x4*)(lds + G8_SB(b, h) + boff + n * 2048), hi_ = *(const LAS i32x4*)(lds + G8_SB(b, h) + boff + n * 2048 + 1024); dst8[n] = __builtin_shufflevector(lo_, hi_, 0, 1, 2, 3, 4, 5, 6, 7); } \
        else { _Pragma("unroll") for (int k = 0; k < 2; ++k) dst[n][k] = *(const LAS bf16x8*)(lds + G8_SB(b, h) + boff + n * 2048 + k * 1024); } } } while (0)
#define G8_MMA(ai, bj, At, At8, Bt, Bt8) do { __builtin_amdgcn_s_setprio(1); _Pragma("unroll") for (int m = 0; m < 4; ++m) _Pragma("unroll") for (int n = 0; n < 2; ++n) { \
        if constexpr (FP8) acc[ai][bj][m][n] = __builtin_amdgcn_mfma_scale_f32_16x16x128_f8f6f4(Bt8[n], At8[m], acc[ai][bj][m][n], 0, 0, 0, 0, 0, 0);     \
        else { _Pragma("unroll") for (int k = 0; k < 2; ++k) acc[ai][bj][m][n] = __builtin_amdgcn_mfma_f32_16x16x32_bf16(Bt[n][k], At[m][k], acc[ai][bj][m][n], 0, 0, 0); } } __builtin_amdgcn_s_setprio(0); } while (0)
#define G8_WAIT_V(n) asm volatile("s_waitcnt vmcnt(" #n ")" ::: "memory")
#define G8_WAIT_L(n) asm volatile("s_waitcnt lgkmcnt(" #n ")" ::: "memory")
#define G8_BAR __builtin_amdgcn_s_barrier()
#define G8_SCHED __builtin_amdgcn_sched_barrier(0)
    Unit cur, nxt; int ui = 0;
    if (!S.next(0, cur)) return;
    f32x4 acc[2][2][4][2];
#pragma unroll
    for (int a = 0; a < 2; ++a)
#pragma unroll
        for (int b = 0; b < 2; ++b)
#pragma unroll
            for (int m = 0; m < 4; ++m)
#pragma unroll
                for (int n = 0; n < 2; ++n) acc[a][b][m][n] = (f32x4){0.f, 0.f, 0.f, 0.f};
    bf16x8 At[4][2], B0[2][2], B1[2][2]; i32x8 At8[4], B08[2], B18[2];
    LAS unsigned* ROFF = (LAS unsigned*)(lds + STAGE_BYTES + 1024);
    LAS unsigned* SIDE = (LAS unsigned*)(lds + STAGE_BYTES + 12288);
    int parA = 0;
    if constexpr (GATHER) {
        if (wr == 0) S.roff_dma(cur, tid, (LAS unsigned char*)ROFF + wid * 256);
        asm volatile("s_waitcnt vmcnt(0)" ::: "memory"); __builtin_amdgcn_s_barrier(); asm volatile("" ::: "memory");
    }
    const char* cA = cur.a; const char* cB = cur.b;
    { G8_OFFS(0); G8_STB(G8_SB(0, 0), cB); G8_STB(G8_SB(0, 1), cB + hstep); G8_STA(G8_SA(0, 0), cA, 0); }
    { G8_OFFS(1); G8_STA(G8_SA(0, 1), cA, 1); }
    if (wr == 1) G8_BAR;
    G8_WAIT_V(2); G8_BAR;
    { G8_OFFS(0); G8_STB(G8_SB(1, 0), cB + kstep); G8_STA(G8_SA(1, 0), cA + kstep, 0); G8_STB(G8_SB(1, 1), cB + hstep + kstep); }
    G8_WAIT_V(6); G8_BAR;
#if defined(TIMEPROBE)
    unsigned long long tp_loop = 0ull, tp_t0 = 0ull; const unsigned long long tp_start = __builtin_amdgcn_s_memrealtime(); const unsigned long long tp_c0 = __builtin_amdgcn_s_memtime();
#endif
    for (;;) {
        const bool has_next = S.next(ui + 1, nxt);
#if defined(TIMEPROBE)
        tp_t0 = __builtin_amdgcn_s_memrealtime();
#endif
        const char* nA = has_next ? nxt.a : cA; const char* nB = has_next ? nxt.b : cB;
#pragma clang loop unroll(disable)
        for (int t = 0; t < nt; t += 2) {
            const bool last = (t == nt - 2);
            int to = t; asm volatile("" : "+s"(to));
            const char* a1 = cA + (size_t)(to + 1) * kstep;
            const char* a2 = last ? nA : cA + (size_t)(to + 2) * kstep; const char* b2 = last ? nB : cB + (size_t)(to + 2) * kstep;
            const char* a3 = a2 + kstep; const char* b3 = b2 + kstep;
            if (t == 0 && wr == 0) E.side_dma(cur, tid_(), (LAS unsigned char*)(SIDE + (ui & 1) * 768) + wid * 256);
            if constexpr (GATHER) { if (has_next && t == nt - 4 && wr == 0) S.roff_dma(nxt, tid_(), (LAS unsigned char*)(ROFF + (parA ^ 1) * 256) + wid * 256); }
            { G8_OFFS(1); G8_LDB(B0, B08, 0, 0); G8_LDB(B1, B18, 0, 1); G8_SCHED; G8_LDA(At, At8, 0, 0); G8_STA(G8_SA(1, 1), a1, 1); }
            if constexpr (GATHER) { if (has_next && last) parA ^= 1; }
            G8_WAIT_V(8); G8_WAIT_L(0); G8_BAR; G8_MMA(0, 0, At, At8, B0, B08); G8_MMA(0, 1, At, At8, B1, B18); G8_BAR; G8_SCHED;
            { G8_OFFS(0); G8_LDA(At, At8, 0, 1); G8_STB(G8_SB(0, 0), b2); G8_STB(G8_SB(0, 1), b2 + hstep); G8_STA(G8_SA(0, 0), a2, 0); }
            G8_WAIT_V(8); G8_WAIT_L(0); G8_BAR; G8_MMA(1, 0, At, At8, B0, B08); G8_MMA(1, 1, At, At8, B1, B18); G8_BAR; G8_SCHED;
            { G8_OFFS(1); G8_LDB(B0, B08, 1, 0); G8_LDB(B1, B18, 1, 1); G8_SCHED; G8_LDA(At, At8, 1, 0); G8_STA(G8_SA(0, 1), a2, 1); }
            G8_WAIT_V(8); G8_WAIT_L(0); G8_BAR; G8_MMA(0, 0, At, At8, B0, B08); G8_MMA(0, 1, At, At8, B1, B18); G8_BAR; G8_SCHED;
            { G8_OFFS(0); G8_LDA(At, At8, 1, 1); G8_STB(G8_SB(1, 0), b3); G8_STB(G8_SB(1, 1), b3 + hstep); G8_STA(G8_SA(1, 0), a3, 0); }
            G8_WAIT_V(8); G8_WAIT_L(0); G8_BAR; G8_MMA(1, 0, At, At8, B0, B08); G8_MMA(1, 1, At, At8, B1, B18); G8_BAR; G8_SCHED;
        }
#if defined(TIMEPROBE)
        tp_loop += __builtin_amdgcn_s_memrealtime() - tp_t0;
#endif
        if (wr == 0) G8_BAR;
        E(acc, cur, wr, wc, fr, fq, (const LAS unsigned*)(SIDE + (ui & 1) * 768));
#if defined(EPIREP)
        if constexpr (GATHER) { asm volatile("" ::: "memory"); E(acc, cur, wr, wc, fr, fq, (const LAS unsigned*)(SIDE + (ui & 1) * 768)); }
#endif
        if (!has_next) break;
#pragma unroll
        for (int a = 0; a < 2; ++a)
#pragma unroll
            for (int b = 0; b < 2; ++b)
#pragma unroll
                for (int m = 0; m < 4; ++m)
#pragma unroll
                    for (int n = 0; n < 2; ++n) acc[a][b][m][n] = (f32x4){0.f, 0.f, 0.f, 0.f};
        cur = nxt; cA = nA; cB = nB; ++ui;
        if (wr == 1) G8_BAR;
    }
    G8_WAIT_V(0);
    G8_BAR;
#if defined(TIMEPROBE)
    if constexpr (GATHER) { if (blockIdx.x == 0 && tid == 0) { const unsigned long long tot = __builtin_amdgcn_s_memrealtime() - tp_start, cyc = __builtin_amdgcn_s_memtime() - tp_c0;
        float* dg = (float*)(lds - LDS_BASE + 128);
        (void)dg; S.diag[0] = TIMEPROBE == 5 ? 10.0f * rintf(16.0f * (float)tp_loop / (float)tot) : (TIMEPROBE == 6 ? 10.0f * rintf((float)cyc / (float)tot) : (TIMEPROBE == 7 ? 10.0f * rintf((float)tot / (float)(ui + 1) / 100.0f) : (float)(ui + 1)));     } }
#endif
#undef G8_SA
#undef G8_SB
#undef G8_OFFS
#undef G8_LD2
#undef G8_STB
#undef G8_STA
#undef G8_LDA
#undef G8_LDB
#undef G8_MMA
#undef G8_WAIT_V
#undef G8_WAIT_L
#undef G8_BAR
#undef G8_SCHED
}
}

struct Params {
    const float *x, *c, *ctx, *c_ctx, *w_mod, *b_mod, *norm1_g, *norm2_g, *w_in, *b_in, *conv_a_w, *conv_a_b, *w_rg_r, *b_rg_r, *w_rg_i, *b_rg_i, *rg_lambda,
        *w_pool, *b_pool, *pool_scale, *w_four, *b_four, *conv_d_w, *conv_d_b, *ln_d_g, *ln_d_b, *w_pw, *b_pw, *w_out, *b_out, *w_router, *b_router,
        *w_gu, *b_gu, *w_down, *b_down, *final_norm_g;
    float* out; unsigned char* ws; int ph_lo, ph_hi;
};
typedef const Params __attribute__((address_space(4)))* CP;
__device__ __forceinline__ CP launder_params() { CP k = (CP)__builtin_amdgcn_kernarg_segment_ptr(); asm volatile("" : "+s"(k)); return k; }
__device__ __forceinline__ int row_mb(int row) { return row < TL ? (row >> 12) : 8; }

template <class RowMap>
__device__ __forceinline__ void tr_block(const float* __restrict__ src, int spitch, int k0, int n0, bf16_t* __restrict__ dst, int dpitch, int kd0, RowMap rm, LAS unsigned char* lds) {
    LAS unsigned* T = (LAS unsigned*)lds;
    const int tid = tid_();
    __syncthreads();
#pragma unroll
    for (int it = 0; it < 4; ++it) { const int task = it * 512 + tid, q = task & 63, kp = task >> 6;
        const f32x4 v0 = *(const f32x4*)(src + (size_t)(k0 + 2 * kp) * spitch + n0 + 4 * q), v1 = *(const f32x4*)(src + (size_t)(k0 + 2 * kp + 1) * spitch + n0 + 4 * q);
        u32x4 w; w.x = cvt_pk_bf16(v0[0], v1[0]); w.y = cvt_pk_bf16(v0[1], v1[1]); w.z = cvt_pk_bf16(v0[2], v1[2]); w.w = cvt_pk_bf16(v0[3], v1[3]);
        *(LAS u32x4*)(T + kp * 260 + 4 * q) = w; }
    __syncthreads();
#pragma unroll
    for (int it = 0; it < 4; ++it) { const int n = tid & 255, c = (tid >> 8) * 4 + it;
        u32x4 w; w.x = T[(4 * c + 0) * 260 + n]; w.y = T[(4 * c + 1) * 260 + n]; w.z = T[(4 * c + 2) * 260 + n]; w.w = T[(4 * c + 3) * 260 + n];
        *(u32x4*)(dst + (size_t)rm(n0 + n) * dpitch + kd0 + 8 * c) = w; }
}
template <class RowMap>
__device__ __forceinline__ void tr_block8(const float* __restrict__ src, int spitch, int k0, int n0, unsigned char* __restrict__ dst, int dpitch, int kd0, RowMap rm, LAS unsigned char* lds) {
    LAS unsigned* T = (LAS unsigned*)lds;
    const int tid = tid_();
    __syncthreads();
#pragma unroll
    for (int it = 0; it < 4; ++it) { const int task = it * 512 + tid, q = task & 63, kq = task >> 6; f32x4 v[4];
#pragma unroll
        for (int r = 0; r < 4; ++r) v[r] = *(const f32x4*)(src + (size_t)(k0 + 4 * kq + r) * spitch + n0 + 4 * q) * 64.0f;
        u32x4 w; w.x = pk4_fp8(v[0][0], v[1][0], v[2][0], v[3][0]); w.y = pk4_fp8(v[0][1], v[1][1], v[2][1], v[3][1]); w.z = pk4_fp8(v[0][2], v[1][2], v[2][2], v[3][2]); w.w = pk4_fp8(v[0][3], v[1][3], v[2][3], v[3][3]);
        *(LAS u32x4*)(T + kq * 260 + 4 * q) = w; }
    __syncthreads();
#pragma unroll
    for (int it = 0; it < 4; ++it) { const int n = tid & 255, c = (tid >> 8) * 4 + it;
        u32x4 w; w.x = T[(4 * c + 0) * 260 + n]; w.y = T[(4 * c + 1) * 260 + n]; w.z = T[(4 * c + 2) * 260 + n]; w.w = T[(4 * c + 3) * 260 + n];
        *(u32x4*)(dst + (size_t)rm(n0 + n) * dpitch + kd0 + 16 * c) = w; }
}
struct RmId { int off; __device__ __forceinline__ int operator()(int n) const { return n + off; } };
struct RmGu { __device__ __forceinline__ int operator()(int n) const { const int rem = n & 1023; return 256 * (rem >> 7) + 128 * (n >> 10) + (rem & 127); } };
struct RmIn { __device__ __forceinline__ int operator()(int n) const { return n < 512 ? n : n - 1024 + 768; } };

__device__ __forceinline__ void job_mod(CP p, int l, int cb, LAS unsigned char* lds) {
    LAS float* SC = (LAS float*)lds;
    LAS float* RED = (LAS float*)(lds + 49152);
    const int tid = tid_();
    __syncthreads();
    for (int i = tid; i < 9 * 1024; i += 512) { const int b = i >> 10, k = i & 1023; const float v = b < 8 ? p->c[b * 1024 + k] : p->c_ctx[k]; SC[k * 12 + b] = v * sigmoidf_(v); }
    __syncthreads();
    const int col = cb * 64 + (tid & 63), kg = tid >> 6;
    float acc[9];
#pragma unroll
    for (int b = 0; b < 9; ++b) acc[b] = 0.f;
    const float* wp = p->w_mod + (size_t)l * 1024 * 6144 + col;
#pragma unroll 8
    for (int kk = 0; kk < 128; ++kk) { const int k = kg * 128 + kk; const float w = wp[(size_t)k * 6144];
        const f32x4 s0 = *(const LAS f32x4*)(SC + k * 12), s1 = *(const LAS f32x4*)(SC + k * 12 + 4); const float s8 = SC[k * 12 + 8];
        acc[0] += s0[0] * w; acc[1] += s0[1] * w; acc[2] += s0[2] * w; acc[3] += s0[3] * w; acc[4] += s1[0] * w; acc[5] += s1[1] * w; acc[6] += s1[2] * w; acc[7] += s1[3] * w; acc[8] += s8 * w; }
#pragma unroll
    for (int b = 0; b < 9; ++b) RED[(kg * 9 + b) * 64 + (tid & 63)] = acc[b];
    __syncthreads();
    for (int i = tid; i < 9 * 64; i += 512) { const int b = i >> 6, cc = i & 63; float s = 0.f;
#pragma unroll
        for (int g = 0; g < 8; ++g) s += RED[(g * 9 + b) * 64 + cc];
        ((float*)(p->ws + WS_MODV))[(size_t)(l * 9 + b) * 6144 + cb * 64 + cc] = s + p->b_mod[l * 6144 + cb * 64 + cc]; }
}
__device__ __forceinline__ void job_fold_out(CP p, int l, int nb, LAS unsigned char* lds) {
    LAS float* WO = (LAS float*)lds;
    LAS float* PW = (LAS float*)(lds + 65536);
    const int tid = tid_(), lane = tid & 63, w = __builtin_amdgcn_readfirstlane(tid >> 6);
    __syncthreads();
#pragma unroll
    for (int it = 0; it < 8; ++it) { const int task = it * 512 + tid, j = task >> 4, q = task & 15;
        *(LAS f32x4*)(WO + j * 64 + 4 * q) = *(const f32x4*)(p->w_out + ((size_t)l * 1024 + 768 + j) * 1024 + nb * 64 + 4 * q); }
    float acc[32];
#pragma unroll
    for (int i = 0; i < 32; ++i) acc[i] = 0.f;
    for (int jc = 0; jc < 4; ++jc) {
        __syncthreads();
#pragma unroll
        for (int it = 0; it < 8; ++it) { const int task = it * 512 + tid, i = task & 255, jq = task >> 8;
            const f32x4 v = *(const f32x4*)(p->w_pw + ((size_t)l * 256 + i) * 256 + jc * 64 + 4 * jq);
            PW[(4 * jq + 0) * 256 + i] = v[0]; PW[(4 * jq + 1) * 256 + i] = v[1]; PW[(4 * jq + 2) * 256 + i] = v[2]; PW[(4 * jq + 3) * 256 + i] = v[3]; }
        __syncthreads();
        for (int jj = 0; jj < 64; ++jj) { const float b = WO[(jc * 64 + jj) * 64 + lane];
#pragma unroll
            for (int i4 = 0; i4 < 8; ++i4) { const f32x4 a = *(const LAS f32x4*)(PW + jj * 256 + 32 * w + 4 * i4);
                acc[4 * i4 + 0] += a[0] * b; acc[4 * i4 + 1] += a[1] * b; acc[4 * i4 + 2] += a[2] * b; acc[4 * i4 + 3] += a[3] * b; } }
    }
    bf16_t* dst = (bf16_t*)(p->ws + WS_WOUTT) + ((size_t)l * 1024 + nb * 64 + lane) * 1024 + 768 + 32 * w;
#pragma unroll
    for (int c = 0; c < 4; ++c) { float f[8];
#pragma unroll
        for (int e = 0; e < 8; ++e) f[e] = acc[8 * c + e];
        *(u32x4*)(dst + 8 * c) = pack8(f); }
    if (w == 0) { float s = p->b_out[l * 1024 + nb * 64 + lane];
        for (int j = 0; j < 256; ++j) s += p->b_pw[l * 256 + j] * WO[j * 64 + lane];
        ((float*)(p->ws + WS_BOUT))[l * 1024 + nb * 64 + lane] = s; }
}
__device__ __forceinline__ void job_fold_in(CP p, int l, int f, int g, int kb, LAS unsigned char* lds) {
    LAS float* M = (LAS float*)lds;
    LAS float* WI = (LAS float*)(lds + 16384);
    const int tid = tid_();
    const int cbase = f == 0 ? 512 : 768;
    LAS float* TRG = (LAS float*)(lds + 16384 + 256 * 65 * 4);
    __syncthreads();
    if (tid < 64) TRG[tid] = f == 2 ? sinpif((float)tid * (1.0f / 32.0f)) : cospif((float)tid * (1.0f / 32.0f));
    __syncthreads();
#pragma unroll
    for (int it = 0; it < 8; ++it) { const int id = it * 512 + tid, i = id >> 6, j = id & 63; float s;
        if (f == 0) s = p->w_pool[(((size_t)l * 4 + g) * 64 + i) * 64 + j];
        else { s = 0.f; for (int m = 0; m < 64; ++m) s += TRG[(i * m) & 63] * p->w_four[(((size_t)l * 4 + g) * 64 + m) * 64 + j]; }
        M[i * 64 + j] = s; }
#pragma unroll
    for (int it = 0; it < 8; ++it) { const int task = it * 512 + tid, kk = task >> 4, i4 = task & 15;
        const f32x4 v = *(const f32x4*)(p->w_in + ((size_t)l * 1024 + kb * 256 + kk) * 1536 + cbase + 64 * g + 4 * i4);
        WI[kk * 65 + 4 * i4 + 0] = v[0]; WI[kk * 65 + 4 * i4 + 1] = v[1]; WI[kk * 65 + 4 * i4 + 2] = v[2]; WI[kk * 65 + 4 * i4 + 3] = v[3]; }
    __syncthreads();
    const int kk = tid & 255, jh = tid >> 8;
    float acc[32];
#pragma unroll
    for (int j = 0; j < 32; ++j) acc[j] = 0.f;
    for (int i = 0; i < 64; ++i) { const float a = WI[kk * 65 + i];
#pragma unroll
        for (int j4 = 0; j4 < 8; ++j4) { const f32x4 m = *(const LAS f32x4*)(M + i * 64 + 32 * jh + 4 * j4);
            acc[4 * j4 + 0] += a * m[0]; acc[4 * j4 + 1] += a * m[1]; acc[4 * j4 + 2] += a * m[2]; acc[4 * j4 + 3] += a * m[3]; } }
    bf16_t* dst = f == 0 ? (bf16_t*)(p->ws + WS_WINT) + ((size_t)l * NPROJ + 512 + 64 * g) * 1024 : (bf16_t*)(p->ws + WS_WFT) + ((size_t)l * 512 + (f - 1) * 256 + 64 * g) * 1024;
#pragma unroll
    for (int j = 0; j < 32; ++j) dst[(size_t)(32 * jh + j) * 1024 + kb * 256 + kk] = f2bf(acc[j]);
    if (kb == 0 && f >= 1 && tid < 64) { float s = 0.f;
        for (int i = 0; i < 64; ++i) s += p->b_in[l * 1536 + 768 + 64 * g + i] * M[i * 64 + tid];
        ((float*)(p->ws + WS_BF))[l * 512 + (f - 1) * 256 + 64 * g + tid] = s; }
    if (kb == 0 && f == 0 && g == 0) for (int i = tid; i < NPROJ; i += 512)
        ((float*)(p->ws + WS_BIN))[l * NPROJ + i] = i < 512 ? p->b_in[l * 1536 + i] : (i < 768 ? 0.f : p->b_in[l * 1536 + i - 768 + 1024]);
}
__device__ __forceinline__ void job_small(CP p, int j) {
    const int tid = tid_();
    if (j < 32) {
        const int l = j >> 4, d = (j >> 3) & 1, gate = (j >> 2) & 1, hd = j & 3;
        const float* src = (gate ? p->w_rg_i : p->w_rg_r) + ((size_t)((l * 2 + d) * 4 + hd)) * 4096;
        bf16_t* dst = (bf16_t*)(p->ws + WS_WGT) + (size_t)j * 4096;
        for (int id = tid; id < 4096; id += 512) { const int n = id >> 6, k = id & 63; dst[id] = f2bf(src[k * 64 + n]); }
        return; }
    j -= 32;
    if (j < 2) {
        const int l = j; bf16_t* hi = (bf16_t*)(p->ws + WS_WRT) + (size_t)l * 2 * NE * 1024; bf16_t* lo = hi + NE * 1024;
        for (int id = tid; id < NE * 1024; id += 512) { const int e = id >> 10, c = id & 1023; const float v = p->w_router[((size_t)l * 1024 + c) * NE + e];
            const bf16_t h = f2bf(v); hi[id] = h; lo[id] = f2bf(v - bf2f(h)); }
        return; }
    j -= 2;
    if (j < 144 + 128) {
        const bool sn = j >= 144; const int r0 = (sn ? j - 144 : j) * 16; unsigned* dst = (unsigned*)(p->ws + (sn ? WS_SMAT : WS_CMAT));
        for (int id = tid; id < 16 * 1024; id += 512) { const int k = r0 + (id >> 10), t4 = (id & 1023) * 4; float v[4];
#pragma unroll
            for (int e = 0; e < 4; ++e) { const float ang = (float)((k * (t4 + e)) & 4095) * (1.0f / 2048.0f); v[e] = 64.0f * (sn ? sinpif(ang) : cospif(ang)); }
            dst[((size_t)k * 4096 + t4) >> 2] = pk4_fp8(v[0], v[1], v[2], v[3]); }
        return; }
    j -= 272;
    if (j == 1) {
        float* dst = (float*)(p->ws + WS_POS);
        for (int id = tid; id < 64 * 512; id += 512) { const int pp = id >> 9, jj = id & 511, i = jj & 255; const float a = (float)pp * exp2f(-(float)i * (13.287712379549449f / 256.0f));
            dst[id] = jj < 256 ? sinf(a) : cosf(a); }
        return; }
    {
        unsigned* dst = (unsigned*)(p->ws + WS_DFTC);
        for (int id = tid; id < 256 * 128; id += 512) { const int k = id >> 7, j4 = (id & 127) * 4; float v[4];
#pragma unroll
            for (int e = 0; e < 4; ++e) { const int jj = j4 + e, t = jj & 255; const float ang = (float)((k * t) & 255) * (1.0f / 128.0f); v[e] = 64.0f * (jj < 256 ? cospif(ang) : -sinpif(ang)); }
            dst[id] = pk4_fp8(v[0], v[1], v[2], v[3]); }
    }
}
#ifndef MOE_W_IN_QUEUE
#define MOE_W_IN_QUEUE 0
#endif
constexpr bool fp8_layer(int l) { return l >= FP8_FROM; }
constexpr int J_TGU_L(int l) { return fp8_layer(l) ? 32 * 8 * 8 : 32 * 16 * 8; }
constexpr int J_TD_L(int l) { return fp8_layer(l) ? 32 * 8 * 4 : 32 * 16 * 4; }
constexpr int J_MOD = 192, J_FOUT = 32, J_FIN = 96, J_SMALL = 32 + 2 + 272 + 2, J_TIN = 128, J_TOUT = 96, J_TGU = J_TGU_L(0) + J_TGU_L(1), J_TD = J_TD_L(0) + J_TD_L(1);
static_assert(!MOE_W_IN_QUEUE || (J_TGU_L(0) + J_TD_L(0) <= 6 * NCHUNK && J_TGU_L(1) + J_TD_L(1) <= 6 * NCHUNK), "the phase-3 queue interleaves at most 2 weight jobs per compute unit: needs fp8 expert weights in both layers");
constexpr int J_TOTAL = J_MOD + J_FOUT + J_FIN + J_SMALL + J_TIN + J_TOUT + (MOE_W_IN_QUEUE ? 0 : J_TGU + J_TD);
template <class RowMap>
__device__ __forceinline__ void tr8_slab(const float* __restrict__ src, int spitch, int k0, int n4, unsigned char* __restrict__ dst, int dpitch, RowMap rm) {
    f32x4 v[16];
#pragma unroll
    for (int r = 0; r < 16; ++r) v[r] = *(const f32x4*)(src + (size_t)(k0 + r) * spitch + n4) * 64.0f;
#pragma unroll
    for (int j = 0; j < 4; ++j) { u32x4 w; w.x = pk4_fp8(v[0][j], v[1][j], v[2][j], v[3][j]); w.y = pk4_fp8(v[4][j], v[5][j], v[6][j], v[7][j]); w.z = pk4_fp8(v[8][j], v[9][j], v[10][j], v[11][j]); w.w = pk4_fp8(v[12][j], v[13][j], v[14][j], v[15][j]);
        *(u32x4*)(dst + (size_t)rm(n4 + j) * dpitch + k0) = w; }
}
struct W8Job { const float* src; unsigned char* dst; int spitch, gu; };
__device__ __forceinline__ bool w8_job(CP p, int jm, W8Job& J, int& n0) {
    constexpr int PER_L = 32 * 64 + 32 * 32; if (jm >= 2 * PER_L) return false;
    const int l = jm / PER_L; int jj = jm - l * PER_L;
    if (jj < 32 * 64) { const int e = jj >> 6, r = jj & 63, kb = r >> 3, q = r & 7; J.spitch = 2048; J.gu = 1; n0 = q * 256;
        J.src = p->w_gu + ((size_t)(l * NE + e) * 1024 + kb * 128) * 2048 + n0; J.dst = p->ws + WS_WGUT + (size_t)l * NE * 2048 * 2048 + (size_t)e * 2048 * 1024 + kb * 128; }
    else { jj -= 32 * 64; const int e = jj >> 5, r = jj & 31, kb = r >> 2, q = r & 3; J.spitch = 1024; J.gu = 0; n0 = q * 256;
        J.src = p->w_down + ((size_t)(l * NE + e) * 1024 + kb * 128) * 1024 + n0; J.dst = p->ws + WS_WDT + (size_t)l * NE * 1024 * 2048 + (size_t)e * 1024 * 1024 + kb * 128; }
    return true;
}
__device__ __forceinline__ void w8_load(const W8Job& J, int tid, f32x4 (&v)[4][4]) {
#pragma unroll
    for (int it = 0; it < 4; ++it) { const int task = it * 512 + tid, q = task & 63, kq = task >> 6;
#pragma unroll
        for (int r = 0; r < 4; ++r) v[it][r] = *(const f32x4*)(J.src + (size_t)(4 * kq + r) * J.spitch + 4 * q); }
}
__device__ __forceinline__ void w8_finish(const W8Job& J, int n0, int tid, const f32x4 (&v)[4][4], LAS unsigned char* lds) {
    LAS unsigned* T = (LAS unsigned*)lds;
    __syncthreads();
#pragma unroll
    for (int it = 0; it < 4; ++it) { const int task = it * 512 + tid, q = task & 63, kq = task >> 6;
        u32x4 w; w.x = pk4_fp8(v[it][0][0] * 64.f, v[it][1][0] * 64.f, v[it][2][0] * 64.f, v[it][3][0] * 64.f); w.y = pk4_fp8(v[it][0][1] * 64.f, v[it][1][1] * 64.f, v[it][2][1] * 64.f, v[it][3][1] * 64.f);
        w.z = pk4_fp8(v[it][0][2] * 64.f, v[it][1][2] * 64.f, v[it][2][2] * 64.f, v[it][3][2] * 64.f); w.w = pk4_fp8(v[it][0][3] * 64.f, v[it][1][3] * 64.f, v[it][2][3] * 64.f, v[it][3][3] * 64.f);
        *(LAS u32x4*)(T + kq * 260 + 4 * q) = w; }
    __syncthreads();
    if (tid < 256) {
        const int n = tid, nn = n0 + n; const int row = J.gu ? RmGu{}(nn) : nn; u32x4 w[8];
#pragma unroll
        for (int c = 0; c < 8; ++c) { w[c].x = T[(4 * c + 0) * 260 + n]; w[c].y = T[(4 * c + 1) * 260 + n]; w[c].z = T[(4 * c + 2) * 260 + n]; w[c].w = T[(4 * c + 3) * 260 + n]; }
#pragma unroll
        for (int c = 0; c < 8; ++c) *(u32x4*)(J.dst + (size_t)row * 1024 + 16 * c) = w[c]; }
}
__device__ __forceinline__ void moe_weight_job(CP p, int l, int jj, LAS unsigned char* lds) {
    const bool f8 = l >= FP8_FROM;
    if (jj < (f8 ? 32 * 8 * 8 : 32 * 16 * 8)) { const float* src = p->w_gu + (size_t)l * NE * 1024 * 2048; unsigned char* dstb = p->ws + WS_WGUT + (size_t)l * NE * 2048 * 2048;
        if (f8) { const int e = jj >> 6, r = jj & 63, kb = r >> 3, q = r & 7; tr_block8(src + (size_t)e * 1024 * 2048, 2048, kb * 128, q * 256, dstb + (size_t)e * 2048 * 1024, 1024, kb * 128, RmGu{}, lds); }
        else { const int e = jj >> 7, r = jj & 127, kb = r >> 3, q = r & 7; tr_block(src + (size_t)e * 1024 * 2048, 2048, kb * 64, q * 256, (bf16_t*)dstb + (size_t)e * 2048 * 1024, 1024, kb * 64, RmGu{}, lds); }
        return; }
    jj -= (f8 ? 32 * 8 * 8 : 32 * 16 * 8);
    { const float* src = p->w_down + (size_t)l * NE * 1024 * 1024; unsigned char* dstb = p->ws + WS_WDT + (size_t)l * NE * 1024 * 2048;
        if (f8) { const int e = jj >> 5, r = jj & 31, kb = r >> 2, q = r & 3; tr_block8(src + (size_t)e * 1024 * 1024, 1024, kb * 128, q * 256, dstb + (size_t)e * 1024 * 1024, 1024, kb * 128, RmId{0}, lds); }
        else { const int e = jj >> 6, r = jj & 63, kb = r >> 2, q = r & 3; tr_block(src + (size_t)e * 1024 * 1024, 1024, kb * 64, q * 256, (bf16_t*)dstb + (size_t)e * 1024 * 1024, 1024, kb * 64, RmId{0}, lds); } }
}
constexpr bool W8_PIPE = (FP8_FROM == 0) && !MOE_W_IN_QUEUE;
#ifndef PRO_PART
#define PRO_PART 0
#endif
__device__ __forceinline__ int q_pull(unsigned* head, LAS int* slot) {
    __syncthreads(); if (tid_() == 0) *slot = (int)__hip_atomic_fetch_add(head, 1u, __ATOMIC_RELAXED, __HIP_MEMORY_SCOPE_AGENT); __syncthreads();
    return __builtin_amdgcn_readfirstlane(*slot);
}
__device__ __forceinline__ void phase_prologue(CP p, LAS unsigned char* lds, int rep) {
    unsigned* qs = (unsigned*)(p->ws + WS_CTL) + CW_QUEUE + (4 + rep) * 64; unsigned* qw = (unsigned*)(p->ws + WS_CTL) + CW_QUEUE + (6 + rep) * 64; LAS int* qslot = (LAS int*)(lds - LDS_BASE + 64);
    const int njobs = (rep && PRO_PART == 1) ? 0 : J_TOTAL - (W8_PIPE ? J_TGU + J_TD : 0);
    if (!W8_PIPE || (blockIdx.x & 1) == 0) for (;;) {
        int j = q_pull(qs, qslot); if (j >= njobs) break;
        if (j < J_FIN) { const int l = j / 48, r = j % 48; job_fold_in(p, l, r / 16, (r >> 2) & 3, r & 3, lds); continue; } j -= J_FIN;
        if (j < J_FOUT) { job_fold_out(p, j >> 4, j & 15, lds); continue; } j -= J_FOUT;
        if (j < J_MOD) { job_mod(p, j / 96, j % 96, lds); continue; } j -= J_MOD;
        if (j < J_SMALL) { job_small(p, j); continue; } j -= J_SMALL;
        if (j < J_TIN) { const int l = j >> 6, r = j & 63, kb = r >> 2, q = r & 3;
            tr_block(p->w_in + (size_t)l * 1024 * 1536, 1536, kb * 64, q < 2 ? q * 256 : 1024 + (q - 2) * 256, (bf16_t*)(p->ws + WS_WINT) + (size_t)l * NPROJ * 1024, 1024, kb * 64, RmIn{}, lds); continue; } j -= J_TIN;
        if (j < J_TOUT) { const int l = j / 48, r = j % 48, kb = r >> 2, q = r & 3;
            tr_block(p->w_out + (size_t)l * 1024 * 1024, 1024, kb * 64, q * 256, (bf16_t*)(p->ws + WS_WOUTT) + (size_t)l * 1024 * 1024, 1024, kb * 64, RmId{0}, lds); continue; } j -= J_TOUT;
        moe_weight_job(p, j < J_TGU_L(0) + J_TD_L(0) ? 0 : 1, j < J_TGU_L(0) + J_TD_L(0) ? j : j - J_TGU_L(0) - J_TD_L(0), lds);
    }
    if (W8_PIPE && !(rep && PRO_PART == 2)) { const int tid = tid_(); W8Job Jc, Jn; int nc = 0, nn_ = 0; f32x4 va[4][4], vb[4][4];
        bool okc = w8_job(p, q_pull(qw, qslot), Jc, nc); if (okc) w8_load(Jc, tid, va);
        while (okc) {
            const bool okn = w8_job(p, q_pull(qw, qslot), Jn, nn_); if (okn) w8_load(Jn, tid, vb);
            w8_finish(Jc, nc, tid, va, lds);
            if (!okn) break;
            okc = w8_job(p, q_pull(qw, qslot), Jc, nc); if (okc) w8_load(Jc, tid, va);
            w8_finish(Jn, nn_, tid, vb, lds); } }
}

__device__ __forceinline__ void phase_norm(CP p, int mode) {
    const int tid = tid_(), lane = tid & 63, wid = tid >> 6;
    bf16_t* X = (bf16_t*)(p->ws + WS_X); bf16_t* U = (bf16_t*)(p->ws + WS_U); const bf16_t* YS = (const bf16_t*)(p->ws + WS_YS); const float* modv = (const float*)(p->ws + WS_MODV);
    const float* POS = (const float*)(p->ws + WS_POS);
    const int nrows = mode == 2 ? TL : TT;
    const int lprev = mode == 2 ? 1 : 0, lcur = mode == 0 ? 0 : 1;
    const int nw = (int)gridDim.x * 8;
    for (int rowa = blockIdx.x * 8 + wid; rowa < nrows; rowa += 2 * nw) {
        int rows[2]; bool ok[2]; f32x4 v[2][4];
#pragma unroll
        for (int rb = 0; rb < 2; ++rb) { const int r = rowa + rb * nw; ok[rb] = r < nrows; rows[rb] = ok[rb] ? r : rowa; }
        if (mode == 0) {
#pragma unroll
            for (int rb = 0; rb < 2; ++rb) { const int row = rows[rb]; const float* src = row < TL ? p->x + (size_t)row * D : p->ctx + (size_t)(row - TL) * D;
#pragma unroll
                for (int j = 0; j < 4; ++j) v[rb][j] = __builtin_nontemporal_load((const f32x4*)(src + 256 * j + 4 * lane)); }
#pragma unroll
            for (int rb = 0; rb < 2; ++rb) { const int row = rows[rb]; if (row < TL) { const int t = row & 4095;
#pragma unroll
                    for (int j = 0; j < 4; ++j) v[rb][j] += *(const f32x4*)(POS + (size_t)(j < 2 ? (t >> 6) : (t & 63)) * 512 + (j & 1) * 256 + 4 * lane); } }
        } else {
            unsigned ys[2][4][4]; u32x2 y2[2][4]; const bf16_t* Y2 = (const bf16_t*)(p->ws + WS_PROJ);
#pragma unroll
            for (int rb = 0; rb < 2; ++rb) { const int row = rows[rb];
#pragma unroll
                for (int j = 0; j < 4; ++j) { v[rb][j] = ld4bf(X + (size_t)row * D + 256 * j + 4 * lane); y2[rb][j] = __builtin_nontemporal_load((const u32x2*)(Y2 + (size_t)row * D + 256 * j + 4 * lane));
#pragma unroll
                    for (int k = 0; k < 4; ++k) ys[rb][j][k] = __builtin_nontemporal_load((const unsigned*)((const unsigned char*)YS + ((size_t)row * 4 + k) * D + 256 * j + 4 * lane)); } }
#pragma unroll
            for (int rb = 0; rb < 2; ++rb) { const float* g2 = modv + (size_t)(lprev * 9 + row_mb(rows[rb])) * 6144 + 5120;
#pragma unroll
                for (int j = 0; j < 4; ++j) { f32x4 s = {0.f, 0.f, 0.f, 0.f};
#pragma unroll
                    for (int k = 0; k < 4; ++k) { const int w = (int)ys[rb][j][k]; const f32x2 lo = __builtin_amdgcn_cvt_pk_f32_fp8(w, false), hi = __builtin_amdgcn_cvt_pk_f32_fp8(w, true); s[0] += lo.x; s[1] += lo.y; s[2] += hi.x; s[3] += hi.y; }
                    v[rb][j] += (f32x4){bflo(y2[rb][j].x), bfhi(y2[rb][j].x), bflo(y2[rb][j].y), bfhi(y2[rb][j].y)} + *(const f32x4*)(g2 + 256 * j + 4 * lane) * (s * (1.0f / 16.0f)); } }
        }
        float ss[2];
#pragma unroll
        for (int rb = 0; rb < 2; ++rb) { ss[rb] = 0.f;
#pragma unroll
            for (int j = 0; j < 4; ++j) ss[rb] += v[rb][j][0] * v[rb][j][0] + v[rb][j][1] * v[rb][j][1] + v[rb][j][2] * v[rb][j][2] + v[rb][j][3] * v[rb][j][3]; }
#pragma unroll
        for (int o = 32; o >= 1; o >>= 1) { const float t0 = bperm(ss[0], lane ^ o), t1 = bperm(ss[1], lane ^ o); ss[0] += t0; ss[1] += t1; }
#pragma unroll
        for (int rb = 0; rb < 2; ++rb) { if (!ok[rb]) continue; const int row = rows[rb]; const float rstd = __builtin_amdgcn_rsqf(ss[rb] * (1.0f / 1024.0f) + 1e-6f);
            if (mode == 2) {
#pragma unroll
                for (int j = 0; j < 4; ++j) __builtin_nontemporal_store(v[rb][j] * rstd * *(const f32x4*)(p->final_norm_g + 256 * j + 4 * lane), (f32x4*)(p->out + (size_t)row * D + 256 * j + 4 * lane));
            } else { const float* mv = modv + (size_t)(lcur * 9 + row_mb(row)) * 6144;
#pragma unroll
                for (int j = 0; j < 4; ++j) { const int col = 256 * j + 4 * lane;
                    st4bf(X + (size_t)row * D + col, v[rb][j]);
                    const f32x4 g = *(const f32x4*)(p->norm1_g + lcur * D + col), sc = *(const f32x4*)(mv + 1024 + col), sh = *(const f32x4*)(mv + col);
                    const f32x4 u = v[rb][j] * rstd * g * (sc + 1.0f) + sh;
                    u32x2 w; w.x = cvt_pk_bf16(u[0], u[1]); w.y = cvt_pk_bf16(u[2], u[3]); *(u32x2*)(U + (size_t)row * D + col) = w; } }
        }
    }
}

constexpr int HP = 2064;
__device__ __forceinline__ void phase_router(CP p, int l, LAS unsigned char* lds, int rep) {
    LAS unsigned char* HHI = lds; LAS unsigned char* HLO = lds + 32 * HP;
    LAS float* LG = (LAS float*)(lds + 64 * HP);
    LAS int* hist = (LAS int*)(lds + 64 * HP + 8448); LAS int* basee = hist + 32;
    const int tid = tid_(), lane = tid & 63, wid = __builtin_amdgcn_readfirstlane(tid >> 6), fr = lane & 15, fq = lane >> 4;
    const bf16_t* X = (const bf16_t*)(p->ws + WS_X); const bf16_t* Y2 = (const bf16_t*)(p->ws + WS_PROJ);
    bf16_t* U = (bf16_t*)(p->ws + (rep ? WS_ACT + (size_t)TT * D * 4 : WS_U)); const float* modv = (const float*)(p->ws + WS_MODV);
    unsigned char* U8 = p->ws + (rep ? WS_ACT + (size_t)TT * D * 4 : WS_U8);
    unsigned* ctl = (unsigned*)(p->ws + WS_CTL) + (rep ? 4096 : 0); int* rasg = (int*)(p->ws + (rep ? WS_YS : WS_RASG)); float* rgate = (float*)(p->ws + (rep ? WS_YS + (size_t)NE * TT * 4 : WS_RGATE)); unsigned* rroff = (unsigned*)(p->ws + (rep ? WS_YS + (size_t)2 * NE * TT * 4 : WS_RROFF));
    const bf16_t* wrt = (const bf16_t*)(p->ws + WS_WRT) + (size_t)l * 2 * NE * 1024;
    const int ntiles = (l == 0 ? TT : TL) / 32;
    bf16x8 Bh[16], Bl[16];
    { const int ntl = (wid >> 1) & 1, kh = wid >> 2; const bf16_t* bh = wrt + (size_t)(16 * ntl + fr) * 1024 + kh * 512 + 8 * fq;
#pragma unroll
      for (int s_ = 0; s_ < 16; ++s_) { Bh[s_] = *(const bf16x8*)(bh + s_ * 32); Bl[s_] = *(const bf16x8*)(bh + NE * 1024 + s_ * 32); } }
    for (int tile = blockIdx.x; tile < ntiles; tile += gridDim.x) {
        const int row0 = tile * 32, mb = row_mb(row0);
        const float* mv = modv + (size_t)(l * 9 + mb) * 6144;
        __syncthreads();
        if (tid < 32) hist[tid] = 0;
        for (int rg = 0; rg < 2; ++rg) { f32x4 v[2][4]; u32x2 y2[2][4]; float ss[2];
#pragma unroll
          for (int rr = 0; rr < 2; ++rr)
#pragma unroll
              for (int j = 0; j < 4; ++j) { const size_t o = (size_t)(row0 + wid * 4 + 2 * rg + rr) * D + 256 * j + 4 * lane; v[rr][j] = ld4bf(X + o); y2[rr][j] = __builtin_nontemporal_load((const u32x2*)(Y2 + o)); }
#pragma unroll
          for (int rr = 0; rr < 2; ++rr) { ss[rr] = 0.f;
#pragma unroll
              for (int j = 0; j < 4; ++j) { v[rr][j] += (f32x4){bflo(y2[rr][j].x), bfhi(y2[rr][j].x), bflo(y2[rr][j].y), bfhi(y2[rr][j].y)};
                  ss[rr] += v[rr][j][0] * v[rr][j][0] + v[rr][j][1] * v[rr][j][1] + v[rr][j][2] * v[rr][j][2] + v[rr][j][3] * v[rr][j][3]; } }
#pragma unroll
          for (int o = 32; o >= 1; o >>= 1) { const float t0_ = bperm(ss[0], lane ^ o), t1_ = bperm(ss[1], lane ^ o); ss[0] += t0_; ss[1] += t1_; }
#pragma unroll
          for (int j = 0; j < 4; ++j) { const int col = 256 * j + 4 * lane;
              const f32x4 g = *(const f32x4*)(p->norm2_g + l * D + col), sc = *(const f32x4*)(mv + 4096 + col), sh = *(const f32x4*)(mv + 3072 + col);
#pragma unroll
              for (int rr = 0; rr < 2; ++rr) { const int r = wid * 4 + 2 * rg + rr; const float rstd = __builtin_amdgcn_rsqf(ss[rr] * (1.0f / 1024.0f) + 1e-6f);
                  const f32x4 h = v[rr][j] * rstd * g * (sc + 1.0f) + sh;
                  u32x2 w; w.x = cvt_pk_bf16(h[0], h[1]); w.y = cvt_pk_bf16(h[2], h[3]);
                  if (fp8_layer(l)) *(unsigned*)(U8 + (size_t)(row0 + r) * D + col) = pk4_fp8(h[0], h[1], h[2], h[3]); else *(u32x2*)(U + (size_t)(row0 + r) * D + col) = w;
                  u32x2 wl; wl.x = cvt_pk_bf16(h[0] - bflo(w.x), h[1] - bfhi(w.x)); wl.y = cvt_pk_bf16(h[2] - bflo(w.y), h[3] - bfhi(w.y));
                  *(LAS u32x2*)(HHI + r * HP + col * 2) = w; *(LAS u32x2*)(HLO + r * HP + col * 2) = wl; } } }
        __syncthreads();
        { const int mt = wid & 1, ntl = (wid >> 1) & 1, kh = wid >> 2;
          f32x4 acc = {0.f, 0.f, 0.f, 0.f};
          const LAS unsigned char* ah = HHI + (16 * mt + fr) * HP + (kh * 512 + 8 * fq) * 2; const LAS unsigned char* al = HLO + (16 * mt + fr) * HP + (kh * 512 + 8 * fq) * 2;
#pragma unroll
          for (int s_ = 0; s_ < 16; ++s_) { const bf16x8 Ah = *(const LAS bf16x8*)(ah + s_ * 64), Al = *(const LAS bf16x8*)(al + s_ * 64);
              acc = __builtin_amdgcn_mfma_f32_16x16x32_bf16(Ah, Bh[s_], acc, 0, 0, 0); acc = __builtin_amdgcn_mfma_f32_16x16x32_bf16(Ah, Bl[s_], acc, 0, 0, 0); acc = __builtin_amdgcn_mfma_f32_16x16x32_bf16(Al, Bh[s_], acc, 0, 0, 0); }
#pragma unroll
          for (int j = 0; j < 4; ++j) LG[(kh * 32 + 16 * mt + 4 * fq + j) * 33 + 16 * ntl + fr] = acc[j]; }
        __syncthreads();
        int ek[4] = {0, 0, 0, 0}, rk[4] = {0, 0, 0, 0}; float gk[4] = {0.f, 0.f, 0.f, 0.f};
        if (tid < 32) { float lg[32];
#pragma unroll
            for (int e = 0; e < 32; ++e) lg[e] = LG[tid * 33 + e] + LG[(32 + tid) * 33 + e] + p->b_router[l * NE + e];
            float vk[4];
#pragma unroll
            for (int k = 0; k < 4; ++k) { float best = -3.0e38f; int bi = 0;
#pragma unroll
                for (int e = 0; e < 32; ++e) if (lg[e] > best) { best = lg[e]; bi = e; }
                vk[k] = best; ek[k] = bi;
#pragma unroll
                for (int e = 0; e < 32; ++e) if (e == bi) lg[e] = -3.0e38f; }
            float sum = 0.f;
#pragma unroll
            for (int k = 0; k < 4; ++k) { gk[k] = fexp2(1.4426950408889634f * (vk[k] - vk[0])); sum += gk[k]; }
            const float inv = 1.0f / sum;
#pragma unroll
            for (int k = 0; k < 4; ++k) { gk[k] *= inv; rk[k] = __hip_atomic_fetch_add(hist + ek[k], 1, __ATOMIC_RELAXED, __HIP_MEMORY_SCOPE_WORKGROUP); } }
        __syncthreads();
        if (tid < 32) { const int h = hist[tid]; basee[tid] = h ? (int)__hip_atomic_fetch_add(ctl + CW_COUNT + (l * NE + tid) * 64, (unsigned)h, __ATOMIC_RELAXED, __HIP_MEMORY_SCOPE_AGENT) : 0; }
        __syncthreads();
        if (tid < 32) { const int tok = row0 + tid;
#pragma unroll
            for (int k = 0; k < 4; ++k) { const size_t pos = (size_t)ek[k] * TT + basee[ek[k]] + rk[k]; rasg[pos] = tok * 4 + k; rgate[pos] = gk[k]; rroff[pos] = (unsigned)tok * (fp8_layer(l) ? 1024u : 2048u); } }
    }
}

constexpr int XCP = 144;
constexpr int XAP = 528;
struct Seq { int b, jc, L, rowbase, t0; bool lat; };
__device__ __forceinline__ Seq seq_of(int q) { Seq s; s.lat = q < 512; s.b = s.lat ? q >> 6 : (q - 512) >> 2; s.jc = s.lat ? q & 63 : (q - 512) & 3; s.L = s.lat ? SEQ : LCX; s.rowbase = s.lat ? s.b * SEQ : TL + s.b * LCX; s.t0 = s.jc * 64; return s; }
template <int PASS>
__device__ __forceinline__ void scan_unit(CP p, int l, int q, LAS unsigned char* lds) {
    const int tid = tid_(), lane = tid & 63, wid = __builtin_amdgcn_readfirstlane(tid >> 6), d = wid >> 2, hd = wid & 3, fr = lane & 15, fq = lane >> 4;
    LAS unsigned char* XC = lds + wid * (64 * XCP);
    LAS float* CAR = (LAS float*)(lds + 8 * 64 * XCP + wid * 256);
    LAS unsigned char* HB = lds + 8 * 64 * XCP + 2048;
    LAS unsigned char* XA = HB;
    const bf16_t* PROJ = (const bf16_t*)(p->ws + WS_PROJ); float* SUMM = (float*)(p->ws + WS_SUMM);
    const Seq sq = seq_of(q); const int b = sq.b, jc = sq.jc, L = sq.L, rowbase = sq.rowbase, t0 = sq.t0; const bool lat = sq.lat;
    __syncthreads();
    { u32x4 w[5];
#pragma unroll
      for (int it = 0; it < 5; ++it) { const int task = it * 512 + tid, r = task >> 5, cg = task & 31, tt = t0 - 3 + r; w[it] = (u32x4){0u, 0u, 0u, 0u};
          if (task < 70 * 32 && tt >= 0 && tt < L) w[it] = *(const u32x4*)(PROJ + (size_t)(rowbase + tt) * NPROJ + 8 * cg); }
#pragma unroll
      for (int it = 0; it < 5; ++it) { const int task = it * 512 + tid, r = task >> 5, cg = task & 31; if (task < 70 * 32) *(LAS u32x4*)(XA + r * XAP + cg * 16) = w[it]; } }
    bf16x8 Bra[4][2], Bia[4][2];
    { const bf16_t* wg0 = (const bf16_t*)(p->ws + WS_WGT) + (size_t)((l * 2 + d) * 2) * 4 * 4096;
#pragma unroll
      for (int n = 0; n < 4; ++n)
#pragma unroll
          for (int s = 0; s < 2; ++s) { Bra[n][s] = *(const bf16x8*)(wg0 + ((size_t)(0 * 4 + hd) * 64 + 16 * n + fr) * 64 + 32 * s + 8 * fq); Bia[n][s] = *(const bf16x8*)(wg0 + ((size_t)(1 * 4 + hd) * 64 + 16 * n + fr) * 64 + 32 * s + 8 * fq); } }
    float car = 0.f;
    if (PASS == 2) { const int c = 64 * hd + lane;
        const int n = d == 0 ? (lat ? 4 + jc : jc) : (lat ? 4 + 63 - jc : 3 - jc);
        for (int s0 = 0; s0 < n; s0 += 16) { float A_[16], H_[16];
#pragma unroll
            for (int e = 0; e < 16; ++e) { const int s = s0 + e; int qq;
                if (d == 0) qq = (lat && s >= 4) ? b * 64 + (s - 4) : 512 + b * 4 + s; else qq = (lat && s >= 4) ? b * 64 + 63 - (s - 4) : 512 + b * 4 + 3 - s;
                A_[e] = 1.f; H_[e] = 0.f; if (s < n) { const float* sp_ = SUMM + ((size_t)qq * 2 + d) * 512; A_[e] = sp_[c]; H_[e] = sp_[256 + c]; } }
#pragma unroll
            for (int e = 0; e < 16; ++e) car = A_[e] * car + H_[e]; } }
    __syncthreads();
    { const int c = 64 * hd + lane; const float* cw = p->conv_a_w + ((size_t)(l * 2 + d) * 4) * 256 + c;
      const float w0 = cw[0], w1 = cw[256], w2 = cw[512], w3 = cw[768], cb = p->conv_a_b[(l * 2 + d) * 256 + c];
      const float k0 = d ? w3 : w0, k1 = d ? w2 : w1, k2 = d ? w1 : w2, k3 = d ? w0 : w3;
      const LAS unsigned char* xp = XA + (d ? 3 : 0) * XAP + c * 2;
      float xa_ = bf2f(*(const LAS bf16_t*)(xp)), xb_ = bf2f(*(const LAS bf16_t*)(xp + XAP)), xc_ = bf2f(*(const LAS bf16_t*)(xp + 2 * XAP));
#pragma unroll 16
      for (int t = 0; t < 64; ++t) { const float xd_ = bf2f(*(const LAS bf16_t*)(xp + (t + 3) * XAP)); const float v = k0 * xa_ + k1 * xb_ + k2 * xc_ + k3 * xd_ + cb;
          *(LAS bf16_t*)(XC + t * XCP + lane * 2) = f2bf(v); xa_ = xb_; xb_ = xc_; xc_ = xd_; } }
    if (PASS == 2) CAR[lane] = car;
    asm volatile("" ::: "memory");
    if (PASS == 2) __syncthreads();
    float cr[4], at[4], sp[4], brr[4], bii[4];
#pragma unroll
    for (int n = 0; n < 4; ++n) { const int ch = 16 * n + fr; cr[n] = PASS == 2 ? CAR[ch] : 0.f; at[n] = 1.f;
        const float lam = p->rg_lambda[(l * 2 + d) * 256 + 64 * hd + ch]; sp[n] = -8.0f * 1.4426950408889634f * log1pf(__expf(-lam));
        brr[n] = p->b_rg_r[((l * 2 + d) * 4 + hd) * 64 + ch]; bii[n] = p->b_rg_i[((l * 2 + d) * 4 + hd) * 64 + ch]; }
    const bf16_t* wg = (const bf16_t*)(p->ws + WS_WGT) + (size_t)((l * 2 + d) * 2) * 4 * 4096;
    u32x4* ABo = (u32x4*)(p->ws + WS_AB) + ((size_t)q * 8 + wid) * 16 * 64 + lane;
    const int src1 = d ? lane + 16 : lane - 16, src2 = d ? lane + 32 : lane - 32, srct = d ? fr : 48 + fr;
    const bool has1 = d ? fq <= 2 : fq >= 1, has2 = d ? fq <= 1 : fq >= 2;
#pragma unroll
    for (int n = 0; n < 4; ++n) {
        const bf16x8 (&Br)[2] = Bra[n]; const bf16x8 (&Bi)[2] = Bia[n];
        float Hj[4][4], Aj[4][4];
#pragma unroll
        for (int mt = 0; mt < 4; ++mt) {
            const bf16x8 A0 = *(const LAS bf16x8*)(XC + (16 * mt + fr) * XCP + (8 * fq) * 2), A1 = *(const LAS bf16x8*)(XC + (16 * mt + fr) * XCP + (32 + 8 * fq) * 2);
            f32x4 ar = {0.f, 0.f, 0.f, 0.f}, ai = {0.f, 0.f, 0.f, 0.f};
            ar = __builtin_amdgcn_mfma_f32_16x16x32_bf16(A0, Br[0], ar, 0, 0, 0); ar = __builtin_amdgcn_mfma_f32_16x16x32_bf16(A1, Br[1], ar, 0, 0, 0);
            ai = __builtin_amdgcn_mfma_f32_16x16x32_bf16(A0, Bi[0], ai, 0, 0, 0); ai = __builtin_amdgcn_mfma_f32_16x16x32_bf16(A1, Bi[1], ai, 0, 0, 0);
            float a_[4], b_[4], la_[4];
#pragma unroll
            for (int j = 0; j < 4; ++j) { const float r = sigmoidf_(ar[j] + brr[n]); la_[j] = r * sp[n]; }
            u32x4 w; w.x = cvt_pk_bf16(la_[0], la_[1]); w.y = cvt_pk_bf16(la_[2], la_[3]);
            la_[0] = bflo(w.x); la_[1] = bfhi(w.x); la_[2] = bflo(w.y); la_[3] = bfhi(w.y);
#pragma unroll
            for (int j = 0; j < 4; ++j) { const int tok = 16 * mt + 4 * fq + j; const float xcv = bf2f(*(const LAS bf16_t*)(XC + tok * XCP + (16 * n + fr) * 2));
                const float ig = sigmoidf_(ai[j] + bii[n]); const float a = fexp2(la_[j]);
                a_[j] = a; b_[j] = __builtin_amdgcn_sqrtf(fmaxf(1.0f - a * a, 0.f)) * (ig * xcv); }
            w.z = cvt_pk_bf16(b_[0], b_[1]); w.w = cvt_pk_bf16(b_[2], b_[3]);
            b_[0] = bflo(w.z); b_[1] = bfhi(w.z); b_[2] = bflo(w.w); b_[3] = bfhi(w.w);
            __builtin_nontemporal_store(w, ABo + (size_t)((n * 4 + mt) * 64));
            if (d == 0) { Hj[mt][0] = b_[0]; Aj[mt][0] = a_[0];
#pragma unroll
                for (int j = 1; j < 4; ++j) { Hj[mt][j] = a_[j] * Hj[mt][j - 1] + b_[j]; Aj[mt][j] = a_[j] * Aj[mt][j - 1]; } }
            else { Hj[mt][3] = b_[3]; Aj[mt][3] = a_[3];
#pragma unroll
                for (int j = 2; j >= 0; --j) { Hj[mt][j] = a_[j] * Hj[mt][j + 1] + b_[j]; Aj[mt][j] = a_[j] * Aj[mt][j + 1]; } }
        }
        float iA[4], iH[4], eA[4], eH[4], tA[4], tH[4];
#pragma unroll
        for (int mt = 0; mt < 4; ++mt) { iA[mt] = d ? Aj[mt][0] : Aj[mt][3]; iH[mt] = d ? Hj[mt][0] : Hj[mt][3]; }
        { float pA[4], pH[4];
#pragma unroll
          for (int mt = 0; mt < 4; ++mt) { pA[mt] = bperm(iA[mt], src1); pH[mt] = bperm(iH[mt], src1); }
#pragma unroll
          for (int mt = 0; mt < 4; ++mt) if (has1) { iH[mt] = iA[mt] * pH[mt] + iH[mt]; iA[mt] = iA[mt] * pA[mt]; }
#pragma unroll
          for (int mt = 0; mt < 4; ++mt) { pA[mt] = bperm(iA[mt], src2); pH[mt] = bperm(iH[mt], src2); }
#pragma unroll
          for (int mt = 0; mt < 4; ++mt) if (has2) { iH[mt] = iA[mt] * pH[mt] + iH[mt]; iA[mt] = iA[mt] * pA[mt]; } }
#pragma unroll
        for (int mt = 0; mt < 4; ++mt) { eA[mt] = bperm(iA[mt], src1); eH[mt] = bperm(iH[mt], src1); tA[mt] = bperm(iA[mt], srct); tH[mt] = bperm(iH[mt], srct); if (!has1) { eA[mt] = 1.f; eH[mt] = 0.f; } }
#pragma unroll
        for (int mi = 0; mi < 4; ++mi) { const int mt = d ? 3 - mi : mi;
            const float hin = eH[mt] + eA[mt] * cr[n];
            if (PASS == 2) {
#pragma unroll
                for (int j = 0; j < 4; ++j) { const int tok = 16 * mt + 4 * fq + j; *(LAS bf16_t*)(HB + ((d * 64 + tok) * 256 + 64 * hd + 16 * n + fr) * 2) = f2bf(Hj[mt][j] + Aj[mt][j] * hin); } }
            cr[n] = tH[mt] + tA[mt] * cr[n]; at[n] *= tA[mt]; }
    }
    if (PASS == 1) { if (fq == 0) {
#pragma unroll
            for (int n = 0; n < 4; ++n) { float* s = SUMM + ((size_t)q * 2 + d) * 512 + 64 * hd + 16 * n + fr; s[0] = at[n]; s[256] = cr[n]; } } }
    else {
        __syncthreads();
        bf16_t* Y = (bf16_t*)(p->ws + WS_YCAT);
        u32x4 gaw[4];
#pragma unroll
        for (int it = 0; it < 4; ++it) { const int task = it * 512 + tid, tok = task >> 5, cg = task & 31; gaw[it] = *(const u32x4*)(PROJ + ((size_t)rowbase + t0 + tok) * NPROJ + 256 + 8 * cg); }
#pragma unroll
        for (int it = 0; it < 4; ++it) { const int task = it * 512 + tid, tok = task >> 5, cg = task & 31; const size_t row = (size_t)rowbase + t0 + tok;
            float hf[8], hb[8], ga[8], y[8];
            unpack8(*(const LAS u32x4*)(HB + ((0 * 64 + tok) * 256 + 8 * cg) * 2), hf); unpack8(*(const LAS u32x4*)(HB + ((1 * 64 + tok) * 256 + 8 * cg) * 2), hb);
            unpack8(gaw[it], ga);
#pragma unroll
            for (int e = 0; e < 8; ++e) { const float g = ga[e]; y[e] = (hf[e] + hb[e]) * (g * sigmoidf_(1.5957691216057308f * (g + 0.044715f * g * g * g))); }
            *(u32x4*)(Y + row * D + 8 * cg) = pack8(y); }
    }
}

__device__ __forceinline__ void scan2_unit(CP p, int l, int q, LAS unsigned char* lds) {
    const int tid = tid_(), lane = tid & 63, wid = __builtin_amdgcn_readfirstlane(tid >> 6), d = wid >> 2, hd = wid & 3, fr = lane & 15, fq = lane >> 4;
    LAS float* CAR = (LAS float*)(lds + wid * 256);
    LAS unsigned char* HB = lds + 2048;
    const bf16_t* PROJ = (const bf16_t*)(p->ws + WS_PROJ); const float* SUMM = (const float*)(p->ws + WS_SUMM);
    const Seq sq = seq_of(q); const int b = sq.b, jc = sq.jc, rowbase = sq.rowbase, t0 = sq.t0; const bool lat = sq.lat;
    __syncthreads();
    u32x4 ab[4][4];
    { const u32x4* ABi = (const u32x4*)(p->ws + WS_AB) + ((size_t)q * 8 + wid) * 16 * 64 + lane;
#pragma unroll
      for (int n = 0; n < 4; ++n)
#pragma unroll
          for (int mt = 0; mt < 4; ++mt) ab[n][mt] = __builtin_nontemporal_load(ABi + (size_t)((n * 4 + mt) * 64)); }
    u32x4 gaw[4];
#pragma unroll
    for (int it = 0; it < 4; ++it) { const int task = it * 512 + tid, tok = task >> 5, cg = task & 31; gaw[it] = *(const u32x4*)(PROJ + ((size_t)rowbase + t0 + tok) * NPROJ + 256 + 8 * cg); }
    { float car = 0.f; const int c = 64 * hd + lane;
      const int n = d == 0 ? (lat ? 4 + jc : jc) : (lat ? 4 + 63 - jc : 3 - jc);
      for (int s0 = 0; s0 < n; s0 += 16) { float A_[16], H_[16];
#pragma unroll
          for (int e = 0; e < 16; ++e) { const int s = s0 + e; int qq;
              if (d == 0) qq = (lat && s >= 4) ? b * 64 + (s - 4) : 512 + b * 4 + s; else qq = (lat && s >= 4) ? b * 64 + 63 - (s - 4) : 512 + b * 4 + 3 - s;
              A_[e] = 1.f; H_[e] = 0.f; if (s < n) { const float* sp_ = SUMM + ((size_t)qq * 2 + d) * 512; A_[e] = sp_[c]; H_[e] = sp_[256 + c]; } }
#pragma unroll
          for (int e = 0; e < 16; ++e) car = A_[e] * car + H_[e]; }
      CAR[lane] = car; }
    asm volatile("" ::: "memory");
    const int src1 = d ? lane + 16 : lane - 16, src2 = d ? lane + 32 : lane - 32, srct = d ? fr : 48 + fr;
    const bool has1 = d ? fq <= 2 : fq >= 1, has2 = d ? fq <= 1 : fq >= 2;
#pragma unroll
    for (int n = 0; n < 4; ++n) { float cr = CAR[16 * n + fr];
        float Hj[4][4], Aj[4][4];
#pragma unroll
        for (int mt = 0; mt < 4; ++mt) { const u32x4 w = ab[n][mt];
            const float a_[4] = {fexp2(bflo(w.x)), fexp2(bfhi(w.x)), fexp2(bflo(w.y)), fexp2(bfhi(w.y))}, b_[4] = {bflo(w.z), bfhi(w.z), bflo(w.w), bfhi(w.w)};
            if (d == 0) { Hj[mt][0] = b_[0]; Aj[mt][0] = a_[0];
#pragma unroll
                for (int j = 1; j < 4; ++j) { Hj[mt][j] = a_[j] * Hj[mt][j - 1] + b_[j]; Aj[mt][j] = a_[j] * Aj[mt][j - 1]; } }
            else { Hj[mt][3] = b_[3]; Aj[mt][3] = a_[3];
#pragma unroll
                for (int j = 2; j >= 0; --j) { Hj[mt][j] = a_[j] * Hj[mt][j + 1] + b_[j]; Aj[mt][j] = a_[j] * Aj[mt][j + 1]; } } }
        float iA[4], iH[4], eA[4], eH[4], tA[4], tH[4];
#pragma unroll
        for (int mt = 0; mt < 4; ++mt) { iA[mt] = d ? Aj[mt][0] : Aj[mt][3]; iH[mt] = d ? Hj[mt][0] : Hj[mt][3]; }
        { float pA[4], pH[4];
#pragma unroll
          for (int mt = 0; mt < 4; ++mt) { pA[mt] = bperm(iA[mt], src1); pH[mt] = bperm(iH[mt], src1); }
#pragma unroll
          for (int mt = 0; mt < 4; ++mt) if (has1) { iH[mt] = iA[mt] * pH[mt] + iH[mt]; iA[mt] = iA[mt] * pA[mt]; }
#pragma unroll
          for (int mt = 0; mt < 4; ++mt) { pA[mt] = bperm(iA[mt], src2); pH[mt] = bperm(iH[mt], src2); }
#pragma unroll
          for (int mt = 0; mt < 4; ++mt) if (has2) { iH[mt] = iA[mt] * pH[mt] + iH[mt]; iA[mt] = iA[mt] * pA[mt]; } }
#pragma unroll
        for (int mt = 0; mt < 4; ++mt) { eA[mt] = bperm(iA[mt], src1); eH[mt] = bperm(iH[mt], src1); tA[mt] = bperm(iA[mt], srct); tH[mt] = bperm(iH[mt], srct); if (!has1) { eA[mt] = 1.f; eH[mt] = 0.f; } }
#pragma unroll
        for (int mi = 0; mi < 4; ++mi) { const int mt = d ? 3 - mi : mi;
            const float hin = eH[mt] + eA[mt] * cr;
#pragma unroll
            for (int j = 0; j < 4; j += 2) { const int tok = 16 * mt + 4 * fq + j; const LAS unsigned char* dummy = HB; (void)dummy;
                *(LAS bf16_t*)(HB + ((d * 64 + tok) * 256 + 64 * hd + 16 * n + fr) * 2) = f2bf(Hj[mt][j] + Aj[mt][j] * hin);
                *(LAS bf16_t*)(HB + ((d * 64 + tok + 1) * 256 + 64 * hd + 16 * n + fr) * 2) = f2bf(Hj[mt][j + 1] + Aj[mt][j + 1] * hin); }
            cr = tH[mt] + tA[mt] * cr; } }
    __syncthreads();
    bf16_t* Y = (bf16_t*)(p->ws + WS_YCAT);
#pragma unroll
    for (int it = 0; it < 4; ++it) { const int task = it * 512 + tid, tok = task >> 5, cg = task & 31; const size_t row = (size_t)rowbase + t0 + tok;
        float hf[8], hb[8], ga[8], y[8];
        unpack8(*(const LAS u32x4*)(HB + ((0 * 64 + tok) * 256 + 8 * cg) * 2), hf); unpack8(*(const LAS u32x4*)(HB + ((1 * 64 + tok) * 256 + 8 * cg) * 2), hb);
        unpack8(gaw[it], ga);
#pragma unroll
        for (int e = 0; e < 8; ++e) { const float g = ga[e]; y[e] = (hf[e] + hb[e]) * (g * sigmoidf_(1.5957691216057308f * (g + 0.044715f * g * g * g))); }
        *(u32x4*)(Y + row * D + 8 * cg) = pack8(y); }
}

template <int HW>
__device__ __forceinline__ void pool_core(const float (&vals)[48], int tb, int L, float bp, float ps, bf16_t* yp) {
    float sacc = 0.f;
#pragma unroll
    for (int i = 8 - HW; i < 8 + HW; ++i) sacc += vals[i];
#pragma unroll
    for (int o = 0; o < 32; ++o) { const int t = tb + o; const int cnt = min(t + HW, L) - max(t - HW, 0);
        const float yv = (sacc * frcp((float)cnt) - vals[8 + o] + bp) * ps;
        yp[(size_t)o * D] = f2bf(yv);
        if (o < 31) sacc += vals[8 + o + HW] - vals[8 + o - HW]; }
}
__device__ __forceinline__ void pool_unit(CP p, int l, int q, LAS unsigned char* lds) {
    LAS float* PB = (LAS float*)lds;
    const int tid = tid_();
    const bf16_t* PROJ = (const bf16_t*)(p->ws + WS_PROJ); bf16_t* Y = (bf16_t*)(p->ws + WS_YCAT);
    const Seq sq = seq_of(q); const int L = sq.L, rowbase = sq.rowbase, t0 = sq.t0;
    __syncthreads();
    { u32x4 w[5];
#pragma unroll
      for (int it = 0; it < 5; ++it) { const int task = it * 512 + tid, r = task >> 5, cg = task & 31, tt = t0 - 8 + r; w[it] = (u32x4){0u, 0u, 0u, 0u};
          if (tt >= 0 && tt < L) w[it] = *(const u32x4*)(PROJ + (size_t)(rowbase + tt) * NPROJ + 512 + 8 * cg); }
#pragma unroll
      for (int it = 0; it < 5; ++it) { const int task = it * 512 + tid, r = task >> 5, cg = task & 31; float f[8]; unpack8(w[it], f);
          *(LAS f32x4*)(PB + r * 256 + 8 * cg) = (f32x4){f[0], f[1], f[2], f[3]}; *(LAS f32x4*)(PB + r * 256 + 8 * cg + 4) = (f32x4){f[4], f[5], f[6], f[7]}; } }
    __syncthreads();
    { const int c = tid & 255, th = tid >> 8, g = __builtin_amdgcn_readfirstlane(c >> 6); const float bp = p->b_pool[l * 256 + c], ps = p->pool_scale[l * 256 + c];
      float vals[48];
#pragma unroll
      for (int i = 0; i < 48; ++i) vals[i] = PB[(32 * th + i) * 256 + c];
      bf16_t* yp = Y + (size_t)(rowbase + t0 + 32 * th) * D + 256 + c; const int tb = t0 + 32 * th;
      if (g == 0) pool_core<1>(vals, tb, L, bp, ps, yp); else if (g == 1) pool_core<2>(vals, tb, L, bp, ps, yp); else if (g == 2) pool_core<4>(vals, tb, L, bp, ps, yp); else pool_core<8>(vals, tb, L, bp, ps, yp); }
}
__device__ __forceinline__ void four_unit(CP p, int l, int q) {
    const int tid = tid_();
    bf16_t* Y = (bf16_t*)(p->ws + WS_YCAT);
    const Seq sq = seq_of(q); const int b = sq.b, rowbase = sq.rowbase, t0 = sq.t0; const bool lat = sq.lat;
    const float* UU = (const float*)(p->ws + WS_UU); const float* VV = (const float*)(p->ws + WS_VV); const float* YCX = (const float*)(p->ws + WS_YCX);
#pragma unroll
    for (int it = 0; it < 4; ++it) { const int task = it * 512 + tid, tl = task >> 5, cg = task & 31, t = t0 + tl; float y[8];
        f32x4 u0, u1, v0 = {0.f, 0.f, 0.f, 0.f}, v1 = {0.f, 0.f, 0.f, 0.f}; float sgn, scale;
        if (lat) { const int k = t <= 2048 ? t : 4096 - t; sgn = t <= 2048 ? -1.0f : 1.0f; scale = 1.0f / (512.0f * 64.0f);
            const float* up = UU + (size_t)k * 2048 + b * 256 + 8 * cg; u0 = *(const f32x4*)up; u1 = *(const f32x4*)(up + 4);
            if (k < 2048) { const float* vp = VV + (size_t)k * 2048 + b * 256 + 8 * cg; v0 = *(const f32x4*)vp; v1 = *(const f32x4*)(vp + 4); } }
        else { sgn = 0.f; scale = 1.0f / (128.0f * 64.0f); const float* up = YCX + (size_t)t * 2048 + b * 256 + 8 * cg; u0 = *(const f32x4*)up; u1 = *(const f32x4*)(up + 4); }
        const f32x4 bf0 = *(const f32x4*)(p->b_four + l * 256 + 8 * cg), bf1 = *(const f32x4*)(p->b_four + l * 256 + 8 * cg + 4);
        const f32x4 r0 = (u0 + v0 * sgn) * scale + bf0, r1 = (u1 + v1 * sgn) * scale + bf1;
        y[0] = r0[0]; y[1] = r0[1]; y[2] = r0[2]; y[3] = r0[3]; y[4] = r1[0]; y[5] = r1[1]; y[6] = r1[2]; y[7] = r1[3];
        *(u32x4*)(Y + (size_t)(rowbase + t) * D + 512 + 8 * cg) = pack8(y); }
}
__device__ __forceinline__ void conformer_unit(CP p, int l, int q, LAS unsigned char* lds) {
    LAS float* V = (LAS float*)lds;
    const int tid = tid_(), lane = tid & 63, wid = __builtin_amdgcn_readfirstlane(tid >> 6);
    const bf16_t* PROJ = (const bf16_t*)(p->ws + WS_PROJ); bf16_t* Y = (bf16_t*)(p->ws + WS_YCAT);
    const Seq sq = seq_of(q); const int L = sq.L, rowbase = sq.rowbase, t0 = sq.t0;
    __syncthreads();
    { u32x4 wa[6], wg_[6];
#pragma unroll
      for (int it = 0; it < 6; ++it) { const int task = it * 512 + tid, r = task >> 5, cg = task & 31, tt = t0 - 15 + r; wa[it] = (u32x4){0u, 0u, 0u, 0u}; wg_[it] = wa[it];
          if (task < 94 * 32 && tt >= 0 && tt < L) { const bf16_t* pr = PROJ + (size_t)(rowbase + tt) * NPROJ + 768 + 8 * cg; wa[it] = *(const u32x4*)pr; wg_[it] = *(const u32x4*)(pr + 256); } }
#pragma unroll
      for (int it = 0; it < 6; ++it) { const int task = it * 512 + tid, r = task >> 5, cg = task & 31; float a[8], g[8], f[8]; unpack8(wa[it], a); unpack8(wg_[it], g);
#pragma unroll
          for (int e = 0; e < 8; ++e) f[e] = a[e] * sigmoidf_(g[e]);
          if (task < 94 * 32) { *(LAS f32x4*)(V + r * 256 + 8 * cg) = (f32x4){f[0], f[1], f[2], f[3]}; *(LAS f32x4*)(V + r * 256 + 8 * cg + 4) = (f32x4){f[4], f[5], f[6], f[7]}; } } }
    __syncthreads();
    const int hp = wid & 1, tq = wid >> 1, c0 = 128 * hp + 2 * lane;
    f32x2 wk[31];
#pragma unroll
    for (int k = 0; k < 31; ++k) wk[k] = *(const f32x2*)(p->conv_d_w + ((size_t)l * 31 + k) * 256 + c0);
    const f32x2 cb = *(const f32x2*)(p->conv_d_b + l * 256 + c0), lg = *(const f32x2*)(p->ln_d_g + l * 256 + c0), lb = *(const f32x2*)(p->ln_d_b + l * 256 + c0);
    for (int blk = 0; blk < 2; ++blk) { const int tl0 = 16 * tq + 8 * blk;
        f32x2 win[38];
#pragma unroll
        for (int i = 0; i < 38; ++i) win[i] = *(const LAS f32x2*)(V + (tl0 + i) * 256 + c0);
        f32x2 sv[8]; float m1[8], m2[8];
#pragma unroll
        for (int o = 0; o < 8; ++o) { f32x2 sacc = cb;
#pragma unroll
            for (int k = 0; k < 31; ++k) sacc += wk[k] * win[o + k];
            sv[o] = sacc; m1[o] = sacc.x + sacc.y; m2[o] = sacc.x * sacc.x + sacc.y * sacc.y; }
#pragma unroll
        for (int st = 16; st >= 1; st >>= 1) { float t1[8], t2[8];
#pragma unroll
            for (int o = 0; o < 8; ++o) { t1[o] = bperm(m1[o], lane ^ st); t2[o] = bperm(m2[o], lane ^ st); }
#pragma unroll
            for (int o = 0; o < 8; ++o) { m1[o] += t1[o]; m2[o] += t2[o]; } }
#pragma unroll
        for (int o = 0; o < 8; ++o) { const float mean = m1[o] * (1.0f / 64.0f); const float var = fmaxf(m2[o] * (1.0f / 64.0f) - mean * mean, 0.f); const float rs = __builtin_amdgcn_rsqf(var + 1e-6f);
            f32x2 yv = (sv[o] - mean) * rs * lg + lb; yv.x = yv.x * sigmoidf_(yv.x); yv.y = yv.y * sigmoidf_(yv.y);
            *(unsigned*)(Y + (size_t)(rowbase + t0 + tl0 + o) * D + 768 + c0) = cvt_pk_bf16(yv.x, yv.y); } }
}

struct SchedIn { const char *U, *W, *WF; char *PROJ, *PQT, *PQC; int lastl;
    __device__ __forceinline__ bool next(int i, g8::Unit& u) const { const int nu = lastl ? 904 : 952, nmain = lastl ? 648 : 680; const int L = i * (int)gridDim.x + (int)blockIdx.x; if (L >= nu) return false; int id = g8::xcd_remap(L, nu);
        if (id < nmain) { u.kind = 0; if (lastl && id >= 640) { u.pm = 128 + (id - 640); u.pn = 0; } else { u.pm = id / 5; u.pn = id % 5; } u.a = U + (size_t)u.pm * 256 * 2048; u.b = W + (size_t)u.pn * 256 * 2048; u.o = PROJ; u.e = 0; }
        else { const int r = id - nmain; u.kind = 1; u.pm = r & 1; u.pn = r >> 1; u.a = WF + (size_t)u.pm * 256 * 2048; u.b = U + (size_t)u.pn * 256 * 2048; u.e = 0;
            if (u.pn < 128) u.o = PQT + ((size_t)(u.pm * 2048 + (u.pn >> 4) * 256) * 4096 + (u.pn & 15) * 256); else u.o = PQC + ((size_t)((u.pn - 128) * 256) * 512 + u.pm * 256); }
        return true; } };
struct EpiIn { static constexpr bool PERM = true; const float* bin; const float* bf;
    __device__ __forceinline__ void side_dma(const g8::Unit& u, int t, LAS unsigned char* d) const { g8::dma4((u.kind == 0 ? bin + u.pn * 256 : bf + u.pm * 256) + t, d); }
    __device__ __forceinline__ void operator()(const f32x4 (&acc)[2][2][4][2], const g8::Unit& u, int wr, int wc, int fr, int fq, const LAS unsigned* sd) const {
        { const int ln_ = tid_() & 63; fr = ln_ & 15; fq = ln_ >> 4; }
        if (u.kind == 0) { const int row0 = u.pm * 256 + wr * 64 + fr, col0 = u.pn * 256 + wc * 32 + 8 * fq; bf16_t* O = (bf16_t*)u.o;
            f32x4 bv[2][2];
#pragma unroll
            for (int bj = 0; bj < 2; ++bj)
#pragma unroll
                for (int n = 0; n < 2; ++n) bv[bj][n] = *(const LAS f32x4*)(sd + wc * 32 + 8 * fq + bj * 128 + 4 * n);
#pragma unroll
            for (int ai = 0; ai < 2; ++ai)
#pragma unroll
                for (int m = 0; m < 4; ++m) { bf16_t* rowp = O + (size_t)(row0 + ai * 128 + m * 16) * NPROJ + col0;
#pragma unroll
                    for (int bj = 0; bj < 2; ++bj) { const f32x4 v0 = acc[ai][bj][m][0] + bv[bj][0], v1 = acc[ai][bj][m][1] + bv[bj][1];
                        u32x4 w; w.x = cvt_pk_bf16(v0[0], v0[1]); w.y = cvt_pk_bf16(v0[2], v0[3]); w.z = cvt_pk_bf16(v1[0], v1[1]); w.w = cvt_pk_bf16(v1[2], v1[3]); *(u32x4*)(rowp + bj * 128) = w; } }
        } else { const int pitch = u.pn < 128 ? 4096 : 512; unsigned char* O = (unsigned char*)u.o; const int col0 = wc * 32 + 8 * fq;
#pragma unroll
            for (int ai = 0; ai < 2; ++ai)
#pragma unroll
                for (int m = 0; m < 4; ++m) { const int r = ai * 128 + wr * 64 + m * 16 + fr; const float bb = __uint_as_float(sd[r]); unsigned char* rowp = O + (size_t)r * pitch + col0;
#pragma unroll
                    for (int bj = 0; bj < 2; ++bj) { const f32x4 v0 = acc[ai][bj][m][0] + bb, v1 = acc[ai][bj][m][1] + bb;
                        u32x2 w; w.x = pk4_fp8(v0[0], v0[1], v0[2], v0[3]); w.y = pk4_fp8(v1[0], v1[1], v1[2], v1[3]); *(u32x2*)(rowp + bj * 128) = w; } }
        } } };
struct SchedDft { const char *CM, *SM, *PQT; char *UU, *VV;
    __device__ __forceinline__ bool next(int i, g8::Unit& u) const { const int id = (int)blockIdx.x; if (i > 0 || id >= 136) return false; u.kind = 0; u.e = 0;
        if (id < 72) { u.pm = id >> 3; u.pn = id & 7; u.a = CM + (size_t)u.pm * 256 * 8192; u.b = PQT + (size_t)u.pn * 256 * 8192; u.o = UU + ((size_t)u.pm * 256 * 2048 + u.pn * 256) * 4; }
        else { const int r = id - 72; u.pm = r >> 3; u.pn = r & 7; u.a = SM + (size_t)u.pm * 256 * 8192; u.b = PQT + (size_t)(2048 + u.pn * 256) * 8192; u.o = VV + ((size_t)u.pm * 256 * 2048 + u.pn * 256) * 4; }
        return true; } };
struct SchedOne { g8::Unit u; __device__ __forceinline__ bool next(int i, g8::Unit& o) const { if (i > 0) return false; o = u; return true; } };
struct SchedDftC { const char *DC, *PQC; char* YCX;
    __device__ __forceinline__ bool next(int i, g8::Unit& u) const { const int id = (int)blockIdx.x - 136; if (i > 0 || id < 0 || id >= 8) return false; u.kind = 0; u.e = 0; u.pm = 0; u.pn = id;
        u.a = DC; u.b = PQC + (size_t)id * 256 * 1024; u.o = YCX + (size_t)id * 256 * 4; return true; } };
struct EpiF32 { static constexpr bool PERM = false;
    __device__ __forceinline__ void side_dma(const g8::Unit&, int, LAS unsigned char*) const {}
    __device__ __forceinline__ void operator()(const f32x4 (&acc)[2][2][4][2], const g8::Unit& u, int wr, int wc, int fr, int fq, const LAS unsigned* sd) const {
        { const int ln_ = tid_() & 63; fr = ln_ & 15; fq = ln_ >> 4; }
        float* O = (float*)u.o; const int row0 = wr * 64 + fr, col0 = wc * 32 + 4 * fq;
#pragma unroll
        for (int ai = 0; ai < 2; ++ai)
#pragma unroll
            for (int m = 0; m < 4; ++m) { float* rowp = O + (size_t)(row0 + ai * 128 + m * 16) * 2048 + col0;
#pragma unroll
                for (int bj = 0; bj < 2; ++bj)
#pragma unroll
                    for (int n = 0; n < 2; ++n) *(f32x4*)(rowp + bj * 128 + n * 16) = acc[ai][bj][m][n]; } } };
struct SchedOut { const char *Y, *W; int nm; const float* modv_l;
    __device__ __forceinline__ bool next(int i, g8::Unit& u) const { const int nu = nm * 4, L = i * (int)gridDim.x + (int)blockIdx.x; if (L >= nu) return false; const int id = g8::xcd_remap(L, nu);
        u.kind = 0; u.pm = id >> 2; u.pn = id & 3; u.a = Y + (size_t)u.pm * 256 * 2048; u.b = W + (size_t)u.pn * 256 * 2048; u.o = nullptr; u.e = u.pm < 128 ? u.pm >> 4 : 8; return true; } };
struct EpiOut { static constexpr bool PERM = true; bf16_t* Y2; const float* bout; const float* modv_l;
    __device__ __forceinline__ void side_dma(const g8::Unit& u, int t, LAS unsigned char* d) const { g8::dma4(bout + u.pn * 256 + t, d); g8::dma4(modv_l + (size_t)u.e * 6144 + 2048 + u.pn * 256 + t, d + 1024); }
    __device__ __forceinline__ void operator()(const f32x4 (&acc)[2][2][4][2], const g8::Unit& u, int wr, int wc, int fr, int fq, const LAS unsigned* sd) const {
        { const int ln_ = tid_() & 63; fr = ln_ & 15; fq = ln_ >> 4; }
        const int row0 = u.pm * 256 + wr * 64 + fr, col0 = u.pn * 256 + wc * 32 + 8 * fq;
        f32x4 bv[2][2], gv[2][2];
#pragma unroll
        for (int bj = 0; bj < 2; ++bj)
#pragma unroll
            for (int n = 0; n < 2; ++n) { bv[bj][n] = *(const LAS f32x4*)(sd + wc * 32 + 8 * fq + bj * 128 + 4 * n); gv[bj][n] = *(const LAS f32x4*)(sd + 256 + wc * 32 + 8 * fq + bj * 128 + 4 * n); }
#pragma unroll
        for (int ai = 0; ai < 2; ++ai)
#pragma unroll
            for (int m = 0; m < 4; ++m) { bf16_t* rowp = Y2 + (size_t)(row0 + ai * 128 + m * 16) * D + col0;
#pragma unroll
                for (int bj = 0; bj < 2; ++bj) { const f32x4 v0 = gv[bj][0] * (acc[ai][bj][m][0] + bv[bj][0]), v1 = gv[bj][1] * (acc[ai][bj][m][1] + bv[bj][1]);
                    u32x4 w; w.x = cvt_pk_bf16(v0[0], v0[1]); w.y = cvt_pk_bf16(v0[2], v0[3]); w.z = cvt_pk_bf16(v1[0], v1[1]); w.w = cvt_pk_bf16(v1[2], v1[3]); *(u32x4*)(rowp + bj * 128) = w; } } } };
struct MoeTab { const LAS int* pref; const LAS int* cnt; const LAS unsigned char* t2e; int ntile;
    __device__ __forceinline__ int pref_(int e) const { return __builtin_amdgcn_readfirstlane(pref[e]); }
    __device__ __forceinline__ int cnt_(int e) const { return __builtin_amdgcn_readfirstlane(cnt[e]); }
    __device__ __forceinline__ int expert_of(int pm) const { return __builtin_amdgcn_readfirstlane((int)t2e[pm]); } };
struct SchedGu { MoeTab tb; const char *U, *W; char* ACT; const unsigned* rroff; unsigned maxoff; int rb; float* diag; int kz;
    __device__ __forceinline__ bool next(int i, g8::Unit& u) const { const int nu = tb.ntile * 8, L = i * (int)gridDim.x + (int)blockIdx.x; if (L >= nu) return false; const int id = g8::xcd_remap(L, nu);
        u.kind = 0; u.pm = id >> 3; u.pn = id & 7; u.e = tb.expert_of(u.pm); u.a = U; u.b = W + ((size_t)u.e * 2048 + u.pn * 256) * rb; u.o = ACT + (size_t)u.pm * 256 * rb; return true; }
    __device__ __forceinline__ void roff_dma(const g8::Unit& u, int t, LAS unsigned char* d) const { g8::dma4(rroff + (size_t)u.e * TT + (u.pm - tb.pref_(u.e)) * 256 + t, d); } };
template <bool F8> struct EpiGu { static constexpr bool PERM = true; const float* bgu;
    __device__ __forceinline__ void side_dma(const g8::Unit& u, int t, LAS unsigned char* d) const { g8::dma4(bgu + (size_t)u.e * 2048 + (t < 128 ? 0 : 1024 - 128) + u.pn * 128 + t, d); }
    __device__ __forceinline__ void operator()(const f32x4 (&acc)[2][2][4][2], const g8::Unit& u, int wr, int wc, int fr, int fq, const LAS unsigned* sd) const {
        { const int ln_ = tid_() & 63; fr = ln_ & 15; fq = ln_ >> 4; }
        const int col0 = u.pn * 128 + wc * 32 + 8 * fq; float sc = F8 ? (1.0f / 64.0f) : 1.0f;
#if defined(EPIREP)
        asm volatile("" : "+v"(sc));
#endif
        f32x4 bgt[2], bup[2];
#pragma unroll
        for (int n = 0; n < 2; ++n) { bgt[n] = *(const LAS f32x4*)(sd + wc * 32 + 8 * fq + 4 * n); bup[n] = *(const LAS f32x4*)(sd + 128 + wc * 32 + 8 * fq + 4 * n); }
#pragma unroll
        for (int ai = 0; ai < 2; ++ai)
#pragma unroll
            for (int m = 0; m < 4; ++m) { const int r = ai * 128 + wr * 64 + m * 16 + fr; float y[8];
#pragma unroll
                for (int n = 0; n < 2; ++n)
#pragma unroll
                    for (int h = 0; h < 2; ++h) {
                        f32x2 g2 = (f32x2){acc[ai][0][m][n][2 * h], acc[ai][0][m][n][2 * h + 1]} * sc + (f32x2){bgt[n][2 * h], bgt[n][2 * h + 1]};
                        f32x2 u2 = (f32x2){acc[ai][1][m][n][2 * h], acc[ai][1][m][n][2 * h + 1]} * sc + (f32x2){bup[n][2 * h], bup[n][2 * h + 1]};
                        g2.x = fminf(g2.x, 7.0f); g2.y = fminf(g2.y, 7.0f); u2.x = __builtin_amdgcn_fmed3f(u2.x, -7.0f, 7.0f); u2.y = __builtin_amdgcn_fmed3f(u2.y, -7.0f, 7.0f);
                        const f32x2 t2 = g2 * (-1.702f * 1.4426950408889634f); f32x2 d2; d2.x = fexp2(t2.x); d2.y = fexp2(t2.y); d2 = d2 + 1.0f;
                        f32x2 s2; s2.x = frcp(d2.x); s2.y = frcp(d2.y);
                        const f32x2 y2 = (u2 + 1.0f) * g2 * s2; y[4 * n + 2 * h] = y2.x; y[4 * n + 2 * h + 1] = y2.y; }
                if constexpr (F8) { u32x2 w; w.x = pk4_fp8(y[0], y[1], y[2], y[3]); w.y = pk4_fp8(y[4], y[5], y[6], y[7]); *(u32x2*)((unsigned char*)u.o + (size_t)r * D + col0) = w; }
                else *(u32x4*)((bf16_t*)u.o + (size_t)r * D + col0) = pack8(y); } } };
struct SchedDown { MoeTab tb; const char *ACT, *W; int rb;
    __device__ __forceinline__ bool next(int i, g8::Unit& u) const { const int nu = tb.ntile * 4, L = i * (int)gridDim.x + (int)blockIdx.x; if (L >= nu) return false; const int id = g8::xcd_remap(L, nu);
        u.kind = 0; u.pm = id >> 2; u.pn = id & 3; u.e = tb.expert_of(u.pm); u.a = ACT + (size_t)u.pm * 256 * rb; u.b = W + ((size_t)u.e * 1024 + u.pn * 256) * rb; u.o = nullptr; return true; } };
struct EpiDown { static constexpr bool PERM = true; MoeTab tb; const float* bd; const int* rasg; const float* gate; bf16_t* YS; float sc;
    __device__ __forceinline__ void side_dma(const g8::Unit& u, int t, LAS unsigned char* d) const { const size_t pos = (size_t)u.e * TT + (u.pm - tb.pref_(u.e)) * 256 + t;
        g8::dma4(rasg + pos, d); g8::dma4(gate + pos, d + 1024); g8::dma4(bd + (size_t)u.e * 1024 + u.pn * 256 + t, d + 2048); }
    __device__ __forceinline__ void operator()(const f32x4 (&acc)[2][2][4][2], const g8::Unit& u, int wr, int wc, int fr, int fq, const LAS unsigned* sd) const {
        { const int ln_ = tid_() & 63; fr = ln_ & 15; fq = ln_ >> 4; }
        const int col0 = u.pn * 256 + wc * 32 + 8 * fq; const int rank0 = (u.pm - tb.pref_(u.e)) * 256, cnt = tb.cnt_(u.e);
        f32x4 bv[2][2];
#pragma unroll
        for (int bj = 0; bj < 2; ++bj)
#pragma unroll
            for (int n = 0; n < 2; ++n) bv[bj][n] = *(const LAS f32x4*)(sd + 512 + wc * 32 + 8 * fq + bj * 128 + 4 * n);
#pragma unroll
        for (int ai = 0; ai < 2; ++ai)
#pragma unroll
            for (int m = 0; m < 4; ++m) { const int r = ai * 128 + wr * 64 + m * 16 + fr; const int asg = (int)sd[r]; const float g = __uint_as_float(sd[256 + r]);
                if (rank0 + r < cnt) { unsigned char* rowp = (unsigned char*)YS + (size_t)asg * D + col0; const float g16 = g * 16.0f;
#pragma unroll
                    for (int bj = 0; bj < 2; ++bj) { const f32x4 v0 = (acc[ai][bj][m][0] * sc + bv[bj][0]) * g16, v1 = (acc[ai][bj][m][1] * sc + bv[bj][1]) * g16;
                        u32x2 w; w.x = pk4_fp8(v0[0], v0[1], v0[2], v0[3]); w.y = pk4_fp8(v1[0], v1[1], v1[2], v1[3]); *(u32x2*)(rowp + bj * 128) = w; } } } } };
__device__ __forceinline__ MoeTab moe_tables(CP p, int l, LAS unsigned char* lds) {
    LAS int* pref = (LAS int*)(lds + g8::STAGE_BYTES); LAS int* cnt = pref + 64; LAS unsigned char* t2e = (LAS unsigned char*)(lds + g8::STAGE_BYTES + 384);
    unsigned* ctl = (unsigned*)(p->ws + WS_CTL);
    const int tid = tid_();
    __syncthreads();
    if (tid < 32) cnt[tid] = (int)__hip_atomic_load(ctl + CW_COUNT + (l * NE + tid) * 64, __ATOMIC_RELAXED, __HIP_MEMORY_SCOPE_AGENT);
    __syncthreads();
    if (tid == 0) { int s = 0; for (int e = 0; e < 32; ++e) { pref[e] = s; s += (cnt[e] + 255) >> 8; } pref[32] = s; }
    __syncthreads();
    for (int pm = tid; pm < NTILE_MAX; pm += 512) { int e = 0; for (int k = 1; k < 32; ++k) e += (pm >= pref[k]) ? 1 : 0; t2e[pm] = (unsigned char)e; }
    __syncthreads();
    MoeTab tb; tb.pref = pref; tb.cnt = cnt; tb.t2e = t2e; tb.ntile = __builtin_amdgcn_readfirstlane(pref[32]); return tb;
}

constexpr int N_PHASES = 18;
__global__ void __launch_bounds__(512, 2) mega_fwd(Params p_unused) {
    CP p = launder_params();
    extern __shared__ __attribute__((aligned(16))) unsigned char shm_[];
    LAS unsigned char* lds0 = (LAS unsigned char*)shm_;
    LAS unsigned char* lds = lds0 + LDS_BASE;
    if (tid_() == 0) *(LAS u32x4*)lds0 = (u32x4){0u, 0u, 0u, 0u};
    __syncthreads();
    XcdBarrier bar = xcd_barrier_post((unsigned*)(p->ws + WS_CTL), (volatile LAS unsigned*)lds0);
    int ph = 0;
#ifndef P3A
#define P3A 1
#define P3B 1
#define P3C 1
#endif
#ifndef PHMASK
#define PHMASK 0x3ff
#endif
#ifndef REPMASK
#define REPMASK 0
#endif
#define PHASE_BEGIN_K(k) p = launder_params(); if (((PHMASK >> (k)) & 1) && ph >= p->ph_lo && ph < p->ph_hi) for (int rep_ = 0; rep_ < ((((REPMASK) >> (k)) & 1) ? 2 : 1); ++rep_) {
#define PHASE_END } ++ph; if (ph > p->ph_lo && ph < p->ph_hi) xcd_barrier(bar);
    PHASE_BEGIN_K(0) phase_prologue(p, lds, rep_); PHASE_END
    for (int l = 0; l < 2; ++l) {
        const float* modv_l = (const float*)(p->ws + WS_MODV) + (size_t)l * 9 * 6144;
        PHASE_BEGIN_K(1) phase_norm(p, l); PHASE_END
        PHASE_BEGIN_K(2) { SchedIn S; S.lastl = l == 1; S.U = (const char*)(p->ws + WS_U); S.W = (const char*)(p->ws + WS_WINT) + (size_t)l * NPROJ * 2048; S.WF = (const char*)(p->ws + WS_WFT) + (size_t)l * 512 * 2048;
                      S.PROJ = (char*)(p->ws + WS_PROJ); S.PQT = (char*)(p->ws + WS_PQT); S.PQC = (char*)(p->ws + WS_PQC);
                      EpiIn E; E.bin = (const float*)(p->ws + WS_BIN) + l * NPROJ; E.bf = (const float*)(p->ws + WS_BF) + l * 512;
                      g8::gemm_phase<EpiIn, SchedIn, false>(lds, 1024, S, E); } PHASE_END
        PHASE_BEGIN_K(3) {
                      unsigned* qhead = (unsigned*)(p->ws + WS_CTL) + CW_QUEUE + (l * 2 + rep_) * 64; LAS int* qslot = (LAS int*)(lds - LDS_BASE + 64);
                      int tkt = 0; if (tid_() == 0) tkt = (int)__hip_atomic_fetch_add(qhead, 1u, __ATOMIC_RELAXED, __HIP_MEMORY_SCOPE_AGENT);
                      for (;;) { __syncthreads(); if (tid_() == 0) { *qslot = tkt; tkt = (int)__hip_atomic_fetch_add(qhead, 1u, __ATOMIC_RELAXED, __HIP_MEMORY_SCOPE_AGENT); } __syncthreads();
                          const int id = __builtin_amdgcn_readfirstlane(*qslot); const int nwj = MOE_W_IN_QUEUE ? (l == 0 ? J_TGU_L(0) + J_TD_L(0) : J_TGU_L(1) + J_TD_L(1)) : 0;
                          if (id >= 144 + (MOE_W_IN_QUEUE ? 9 : 3) * NCHUNK) break;
#if defined(P3KIND)
                          if (rep_) { const int kc = id < 144 ? 0 : (MOE_W_IN_QUEUE ? ((id - 144) % 3 != 0 ? 4 : 1 + ((id - 144) / 3) / NCHUNK) : 1 + (id - 144) / NCHUNK); if (kc != P3KIND) continue; }
#endif
                          int small = -1;
                          if (id >= 144) { if (!MOE_W_IN_QUEUE) small = id - 144; else { const int r = id - 144, g = r / 3, k = r - 3 * g; if (k == 0) small = g; else { const int wj = 2 * g + (k - 1); if (wj < nwj) moe_weight_job(p, l, wj, lds); continue; } } }
                          if (l == 1 && ((id >= 136 && id < 144) || (id >= 144 + NCHUNK && (id - 144) % NCHUNK >= 512))) continue;
                          if (id < 136) { SchedOne S; S.u.kind = 0; S.u.e = 0;
                              if (id < 72) { S.u.pm = id >> 3; S.u.pn = id & 7; S.u.a = (const char*)(p->ws + WS_CMAT) + (size_t)S.u.pm * 256 * 4096; S.u.b = (const char*)(p->ws + WS_PQT) + (size_t)S.u.pn * 256 * 4096; S.u.o = (char*)(p->ws + WS_UU) + ((size_t)S.u.pm * 256 * 2048 + S.u.pn * 256) * 4; }
                              else { const int r = id - 72; S.u.pm = r >> 3; S.u.pn = r & 7; S.u.a = (const char*)(p->ws + WS_SMAT) + (size_t)S.u.pm * 256 * 4096; S.u.b = (const char*)(p->ws + WS_PQT) + (size_t)(2048 + S.u.pn * 256) * 4096; S.u.o = (char*)(p->ws + WS_VV) + ((size_t)S.u.pm * 256 * 2048 + S.u.pn * 256) * 4; }
                              g8::gemm_phase<EpiF32, SchedOne, false, true>(lds, 2048, S, EpiF32{}); }
                          else if (id < 144) { SchedOne S; S.u.kind = 0; S.u.e = 0; S.u.pm = 0; S.u.pn = id - 136; S.u.a = (const char*)(p->ws + WS_DFTC); S.u.b = (const char*)(p->ws + WS_PQC) + (size_t)S.u.pn * 256 * 512; S.u.o = (char*)(p->ws + WS_YCX) + (size_t)S.u.pn * 256 * 4;
                              g8::gemm_phase<EpiF32, SchedOne, false, true>(lds, 256, S, EpiF32{}); }
                          else { const int uu = small, kind = uu / NCHUNK, q = uu % NCHUNK;
                              if (kind == 0) scan_unit<1>(p, l, q, lds); else if (kind == 1) conformer_unit(p, l, q, lds); else pool_unit(p, l, q, lds); } } } PHASE_END
        PHASE_BEGIN_K(4) { for (int q = blockIdx.x; q < (l == 1 ? 512 : NCHUNK); q += gridDim.x) { scan2_unit(p, l, q, lds); four_unit(p, l, q); } } PHASE_END
        PHASE_BEGIN_K(5) { SchedOut S; S.Y = (const char*)(p->ws + WS_YCAT); S.W = (const char*)(p->ws + WS_WOUTT) + (size_t)l * D * 2048; S.nm = l == 0 ? 136 : 128; S.modv_l = modv_l;
                      EpiOut E; E.Y2 = (bf16_t*)(p->ws + WS_PROJ);   E.bout = (const float*)(p->ws + WS_BOUT) + l * D; E.modv_l = modv_l;
                      g8::gemm_phase<EpiOut, SchedOut, false>(lds, 1024, S, E); } PHASE_END
        PHASE_BEGIN_K(6) phase_router(p, l, lds, rep_); PHASE_END
        PHASE_BEGIN_K(7) { MoeTab tb = moe_tables(p, l, lds);
                      SchedGu S; S.tb = tb; S.W = (const char*)(p->ws + WS_WGUT) + (size_t)l * NE * 2048 * 2048; S.ACT = (char*)(p->ws + WS_ACT); S.rroff = (const unsigned*)(p->ws + WS_RROFF); S.diag = (float*)(p->ws + WS_CTL) + 15000 + l; S.kz = 0;
#if defined(KZPROBE)
                      if (rep_) { S.ACT = (char*)(p->ws + WS_ACT) + (size_t)NTILE_MAX * 256 * 1024; S.kz = KZPROBE; }
#endif
                      S.maxoff = (unsigned)(TT - 1) * (fp8_layer(l) ? 1024u : 2048u);
                      if (fp8_layer(l)) { S.U = (const char*)(p->ws + WS_U8); S.rb = 1024; EpiGu<true> E; E.bgu = p->b_gu + (size_t)l * NE * 2048; g8::gemm_phase<EpiGu<true>, SchedGu, true, true>(lds, 512, S, E); }
                      else { S.U = (const char*)(p->ws + WS_U); S.rb = 2048; EpiGu<false> E; E.bgu = p->b_gu + (size_t)l * NE * 2048; g8::gemm_phase<EpiGu<false>, SchedGu, true, false>(lds, 1024, S, E); } } PHASE_END
        PHASE_BEGIN_K(8) { MoeTab tb = moe_tables(p, l, lds);
                      SchedDown S; S.tb = tb; S.ACT = (const char*)(p->ws + WS_ACT); S.W = (const char*)(p->ws + WS_WDT) + (size_t)l * NE * 1024 * 2048;
                      EpiDown E; E.tb = tb; E.bd = p->b_down + (size_t)l * NE * 1024; E.rasg = (const int*)(p->ws + WS_RASG); E.gate = (const float*)(p->ws + WS_RGATE); E.YS = (bf16_t*)(p->ws + WS_YS);
                      if (fp8_layer(l)) { S.rb = 1024; E.sc = 1.0f / 64.0f; g8::gemm_phase<EpiDown, SchedDown, false, true>(lds, 512, S, E); }
                      else { S.rb = 2048; E.sc = 1.0f; g8::gemm_phase<EpiDown, SchedDown, false, false>(lds, 1024, S, E); } } PHASE_END
    }
    PHASE_BEGIN_K(9) phase_norm(p, 2); PHASE_END
#if defined(TIMEPROBE)
    __syncthreads(); if (blockIdx.x == 0 && tid_() == 0) { asm volatile("s_waitcnt vmcnt(0)" ::: "memory"); p->out[0] = ((const float*)(p->ws + WS_CTL))[15000]; }
#endif
#undef PHASE_BEGIN_K
#undef PHASE_END
}

extern "C" void kernel_launch(void* const* d_in, const int* in_sizes, int n_in, void* d_out, int out_size, void* d_ws, size_t ws_size, hipStream_t stream) {
    static int grid = 0;
    if (!grid) {
        if (n_in != 37 || ws_size < WS_END) { fprintf(stderr, "kernel_launch: expected 37 inputs and >= %zu bytes of workspace (got %d, %zu)\n", (size_t)WS_END, n_in, ws_size); }
        int dev = 0, cus = 0, per_cu = 0;
        hipGetDevice(&dev); hipDeviceGetAttribute(&cus, hipDeviceAttributeMultiprocessorCount, dev);
        hipFuncSetAttribute((const void*)mega_fwd, hipFuncAttributeMaxDynamicSharedMemorySize, LDS_BYTES);
        hipOccupancyMaxActiveBlocksPerMultiprocessor(&per_cu, (const void*)mega_fwd, 512, LDS_BYTES);
        if (per_cu < 1) fprintf(stderr, "kernel_launch: occupancy query reports %d workgroups per CU\n", per_cu);
        grid = cus > 0 ? cus : 256;
    }
    hipMemsetAsync((char*)d_ws + WS_CTL, 0, CTL_BYTES, stream);
    Params hp{};
    const float** f = (const float**)&hp;
    for (int i = 0; i < 37; ++i) f[i] = (const float*)d_in[i];
    hp.out = (float*)d_out; hp.ws = (unsigned char*)d_ws;
#if MK_N_LAUNCHES == 1
    hp.ph_lo = 0; hp.ph_hi = N_PHASES;
    hipLaunchKernelGGL(mega_fwd, dim3(grid), dim3(512), LDS_BYTES, stream, hp);
#else
    for (int ph = 0; ph < N_PHASES; ++ph) { hp.ph_lo = ph; hp.ph_hi = ph + 1; hipLaunchKernelGGL(mega_fwd, dim3(grid), dim3(512), LDS_BYTES, stream, hp); }
#endif
}
```

```cpp
#include <hip/hip_runtime.h>
#include <cstdio>
#include <cstdint>

#ifndef MK_N_LAUNCHES
#define MK_N_LAUNCHES 1
#endif

#ifndef FP8_FROM
#define FP8_FROM 0
#endif
#define LAS __attribute__((address_space(3)))
typedef unsigned short bf16_t;
typedef short bf16x8 __attribute__((ext_vector_type(8)));
typedef float f32x4 __attribute__((ext_vector_type(4)));
typedef float f32x2 __attribute__((ext_vector_type(2)));
typedef unsigned u32x4 __attribute__((ext_vector_type(4)));
typedef unsigned u32x2 __attribute__((ext_vector_type(2)));
typedef int i32x4 __attribute__((ext_vector_type(4)));
typedef int i32x8 __attribute__((ext_vector_type(8)));

constexpr int D = 1024, NB = 8, SEQ = 4096, LCX = 256, TL = NB * SEQ, TC = NB * LCX, TT = TL + TC;
constexpr int NPROJ = 1280;
constexpr int NE = 32, NCHUNK = 544;
constexpr int NTILE_MAX = 576;

constexpr size_t AL(size_t x) { return (x + 255) & ~(size_t)255; }
constexpr size_t CTL_BYTES = 65536;
constexpr size_t WS_CTL = 0;
constexpr size_t WS_MODV = WS_CTL + CTL_BYTES;
constexpr size_t WS_X = AL(WS_MODV + (size_t)2 * 9 * 6144 * 4);
constexpr size_t WS_U = AL(WS_X + (size_t)TT * D * 4);
constexpr size_t WS_PROJ = AL(WS_U + (size_t)TT * D * 2);
constexpr size_t WS_PQT = AL(WS_PROJ + (size_t)TT * NPROJ * 2);
constexpr size_t WS_PQC = AL(WS_PQT + (size_t)4096 * 4096 * 2);
constexpr size_t WS_UU = AL(WS_PQC + (size_t)2048 * 512 * 2);
constexpr size_t WS_VV = AL(WS_UU + (size_t)2304 * 2048 * 4);
constexpr size_t WS_YCX = AL(WS_VV + (size_t)2048 * 2048 * 4);
constexpr size_t WS_YCAT = AL(WS_YCX + (size_t)256 * 2048 * 4);
constexpr size_t WS_SUMM = AL(WS_YCAT + (size_t)TT * D * 2);
constexpr size_t WS_WINT = AL(WS_SUMM + (size_t)NCHUNK * 1024 * 4);
constexpr size_t WS_WFT = AL(WS_WINT + (size_t)2 * NPROJ * D * 2);
constexpr size_t WS_BIN = AL(WS_WFT + (size_t)2 * 512 * D * 2);
constexpr size_t WS_BF = AL(WS_BIN + (size_t)2 * NPROJ * 4);
constexpr size_t WS_WOUTT = AL(WS_BF + (size_t)2 * 512 * 4);
constexpr size_t WS_BOUT = AL(WS_WOUTT + (size_t)2 * D * D * 2);
constexpr size_t WS_WGUT = AL(WS_BOUT + (size_t)2 * D * 4);
constexpr size_t WS_WDT = AL(WS_WGUT + (size_t)2 * NE * 2048 * D * 2);
constexpr size_t WS_WRT = AL(WS_WDT + (size_t)2 * NE * D * D * 2);
constexpr size_t WS_WGT = AL(WS_WRT + (size_t)2 * 2 * NE * D * 2);
constexpr size_t WS_CMAT = AL(WS_WGT + (size_t)2 * 2 * 2 * 4 * 64 * 64 * 2);
constexpr size_t WS_SMAT = AL(WS_CMAT + (size_t)2304 * 4096 * 2);
constexpr size_t WS_DFTC = AL(WS_SMAT + (size_t)2048 * 4096 * 2);
constexpr size_t WS_RASG = AL(WS_DFTC + (size_t)256 * 512 * 2);
constexpr size_t WS_GATE = AL(WS_RASG + (size_t)NE * TT * 4);
constexpr size_t WS_ACT = AL(WS_GATE + (size_t)TT * 4 * 4);
constexpr size_t WS_YS = AL(WS_ACT + (size_t)NTILE_MAX * 256 * D * 2);
constexpr size_t WS_POS = AL(WS_YS + (size_t)TT * 4 * D * 2);
constexpr size_t WS_AB = AL(WS_POS + (size_t)64 * 512 * 4);
constexpr size_t WS_U8 = AL(WS_AB + (size_t)NCHUNK * 8 * 16 * 64 * 16);
constexpr size_t WS_RGATE = AL(WS_U8 + (size_t)TT * D);
constexpr size_t WS_RROFF = AL(WS_RGATE + (size_t)NE * TT * 4 + 4096);
constexpr size_t WS_END = AL(WS_RROFF + (size_t)NE * TT * 4 + 4096);
constexpr int CW_QUEUE = 12288;
constexpr int CW_COUNT = 4096;

constexpr int LDS_BYTES = 159744;
constexpr int LDS_BASE = 1024;

__device__ __forceinline__ unsigned cvt_pk_bf16(float lo, float hi) { unsigned r; asm("v_cvt_pk_bf16_f32 %0, %1, %2" : "=v"(r) : "v"(lo), "v"(hi)); return r; }
__device__ __forceinline__ bf16_t f2bf(float f) { return (bf16_t)(cvt_pk_bf16(f, 0.f) & 0xffffu); }
__device__ __forceinline__ unsigned pk4_fp8(float a, float b, float c, float d) { int w = 0; w = __builtin_amdgcn_cvt_pk_fp8_f32(a, b, w, false); w = __builtin_amdgcn_cvt_pk_fp8_f32(c, d, w, true); return (unsigned)w; }
__device__ __forceinline__ float bf2f(bf16_t b) { return __uint_as_float(((unsigned)b) << 16); }
__device__ __forceinline__ float bflo(unsigned w) { return __uint_as_float(w << 16); }
__device__ __forceinline__ float bfhi(unsigned w) { return __uint_as_float(w & 0xffff0000u); }
__device__ __forceinline__ float fexp2(float x) { return __builtin_amdgcn_exp2f(x); }
__device__ __forceinline__ float frcp(float x) { return __builtin_amdgcn_rcpf(x); }
__device__ __forceinline__ f32x4 ld4bf(const bf16_t* p_) { const u32x2 w = __builtin_nontemporal_load((const u32x2*)p_); return (f32x4){bflo(w.x), bfhi(w.x), bflo(w.y), bfhi(w.y)}; }
__device__ __forceinline__ void st4bf(bf16_t* p_, const f32x4 v_) { u32x2 w; w.x = cvt_pk_bf16(v_[0], v_[1]); w.y = cvt_pk_bf16(v_[2], v_[3]); __builtin_nontemporal_store(w, (u32x2*)p_); }
__device__ __forceinline__ float sigmoidf_(float x) { return frcp(1.0f + fexp2(-1.4426950408889634f * x)); }
__device__ __forceinline__ int tid_() { int t = (int)threadIdx.x; asm volatile("" : "+v"(t)); return t; }
__device__ __forceinline__ float bperm(float v, int src) { return __int_as_float(__builtin_amdgcn_ds_bpermute(src << 2, __float_as_int(v))); }
__device__ __forceinline__ float wave_sum(float v, int lane) {
#pragma unroll
    for (int o = 32; o >= 1; o >>= 1) v += bperm(v, lane ^ o);
    return v;
}
__device__ __forceinline__ void unpack8(const u32x4 w, float (&f)[8]) { f[0] = bflo(w.x); f[1] = bfhi(w.x); f[2] = bflo(w.y); f[3] = bfhi(w.y); f[4] = bflo(w.z); f[5] = bfhi(w.z); f[6] = bflo(w.w); f[7] = bfhi(w.w); }
__device__ __forceinline__ u32x4 pack8(const float (&f)[8]) { u32x4 w; w.x = cvt_pk_bf16(f[0], f[1]); w.y = cvt_pk_bf16(f[2], f[3]); w.z = cvt_pk_bf16(f[4], f[5]); w.w = cvt_pk_bf16(f[6], f[7]); return w; }

#define XB_TMO      128
#define XB_XCNT(j)  (256  + 64 * (j))
#define XB_XSUB(j)  (1280 + 64 * (j))
#define XB_XGEN(j)  (2304 + 64 * (j))
#define XB_TOP      3328
#define XB_TOPGEN   3392
#define XCD_BAR_WORDS 3456
#define XB_SPIN_CAP (1u << 18)
__device__ __forceinline__ unsigned xb_ld(unsigned* p)              { return __hip_atomic_load(p, __ATOMIC_RELAXED, __HIP_MEMORY_SCOPE_AGENT); }
__device__ __forceinline__ unsigned xb_add(unsigned* p, unsigned v) { return __hip_atomic_fetch_add(p, v, __ATOMIC_RELAXED, __HIP_MEMORY_SCOPE_AGENT); }
__device__ __forceinline__ unsigned xb_xcc_id() { return (unsigned)__builtin_amdgcn_s_getreg((3 << 11) | 20) & 0xFu; }
#define XB_SPIN(cond, bar) do { unsigned _sp = 0; while (cond) { __builtin_amdgcn_s_sleep(1); \
    if ((++_sp & 255u) == 0u) { if (xb_ld(&(bar)[XB_TMO])) break; if (_sp > XB_SPIN_CAP) { atomicAdd(&(bar)[XB_TMO], 1u); break; } } } } while (0)
struct XcdBarrier { unsigned* bar; unsigned x; volatile LAS unsigned* st; };
__device__ __forceinline__ XcdBarrier xcd_barrier_post(unsigned* bar, volatile LAS unsigned* st) {
    XcdBarrier b; b.bar = bar; b.x = xb_xcc_id(); b.st = st;
    if (threadIdx.x == 0) (void)xb_add(&bar[XB_XCNT(b.x)], 1u);
    return b;
}
__device__ __forceinline__ void xcd_barrier_complete(unsigned* bar, unsigned x, unsigned& nloc, unsigned& nx) {
    const unsigned G = gridDim.x * gridDim.y * gridDim.z;
    unsigned sum, cnt, mine, sp = 0u;
    for (;;) {
        sum = 0u; cnt = 0u; mine = 0u;
#pragma unroll
        for (unsigned j = 0; j < 16; ++j) { const unsigned c = xb_ld(&bar[XB_XCNT(j)]); sum += c; cnt += (c > 0u) ? 1u : 0u; mine = (j == x) ? c : mine; }
        if (sum == G) break;
        __builtin_amdgcn_s_sleep(1);
        if ((++sp & 255u) == 0u) { if (xb_ld(&bar[XB_TMO])) break; if (sp > XB_SPIN_CAP) { atomicAdd(&bar[XB_TMO], 1u); break; } }
    }
    nloc = mine > 0u ? mine : 1u; nx = cnt > 0u ? cnt : 1u;
}
__device__ __forceinline__ void xcd_barrier(const XcdBarrier& b) {
    asm volatile("s_waitcnt vmcnt(0)" ::: "memory");
    __syncthreads();
    if (threadIdx.x == 0) {
        unsigned* bar = b.bar;
        __builtin_amdgcn_s_waitcnt(0);
        unsigned nloc = b.st[0], nx = b.st[1];
        if (nloc == 0u) { unsigned xo = b.x; asm volatile("" : "+s"(xo)); xcd_barrier_complete(bar, xo, nloc, nx); b.st[0] = nloc; b.st[1] = nx; }
        const unsigned old = xb_add(&bar[XB_XSUB(b.x)], 1u);
        const unsigned gen = old / nloc;
        if (old + 1u == (gen + 1u) * nloc) {
            __builtin_amdgcn_fence(__ATOMIC_RELEASE, "agent");
            asm volatile("s_waitcnt vmcnt(0)" ::: "memory");
            const unsigned og = xb_add(&bar[XB_TOP], 1u);
            const unsigned tg = og / nx;
            if (og + 1u == (tg + 1u) * nx) xb_add(&bar[XB_TOPGEN], 1u);
            else XB_SPIN(xb_ld(&bar[XB_TOPGEN]) == tg, bar);
            __builtin_amdgcn_fence(__ATOMIC_ACQUIRE, "agent");
            xb_add(&bar[XB_XGEN(b.x)], 1u);
            asm volatile("s_waitcnt vmcnt(0)" ::: "memory");
        } else {
            XB_SPIN(xb_ld(&bar[XB_XGEN(b.x)]) == gen, bar);
            __builtin_amdgcn_fence(__ATOMIC_ACQUIRE, "agent");
            asm volatile("s_waitcnt vmcnt(0)" ::: "memory");
        }
    }
    __syncthreads();
}

namespace g8 {
constexpr int BM = 256, BK = 64, HALF = 128, HTB = HALF * BK * 2, STAGE_BYTES = 8 * HTB;
__device__ __forceinline__ int lds_byte(int r, int c) { const int st = (r >> 4) * 2 + (c >> 5), rr = r & 15, cc = c & 31, ob = rr * 64 + cc * 2; return st * 1024 + (ob ^ (((ob >> 9) & 1) << 5)); }
__device__ __forceinline__ void stage_rc(int b, int& R, int& C) { const int st = b / 1024, sb = b % 1024, swz = sb ^ (((sb >> 9) & 1) << 5); R = (st >> 1) * 16 + swz / 64; C = (st & 1) * 32 + (swz % 64) / 2; }
__device__ __forceinline__ int perm32(int rho) { const int n = rho >> 4, i = rho & 15; return 8 * (i >> 2) + 4 * n + (i & 3); }

struct Unit { const char* a; const char* b; char* o; int kind, pm, pn, e; };
__device__ __forceinline__ void dma4(const void* g, LAS unsigned char* l) { __builtin_amdgcn_global_load_lds((const unsigned*)g, (LAS unsigned*)l, 4, 0, 0); }

__device__ __forceinline__ int xcd_remap(int L, int nu) { const int q = nu / 8, r = nu % 8, xcd = L % 8, off = L / 8; return (xcd < r ? xcd * (q + 1) : r * (q + 1) + (xcd - r) * q) + off; }

template <class Epi, class Sched, bool GATHER, bool FP8 = false>
__device__ __forceinline__ void gemm_phase(LAS unsigned char* lds, const int K, const Sched& S, const Epi& E) {
    const int tid = tid_(), wid = __builtin_amdgcn_readfirstlane(tid >> 6), lane = tid & 63, wr = wid >> 2, wc = wid & 3, fr = lane & 15, fq = lane >> 4;
    const int nt = K / BK;
    size_t kstep = (size_t)(BK * 2);
    if constexpr (GATHER) { if (S.kz) kstep = 0; }
    const size_t hstep = (size_t)HALF * K * 2;
    const unsigned ldsw = (unsigned)wid * 1024u;
    const int aoff = lds_byte(wr * 64 + fr, fq * 8), boff = lds_byte(wc * 32 + fr, fq * 8);
#define G8_SA(b, h) (((b) * 2 + (h)) * HTB)
#define G8_SB(b, h) ((4 + (b) * 2 + (h)) * HTB)
    const unsigned K2 = (unsigned)K * 2u, urow = (unsigned)(wid >> 1) * 16u, ucol = (unsigned)(wid & 1) * 64u;
    const unsigned uA0 = urow * K2 + ucol, uA1 = (urow + 64u) * K2 + ucol;
    const unsigned uB0 = Epi::PERM ? ((urow & ~31u) + 4u * ((unsigned)(wid >> 1) & 1u)) * K2 + ucol : uA0, uB1 = Epi::PERM ? (((urow + 64u) & ~31u) + 4u * ((unsigned)(wid >> 1) & 1u)) * K2 + ucol : uA1;
#define G8_OFFS(h) const unsigned ln_ = (unsigned)tid_() & 63u; const unsigned cl_ = (((ln_ & 3u) << 3) ^ ((ln_ >> 5) << 4)) * 2u; \
        const unsigned la_ = (ln_ >> 2) * K2 + cl_; const unsigned lb_ = Epi::PERM ? (8u * (ln_ >> 4) + ((ln_ >> 2) & 3u)) * K2 + cl_ : la_; (void)la_; (void)lb_; \
        unsigned ro_[2] = {0u, 0u}; if constexpr (GATHER) { _Pragma("unroll") for (int _i = 0; _i < 2; ++_i) ro_[_i] = ROFF[parA * 256 + (h) * 128 + (int)urow + 64 * _i + (int)(ln_ >> 2)]; }
#define G8_LD2(bufoff, g0, g1, o0, o1) do { _Pragma("unroll") for (int _i = 0; _i < 2; ++_i) { unsigned _vo = _i ? (o1) : (o0); asm volatile("" : "+v"(_vo)); \
        __builtin_amdgcn_global_load_lds((const unsigned*)((const char*)(_i ? (g1) : (g0)) + _vo), (LAS unsigned*)(lds + (bufoff) + ldsw + _i * 8192), 16, 0, 0); } } while (0)
#define G8_STB(bufoff, gbase) G8_LD2(bufoff, (gbase) + uB0, (gbase) + uB1, lb_, lb_)
#define G8_STA(bufoff, gbase, h) do { if constexpr (GATHER) { G8_LD2(bufoff, (gbase) + ucol, (gbase) + ucol, min(ro_[0], S.maxoff) + cl_, min(ro_[1], S.maxoff) + cl_); } \
        else { G8_LD2(bufoff, (gbase) + (h) * hstep + uA0, (gbase) + (h) * hstep + uA1, la_, la_); } } while (0)
#define G8_LDA(dst, dst8, b, h) do { _Pragma("unroll") for (int m = 0; m < 4; ++m) { if constexpr (FP8) { const i32x4 lo_ = *(const LAS i32x4*)(lds + G8_SA(b, h) + aoff + m * 2048), hi_ = *(const LAS i32x4*)(lds + G8_SA(b, h) + aoff + m * 2048 + 1024); dst8[m] = __builtin_shufflevector(lo_, hi_, 0, 1, 2, 3, 4, 5, 6, 7); } \
        else { _Pragma("unroll") for (int k = 0; k < 2; ++k) dst[m][k] = *(const LAS bf16x8*)(lds + G8_SA(b, h) + aoff + m * 2048 + k * 1024); } } } while (0)
#define G8_LDB(dst, dst8, b, h) do { _Pragma("unroll") for (int n = 0; n < 2; ++n) { if constexpr (FP8) { const i32x4 lo_ = *(const LAS i32x4*)(lds + G8_SB(b, h) + boff + n * 2048), hi_ = *(const LAS i32x4*)(lds + G8_SB(b, h) + boff + n * 2048 + 1024); dst8[n] = __builtin_shufflevector(lo_, hi_, 0, 1, 2, 3, 4, 5, 6, 7); } \
        else { _Pragma("unroll") for (int k = 0; k < 2; ++k) dst[n][k] = *(const LAS bf16x8*)(lds + G8_SB(b, h) + boff + n * 2048 + k * 1024); } } } while (0)
#define G8_MMA(ai, bj, At, At8, Bt, Bt8) do { __builtin_amdgcn_s_setprio(1); _Pragma("unroll") for (int m = 0; m < 4; ++m) _Pragma("unroll") for (int n = 0; n < 2; ++n) { \
        if constexpr (FP8) acc[ai][bj][m][n] = __builtin_amdgcn_mfma_scale_f32_16x16x128_f8f6f4(Bt8[n], At8[m], acc[ai][bj][m][n], 0, 0, 0, 0, 0, 0);     \
        else { _Pragma("unroll") for (int k = 0; k < 2; ++k) acc[ai][bj][m][n] = __builtin_amdgcn_mfma_f32_16x16x32_bf16(Bt[n][k], At[m][k], acc[ai][bj][m][n], 0, 0, 0); } } __builtin_amdgcn_s_setprio(0); } while (0)
#define G8_WAIT_V(n) asm volatile("s_waitcnt vmcnt(" #n ")" ::: "memory")
#define G8_WAIT_L(n) asm volatile("s_waitcnt lgkmcnt(" #n ")" ::: "memory")
#define G8_BAR __builtin_amdgcn_s_barrier()
#define G8_SCHED __builtin_amdgcn_sched_barrier(0)
    Unit cur, nxt; int ui = 0;
    if (!S.next(0, cur)) return;
    f32x4 acc[2][2][4][2];
#pragma unroll
    for (int a = 0; a < 2; ++a)
#pragma unroll
        for (int b = 0; b < 2; ++b)
#pragma unroll
            for (int m = 0; m < 4; ++m)
#pragma unroll
                for (int n = 0; n < 2; ++n) acc[a][b][m][n] = (f32x4){0.f, 0.f, 0.f, 0.f};
    bf16x8 At[4][2], B0[2][2], B1[2][2]; i32x8 At8[4], B08[2], B18[2];
    LAS unsigned* ROFF = (LAS unsigned*)(lds + STAGE_BYTES + 1024);
    LAS unsigned* SIDE = (LAS unsigned*)(lds + STAGE_BYTES + 12288);
    int parA = 0;
    if constexpr (GATHER) {
        if (wr == 0) S.roff_dma(cur, tid, (LAS unsigned char*)ROFF + wid * 256);
        asm volatile("s_waitcnt vmcnt(0)" ::: "memory"); __builtin_amdgcn_s_barrier(); asm volatile("" ::: "memory");
    }
    const char* cA = cur.a; const char* cB = cur.b;
    { G8_OFFS(0); G8_STB(G8_SB(0, 0), cB); G8_STB(G8_SB(0, 1), cB + hstep); G8_STA(G8_SA(0, 0), cA, 0); }
    { G8_OFFS(1); G8_STA(G8_SA(0, 1), cA, 1); }
    if (wr == 1) G8_BAR;
    G8_WAIT_V(2); G8_BAR;
    { G8_OFFS(0); G8_STB(G8_SB(1, 0), cB + kstep); G8_STA(G8_SA(1, 0), cA + kstep, 0); G8_STB(G8_SB(1, 1), cB + hstep + kstep); }
    G8_WAIT_V(6); G8_BAR;
#if defined(TIMEPROBE)
    unsigned long long tp_loop = 0ull, tp_t0 = 0ull; const unsigned long long tp_start = __builtin_amdgcn_s_memrealtime(); const unsigned long long tp_c0 = __builtin_amdgcn_s_memtime();
#endif
    for (;;) {
        const bool has_next = S.next(ui + 1, nxt);
#if defined(TIMEPROBE)
        tp_t0 = __builtin_amdgcn_s_memrealtime();
#endif
        const char* nA = has_next ? nxt.a : cA; const char* nB = has_next ? nxt.b : cB;
#pragma clang loop unroll(disable)
        for (int t = 0; t < nt; t += 2) {
            const bool last = (t == nt - 2);
            int to = t; asm volatile("" : "+s"(to));
            const char* a1 = cA + (size_t)(to + 1) * kstep;
            const char* a2 = last ? nA : cA + (size_t)(to + 2) * kstep; const char* b2 = last ? nB : cB + (size_t)(to + 2) * kstep;
            const char* a3 = a2 + kstep; const char* b3 = b2 + kstep;
            if (t == 0 && wr == 0) E.side_dma(cur, tid_(), (LAS unsigned char*)(SIDE + (ui & 1) * 768) + wid * 256);
            if constexpr (GATHER) { if (has_next && t == nt - 4 && wr == 0) S.roff_dma(nxt, tid_(), (LAS unsigned char*)(ROFF + (parA ^ 1) * 256) + wid * 256); }
            { G8_OFFS(1); G8_LDB(B0, B08, 0, 0); G8_LDB(B1, B18, 0, 1); G8_SCHED; G8_LDA(At, At8, 0, 0); G8_STA(G8_SA(1, 1), a1, 1); }
            if constexpr (GATHER) { if (has_next && last) parA ^= 1; }
            G8_WAIT_V(8); G8_WAIT_L(0); G8_BAR; G8_MMA(0, 0, At, At8, B0, B08); G8_MMA(0, 1, At, At8, B1, B18); G8_BAR; G8_SCHED;
            { G8_OFFS(0); G8_LDA(At, At8, 0, 1); G8_STB(G8_SB(0, 0), b2); G8_STB(G8_SB(0, 1), b2 + hstep); G8_STA(G8_SA(0, 0), a2, 0); }
            G8_WAIT_V(8); G8_WAIT_L(0); G8_BAR; G8_MMA(1, 0, At, At8, B0, B08); G8_MMA(1, 1, At, At8, B1, B18); G8_BAR; G8_SCHED;
            { G8_OFFS(1); G8_LDB(B0, B08, 1, 0); G8_LDB(B1, B18, 1, 1); G8_SCHED; G8_LDA(At, At8, 1, 0); G8_STA(G8_SA(0, 1), a2, 1); }
            G8_WAIT_V(8); G8_WAIT_L(0); G8_BAR; G8_MMA(0, 0, At, At8, B0, B08); G8_MMA(0, 1, At, At8, B1, B18); G8_BAR; G8_SCHED;
            { G8_OFFS(0); G8_LDA(At, At8, 1, 1); G8_STB(G8_SB(1, 0), b3); G8_STB(G8_SB(1, 1), b3 + hstep); G8_STA(G8_SA(1, 0), a3, 0); }
            G8_WAIT_V(8); G8_WAIT_L(0); G8_BAR; G8_MMA(1, 0, At, At8, B0, B08); G8_MMA(1, 1, At, At8, B1, B18); G8_BAR; G8_SCHED;
        }
#if defined(TIMEPROBE)
        tp_loop += __builtin_amdgcn_s_memrealtime() - tp_t0;
#endif
        if (wr == 0) G8_BAR;
        E(acc, cur, wr, wc, fr, fq, (const LAS unsigned*)(SIDE + (ui & 1) * 768));
#if defined(EPIREP)
        if constexpr (GATHER) { asm volatile("" ::: "memory"); E(acc, cur, wr, wc, fr, fq, (const LAS unsigned*)(SIDE + (ui & 1) * 768)); }
#endif
        if (!has_next) break;
#pragma unroll
        for (int a = 0; a < 2; ++a)
#pragma unroll
            for (int b = 0; b < 2; ++b)
#pragma unroll
                for (int m = 0; m < 4; ++m)
#pragma unroll
                    for (int n = 0; n < 2; ++n) acc[a][b][m][n] = (f32x4){0.f, 0.f, 0.f, 0.f};
        cur = nxt; cA = nA; cB = nB; ++ui;
        if (wr == 1) G8_BAR;
    }
    G8_WAIT_V(0);
    G8_BAR;
#if defined(TIMEPROBE)
    if constexpr (GATHER) { if (blockIdx.x == 0 && tid == 0) { const unsigned long long tot = __builtin_amdgcn_s_memrealtime() - tp_start, cyc = __builtin_amdgcn_s_memtime() - tp_c0;
        float* dg = (float*)(lds - LDS_BASE + 128);
        (void)dg; S.diag[0] = TIMEPROBE == 5 ? 10.0f * rintf(16.0f * (float)tp_loop / (float)tot) : (TIMEPROBE == 6 ? 10.0f * rintf((float)cyc / (float)tot) : (TIMEPROBE == 7 ? 10.0f * rintf((float)tot / (float)(ui + 1) / 100.0f) : (float)(ui + 1)));     } }
#endif
#undef G8_SA
#undef G8_SB
#undef G8_OFFS
#undef G8_LD2
#undef G8_STB
#undef G8_STA
#undef G8_LDA
#undef G8_LDB
#undef G8_MMA
#undef G8_WAIT_V
#undef G8_WAIT_L
#undef G8_BAR
#undef G8_SCHED
}
}

struct Params {
    const float *x, *c, *ctx, *c_ctx, *w_mod, *b_mod, *norm1_g, *norm2_g, *w_in, *b_in, *conv_a_w, *conv_a_b, *w_rg_r, *b_rg_r, *w_rg_i, *b_rg_i, *rg_lambda,
        *w_pool, *b_pool, *pool_scale, *w_four, *b_four, *conv_d_w, *conv_d_b, *ln_d_g, *ln_d_b, *w_pw, *b_pw, *w_out, *b_out, *w_router, *b_router,
        *w_gu, *b_gu, *w_down, *b_down, *final_norm_g;
    float* out; unsigned char* ws; int ph_lo, ph_hi;
};
typedef const Params __attribute__((address_space(4)))* CP;
__device__ __forceinline__ CP launder_params() { CP k = (CP)__builtin_amdgcn_kernarg_segment_ptr(); asm volatile("" : "+s"(k)); return k; }
__device__ __forceinline__ int row_mb(int row) { return row < TL ? (row >> 12) : 8; }

template <class RowMap>
__device__ __forceinline__ void tr_block(const float* __restrict__ src, int spitch, int k0, int n0, bf16_t* __restrict__ dst, int dpitch, int kd0, RowMap rm, LAS unsigned char* lds) {
    LAS unsigned* T = (LAS unsigned*)lds;
    const int tid = tid_();
    __syncthreads();
#pragma unroll
    for (int it = 0; it < 4; ++it) { const int task = it * 512 + tid, q = task & 63, kp = task >> 6;
        const f32x4 v0 = *(const f32x4*)(src + (size_t)(k0 + 2 * kp) * spitch + n0 + 4 * q), v1 = *(const f32x4*)(src + (size_t)(k0 + 2 * kp + 1) * spitch + n0 + 4 * q);
        u32x4 w; w.x = cvt_pk_bf16(v0[0], v1[0]); w.y = cvt_pk_bf16(v0[1], v1[1]); w.z = cvt_pk_bf16(v0[2], v1[2]); w.w = cvt_pk_bf16(v0[3], v1[3]);
        *(LAS u32x4*)(T + kp * 260 + 4 * q) = w; }
    __syncthreads();
#pragma unroll
    for (int it = 0; it < 4; ++it) { const int n = tid & 255, c = (tid >> 8) * 4 + it;
        u32x4 w; w.x = T[(4 * c + 0) * 260 + n]; w.y = T[(4 * c + 1) * 260 + n]; w.z = T[(4 * c + 2) * 260 + n]; w.w = T[(4 * c + 3) * 260 + n];
        *(u32x4*)(dst + (size_t)rm(n0 + n) * dpitch + kd0 + 8 * c) = w; }
}
template <class RowMap>
__device__ __forceinline__ void tr_block8(const float* __restrict__ src, int spitch, int k0, int n0, unsigned char* __restrict__ dst, int dpitch, int kd0, RowMap rm, LAS unsigned char* lds) {
    LAS unsigned* T = (LAS unsigned*)lds;
    const int tid = tid_();
    __syncthreads();
#pragma unroll
    for (int it = 0; it < 4; ++it) { const int task = it * 512 + tid, q = task & 63, kq = task >> 6; f32x4 v[4];
#pragma unroll
        for (int r = 0; r < 4; ++r) v[r] = *(const f32x4*)(src + (size_t)(k0 + 4 * kq + r) * spitch + n0 + 4 * q) * 64.0f;
        u32x4 w; w.x = pk4_fp8(v[0][0], v[1][0], v[2][0], v[3][0]); w.y = pk4_fp8(v[0][1], v[1][1], v[2][1], v[3][1]); w.z = pk4_fp8(v[0][2], v[1][2], v[2][2], v[3][2]); w.w = pk4_fp8(v[0][3], v[1][3], v[2][3], v[3][3]);
        *(LAS u32x4*)(T + kq * 260 + 4 * q) = w; }
    __syncthreads();
#pragma unroll
    for (int it = 0; it < 4; ++it) { const int n = tid & 255, c = (tid >> 8) * 4 + it;
        u32x4 w; w.x = T[(4 * c + 0) * 260 + n]; w.y = T[(4 * c + 1) * 260 + n]; w.z = T[(4 * c + 2) * 260 + n]; w.w = T[(4 * c + 3) * 260 + n];
        *(u32x4*)(dst + (size_t)rm(n0 + n) * dpitch + kd0 + 16 * c) = w; }
}
struct RmId { int off; __device__ __forceinline__ int operator()(int n) const { return n + off; } };
struct RmGu { __device__ __forceinline__ int operator()(int n) const { const int rem = n & 1023; return 256 * (rem >> 7) + 128 * (n >> 10) + (rem & 127); } };
struct RmIn { __device__ __forceinline__ int operator()(int n) const { return n < 512 ? n : n - 1024 + 768; } };

__device__ __forceinline__ void job_mod(CP p, int l, int cb, LAS unsigned char* lds) {
    LAS float* SC = (LAS float*)lds;
    LAS float* RED = (LAS float*)(lds + 49152);
    const int tid = tid_();
    __syncthreads();
    for (int i = tid; i < 9 * 1024; i += 512) { const int b = i >> 10, k = i & 1023; const float v = b < 8 ? p->c[b * 1024 + k] : p->c_ctx[k]; SC[k * 12 + b] = v * sigmoidf_(v); }
    __syncthreads();
    const int col = cb * 64 + (tid & 63), kg = tid >> 6;
    float acc[9];
#pragma unroll
    for (int b = 0; b < 9; ++b) acc[b] = 0.f;
    const float* wp = p->w_mod + (size_t)l * 1024 * 6144 + col;
#pragma unroll 8
    for (int kk = 0; kk < 128; ++kk) { const int k = kg * 128 + kk; const float w = wp[(size_t)k * 6144];
        const f32x4 s0 = *(const LAS f32x4*)(SC + k * 12), s1 = *(const LAS f32x4*)(SC + k * 12 + 4); const float s8 = SC[k * 12 + 8];
        acc[0] += s0[0] * w; acc[1] += s0[1] * w; acc[2] += s0[2] * w; acc[3] += s0[3] * w; acc[4] += s1[0] * w; acc[5] += s1[1] * w; acc[6] += s1[2] * w; acc[7] += s1[3] * w; acc[8] += s8 * w; }
#pragma unroll
    for (int b = 0; b < 9; ++b) RED[(kg * 9 + b) * 64 + (tid & 63)] = acc[b];
    __syncthreads();
    for (int i = tid; i < 9 * 64; i += 512) { const int b = i >> 6, cc = i & 63; float s = 0.f;
#pragma unroll
        for (int g = 0; g < 8; ++g) s += RED[(g * 9 + b) * 64 + cc];
        ((float*)(p->ws + WS_MODV))[(size_t)(l * 9 + b) * 6144 + cb * 64 + cc] = s + p->b_mod[l * 6144 + cb * 64 + cc]; }
}
__device__ __forceinline__ void job_fold_out(CP p, int l, int nb, LAS unsigned char* lds) {
    LAS float* WO = (LAS float*)lds;
    LAS float* PW = (LAS float*)(lds + 65536);
    const int tid = tid_(), lane = tid & 63, w = __builtin_amdgcn_readfirstlane(tid >> 6);
    __syncthreads();
#pragma unroll
    for (int it = 0; it < 8; ++it) { const int task = it * 512 + tid, j = task >> 4, q = task & 15;
        *(LAS f32x4*)(WO + j * 64 + 4 * q) = *(const f32x4*)(p->w_out + ((size_t)l * 1024 + 768 + j) * 1024 + nb * 64 + 4 * q); }
    float acc[32];
#pragma unroll
    for (int i = 0; i < 32; ++i) acc[i] = 0.f;
    for (int jc = 0; jc < 4; ++jc) {
        __syncthreads();
#pragma unroll
        for (int it = 0; it < 8; ++it) { const int task = it * 512 + tid, i = task & 255, jq = task >> 8;
            const f32x4 v = *(const f32x4*)(p->w_pw + ((size_t)l * 256 + i) * 256 + jc * 64 + 4 * jq);
            PW[(4 * jq + 0) * 256 + i] = v[0]; PW[(4 * jq + 1) * 256 + i] = v[1]; PW[(4 * jq + 2) * 256 + i] = v[2]; PW[(4 * jq + 3) * 256 + i] = v[3]; }
        __syncthreads();
        for (int jj = 0; jj < 64; ++jj) { const float b = WO[(jc * 64 + jj) * 64 + lane];
#pragma unroll
            for (int i4 = 0; i4 < 8; ++i4) { const f32x4 a = *(const LAS f32x4*)(PW + jj * 256 + 32 * w + 4 * i4);
                acc[4 * i4 + 0] += a[0] * b; acc[4 * i4 + 1] += a[1] * b; acc[4 * i4 + 2] += a[2] * b; acc[4 * i4 + 3] += a[3] * b; } }
    }
    bf16_t* dst = (bf16_t*)(p->ws + WS_WOUTT) + ((size_t)l * 1024 + nb * 64 + lane) * 1024 + 768 + 32 * w;
#pragma unroll
    for (int c = 0; c < 4; ++c) { float f[8];
#pragma unroll
        for (int e = 0; e < 8; ++e) f[e] = acc[8 * c + e];
        *(u32x4*)(dst + 8 * c) = pack8(f); }
    if (w == 0) { float s = p->b_out[l * 1024 + nb * 64 + lane];
        for (int j = 0; j < 256; ++j) s += p->b_pw[l * 256 + j] * WO[j * 64 + lane];
        ((float*)(p->ws + WS_BOUT))[l * 1024 + nb * 64 + lane] = s; }
}
__device__ __forceinline__ void job_fold_in(CP p, int l, int f, int g, int kb, LAS unsigned char* lds) {
    LAS float* M = (LAS float*)lds;
    LAS float* WI = (LAS float*)(lds + 16384);
    const int tid = tid_();
    const int cbase = f == 0 ? 512 : 768;
    LAS float* TRG = (LAS float*)(lds + 16384 + 256 * 65 * 4);
    __syncthreads();
    if (tid < 64) TRG[tid] = f == 2 ? sinpif((float)tid * (1.0f / 32.0f)) : cospif((float)tid * (1.0f / 32.0f));
    __syncthreads();
#pragma unroll
    for (int it = 0; it < 8; ++it) { const int id = it * 512 + tid, i = id >> 6, j = id & 63; float s;
        if (f == 0) s = p->w_pool[(((size_t)l * 4 + g) * 64 + i) * 64 + j];
        else { s = 0.f; for (int m = 0; m < 64; ++m) s += TRG[(i * m) & 63] * p->w_four[(((size_t)l * 4 + g) * 64 + m) * 64 + j]; }
        M[i * 64 + j] = s; }
#pragma unroll
    for (int it = 0; it < 8; ++it) { const int task = it * 512 + tid, kk = task >> 4, i4 = task & 15;
        const f32x4 v = *(const f32x4*)(p->w_in + ((size_t)l * 1024 + kb * 256 + kk) * 1536 + cbase + 64 * g + 4 * i4);
        WI[kk * 65 + 4 * i4 + 0] = v[0]; WI[kk * 65 + 4 * i4 + 1] = v[1]; WI[kk * 65 + 4 * i4 + 2] = v[2]; WI[kk * 65 + 4 * i4 + 3] = v[3]; }
    __syncthreads();
    const int kk = tid & 255, jh = tid >> 8;
    float acc[32];
#pragma unroll
    for (int j = 0; j < 32; ++j) acc[j] = 0.f;
    for (int i = 0; i < 64; ++i) { const float a = WI[kk * 65 + i];
#pragma unroll
        for (int j4 = 0; j4 < 8; ++j4) { const f32x4 m = *(const LAS f32x4*)(M + i * 64 + 32 * jh + 4 * j4);
            acc[4 * j4 + 0] += a * m[0]; acc[4 * j4 + 1] += a * m[1]; acc[4 * j4 + 2] += a * m[2]; acc[4 * j4 + 3] += a * m[3]; } }
    bf16_t* dst = f == 0 ? (bf16_t*)(p->ws + WS_WINT) + ((size_t)l * NPROJ + 512 + 64 * g) * 1024 : (bf16_t*)(p->ws + WS_WFT) + ((size_t)l * 512 + (f - 1) * 256 + 64 * g) * 1024;
#pragma unroll
    for (int j = 0; j < 32; ++j) dst[(size_t)(32 * jh + j) * 1024 + kb * 256 + kk] = f2bf(acc[j]);
    if (kb == 0 && f >= 1 && tid < 64) { float s = 0.f;
        for (int i = 0; i < 64; ++i) s += p->b_in[l * 1536 + 768 + 64 * g + i] * M[i * 64 + tid];
        ((float*)(p->ws + WS_BF))[l * 512 + (f - 1) * 256 + 64 * g + tid] = s; }
    if (kb == 0 && f == 0 && g == 0) for (int i = tid; i < NPROJ; i += 512)
        ((float*)(p->ws + WS_BIN))[l * NPROJ + i] = i < 512 ? p->b_in[l * 1536 + i] : (i < 768 ? 0.f : p->b_in[l * 1536 + i - 768 + 1024]);
}
__device__ __forceinline__ void job_small(CP p, int j) {
    const int tid = tid_();
    if (j < 32) {
        const int l = j >> 4, d = (j >> 3) & 1, gate = (j >> 2) & 1, hd = j & 3;
        const float* src = (gate ? p->w_rg_i : p->w_rg_r) + ((size_t)((l * 2 + d) * 4 + hd)) * 4096;
        bf16_t* dst = (bf16_t*)(p->ws + WS_WGT) + (size_t)j * 4096;
        for (int id = tid; id < 4096; id += 512) { const int n = id >> 6, k = id & 63; dst[id] = f2bf(src[k * 64 + n]); }
        return; }
    j -= 32;
    if (j < 2) {
        const int l = j; bf16_t* hi = (bf16_t*)(p->ws + WS_WRT) + (size_t)l * 2 * NE * 1024; bf16_t* lo = hi + NE * 1024;
        for (int id = tid; id < NE * 1024; id += 512) { const int e = id >> 10, c = id & 1023; const float v = p->w_router[((size_t)l * 1024 + c) * NE + e];
            const bf16_t h = f2bf(v); hi[id] = h; lo[id] = f2bf(v - bf2f(h)); }
        return; }
    j -= 2;
    if (j < 144 + 128) {
        const bool sn = j >= 144; const int r0 = (sn ? j - 144 : j) * 16; unsigned* dst = (unsigned*)(p->ws + (sn ? WS_SMAT : WS_CMAT));
        for (int id = tid; id < 16 * 1024; id += 512) { const int k = r0 + (id >> 10), t4 = (id & 1023) * 4; float v[4];
#pragma unroll
            for (int e = 0; e < 4; ++e) { const float ang = (float)((k * (t4 + e)) & 4095) * (1.0f / 2048.0f); v[e] = 64.0f * (sn ? sinpif(ang) : cospif(ang)); }
            dst[((size_t)k * 4096 + t4) >> 2] = pk4_fp8(v[0], v[1], v[2], v[3]); }
        return; }
    j -= 272;
    if (j == 1) {
        float* dst = (float*)(p->ws + WS_POS);
        for (int id = tid; id < 64 * 512; id += 512) { const int pp = id >> 9, jj = id & 511, i = jj & 255; const float a = (float)pp * exp2f(-(float)i * (13.287712379549449f / 256.0f));
            dst[id] = jj < 256 ? sinf(a) : cosf(a); }
        return; }
    {
        unsigned* dst = (unsigned*)(p->ws + WS_DFTC);
        for (int id = tid; id < 256 * 128; id += 512) { const int k = id >> 7, j4 = (id & 127) * 4; float v[4];
#pragma unroll
            for (int e = 0; e < 4; ++e) { const int jj = j4 + e, t = jj & 255; const float ang = (float)((k * t) & 255) * (1.0f / 128.0f); v[e] = 64.0f * (jj < 256 ? cospif(ang) : -sinpif(ang)); }
            dst[id] = pk4_fp8(v[0], v[1], v[2], v[3]); }
    }
}
#ifndef MOE_W_IN_QUEUE
#define MOE_W_IN_QUEUE 0
#endif
constexpr bool fp8_layer(int l) { return l >= FP8_FROM; }
constexpr int J_TGU_L(int l) { return fp8_layer(l) ? 32 * 8 * 8 : 32 * 16 * 8; }
constexpr int J_TD_L(int l) { return fp8_layer(l) ? 32 * 8 * 4 : 32 * 16 * 4; }
constexpr int J_MOD = 192, J_FOUT = 32, J_FIN = 96, J_SMALL = 32 + 2 + 272 + 2, J_TIN = 128, J_TOUT = 96, J_TGU = J_TGU_L(0) + J_TGU_L(1), J_TD = J_TD_L(0) + J_TD_L(1);
static_assert(!MOE_W_IN_QUEUE || (J_TGU_L(0) + J_TD_L(0) <= 6 * NCHUNK && J_TGU_L(1) + J_TD_L(1) <= 6 * NCHUNK), "the phase-3 queue interleaves at most 2 weight jobs per compute unit: needs fp8 expert weights in both layers");
constexpr int J_TOTAL = J_MOD + J_FOUT + J_FIN + J_SMALL + J_TIN + J_TOUT + (MOE_W_IN_QUEUE ? 0 : J_TGU + J_TD);
template <class RowMap>
__device__ __forceinline__ void tr8_slab(const float* __restrict__ src, int spitch, int k0, int n4, unsigned char* __restrict__ dst, int dpitch, RowMap rm) {
    f32x4 v[16];
#pragma unroll
    for (int r = 0; r < 16; ++r) v[r] = *(const f32x4*)(src + (size_t)(k0 + r) * spitch + n4) * 64.0f;
#pragma unroll
    for (int j = 0; j < 4; ++j) { u32x4 w; w.x = pk4_fp8(v[0][j], v[1][j], v[2][j], v[3][j]); w.y = pk4_fp8(v[4][j], v[5][j], v[6][j], v[7][j]); w.z = pk4_fp8(v[8][j], v[9][j], v[10][j], v[11][j]); w.w = pk4_fp8(v[12][j], v[13][j], v[14][j], v[15][j]);
        *(u32x4*)(dst + (size_t)rm(n4 + j) * dpitch + k0) = w; }
}
struct W8Job { const float* src; unsigned char* dst; int spitch, gu; };
__device__ __forceinline__ bool w8_job(CP p, int jm, W8Job& J, int& n0) {
    constexpr int PER_L = 32 * 64 + 32 * 32; if (jm >= 2 * PER_L) return false;
    const int l = jm / PER_L; int jj = jm - l * PER_L;
    if (jj < 32 * 64) { const int e = jj >> 6, r = jj & 63, kb = r >> 3, q = r & 7; J.spitch = 2048; J.gu = 1; n0 = q * 256;
        J.src = p->w_gu + ((size_t)(l * NE + e) * 1024 + kb * 128) * 2048 + n0; J.dst = p->ws + WS_WGUT + (size_t)l * NE * 2048 * 2048 + (size_t)e * 2048 * 1024 + kb * 128; }
    else { jj -= 32 * 64; const int e = jj >> 5, r = jj & 31, kb = r >> 2, q = r & 3; J.spitch = 1024; J.gu = 0; n0 = q * 256;
        J.src = p->w_down + ((size_t)(l * NE + e) * 1024 + kb * 128) * 1024 + n0; J.dst = p->ws + WS_WDT + (size_t)l * NE * 1024 * 2048 + (size_t)e * 1024 * 1024 + kb * 128; }
    return true;
}
__device__ __forceinline__ void w8_load(const W8Job& J, int tid, f32x4 (&v)[4][4]) {
#pragma unroll
    for (int it = 0; it < 4; ++it) { const int task = it * 512 + tid, q = task & 63, kq = task >> 6;
#pragma unroll
        for (int r = 0; r < 4; ++r) v[it][r] = *(const f32x4*)(J.src + (size_t)(4 * kq + r) * J.spitch + 4 * q); }
}
__device__ __forceinline__ void w8_finish(const W8Job& J, int n0, int tid, const f32x4 (&v)[4][4], LAS unsigned char* lds) {
    LAS unsigned* T = (LAS unsigned*)lds;
    __syncthreads();
#pragma unroll
    for (int it = 0; it < 4; ++it) { const int task = it * 512 + tid, q = task & 63, kq = task >> 6;
        u32x4 w; w.x = pk4_fp8(v[it][0][0] * 64.f, v[it][1][0] * 64.f, v[it][2][0] * 64.f, v[it][3][0] * 64.f); w.y = pk4_fp8(v[it][0][1] * 64.f, v[it][1][1] * 64.f, v[it][2][1] * 64.f, v[it][3][1] * 64.f);
        w.z = pk4_fp8(v[it][0][2] * 64.f, v[it][1][2] * 64.f, v[it][2][2] * 64.f, v[it][3][2] * 64.f); w.w = pk4_fp8(v[it][0][3] * 64.f, v[it][1][3] * 64.f, v[it][2][3] * 64.f, v[it][3][3] * 64.f);
        *(LAS u32x4*)(T + kq * 260 + 4 * q) = w; }
    __syncthreads();
    if (tid < 256) {
        const int n = tid, nn = n0 + n; const int row = J.gu ? RmGu{}(nn) : nn; u32x4 w[8];
#pragma unroll
        for (int c = 0; c < 8; ++c) { w[c].x = T[(4 * c + 0) * 260 + n]; w[c].y = T[(4 * c + 1) * 260 + n]; w[c].z = T[(4 * c + 2) * 260 + n]; w[c].w = T[(4 * c + 3) * 260 + n]; }
#pragma unroll
        for (int c = 0; c < 8; ++c) *(u32x4*)(J.dst + (size_t)row * 1024 + 16 * c) = w[c]; }
}
__device__ __forceinline__ void moe_weight_job(CP p, int l, int jj, LAS unsigned char* lds) {
    const bool f8 = l >= FP8_FROM;
    if (jj < (f8 ? 32 * 8 * 8 : 32 * 16 * 8)) { const float* src = p->w_gu + (size_t)l * NE * 1024 * 2048; unsigned char* dstb = p->ws + WS_WGUT + (size_t)l * NE * 2048 * 2048;
        if (f8) { const int e = jj >> 6, r = jj & 63, kb = r >> 3, q = r & 7; tr_block8(src + (size_t)e * 1024 * 2048, 2048, kb * 128, q * 256, dstb + (size_t)e * 2048 * 1024, 1024, kb * 128, RmGu{}, lds); }
        else { const int e = jj >> 7, r = jj & 127, kb = r >> 3, q = r & 7; tr_block(src + (size_t)e * 1024 * 2048, 2048, kb * 64, q * 256, (bf16_t*)dstb + (size_t)e * 2048 * 1024, 1024, kb * 64, RmGu{}, lds); }
        return; }
    jj -= (f8 ? 32 * 8 * 8 : 32 * 16 * 8);
    { const float* src = p->w_down + (size_t)l * NE * 1024 * 1024; unsigned char* dstb = p->ws + WS_WDT + (size_t)l * NE * 1024 * 2048;
        if (f8) { const int e = jj >> 5, r = jj & 31, kb = r >> 2, q = r & 3; tr_block8(src + (size_t)e * 1024 * 1024, 1024, kb * 128, q * 256, dstb + (size_t)e * 1024 * 1024, 1024, kb * 128, RmId{0}, lds); }
        else { const int e = jj >> 6, r = jj & 63, kb = r >> 2, q = r & 3; tr_block(src + (size_t)e * 1024 * 1024, 1024, kb * 64, q * 256, (bf16_t*)dstb + (size_t)e * 1024 * 1024, 1024, kb * 64, RmId{0}, lds); } }
}
constexpr bool W8_PIPE = (FP8_FROM == 0) && !MOE_W_IN_QUEUE;
#ifndef PRO_PART
#define PRO_PART 0
#endif
__device__ __forceinline__ int q_pull(unsigned* head, LAS int* slot) {
    __syncthreads(); if (tid_() == 0) *slot = (int)__hip_atomic_fetch_add(head, 1u, __ATOMIC_RELAXED, __HIP_MEMORY_SCOPE_AGENT); __syncthreads();
    return __builtin_amdgcn_readfirstlane(*slot);
}
__device__ __forceinline__ void phase_prologue(CP p, LAS unsigned char* lds, int rep) {
    unsigned* qs = (unsigned*)(p->ws + WS_CTL) + CW_QUEUE + (4 + rep) * 64; unsigned* qw = (unsigned*)(p->ws + WS_CTL) + CW_QUEUE + (6 + rep) * 64; LAS int* qslot = (LAS int*)(lds - LDS_BASE + 64);
    const int njobs = (rep && PRO_PART == 1) ? 0 : J_TOTAL - (W8_PIPE ? J_TGU + J_TD : 0);
    if (!W8_PIPE || (blockIdx.x & 1) == 0) for (;;) {
        int j = q_pull(qs, qslot); if (j >= njobs) break;
        if (j < J_FIN) { const int l = j / 48, r = j % 48; job_fold_in(p, l, r / 16, (r >> 2) & 3, r & 3, lds); continue; } j -= J_FIN;
        if (j < J_FOUT) { job_fold_out(p, j >> 4, j & 15, lds); continue; } j -= J_FOUT;
        if (j < J_MOD) { job_mod(p, j / 96, j % 96, lds); continue; } j -= J_MOD;
        if (j < J_SMALL) { job_small(p, j); continue; } j -= J_SMALL;
        if (j < J_TIN) { const int l = j >> 6, r = j & 63, kb = r >> 2, q = r & 3;
            tr_block(p->w_in + (size_t)l * 1024 * 1536, 1536, kb * 64, q < 2 ? q * 256 : 1024 + (q - 2) * 256, (bf16_t*)(p->ws + WS_WINT) + (size_t)l * NPROJ * 1024, 1024, kb * 64, RmIn{}, lds); continue; } j -= J_TIN;
        if (j < J_TOUT) { const int l = j / 48, r = j % 48, kb = r >> 2, q = r & 3;
            tr_block(p->w_out + (size_t)l * 1024 * 1024, 1024, kb * 64, q * 256, (bf16_t*)(p->ws + WS_WOUTT) + (size_t)l * 1024 * 1024, 1024, kb * 64, RmId{0}, lds); continue; } j -= J_TOUT;
        moe_weight_job(p, j < J_TGU_L(0) + J_TD_L(0) ? 0 : 1, j < J_TGU_L(0) + J_TD_L(0) ? j : j - J_TGU_L(0) - J_TD_L(0), lds);
    }
    if (W8_PIPE && !(rep && PRO_PART == 2)) { const int tid = tid_(); W8Job Jc, Jn; int nc = 0, nn_ = 0; f32x4 va[4][4], vb[4][4];
        bool okc = w8_job(p, q_pull(qw, qslot), Jc, nc); if (okc) w8_load(Jc, tid, va);
        while (okc) {
            const bool okn = w8_job(p, q_pull(qw, qslot), Jn, nn_); if (okn) w8_load(Jn, tid, vb);
            w8_finish(Jc, nc, tid, va, lds);
            if (!okn) break;
            okc = w8_job(p, q_pull(qw, qslot), Jc, nc); if (okc) w8_load(Jc, tid, va);
            w8_finish(Jn, nn_, tid, vb, lds); } }
}

__device__ __forceinline__ void phase_norm(CP p, int mode) {
    const int tid = tid_(), lane = tid & 63, wid = tid >> 6;
    bf16_t* X = (bf16_t*)(p->ws + WS_X); bf16_t* U = (bf16_t*)(p->ws + WS_U); const bf16_t* YS = (const bf16_t*)(p->ws + WS_YS); const float* modv = (const float*)(p->ws + WS_MODV);
    const float* POS = (const float*)(p->ws + WS_POS);
    const int nrows = mode == 2 ? TL : TT;
    const int lprev = mode == 2 ? 1 : 0, lcur = mode == 0 ? 0 : 1;
    const int nw = (int)gridDim.x * 8;
    for (int rowa = blockIdx.x * 8 + wid; rowa < nrows; rowa += 2 * nw) {
        int rows[2]; bool ok[2]; f32x4 v[2][4];
#pragma unroll
        for (int rb = 0; rb < 2; ++rb) { const int r = rowa + rb * nw; ok[rb] = r < nrows; rows[rb] = ok[rb] ? r : rowa; }
        if (mode == 0) {
#pragma unroll
            for (int rb = 0; rb < 2; ++rb) { const int row = rows[rb]; const float* src = row < TL ? p->x + (size_t)row * D : p->ctx + (size_t)(row - TL) * D;
#pragma unroll
                for (int j = 0; j < 4; ++j) v[rb][j] = __builtin_nontemporal_load((const f32x4*)(src + 256 * j + 4 * lane)); }
#pragma unroll
            for (int rb = 0; rb < 2; ++rb) { const int row = rows[rb]; if (row < TL) { const int t = row & 4095;
#pragma unroll
                    for (int j = 0; j < 4; ++j) v[rb][j] += *(const f32x4*)(POS + (size_t)(j < 2 ? (t >> 6) : (t & 63)) * 512 + (j & 1) * 256 + 4 * lane); } }
        } else {
            unsigned ys[2][4][4]; u32x2 y2[2][4]; const bf16_t* Y2 = (const bf16_t*)(p->ws + WS_PROJ);
#pragma unroll
            for (int rb = 0; rb < 2; ++rb) { const int row = rows[rb];
#pragma unroll
                for (int j = 0; j < 4; ++j) { v[rb][j] = ld4bf(X + (size_t)row * D + 256 * j + 4 * lane); y2[rb][j] = __builtin_nontemporal_load((const u32x2*)(Y2 + (size_t)row * D + 256 * j + 4 * lane));
#pragma unroll
                    for (int k = 0; k < 4; ++k) ys[rb][j][k] = __builtin_nontemporal_load((const unsigned*)((const unsigned char*)YS + ((size_t)row * 4 + k) * D + 256 * j + 4 * lane)); } }
#pragma unroll
            for (int rb = 0; rb < 2; ++rb) { const float* g2 = modv + (size_t)(lprev * 9 + row_mb(rows[rb])) * 6144 + 5120;
#pragma unroll
                for (int j = 0; j < 4; ++j) { f32x4 s = {0.f, 0.f, 0.f, 0.f};
#pragma unroll
                    for (int k = 0; k < 4; ++k) { const int w = (int)ys[rb][j][k]; const f32x2 lo = __builtin_amdgcn_cvt_pk_f32_fp8(w, false), hi = __builtin_amdgcn_cvt_pk_f32_fp8(w, true); s[0] += lo.x; s[1] += lo.y; s[2] += hi.x; s[3] += hi.y; }
                    v[rb][j] += (f32x4){bflo(y2[rb][j].x), bfhi(y2[rb][j].x), bflo(y2[rb][j].y), bfhi(y2[rb][j].y)} + *(const f32x4*)(g2 + 256 * j + 4 * lane) * (s * (1.0f / 16.0f)); } }
        }
        float ss[2];
#pragma unroll
        for (int rb = 0; rb < 2; ++rb) { ss[rb] = 0.f;
#pragma unroll
            for (int j = 0; j < 4; ++j) ss[rb] += v[rb][j][0] * v[rb][j][0] + v[rb][j][1] * v[rb][j][1] + v[rb][j][2] * v[rb][j][2] + v[rb][j][3] * v[rb][j][3]; }
#pragma unroll
        for (int o = 32; o >= 1; o >>= 1) { const float t0 = bperm(ss[0], lane ^ o), t1 = bperm(ss[1], lane ^ o); ss[0] += t0; ss[1] += t1; }
#pragma unroll
        for (int rb = 0; rb < 2; ++rb) { if (!ok[rb]) continue; const int row = rows[rb]; const float rstd = __builtin_amdgcn_rsqf(ss[rb] * (1.0f / 1024.0f) + 1e-6f);
            if (mode == 2) {
#pragma unroll
                for (int j = 0; j < 4; ++j) __builtin_nontemporal_store(v[rb][j] * rstd * *(const f32x4*)(p->final_norm_g + 256 * j + 4 * lane), (f32x4*)(p->out + (size_t)row * D + 256 * j + 4 * lane));
            } else { const float* mv = modv + (size_t)(lcur * 9 + row_mb(row)) * 6144;
#pragma unroll
                for (int j = 0; j < 4; ++j) { const int col = 256 * j + 4 * lane;
                    st4bf(X + (size_t)row * D + col, v[rb][j]);
                    const f32x4 g = *(const f32x4*)(p->norm1_g + lcur * D + col), sc = *(const f32x4*)(mv + 1024 + col), sh = *(const f32x4*)(mv + col);
                    const f32x4 u = v[rb][j] * rstd * g * (sc + 1.0f) + sh;
                    u32x2 w; w.x = cvt_pk_bf16(u[0], u[1]); w.y = cvt_pk_bf16(u[2], u[3]); *(u32x2*)(U + (size_t)row * D + col) = w; } }
        }
    }
}

constexpr int HP = 2064;
__device__ __forceinline__ void phase_router(CP p, int l, LAS unsigned char* lds, int rep) {
    LAS unsigned char* HHI = lds;
    LAS float* LG = (LAS float*)(lds + 64 * HP);
    LAS int* hist = (LAS int*)(lds + 64 * HP + 2 * 64 * 33 * 4); LAS int* basee = hist + 32;
    const int tid = tid_(), lane = tid & 63, wid = __builtin_amdgcn_readfirstlane(tid >> 6), fr = lane & 15, fq = lane >> 4;
    const bf16_t* X = (const bf16_t*)(p->ws + WS_X); const bf16_t* Y2 = (const bf16_t*)(p->ws + WS_PROJ);
    bf16_t* U = (bf16_t*)(p->ws + (rep ? WS_ACT + (size_t)TT * D * 4 : WS_U)); const float* modv = (const float*)(p->ws + WS_MODV);
    unsigned char* U8 = p->ws + (rep ? WS_ACT + (size_t)TT * D * 4 : WS_U8);
    unsigned* ctl = (unsigned*)(p->ws + WS_CTL) + (rep ? 4096 : 0); int* rasg = (int*)(p->ws + (rep ? WS_YS : WS_RASG)); float* rgate = (float*)(p->ws + (rep ? WS_YS + (size_t)NE * TT * 4 : WS_RGATE)); unsigned* rroff = (unsigned*)(p->ws + (rep ? WS_YS + (size_t)2 * NE * TT * 4 : WS_RROFF));
    const bf16_t* wrt = (const bf16_t*)(p->ws + WS_WRT) + (size_t)l * 2 * NE * 1024;
    const int ntiles = (l == 0 ? TT : TL) / 64;
    const int mt = wid & 3, kh = wid >> 2;
    bf16x8 Bh[2][16];
#pragma unroll
    for (int nt_ = 0; nt_ < 2; ++nt_) { const bf16_t* bh = wrt + (size_t)(16 * nt_ + fr) * 1024 + kh * 512 + 8 * fq;
#pragma unroll
        for (int s_ = 0; s_ < 16; ++s_) Bh[nt_][s_] = *(const bf16x8*)(bh + s_ * 32); }
    for (int tile = blockIdx.x; tile < ntiles; tile += gridDim.x) {
        const int row0 = tile * 64, mb = row_mb(row0);
        const float* mv = modv + (size_t)(l * 9 + mb) * 6144;
        __syncthreads();
        if (tid < 32) hist[tid] = 0;
        for (int rg = 0; rg < 4; ++rg) { f32x4 v[2][4]; u32x2 y2[2][4]; float ss[2];
#pragma unroll
          for (int rr = 0; rr < 2; ++rr)
#pragma unroll
              for (int j = 0; j < 4; ++j) { const size_t o = (size_t)(row0 + wid * 8 + 2 * rg + rr) * D + 256 * j + 4 * lane; v[rr][j] = ld4bf(X + o); y2[rr][j] = __builtin_nontemporal_load((const u32x2*)(Y2 + o)); }
#pragma unroll
          for (int rr = 0; rr < 2; ++rr) { ss[rr] = 0.f;
#pragma unroll
              for (int j = 0; j < 4; ++j) { v[rr][j] += (f32x4){bflo(y2[rr][j].x), bfhi(y2[rr][j].x), bflo(y2[rr][j].y), bfhi(y2[rr][j].y)};
                  ss[rr] += v[rr][j][0] * v[rr][j][0] + v[rr][j][1] * v[rr][j][1] + v[rr][j][2] * v[rr][j][2] + v[rr][j][3] * v[rr][j][3]; } }
#pragma unroll
          for (int o = 32; o >= 1; o >>= 1) { const float t0_ = bperm(ss[0], lane ^ o), t1_ = bperm(ss[1], lane ^ o); ss[0] += t0_; ss[1] += t1_; }
#pragma unroll
          for (int j = 0; j < 4; ++j) { const int col = 256 * j + 4 * lane;
              const f32x4 g = *(const f32x4*)(p->norm2_g + l * D + col), sc = *(const f32x4*)(mv + 4096 + col), sh = *(const f32x4*)(mv + 3072 + col);
#pragma unroll
              for (int rr = 0; rr < 2; ++rr) { const int r = wid * 8 + 2 * rg + rr; const float rstd = __builtin_amdgcn_rsqf(ss[rr] * (1.0f / 1024.0f) + 1e-6f);
                  const f32x4 h = v[rr][j] * rstd * g * (sc + 1.0f) + sh;
                  u32x2 w; w.x = cvt_pk_bf16(h[0], h[1]); w.y = cvt_pk_bf16(h[2], h[3]);
                  if (fp8_layer(l)) *(unsigned*)(U8 + (size_t)(row0 + r) * D + col) = pk4_fp8(h[0], h[1], h[2], h[3]); else *(u32x2*)(U + (size_t)(row0 + r) * D + col) = w;
                  *(LAS u32x2*)(HHI + r * HP + col * 2) = w; } } }
        __syncthreads();
        { f32x4 acc0 = {0.f, 0.f, 0.f, 0.f}, acc1 = {0.f, 0.f, 0.f, 0.f};
          const LAS unsigned char* ah = HHI + (16 * mt + fr) * HP + (kh * 512 + 8 * fq) * 2;
#pragma unroll
          for (int s_ = 0; s_ < 16; ++s_) { const bf16x8 Ah = *(const LAS bf16x8*)(ah + s_ * 64);
              acc0 = __builtin_amdgcn_mfma_f32_16x16x32_bf16(Ah, Bh[0][s_], acc0, 0, 0, 0); acc1 = __builtin_amdgcn_mfma_f32_16x16x32_bf16(Ah, Bh[1][s_], acc1, 0, 0, 0); }
#pragma unroll
          for (int j = 0; j < 4; ++j) { LG[(kh * 64 + 16 * mt + 4 * fq + j) * 33 + fr] = acc0[j]; LG[(kh * 64 + 16 * mt + 4 * fq + j) * 33 + 16 + fr] = acc1[j]; } }
        __syncthreads();
        int ek[4] = {0, 0, 0, 0}, rk[4] = {0, 0, 0, 0}; float gk[4] = {0.f, 0.f, 0.f, 0.f};
        if (tid < 64) { float lg[32];
#pragma unroll
            for (int e = 0; e < 32; ++e) lg[e] = LG[tid * 33 + e] + LG[(64 + tid) * 33 + e] + p->b_router[l * NE + e];
            float vk[4];
#pragma unroll
            for (int k = 0; k < 4; ++k) { float best = -3.0e38f; int bi = 0;
#pragma unroll
                for (int e = 0; e < 32; ++e) if (lg[e] > best) { best = lg[e]; bi = e; }
                vk[k] = best; ek[k] = bi;
#pragma unroll
                for (int e = 0; e < 32; ++e) if (e == bi) lg[e] = -3.0e38f; }
            float sum = 0.f;
#pragma unroll
            for (int k = 0; k < 4; ++k) { gk[k] = fexp2(1.4426950408889634f * (vk[k] - vk[0])); sum += gk[k]; }
            const float inv = 1.0f / sum;
#pragma unroll
            for (int k = 0; k < 4; ++k) { gk[k] *= inv; rk[k] = __hip_atomic_fetch_add(hist + ek[k], 1, __ATOMIC_RELAXED, __HIP_MEMORY_SCOPE_WORKGROUP); } }
        __syncthreads();
        if (tid < 32) { const int h = hist[tid]; basee[tid] = h ? (int)__hip_atomic_fetch_add(ctl + CW_COUNT + (l * NE + tid) * 64, (unsigned)h, __ATOMIC_RELAXED, __HIP_MEMORY_SCOPE_AGENT) : 0; }
        __syncthreads();
        if (tid < 64) { const int tok = row0 + tid;
#pragma unroll
            for (int k = 0; k < 4; ++k) { const size_t pos = (size_t)ek[k] * TT + basee[ek[k]] + rk[k]; rasg[pos] = tok * 4 + k; rgate[pos] = gk[k]; rroff[pos] = (unsigned)tok * (fp8_layer(l) ? 1024u : 2048u); } }
    }
}

constexpr int XCP = 144;
constexpr int XAP = 528;
struct Seq { int b, jc, L, rowbase, t0; bool lat; };
__device__ __forceinline__ Seq seq_of(int q) { Seq s; s.lat = q < 512; s.b = s.lat ? q >> 6 : (q - 512) >> 2; s.jc = s.lat ? q & 63 : (q - 512) & 3; s.L = s.lat ? SEQ : LCX; s.rowbase = s.lat ? s.b * SEQ : TL + s.b * LCX; s.t0 = s.jc * 64; return s; }
template <int PASS>
__device__ __forceinline__ void scan_unit(CP p, int l, int q, LAS unsigned char* lds) {
    const int tid = tid_(), lane = tid & 63, wid = __builtin_amdgcn_readfirstlane(tid >> 6), d = wid >> 2, hd = wid & 3, fr = lane & 15, fq = lane >> 4;
    LAS unsigned char* XC = lds + wid * (64 * XCP);
    LAS float* CAR = (LAS float*)(lds + 8 * 64 * XCP + wid * 256);
    LAS unsigned char* HB = lds + 8 * 64 * XCP + 2048;
    LAS unsigned char* XA = HB;
    const bf16_t* PROJ = (const bf16_t*)(p->ws + WS_PROJ); float* SUMM = (float*)(p->ws + WS_SUMM);
    const Seq sq = seq_of(q); const int b = sq.b, jc = sq.jc, L = sq.L, rowbase = sq.rowbase, t0 = sq.t0; const bool lat = sq.lat;
    __syncthreads();
    { u32x4 w[5];
#pragma unroll
      for (int it = 0; it < 5; ++it) { const int task = it * 512 + tid, r = task >> 5, cg = task & 31, tt = t0 - 3 + r; w[it] = (u32x4){0u, 0u, 0u, 0u};
          if (task < 70 * 32 && tt >= 0 && tt < L) w[it] = *(const u32x4*)(PROJ + (size_t)(rowbase + tt) * NPROJ + 8 * cg); }
#pragma unroll
      for (int it = 0; it < 5; ++it) { const int task = it * 512 + tid, r = task >> 5, cg = task & 31; if (task < 70 * 32) *(LAS u32x4*)(XA + r * XAP + cg * 16) = w[it]; } }
    bf16x8 Bra[4][2], Bia[4][2];
    { const bf16_t* wg0 = (const bf16_t*)(p->ws + WS_WGT) + (size_t)((l * 2 + d) * 2) * 4 * 4096;
#pragma unroll
      for (int n = 0; n < 4; ++n)
#pragma unroll
          for (int s = 0; s < 2; ++s) { Bra[n][s] = *(const bf16x8*)(wg0 + ((size_t)(0 * 4 + hd) * 64 + 16 * n + fr) * 64 + 32 * s + 8 * fq); Bia[n][s] = *(const bf16x8*)(wg0 + ((size_t)(1 * 4 + hd) * 64 + 16 * n + fr) * 64 + 32 * s + 8 * fq); } }
    float car = 0.f;
    if (PASS == 2) { const int c = 64 * hd + lane;
        const int n = d == 0 ? (lat ? 4 + jc : jc) : (lat ? 4 + 63 - jc : 3 - jc);
        for (int s0 = 0; s0 < n; s0 += 16) { float A_[16], H_[16];
#pragma unroll
            for (int e = 0; e < 16; ++e) { const int s = s0 + e; int qq;
                if (d == 0) qq = (lat && s >= 4) ? b * 64 + (s - 4) : 512 + b * 4 + s; else qq = (lat && s >= 4) ? b * 64 + 63 - (s - 4) : 512 + b * 4 + 3 - s;
                A_[e] = 1.f; H_[e] = 0.f; if (s < n) { const float* sp_ = SUMM + ((size_t)qq * 2 + d) * 512; A_[e] = sp_[c]; H_[e] = sp_[256 + c]; } }
#pragma unroll
            for (int e = 0; e < 16; ++e) car = A_[e] * car + H_[e]; } }
    __syncthreads();
    { const int c = 64 * hd + lane; const float* cw = p->conv_a_w + ((size_t)(l * 2 + d) * 4) * 256 + c;
      const float w0 = cw[0], w1 = cw[256], w2 = cw[512], w3 = cw[768], cb = p->conv_a_b[(l * 2 + d) * 256 + c];
      const float k0 = d ? w3 : w0, k1 = d ? w2 : w1, k2 = d ? w1 : w2, k3 = d ? w0 : w3;
      const LAS unsigned char* xp = XA + (d ? 3 : 0) * XAP + c * 2;
      float xa_ = bf2f(*(const LAS bf16_t*)(xp)), xb_ = bf2f(*(const LAS bf16_t*)(xp + XAP)), xc_ = bf2f(*(const LAS bf16_t*)(xp + 2 * XAP));
#pragma unroll 16
      for (int t = 0; t < 64; ++t) { const float xd_ = bf2f(*(const LAS bf16_t*)(xp + (t + 3) * XAP)); const float v = k0 * xa_ + k1 * xb_ + k2 * xc_ + k3 * xd_ + cb;
          *(LAS bf16_t*)(XC + t * XCP + lane * 2) = f2bf(v); xa_ = xb_; xb_ = xc_; xc_ = xd_; } }
    if (PASS == 2) CAR[lane] = car;
    asm volatile("" ::: "memory");
    if (PASS == 2) __syncthreads();
    float cr[4], at[4], sp[4], brr[4], bii[4];
#pragma unroll
    for (int n = 0; n < 4; ++n) { const int ch = 16 * n + fr; cr[n] = PASS == 2 ? CAR[ch] : 0.f; at[n] = 1.f;
        const float lam = p->rg_lambda[(l * 2 + d) * 256 + 64 * hd + ch]; sp[n] = -8.0f * 1.4426950408889634f * log1pf(__expf(-lam));
        brr[n] = p->b_rg_r[((l * 2 + d) * 4 + hd) * 64 + ch]; bii[n] = p->b_rg_i[((l * 2 + d) * 4 + hd) * 64 + ch]; }
    const bf16_t* wg = (const bf16_t*)(p->ws + WS_WGT) + (size_t)((l * 2 + d) * 2) * 4 * 4096;
    u32x4* ABo = (u32x4*)(p->ws + WS_AB) + ((size_t)q * 8 + wid) * 16 * 64 + lane;
    const int src1 = d ? lane + 16 : lane - 16, src2 = d ? lane + 32 : lane - 32, srct = d ? fr : 48 + fr;
    const bool has1 = d ? fq <= 2 : fq >= 1, has2 = d ? fq <= 1 : fq >= 2;
#pragma unroll
    for (int n = 0; n < 4; ++n) {
        const bf16x8 (&Br)[2] = Bra[n]; const bf16x8 (&Bi)[2] = Bia[n];
        float Hj[4][4], Aj[4][4];
#pragma unroll
        for (int mt = 0; mt < 4; ++mt) {
            const bf16x8 A0 = *(const LAS bf16x8*)(XC + (16 * mt + fr) * XCP + (8 * fq) * 2), A1 = *(const LAS bf16x8*)(XC + (16 * mt + fr) * XCP + (32 + 8 * fq) * 2);
            f32x4 ar = {0.f, 0.f, 0.f, 0.f}, ai = {0.f, 0.f, 0.f, 0.f};
            ar = __builtin_amdgcn_mfma_f32_16x16x32_bf16(A0, Br[0], ar, 0, 0, 0); ar = __builtin_amdgcn_mfma_f32_16x16x32_bf16(A1, Br[1], ar, 0, 0, 0);
            ai = __builtin_amdgcn_mfma_f32_16x16x32_bf16(A0, Bi[0], ai, 0, 0, 0); ai = __builtin_amdgcn_mfma_f32_16x16x32_bf16(A1, Bi[1], ai, 0, 0, 0);
            float a_[4], b_[4], la_[4];
#pragma unroll
            for (int j = 0; j < 4; ++j) { const float r = sigmoidf_(ar[j] + brr[n]); la_[j] = r * sp[n]; }
            u32x4 w; w.x = cvt_pk_bf16(la_[0], la_[1]); w.y = cvt_pk_bf16(la_[2], la_[3]);
            la_[0] = bflo(w.x); la_[1] = bfhi(w.x); la_[2] = bflo(w.y); la_[3] = bfhi(w.y);
#pragma unroll
            for (int j = 0; j < 4; ++j) { const int tok = 16 * mt + 4 * fq + j; const float xcv = bf2f(*(const LAS bf16_t*)(XC + tok * XCP + (16 * n + fr) * 2));
                const float ig = sigmoidf_(ai[j] + bii[n]); const float a = fexp2(la_[j]);
                a_[j] = a; b_[j] = __builtin_amdgcn_sqrtf(fmaxf(1.0f - a * a, 0.f)) * (ig * xcv); }
            w.z = cvt_pk_bf16(b_[0], b_[1]); w.w = cvt_pk_bf16(b_[2], b_[3]);
            b_[0] = bflo(w.z); b_[1] = bfhi(w.z); b_[2] = bflo(w.w); b_[3] = bfhi(w.w);
            __builtin_nontemporal_store(w, ABo + (size_t)((n * 4 + mt) * 64));
            if (d == 0) { Hj[mt][0] = b_[0]; Aj[mt][0] = a_[0];
#pragma unroll
                for (int j = 1; j < 4; ++j) { Hj[mt][j] = a_[j] * Hj[mt][j - 1] + b_[j]; Aj[mt][j] = a_[j] * Aj[mt][j - 1]; } }
            else { Hj[mt][3] = b_[3]; Aj[mt][3] = a_[3];
#pragma unroll
                for (int j = 2; j >= 0; --j) { Hj[mt][j] = a_[j] * Hj[mt][j + 1] + b_[j]; Aj[mt][j] = a_[j] * Aj[mt][j + 1]; } }
        }
        float iA[4], iH[4], eA[4], eH[4], tA[4], tH[4];
#pragma unroll
        for (int mt = 0; mt < 4; ++mt) { iA[mt] = d ? Aj[mt][0] : Aj[mt][3]; iH[mt] = d ? Hj[mt][0] : Hj[mt][3]; }
        { float pA[4], pH[4];
#pragma unroll
          for (int mt = 0; mt < 4; ++mt) { pA[mt] = bperm(iA[mt], src1); pH[mt] = bperm(iH[mt], src1); }
#pragma unroll
          for (int mt = 0; mt < 4; ++mt) if (has1) { iH[mt] = iA[mt] * pH[mt] + iH[mt]; iA[mt] = iA[mt] * pA[mt]; }
#pragma unroll
          for (int mt = 0; mt < 4; ++mt) { pA[mt] = bperm(iA[mt], src2); pH[mt] = bperm(iH[mt], src2); }
#pragma unroll
          for (int mt = 0; mt < 4; ++mt) if (has2) { iH[mt] = iA[mt] * pH[mt] + iH[mt]; iA[mt] = iA[mt] * pA[mt]; } }
#pragma unroll
        for (int mt = 0; mt < 4; ++mt) { eA[mt] = bperm(iA[mt], src1); eH[mt] = bperm(iH[mt], src1); tA[mt] = bperm(iA[mt], srct); tH[mt] = bperm(iH[mt], srct); if (!has1) { eA[mt] = 1.f; eH[mt] = 0.f; } }
#pragma unroll
        for (int mi = 0; mi < 4; ++mi) { const int mt = d ? 3 - mi : mi;
            const float hin = eH[mt] + eA[mt] * cr[n];
            if (PASS == 2) {
#pragma unroll
                for (int j = 0; j < 4; ++j) { const int tok = 16 * mt + 4 * fq + j; *(LAS bf16_t*)(HB + ((d * 64 + tok) * 256 + 64 * hd + 16 * n + fr) * 2) = f2bf(Hj[mt][j] + Aj[mt][j] * hin); } }
            cr[n] = tH[mt] + tA[mt] * cr[n]; at[n] *= tA[mt]; }
    }
    if (PASS == 1) { if (fq == 0) {
#pragma unroll
            for (int n = 0; n < 4; ++n) { float* s = SUMM + ((size_t)q * 2 + d) * 512 + 64 * hd + 16 * n + fr; s[0] = at[n]; s[256] = cr[n]; } } }
    else {
        __syncthreads();
        bf16_t* Y = (bf16_t*)(p->ws + WS_YCAT);
        u32x4 gaw[4];
#pragma unroll
        for (int it = 0; it < 4; ++it) { const int task = it * 512 + tid, tok = task >> 5, cg = task & 31; gaw[it] = *(const u32x4*)(PROJ + ((size_t)rowbase + t0 + tok) * NPROJ + 256 + 8 * cg); }
#pragma unroll
        for (int it = 0; it < 4; ++it) { const int task = it * 512 + tid, tok = task >> 5, cg = task & 31; const size_t row = (size_t)rowbase + t0 + tok;
            float hf[8], hb[8], ga[8], y[8];
            unpack8(*(const LAS u32x4*)(HB + ((0 * 64 + tok) * 256 + 8 * cg) * 2), hf); unpack8(*(const LAS u32x4*)(HB + ((1 * 64 + tok) * 256 + 8 * cg) * 2), hb);
            unpack8(gaw[it], ga);
#pragma unroll
            for (int e = 0; e < 8; ++e) { const float g = ga[e]; y[e] = (hf[e] + hb[e]) * (g * sigmoidf_(1.5957691216057308f * (g + 0.044715f * g * g * g))); }
            *(u32x4*)(Y + row * D + 8 * cg) = pack8(y); }
    }
}

__device__ __forceinline__ void scan2_unit(CP p, int l, int q, LAS unsigned char* lds) {
    const int tid = tid_(), lane = tid & 63, wid = __builtin_amdgcn_readfirstlane(tid >> 6), d = wid >> 2, hd = wid & 3, fr = lane & 15, fq = lane >> 4;
    LAS float* CAR = (LAS float*)(lds + wid * 256);
    LAS unsigned char* HB = lds + 2048;
    const bf16_t* PROJ = (const bf16_t*)(p->ws + WS_PROJ); const float* SUMM = (const float*)(p->ws + WS_SUMM);
    const Seq sq = seq_of(q); const int b = sq.b, jc = sq.jc, rowbase = sq.rowbase, t0 = sq.t0; const bool lat = sq.lat;
    __syncthreads();
    u32x4 ab[4][4];
    { const u32x4* ABi = (const u32x4*)(p->ws + WS_AB) + ((size_t)q * 8 + wid) * 16 * 64 + lane;
#pragma unroll
      for (int n = 0; n < 4; ++n)
#pragma unroll
          for (int mt = 0; mt < 4; ++mt) ab[n][mt] = __builtin_nontemporal_load(ABi + (size_t)((n * 4 + mt) * 64)); }
    u32x4 gaw[4];
#pragma unroll
    for (int it = 0; it < 4; ++it) { const int task = it * 512 + tid, tok = task >> 5, cg = task & 31; gaw[it] = *(const u32x4*)(PROJ + ((size_t)rowbase + t0 + tok) * NPROJ + 256 + 8 * cg); }
    { float car = 0.f; const int c = 64 * hd + lane;
      const int n = d == 0 ? (lat ? 4 + jc : jc) : (lat ? 4 + 63 - jc : 3 - jc);
      for (int s0 = 0; s0 < n; s0 += 16) { float A_[16], H_[16];
#pragma unroll
          for (int e = 0; e < 16; ++e) { const int s = s0 + e; int qq;
              if (d == 0) qq = (lat && s >= 4) ? b * 64 + (s - 4) : 512 + b * 4 + s; else qq = (lat && s >= 4) ? b * 64 + 63 - (s - 4) : 512 + b * 4 + 3 - s;
              A_[e] = 1.f; H_[e] = 0.f; if (s < n) { const float* sp_ = SUMM + ((size_t)qq * 2 + d) * 512; A_[e] = sp_[c]; H_[e] = sp_[256 + c]; } }
#pragma unroll
          for (int e = 0; e < 16; ++e) car = A_[e] * car + H_[e]; }
      CAR[lane] = car; }
    asm volatile("" ::: "memory");
    const int src1 = d ? lane + 16 : lane - 16, src2 = d ? lane + 32 : lane - 32, srct = d ? fr : 48 + fr;
    const bool has1 = d ? fq <= 2 : fq >= 1, has2 = d ? fq <= 1 : fq >= 2;
#pragma unroll
    for (int n = 0; n < 4; ++n) { float cr = CAR[16 * n + fr];
        float Hj[4][4], Aj[4][4];
#pragma unroll
        for (int mt = 0; mt < 4; ++mt) { const u32x4 w = ab[n][mt];
            const float a_[4] = {fexp2(bflo(w.x)), fexp2(bfhi(w.x)), fexp2(bflo(w.y)), fexp2(bfhi(w.y))}, b_[4] = {bflo(w.z), bfhi(w.z), bflo(w.w), bfhi(w.w)};
            if (d == 0) { Hj[mt][0] = b_[0]; Aj[mt][0] = a_[0];
#pragma unroll
                for (int j = 1; j < 4; ++j) { Hj[mt][j] = a_[j] * Hj[mt][j - 1] + b_[j]; Aj[mt][j] = a_[j] * Aj[mt][j - 1]; } }
            else { Hj[mt][3] = b_[3]; Aj[mt][3] = a_[3];
#pragma unroll
                for (int j = 2; j >= 0; --j) { Hj[mt][j] = a_[j] * Hj[mt][j + 1] + b_[j]; Aj[mt][j] = a_[j] * Aj[mt][j + 1]; } } }
        float iA[4], iH[4], eA[4], eH[4], tA[4], tH[4];
#pragma unroll
        for (int mt = 0; mt < 4; ++mt) { iA[mt] = d ? Aj[mt][0] : Aj[mt][3]; iH[mt] = d ? Hj[mt][0] : Hj[mt][3]; }
        { float pA[4], pH[4];
#pragma unroll
          for (int mt = 0; mt < 4; ++mt) { pA[mt] = bperm(iA[mt], src1); pH[mt] = bperm(iH[mt], src1); }
#pragma unroll
          for (int mt = 0; mt < 4; ++mt) if (has1) { iH[mt] = iA[mt] * pH[mt] + iH[mt]; iA[mt] = iA[mt] * pA[mt]; }
#pragma unroll
          for (int mt = 0; mt < 4; ++mt) { pA[mt] = bperm(iA[mt], src2); pH[mt] = bperm(iH[mt], src2); }
#pragma unroll
          for (int mt = 0; mt < 4; ++mt) if (has2) { iH[mt] = iA[mt] * pH[mt] + iH[mt]; iA[mt] = iA[mt] * pA[mt]; } }
#pragma unroll
        for (int mt = 0; mt < 4; ++mt) { eA[mt] = bperm(iA[mt], src1); eH[mt] = bperm(iH[mt], src1); tA[mt] = bperm(iA[mt], srct); tH[mt] = bperm(iH[mt], srct); if (!has1) { eA[mt] = 1.f; eH[mt] = 0.f; } }
#pragma unroll
        for (int mi = 0; mi < 4; ++mi) { const int mt = d ? 3 - mi : mi;
            const float hin = eH[mt] + eA[mt] * cr;
#pragma unroll
            for (int j = 0; j < 4; j += 2) { const int tok = 16 * mt + 4 * fq + j; const LAS unsigned char* dummy = HB; (void)dummy;
                *(LAS bf16_t*)(HB + ((d * 64 + tok) * 256 + 64 * hd + 16 * n + fr) * 2) = f2bf(Hj[mt][j] + Aj[mt][j] * hin);
                *(LAS bf16_t*)(HB + ((d * 64 + tok + 1) * 256 + 64 * hd + 16 * n + fr) * 2) = f2bf(Hj[mt][j + 1] + Aj[mt][j + 1] * hin); }
            cr = tH[mt] + tA[mt] * cr; } }
    __syncthreads();
    bf16_t* Y = (bf16_t*)(p->ws + WS_YCAT);
#pragma unroll
    for (int it = 0; it < 4; ++it) { const int task = it * 512 + tid, tok = task >> 5, cg = task & 31; const size_t row = (size_t)rowbase + t0 + tok;
        float hf[8], hb[8], ga[8], y[8];
        unpack8(*(const LAS u32x4*)(HB + ((0 * 64 + tok) * 256 + 8 * cg) * 2), hf); unpack8(*(const LAS u32x4*)(HB + ((1 * 64 + tok) * 256 + 8 * cg) * 2), hb);
        unpack8(gaw[it], ga);
#pragma unroll
        for (int e = 0; e < 8; ++e) { const float g = ga[e]; y[e] = (hf[e] + hb[e]) * (g * sigmoidf_(1.5957691216057308f * (g + 0.044715f * g * g * g))); }
        *(u32x4*)(Y + row * D + 8 * cg) = pack8(y); }
}

template <int HW>
__device__ __forceinline__ void pool_core(const float (&vals)[48], int tb, int L, float bp, float ps, bf16_t* yp) {
    float sacc = 0.f;
#pragma unroll
    for (int i = 8 - HW; i < 8 + HW; ++i) sacc += vals[i];
#pragma unroll
    for (int o = 0; o < 32; ++o) { const int t = tb + o; const int cnt = min(t + HW, L) - max(t - HW, 0);
        const float yv = (sacc * frcp((float)cnt) - vals[8 + o] + bp) * ps;
        yp[(size_t)o * D] = f2bf(yv);
        if (o < 31) sacc += vals[8 + o + HW] - vals[8 + o - HW]; }
}
__device__ __forceinline__ void pool_unit(CP p, int l, int q, LAS unsigned char* lds) {
    LAS float* PB = (LAS float*)lds;
    const int tid = tid_();
    const bf16_t* PROJ = (const bf16_t*)(p->ws + WS_PROJ); bf16_t* Y = (bf16_t*)(p->ws + WS_YCAT);
    const Seq sq = seq_of(q); const int L = sq.L, rowbase = sq.rowbase, t0 = sq.t0;
    __syncthreads();
    { u32x4 w[5];
#pragma unroll
      for (int it = 0; it < 5; ++it) { const int task = it * 512 + tid, r = task >> 5, cg = task & 31, tt = t0 - 8 + r; w[it] = (u32x4){0u, 0u, 0u, 0u};
          if (tt >= 0 && tt < L) w[it] = *(const u32x4*)(PROJ + (size_t)(rowbase + tt) * NPROJ + 512 + 8 * cg); }
#pragma unroll
      for (int it = 0; it < 5; ++it) { const int task = it * 512 + tid, r = task >> 5, cg = task & 31; float f[8]; unpack8(w[it], f);
          *(LAS f32x4*)(PB + r * 256 + 8 * cg) = (f32x4){f[0], f[1], f[2], f[3]}; *(LAS f32x4*)(PB + r * 256 + 8 * cg + 4) = (f32x4){f[4], f[5], f[6], f[7]}; } }
    __syncthreads();
    { const int c = tid & 255, th = tid >> 8, g = __builtin_amdgcn_readfirstlane(c >> 6); const float bp = p->b_pool[l * 256 + c], ps = p->pool_scale[l * 256 + c];
      float vals[48];
#pragma unroll
      for (int i = 0; i < 48; ++i) vals[i] = PB[(32 * th + i) * 256 + c];
      bf16_t* yp = Y + (size_t)(rowbase + t0 + 32 * th) * D + 256 + c; const int tb = t0 + 32 * th;
      if (g == 0) pool_core<1>(vals, tb, L, bp, ps, yp); else if (g == 1) pool_core<2>(vals, tb, L, bp, ps, yp); else if (g == 2) pool_core<4>(vals, tb, L, bp, ps, yp); else pool_core<8>(vals, tb, L, bp, ps, yp); }
}
__device__ __forceinline__ void four_unit(CP p, int l, int q) {
    const int tid = tid_();
    bf16_t* Y = (bf16_t*)(p->ws + WS_YCAT);
    const Seq sq = seq_of(q); const int b = sq.b, rowbase = sq.rowbase, t0 = sq.t0; const bool lat = sq.lat;
    const float* UU = (const float*)(p->ws + WS_UU); const float* VV = (const float*)(p->ws + WS_VV); const float* YCX = (const float*)(p->ws + WS_YCX);
#pragma unroll
    for (int it = 0; it < 4; ++it) { const int task = it * 512 + tid, tl = task >> 5, cg = task & 31, t = t0 + tl; float y[8];
        f32x4 u0, u1, v0 = {0.f, 0.f, 0.f, 0.f}, v1 = {0.f, 0.f, 0.f, 0.f}; float sgn, scale;
        if (lat) { const int k = t <= 2048 ? t : 4096 - t; sgn = t <= 2048 ? -1.0f : 1.0f; scale = 1.0f / (512.0f * 64.0f);
            const float* up = UU + (size_t)k * 2048 + b * 256 + 8 * cg; u0 = *(const f32x4*)up; u1 = *(const f32x4*)(up + 4);
            if (k < 2048) { const float* vp = VV + (size_t)k * 2048 + b * 256 + 8 * cg; v0 = *(const f32x4*)vp; v1 = *(const f32x4*)(vp + 4); } }
        else { sgn = 0.f; scale = 1.0f / (128.0f * 64.0f); const float* up = YCX + (size_t)t * 2048 + b * 256 + 8 * cg; u0 = *(const f32x4*)up; u1 = *(const f32x4*)(up + 4); }
        const f32x4 bf0 = *(const f32x4*)(p->b_four + l * 256 + 8 * cg), bf1 = *(const f32x4*)(p->b_four + l * 256 + 8 * cg + 4);
        const f32x4 r0 = (u0 + v0 * sgn) * scale + bf0, r1 = (u1 + v1 * sgn) * scale + bf1;
        y[0] = r0[0]; y[1] = r0[1]; y[2] = r0[2]; y[3] = r0[3]; y[4] = r1[0]; y[5] = r1[1]; y[6] = r1[2]; y[7] = r1[3];
        *(u32x4*)(Y + (size_t)(rowbase + t) * D + 512 + 8 * cg) = pack8(y); }
}
__device__ __forceinline__ void conformer_unit(CP p, int l, int q, LAS unsigned char* lds) {
    LAS float* V = (LAS float*)lds;
    const int tid = tid_(), lane = tid & 63, wid = __builtin_amdgcn_readfirstlane(tid >> 6);
    const bf16_t* PROJ = (const bf16_t*)(p->ws + WS_PROJ); bf16_t* Y = (bf16_t*)(p->ws + WS_YCAT);
    const Seq sq = seq_of(q); const int L = sq.L, rowbase = sq.rowbase, t0 = sq.t0;
    __syncthreads();
    { u32x4 wa[6], wg_[6];
#pragma unroll
      for (int it = 0; it < 6; ++it) { const int task = it * 512 + tid, r = task >> 5, cg = task & 31, tt = t0 - 15 + r; wa[it] = (u32x4){0u, 0u, 0u, 0u}; wg_[it] = wa[it];
          if (task < 94 * 32 && tt >= 0 && tt < L) { const bf16_t* pr = PROJ + (size_t)(rowbase + tt) * NPROJ + 768 + 8 * cg; wa[it] = *(const u32x4*)pr; wg_[it] = *(const u32x4*)(pr + 256); } }
#pragma unroll
      for (int it = 0; it < 6; ++it) { const int task = it * 512 + tid, r = task >> 5, cg = task & 31; float a[8], g[8], f[8]; unpack8(wa[it], a); unpack8(wg_[it], g);
#pragma unroll
          for (int e = 0; e < 8; ++e) f[e] = a[e] * sigmoidf_(g[e]);
          if (task < 94 * 32) { *(LAS f32x4*)(V + r * 256 + 8 * cg) = (f32x4){f[0], f[1], f[2], f[3]}; *(LAS f32x4*)(V + r * 256 + 8 * cg + 4) = (f32x4){f[4], f[5], f[6], f[7]}; } } }
    __syncthreads();
    const int hp = wid & 1, tq = wid >> 1, c0 = 128 * hp + 2 * lane;
    f32x2 wk[31];
#pragma unroll
    for (int k = 0; k < 31; ++k) wk[k] = *(const f32x2*)(p->conv_d_w + ((size_t)l * 31 + k) * 256 + c0);
    const f32x2 cb = *(const f32x2*)(p->conv_d_b + l * 256 + c0), lg = *(const f32x2*)(p->ln_d_g + l * 256 + c0), lb = *(const f32x2*)(p->ln_d_b + l * 256 + c0);
    for (int blk = 0; blk < 2; ++blk) { const int tl0 = 16 * tq + 8 * blk;
        f32x2 win[38];
#pragma unroll
        for (int i = 0; i < 38; ++i) win[i] = *(const LAS f32x2*)(V + (tl0 + i) * 256 + c0);
        f32x2 sv[8]; float m1[8], m2[8];
#pragma unroll
        for (int o = 0; o < 8; ++o) { f32x2 sacc = cb;
#pragma unroll
            for (int k = 0; k < 31; ++k) sacc += wk[k] * win[o + k];
            sv[o] = sacc; m1[o] = sacc.x + sacc.y; m2[o] = sacc.x * sacc.x + sacc.y * sacc.y; }
#pragma unroll
        for (int st = 16; st >= 1; st >>= 1) { float t1[8], t2[8];
#pragma unroll
            for (int o = 0; o < 8; ++o) { t1[o] = bperm(m1[o], lane ^ st); t2[o] = bperm(m2[o], lane ^ st); }
#pragma unroll
            for (int o = 0; o < 8; ++o) { m1[o] += t1[o]; m2[o] += t2[o]; } }
#pragma unroll
        for (int o = 0; o < 8; ++o) { const float mean = m1[o] * (1.0f / 64.0f); const float var = fmaxf(m2[o] * (1.0f / 64.0f) - mean * mean, 0.f); const float rs = __builtin_amdgcn_rsqf(var + 1e-6f);
            f32x2 yv = (sv[o] - mean) * rs * lg + lb; yv.x = yv.x * sigmoidf_(yv.x); yv.y = yv.y * sigmoidf_(yv.y);
            *(unsigned*)(Y + (size_t)(rowbase + t0 + tl0 + o) * D + 768 + c0) = cvt_pk_bf16(yv.x, yv.y); } }
}

struct SchedIn { const char *U, *W, *WF; char *PROJ, *PQT, *PQC; int lastl;
    __device__ __forceinline__ bool next(int i, g8::Unit& u) const { const int nu = lastl ? 904 : 952, nmain = lastl ? 648 : 680; const int L = i * (int)gridDim.x + (int)blockIdx.x; if (L >= nu) return false; int id = g8::xcd_remap(L, nu);
        if (id < nmain) { u.kind = 0; if (lastl && id >= 640) { u.pm = 128 + (id - 640); u.pn = 0; } else { u.pm = id / 5; u.pn = id % 5; } u.a = U + (size_t)u.pm * 256 * 2048; u.b = W + (size_t)u.pn * 256 * 2048; u.o = PROJ; u.e = 0; }
        else { const int r = id - nmain; u.kind = 1; u.pm = r & 1; u.pn = r >> 1; u.a = WF + (size_t)u.pm * 256 * 2048; u.b = U + (size_t)u.pn * 256 * 2048; u.e = 0;
            if (u.pn < 128) u.o = PQT + ((size_t)(u.pm * 2048 + (u.pn >> 4) * 256) * 4096 + (u.pn & 15) * 256); else u.o = PQC + ((size_t)((u.pn - 128) * 256) * 512 + u.pm * 256); }
        return true; } };
struct EpiIn { static constexpr bool PERM = true; const float* bin; const float* bf;
    __device__ __forceinline__ void side_dma(const g8::Unit& u, int t, LAS unsigned char* d) const { g8::dma4((u.kind == 0 ? bin + u.pn * 256 : bf + u.pm * 256) + t, d); }
    __device__ __forceinline__ void operator()(const f32x4 (&acc)[2][2][4][2], const g8::Unit& u, int wr, int wc, int fr, int fq, const LAS unsigned* sd) const {
        { const int ln_ = tid_() & 63; fr = ln_ & 15; fq = ln_ >> 4; }
        if (u.kind == 0) { const int row0 = u.pm * 256 + wr * 64 + fr, col0 = u.pn * 256 + wc * 32 + 8 * fq; bf16_t* O = (bf16_t*)u.o;
            f32x4 bv[2][2];
#pragma unroll
            for (int bj = 0; bj < 2; ++bj)
#pragma unroll
                for (int n = 0; n < 2; ++n) bv[bj][n] = *(const LAS f32x4*)(sd + wc * 32 + 8 * fq + bj * 128 + 4 * n);
#pragma unroll
            for (int ai = 0; ai < 2; ++ai)
#pragma unroll
                for (int m = 0; m < 4; ++m) { bf16_t* rowp = O + (size_t)(row0 + ai * 128 + m * 16) * NPROJ + col0;
#pragma unroll
                    for (int bj = 0; bj < 2; ++bj) { const f32x4 v0 = acc[ai][bj][m][0] + bv[bj][0], v1 = acc[ai][bj][m][1] + bv[bj][1];
                        u32x4 w; w.x = cvt_pk_bf16(v0[0], v0[1]); w.y = cvt_pk_bf16(v0[2], v0[3]); w.z = cvt_pk_bf16(v1[0], v1[1]); w.w = cvt_pk_bf16(v1[2], v1[3]); *(u32x4*)(rowp + bj * 128) = w; } }
        } else { const int pitch = u.pn < 128 ? 4096 : 512; unsigned char* O = (unsigned char*)u.o; const int col0 = wc * 32 + 8 * fq;
#pragma unroll
            for (int ai = 0; ai < 2; ++ai)
#pragma unroll
                for (int m = 0; m < 4; ++m) { const int r = ai * 128 + wr * 64 + m * 16 + fr; const float bb = __uint_as_float(sd[r]); unsigned char* rowp = O + (size_t)r * pitch + col0;
#pragma unroll
                    for (int bj = 0; bj < 2; ++bj) { const f32x4 v0 = acc[ai][bj][m][0] + bb, v1 = acc[ai][bj][m][1] + bb;
                        u32x2 w; w.x = pk4_fp8(v0[0], v0[1], v0[2], v0[3]); w.y = pk4_fp8(v1[0], v1[1], v1[2], v1[3]); *(u32x2*)(rowp + bj * 128) = w; } }
        } } };
struct SchedDft { const char *CM, *SM, *PQT; char *UU, *VV;
    __device__ __forceinline__ bool next(int i, g8::Unit& u) const { const int id = (int)blockIdx.x; if (i > 0 || id >= 136) return false; u.kind = 0; u.e = 0;
        if (id < 72) { u.pm = id >> 3; u.pn = id & 7; u.a = CM + (size_t)u.pm * 256 * 8192; u.b = PQT + (size_t)u.pn * 256 * 8192; u.o = UU + ((size_t)u.pm * 256 * 2048 + u.pn * 256) * 4; }
        else { const int r = id - 72; u.pm = r >> 3; u.pn = r & 7; u.a = SM + (size_t)u.pm * 256 * 8192; u.b = PQT + (size_t)(2048 + u.pn * 256) * 8192; u.o = VV + ((size_t)u.pm * 256 * 2048 + u.pn * 256) * 4; }
        return true; } };
struct SchedOne { g8::Unit u; __device__ __forceinline__ bool next(int i, g8::Unit& o) const { if (i > 0) return false; o = u; return true; } };
struct SchedDftC { const char *DC, *PQC; char* YCX;
    __device__ __forceinline__ bool next(int i, g8::Unit& u) const { const int id = (int)blockIdx.x - 136; if (i > 0 || id < 0 || id >= 8) return false; u.kind = 0; u.e = 0; u.pm = 0; u.pn = id;
        u.a = DC; u.b = PQC + (size_t)id * 256 * 1024; u.o = YCX + (size_t)id * 256 * 4; return true; } };
struct EpiF32 { static constexpr bool PERM = false;
    __device__ __forceinline__ void side_dma(const g8::Unit&, int, LAS unsigned char*) const {}
    __device__ __forceinline__ void operator()(const f32x4 (&acc)[2][2][4][2], const g8::Unit& u, int wr, int wc, int fr, int fq, const LAS unsigned* sd) const {
        { const int ln_ = tid_() & 63; fr = ln_ & 15; fq = ln_ >> 4; }
        float* O = (float*)u.o; const int row0 = wr * 64 + fr, col0 = wc * 32 + 4 * fq;
#pragma unroll
        for (int ai = 0; ai < 2; ++ai)
#pragma unroll
            for (int m = 0; m < 4; ++m) { float* rowp = O + (size_t)(row0 + ai * 128 + m * 16) * 2048 + col0;
#pragma unroll
                for (int bj = 0; bj < 2; ++bj)
#pragma unroll
                    for (int n = 0; n < 2; ++n) *(f32x4*)(rowp + bj * 128 + n * 16) = acc[ai][bj][m][n]; } } };
struct SchedOut { const char *Y, *W; int nm; const float* modv_l;
    __device__ __forceinline__ bool next(int i, g8::Unit& u) const { const int nu = nm * 4, L = i * (int)gridDim.x + (int)blockIdx.x; if (L >= nu) return false; const int id = g8::xcd_remap(L, nu);
        u.kind = 0; u.pm = id >> 2; u.pn = id & 3; u.a = Y + (size_t)u.pm * 256 * 2048; u.b = W + (size_t)u.pn * 256 * 2048; u.o = nullptr; u.e = u.pm < 128 ? u.pm >> 4 : 8; return true; } };
struct EpiOut { static constexpr bool PERM = true; bf16_t* Y2; const float* bout; const float* modv_l;
    __device__ __forceinline__ void side_dma(const g8::Unit& u, int t, LAS unsigned char* d) const { g8::dma4(bout + u.pn * 256 + t, d); g8::dma4(modv_l + (size_t)u.e * 6144 + 2048 + u.pn * 256 + t, d + 1024); }
    __device__ __forceinline__ void operator()(const f32x4 (&acc)[2][2][4][2], const g8::Unit& u, int wr, int wc, int fr, int fq, const LAS unsigned* sd) const {
        { const int ln_ = tid_() & 63; fr = ln_ & 15; fq = ln_ >> 4; }
        const int row0 = u.pm * 256 + wr * 64 + fr, col0 = u.pn * 256 + wc * 32 + 8 * fq;
        f32x4 bv[2][2], gv[2][2];
#pragma unroll
        for (int bj = 0; bj < 2; ++bj)
#pragma unroll
            for (int n = 0; n < 2; ++n) { bv[bj][n] = *(const LAS f32x4*)(sd + wc * 32 + 8 * fq + bj * 128 + 4 * n); gv[bj][n] = *(const LAS f32x4*)(sd + 256 + wc * 32 + 8 * fq + bj * 128 + 4 * n); }
#pragma unroll
        for (int ai = 0; ai < 2; ++ai)
#pragma unroll
            for (int m = 0; m < 4; ++m) { bf16_t* rowp = Y2 + (size_t)(row0 + ai * 128 + m * 16) * D + col0;
#pragma unroll
                for (int bj = 0; bj < 2; ++bj) { const f32x4 v0 = gv[bj][0] * (acc[ai][bj][m][0] + bv[bj][0]), v1 = gv[bj][1] * (acc[ai][bj][m][1] + bv[bj][1]);
                    u32x4 w; w.x = cvt_pk_bf16(v0[0], v0[1]); w.y = cvt_pk_bf16(v0[2], v0[3]); w.z = cvt_pk_bf16(v1[0], v1[1]); w.w = cvt_pk_bf16(v1[2], v1[3]); *(u32x4*)(rowp + bj * 128) = w; } } } };
struct MoeTab { const LAS int* pref; const LAS int* cnt; const LAS unsigned char* t2e; int ntile;
    __device__ __forceinline__ int pref_(int e) const { return __builtin_amdgcn_readfirstlane(pref[e]); }
    __device__ __forceinline__ int cnt_(int e) const { return __builtin_amdgcn_readfirstlane(cnt[e]); }
    __device__ __forceinline__ int expert_of(int pm) const { return __builtin_amdgcn_readfirstlane((int)t2e[pm]); } };
struct SchedGu { MoeTab tb; const char *U, *W; char* ACT; const unsigned* rroff; unsigned maxoff; int rb; float* diag; int kz;
    __device__ __forceinline__ bool next(int i, g8::Unit& u) const { const int nu = tb.ntile * 8, L = i * (int)gridDim.x + (int)blockIdx.x; if (L >= nu) return false; const int id = g8::xcd_remap(L, nu);
        u.kind = 0; u.pm = id >> 3; u.pn = id & 7; u.e = tb.expert_of(u.pm); u.a = U; u.b = W + ((size_t)u.e * 2048 + u.pn * 256) * rb; u.o = ACT + (size_t)u.pm * 256 * rb; return true; }
    __device__ __forceinline__ void roff_dma(const g8::Unit& u, int t, LAS unsigned char* d) const { g8::dma4(rroff + (size_t)u.e * TT + (u.pm - tb.pref_(u.e)) * 256 + t, d); } };
template <bool F8> struct EpiGu { static constexpr bool PERM = true; const float* bgu;
    __device__ __forceinline__ void side_dma(const g8::Unit& u, int t, LAS unsigned char* d) const { g8::dma4(bgu + (size_t)u.e * 2048 + (t < 128 ? 0 : 1024 - 128) + u.pn * 128 + t, d); }
    __device__ __forceinline__ void operator()(const f32x4 (&acc)[2][2][4][2], const g8::Unit& u, int wr, int wc, int fr, int fq, const LAS unsigned* sd) const {
        { const int ln_ = tid_() & 63; fr = ln_ & 15; fq = ln_ >> 4; }
        const int col0 = u.pn * 128 + wc * 32 + 8 * fq; float sc = F8 ? (1.0f / 64.0f) : 1.0f;
#if defined(EPIREP)
        asm volatile("" : "+v"(sc));
#endif
        f32x4 bgt[2], bup[2];
#pragma unroll
        for (int n = 0; n < 2; ++n) { bgt[n] = *(const LAS f32x4*)(sd + wc * 32 + 8 * fq + 4 * n); bup[n] = *(const LAS f32x4*)(sd + 128 + wc * 32 + 8 * fq + 4 * n); }
#pragma unroll
        for (int ai = 0; ai < 2; ++ai)
#pragma unroll
            for (int m = 0; m < 4; ++m) { const int r = ai * 128 + wr * 64 + m * 16 + fr; float y[8];
#pragma unroll
                for (int n = 0; n < 2; ++n)
#pragma unroll
                    for (int h = 0; h < 2; ++h) {
                        f32x2 g2 = (f32x2){acc[ai][0][m][n][2 * h], acc[ai][0][m][n][2 * h + 1]} * sc + (f32x2){bgt[n][2 * h], bgt[n][2 * h + 1]};
                        f32x2 u2 = (f32x2){acc[ai][1][m][n][2 * h], acc[ai][1][m][n][2 * h + 1]} * sc + (f32x2){bup[n][2 * h], bup[n][2 * h + 1]};
                        g2.x = fminf(g2.x, 7.0f); g2.y = fminf(g2.y, 7.0f); u2.x = __builtin_amdgcn_fmed3f(u2.x, -7.0f, 7.0f); u2.y = __builtin_amdgcn_fmed3f(u2.y, -7.0f, 7.0f);
                        const f32x2 t2 = g2 * (-1.702f * 1.4426950408889634f); f32x2 d2; d2.x = fexp2(t2.x); d2.y = fexp2(t2.y); d2 = d2 + 1.0f;
                        f32x2 s2; s2.x = frcp(d2.x); s2.y = frcp(d2.y);
                        const f32x2 y2 = (u2 + 1.0f) * g2 * s2; y[4 * n + 2 * h] = y2.x; y[4 * n + 2 * h + 1] = y2.y; }
                if constexpr (F8) { u32x2 w; w.x = pk4_fp8(y[0], y[1], y[2], y[3]); w.y = pk4_fp8(y[4], y[5], y[6], y[7]); *(u32x2*)((unsigned char*)u.o + (size_t)r * D + col0) = w; }
                else *(u32x4*)((bf16_t*)u.o + (size_t)r * D + col0) = pack8(y); } } };
struct SchedDown { MoeTab tb; const char *ACT, *W; int rb;
    __device__ __forceinline__ bool next(int i, g8::Unit& u) const { const int nu = tb.ntile * 4, L = i * (int)gridDim.x + (int)blockIdx.x; if (L >= nu) return false; const int id = g8::xcd_remap(L, nu);
        u.kind = 0; u.pm = id >> 2; u.pn = id & 3; u.e = tb.expert_of(u.pm); u.a = ACT + (size_t)u.pm * 256 * rb; u.b = W + ((size_t)u.e * 1024 + u.pn * 256) * rb; u.o = nullptr; return true; } };
struct EpiDown { static constexpr bool PERM = true; MoeTab tb; const float* bd; const int* rasg; const float* gate; bf16_t* YS; float sc;
    __device__ __forceinline__ void side_dma(const g8::Unit& u, int t, LAS unsigned char* d) const { const size_t pos = (size_t)u.e * TT + (u.pm - tb.pref_(u.e)) * 256 + t;
        g8::dma4(rasg + pos, d); g8::dma4(gate + pos, d + 1024); g8::dma4(bd + (size_t)u.e * 1024 + u.pn * 256 + t, d + 2048); }
    __device__ __forceinline__ void operator()(const f32x4 (&acc)[2][2][4][2], const g8::Unit& u, int wr, int wc, int fr, int fq, const LAS unsigned* sd) const {
        { const int ln_ = tid_() & 63; fr = ln_ & 15; fq = ln_ >> 4; }
        const int col0 = u.pn * 256 + wc * 32 + 8 * fq; const int rank0 = (u.pm - tb.pref_(u.e)) * 256, cnt = tb.cnt_(u.e);
        f32x4 bv[2][2];
#pragma unroll
        for (int bj = 0; bj < 2; ++bj)
#pragma unroll
            for (int n = 0; n < 2; ++n) bv[bj][n] = *(const LAS f32x4*)(sd + 512 + wc * 32 + 8 * fq + bj * 128 + 4 * n);
#pragma unroll
        for (int ai = 0; ai < 2; ++ai)
#pragma unroll
            for (int m = 0; m < 4; ++m) { const int r = ai * 128 + wr * 64 + m * 16 + fr; const int asg = (int)sd[r]; const float g = __uint_as_float(sd[256 + r]);
                if (rank0 + r < cnt) { unsigned char* rowp = (unsigned char*)YS + (size_t)asg * D + col0; const float g16 = g * 16.0f;
#pragma unroll
                    for (int bj = 0; bj < 2; ++bj) { const f32x4 v0 = (acc[ai][bj][m][0] * sc + bv[bj][0]) * g16, v1 = (acc[ai][bj][m][1] * sc + bv[bj][1]) * g16;
                        u32x2 w; w.x = pk4_fp8(v0[0], v0[1], v0[2], v0[3]); w.y = pk4_fp8(v1[0], v1[1], v1[2], v1[3]); *(u32x2*)(rowp + bj * 128) = w; } } } } };
__device__ __forceinline__ MoeTab moe_tables(CP p, int l, LAS unsigned char* lds) {
    LAS int* pref = (LAS int*)(lds + g8::STAGE_BYTES); LAS int* cnt = pref + 64; LAS unsigned char* t2e = (LAS unsigned char*)(lds + g8::STAGE_BYTES + 384);
    unsigned* ctl = (unsigned*)(p->ws + WS_CTL);
    const int tid = tid_();
    __syncthreads();
    if (tid < 32) cnt[tid] = (int)__hip_atomic_load(ctl + CW_COUNT + (l * NE + tid) * 64, __ATOMIC_RELAXED, __HIP_MEMORY_SCOPE_AGENT);
    __syncthreads();
    if (tid == 0) { int s = 0; for (int e = 0; e < 32; ++e) { pref[e] = s; s += (cnt[e] + 255) >> 8; } pref[32] = s; }
    __syncthreads();
    for (int pm = tid; pm < NTILE_MAX; pm += 512) { int e = 0; for (int k = 1; k < 32; ++k) e += (pm >= pref[k]) ? 1 : 0; t2e[pm] = (unsigned char)e; }
    __syncthreads();
    MoeTab tb; tb.pref = pref; tb.cnt = cnt; tb.t2e = t2e; tb.ntile = __builtin_amdgcn_readfirstlane(pref[32]); return tb;
}

constexpr int N_PHASES = 18;
__global__ void __launch_bounds__(512, 2) mega_fwd(Params p_unused) {
    CP p = launder_params();
    extern __shared__ __attribute__((aligned(16))) unsigned char shm_[];
    LAS unsigned char* lds0 = (LAS unsigned char*)shm_;
    LAS unsigned char* lds = lds0 + LDS_BASE;
    if (tid_() == 0) *(LAS u32x4*)lds0 = (u32x4){0u, 0u, 0u, 0u};
    __syncthreads();
    XcdBarrier bar = xcd_barrier_post((unsigned*)(p->ws + WS_CTL), (volatile LAS unsigned*)lds0);
    int ph = 0;
#ifndef P3A
#define P3A 1
#define P3B 1
#define P3C 1
#endif
#ifndef PHMASK
#define PHMASK 0x3ff
#endif
#ifndef REPMASK
#define REPMASK 0
#endif
#define PHASE_BEGIN_K(k) p = launder_params(); if (((PHMASK >> (k)) & 1) && ph >= p->ph_lo && ph < p->ph_hi) for (int rep_ = 0; rep_ < ((((REPMASK) >> (k)) & 1) ? 2 : 1); ++rep_) {
#define PHASE_END } ++ph; if (ph > p->ph_lo && ph < p->ph_hi) xcd_barrier(bar);
    PHASE_BEGIN_K(0) phase_prologue(p, lds, rep_); PHASE_END
    for (int l = 0; l < 2; ++l) {
        const float* modv_l = (const float*)(p->ws + WS_MODV) + (size_t)l * 9 * 6144;
        PHASE_BEGIN_K(1) phase_norm(p, l); PHASE_END
        PHASE_BEGIN_K(2) { SchedIn S; S.lastl = l == 1; S.U = (const char*)(p->ws + WS_U); S.W = (const char*)(p->ws + WS_WINT) + (size_t)l * NPROJ * 2048; S.WF = (const char*)(p->ws + WS_WFT) + (size_t)l * 512 * 2048;
                      S.PROJ = (char*)(p->ws + WS_PROJ); S.PQT = (char*)(p->ws + WS_PQT); S.PQC = (char*)(p->ws + WS_PQC);
                      EpiIn E; E.bin = (const float*)(p->ws + WS_BIN) + l * NPROJ; E.bf = (const float*)(p->ws + WS_BF) + l * 512;
                      g8::gemm_phase<EpiIn, SchedIn, false>(lds, 1024, S, E); } PHASE_END
        PHASE_BEGIN_K(3) {
                      unsigned* qhead = (unsigned*)(p->ws + WS_CTL) + CW_QUEUE + (l * 2 + rep_) * 64; LAS int* qslot = (LAS int*)(lds - LDS_BASE + 64);
                      int tkt = 0; if (tid_() == 0) tkt = (int)__hip_atomic_fetch_add(qhead, 1u, __ATOMIC_RELAXED, __HIP_MEMORY_SCOPE_AGENT);
                      for (;;) { __syncthreads(); if (tid_() == 0) { *qslot = tkt; tkt = (int)__hip_atomic_fetch_add(qhead, 1u, __ATOMIC_RELAXED, __HIP_MEMORY_SCOPE_AGENT); } __syncthreads();
                          const int id = __builtin_amdgcn_readfirstlane(*qslot); const int nwj = MOE_W_IN_QUEUE ? (l == 0 ? J_TGU_L(0) + J_TD_L(0) : J_TGU_L(1) + J_TD_L(1)) : 0;
                          if (id >= 144 + (MOE_W_IN_QUEUE ? 9 : 3) * NCHUNK) break;
#if defined(P3KIND)
                          if (rep_) { const int kc = id < 144 ? 0 : (MOE_W_IN_QUEUE ? ((id - 144) % 3 != 0 ? 4 : 1 + ((id - 144) / 3) / NCHUNK) : 1 + (id - 144) / NCHUNK); if (kc != P3KIND) continue; }
#endif
                          int small = -1;
                          if (id >= 144) { if (!MOE_W_IN_QUEUE) small = id - 144; else { const int r = id - 144, g = r / 3, k = r - 3 * g; if (k == 0) small = g; else { const int wj = 2 * g + (k - 1); if (wj < nwj) moe_weight_job(p, l, wj, lds); continue; } } }
                          if (l == 1 && ((id >= 136 && id < 144) || (id >= 144 + NCHUNK && (id - 144) % NCHUNK >= 512))) continue;
                          if (id < 136) { SchedOne S; S.u.kind = 0; S.u.e = 0;
                              if (id < 72) { S.u.pm = id >> 3; S.u.pn = id & 7; S.u.a = (const char*)(p->ws + WS_CMAT) + (size_t)S.u.pm * 256 * 4096; S.u.b = (const char*)(p->ws + WS_PQT) + (size_t)S.u.pn * 256 * 4096; S.u.o = (char*)(p->ws + WS_UU) + ((size_t)S.u.pm * 256 * 2048 + S.u.pn * 256) * 4; }
                              else { const int r = id - 72; S.u.pm = r >> 3; S.u.pn = r & 7; S.u.a = (const char*)(p->ws + WS_SMAT) + (size_t)S.u.pm * 256 * 4096; S.u.b = (const char*)(p->ws + WS_PQT) + (size_t)(2048 + S.u.pn * 256) * 4096; S.u.o = (char*)(p->ws + WS_VV) + ((size_t)S.u.pm * 256 * 2048 + S.u.pn * 256) * 4; }
                              g8::gemm_phase<EpiF32, SchedOne, false, true>(lds, 2048, S, EpiF32{}); }
                          else if (id < 144) { SchedOne S; S.u.kind = 0; S.u.e = 0; S.u.pm = 0; S.u.pn = id - 136; S.u.a = (const char*)(p->ws + WS_DFTC); S.u.b = (const char*)(p->ws + WS_PQC) + (size_t)S.u.pn * 256 * 512; S.u.o = (char*)(p->ws + WS_YCX) + (size_t)S.u.pn * 256 * 4;
                              g8::gemm_phase<EpiF32, SchedOne, false, true>(lds, 256, S, EpiF32{}); }
                          else { const int uu = small, kind = uu / NCHUNK, q = uu % NCHUNK;
                              if (kind == 0) scan_unit<1>(p, l, q, lds); else if (kind == 1) conformer_unit(p, l, q, lds); else pool_unit(p, l, q, lds); } } } PHASE_END
        PHASE_BEGIN_K(4) { for (int q = blockIdx.x; q < (l == 1 ? 512 : NCHUNK); q += gridDim.x) { scan2_unit(p, l, q, lds); four_unit(p, l, q); } } PHASE_END
        PHASE_BEGIN_K(5) { SchedOut S; S.Y = (const char*)(p->ws + WS_YCAT); S.W = (const char*)(p->ws + WS_WOUTT) + (size_t)l * D * 2048; S.nm = l == 0 ? 136 : 128; S.modv_l = modv_l;
                      EpiOut E; E.Y2 = (bf16_t*)(p->ws + WS_PROJ);   E.bout = (const float*)(p->ws + WS_BOUT) + l * D; E.modv_l = modv_l;
                      g8::gemm_phase<EpiOut, SchedOut, false>(lds, 1024, S, E); } PHASE_END
        PHASE_BEGIN_K(6) phase_router(p, l, lds, rep_); PHASE_END
        PHASE_BEGIN_K(7) { MoeTab tb = moe_tables(p, l, lds);
                      SchedGu S; S.tb = tb; S.W = (const char*)(p->ws + WS_WGUT) + (size_t)l * NE * 2048 * 2048; S.ACT = (char*)(p->ws + WS_ACT); S.rroff = (const unsigned*)(p->ws + WS_RROFF); S.diag = (float*)(p->ws + WS_CTL) + 15000 + l; S.kz = 0;
#if defined(KZPROBE)
                      if (rep_) { S.ACT = (char*)(p->ws + WS_ACT) + (size_t)NTILE_MAX * 256 * 1024; S.kz = KZPROBE; }
#endif
                      S.maxoff = (unsigned)(TT - 1) * (fp8_layer(l) ? 1024u : 2048u);
                      if (fp8_layer(l)) { S.U = (const char*)(p->ws + WS_U8); S.rb = 1024; EpiGu<true> E; E.bgu = p->b_gu + (size_t)l * NE * 2048; g8::gemm_phase<EpiGu<true>, SchedGu, true, true>(lds, 512, S, E); }
                      else { S.U = (const char*)(p->ws + WS_U); S.rb = 2048; EpiGu<false> E; E.bgu = p->b_gu + (size_t)l * NE * 2048; g8::gemm_phase<EpiGu<false>, SchedGu, true, false>(lds, 1024, S, E); } } PHASE_END
        PHASE_BEGIN_K(8) { MoeTab tb = moe_tables(p, l, lds);
                      SchedDown S; S.tb = tb; S.ACT = (const char*)(p->ws + WS_ACT); S.W = (const char*)(p->ws + WS_WDT) + (size_t)l * NE * 1024 * 2048;
                      EpiDown E; E.tb = tb; E.bd = p->b_down + (size_t)l * NE * 1024; E.rasg = (const int*)(p->ws + WS_RASG); E.gate = (const float*)(p->ws + WS_RGATE); E.YS = (bf16_t*)(p->ws + WS_YS);
                      if (fp8_layer(l)) { S.rb = 1024; E.sc = 1.0f / 64.0f; g8::gemm_phase<EpiDown, SchedDown, false, true>(lds, 512, S, E); }
                      else { S.rb = 2048; E.sc = 1.0f; g8::gemm_phase<EpiDown, SchedDown, false, false>(lds, 1024, S, E); } } PHASE_END
    }
    PHASE_BEGIN_K(9) phase_norm(p, 2); PHASE_END
#if defined(TIMEPROBE)
    __syncthreads(); if (blockIdx.x == 0 && tid_() == 0) { asm volatile("s_waitcnt vmcnt(0)" ::: "memory"); p->out[0] = ((const float*)(p->ws + WS_CTL))[15000]; }
#endif
#undef PHASE_BEGIN_K
#undef PHASE_END
}

extern "C" void kernel_launch(void* const* d_in, const int* in_sizes, int n_in, void* d_out, int out_size, void* d_ws, size_t ws_size, hipStream_t stream) {
    static int grid = 0;
    if (!grid) {
        if (n_in != 37 || ws_size < WS_END) { fprintf(stderr, "kernel_launch: expected 37 inputs and >= %zu bytes of workspace (got %d, %zu)\n", (size_t)WS_END, n_in, ws_size); }
        int dev = 0, cus = 0, per_cu = 0;
        hipGetDevice(&dev); hipDeviceGetAttribute(&cus, hipDeviceAttributeMultiprocessorCount, dev);
        hipFuncSetAttribute((const void*)mega_fwd, hipFuncAttributeMaxDynamicSharedMemorySize, LDS_BYTES);
        hipOccupancyMaxActiveBlocksPerMultiprocessor(&per_cu, (const void*)mega_fwd, 512, LDS_BYTES);
        if (per_cu < 1) fprintf(stderr, "kernel_launch: occupancy query reports %d workgroups per CU\n", per_cu);
        grid = cus > 0 ? cus : 256;
    }
    hipMemsetAsync((char*)d_ws + WS_CTL, 0, CTL_BYTES, stream);
    Params hp{};
    const float** f = (const float**)&hp;
    for (int i = 0; i < 37; ++i) f[i] = (const float*)d_in[i];
    hp.out = (float*)d_out; hp.ws = (unsigned char*)d_ws;
#if MK_N_LAUNCHES == 1
    hp.ph_lo = 0; hp.ph_hi = N_PHASES;
    hipLaunchKernelGGL(mega_fwd, dim3(grid), dim3(512), LDS_BYTES, stream, hp);
#else
    for (int ph = 0; ph < N_PHASES; ++ph) { hp.ph_lo = ph; hp.ph_hi = ph + 1; hipLaunchKernelGGL(mega_fwd, dim3(grid), dim3(512), LDS_BYTES, stream, hp); }
#endif
}
```
